# Optimizing an MI355X kernel written in HIP

```python
import math
import jax, jax.numpy as jnp
from jax import lax
import numpy as np

D_MODEL = 1024
BATCH = 16
SEQ = 2048
DEPTH = 2

CTX_LEN = 256
GRID_W = 64
HEAD_DIM = 64
GROUP_WIDTH = D_MODEL // 4
N_MOD = 6
EPS = 1e-6

ATT_HEADS = GROUP_WIDTH // HEAD_DIM
ATT_KV_HEADS = ATT_HEADS // 2
ATT_GROUP = ATT_HEADS // ATT_KV_HEADS
Q_BLOCK = 128
ROPE_BASE = 10000.0

S5_CH = GROUP_WIDTH
S5_GROUP_CH = 16
S5_GROUPS = S5_CH // S5_GROUP_CH
S5_STATE = 64
S5_DT_MIN = 1e-3
S5_DT_MAX = 1e-1
S5_MIN_DECAY = 1e-4

NA_HEADS = GROUP_WIDTH // HEAD_DIM
NA_ROWS = 8
NA_COLS = 16

FN_CH = GROUP_WIDTH
FN_GROUPS = 4
FN_GROUP_CH = FN_CH // FN_GROUPS

D_FF = 4 * D_MODEL

ATT_Q_W = ATT_HEADS * HEAD_DIM
ATT_KV_W = ATT_KV_HEADS * HEAD_DIM
NA_W = NA_HEADS * HEAD_DIM
OFF_ATT_Q = 0
OFF_ATT_K = OFF_ATT_Q + ATT_Q_W
OFF_ATT_V = OFF_ATT_K + ATT_KV_W
OFF_S5 = OFF_ATT_V + ATT_KV_W
OFF_NA_Q = OFF_S5 + S5_CH
OFF_NA_K = OFF_NA_Q + NA_W
OFF_NA_V = OFF_NA_K + NA_W
OFF_FN = OFF_NA_V + NA_W
IN_WIDTH = OFF_FN + FN_CH
MIX_OUT = ATT_Q_W + S5_CH + NA_W + FN_CH

kernel_name = 'hybrid_parallel_group_dit_block'


def rms_norm(x, g):
    x32 = x.astype(jnp.float32)
    y = x32 * lax.rsqrt(jnp.mean(x32 * x32, axis=-1, keepdims=True) + EPS)
    return (y * g.astype(jnp.float32)).astype(x.dtype)


def modulate(x, shift, scale):
    return x * (1 + scale) + shift


def heads(t, lo, hi, nh):
    return t[..., lo:hi].reshape(t.shape[0], t.shape[1], nh, HEAD_DIM)


def rope_axis(x, pos):
    half = x.shape[-1] // 2
    inv = ROPE_BASE ** (-jnp.arange(half, dtype=jnp.float32) / half)
    ang = pos.astype(jnp.float32)[:, None] * inv[None, :]
    cos = jnp.cos(ang)[None, :, None, :]
    sin = jnp.sin(ang)[None, :, None, :]
    x1, x2 = x[..., :half], x[..., half:]
    return jnp.concatenate([x1 * cos - x2 * sin, x1 * sin + x2 * cos], axis=-1)


def rope_2d(x, row, col):
    x32 = x.astype(jnp.float32)
    r = x.shape[-1] // 2
    out = jnp.concatenate([rope_axis(x32[..., :r], row), rope_axis(x32[..., r:], col)], axis=-1)
    return out.astype(x.dtype)


def gqa_mixer(z, zc, g_q, g_k, row, col, need_ctx):
    b, n, _ = z.shape
    lc = zc.shape[1]
    scale = HEAD_DIM ** -0.5
    q = rope_2d(rms_norm(heads(z, OFF_ATT_Q, OFF_ATT_K, ATT_HEADS), g_q), row, col) * scale
    q = q.reshape(b, n, ATT_KV_HEADS, ATT_GROUP, HEAD_DIM)
    k = rope_2d(rms_norm(heads(z, OFF_ATT_K, OFF_ATT_V, ATT_KV_HEADS), g_k), row, col)
    v = heads(z, OFF_ATT_V, OFF_S5, ATT_KV_HEADS)
    kc = rms_norm(heads(zc, OFF_ATT_K, OFF_ATT_V, ATT_KV_HEADS), g_k)
    vc = heads(zc, OFF_ATT_V, OFF_S5, ATT_KV_HEADS)
    k_all = jnp.concatenate([k, kc], axis=1)
    v_all = jnp.concatenate([v, vc], axis=1)

    def attend(qi, kk, vv):
        s = jnp.einsum('bqkgd,bskd->bkgqs', qi, kk).astype(jnp.float32)
        p = jax.nn.softmax(s, axis=-1).astype(vv.dtype)
        return jnp.einsum('bkgqs,bskd->bqkgd', p, vv)

    nblk = n // Q_BLOCK
    qb = q.reshape(b, nblk, Q_BLOCK, ATT_KV_HEADS, ATT_GROUP, HEAD_DIM).transpose(1, 0, 2, 3, 4, 5)
    o = lax.map(lambda qi: attend(qi, k_all, v_all), qb)
    o = o.transpose(1, 0, 2, 3, 4, 5).reshape(b, n, ATT_Q_W)
    oc = None
    if need_ctx:
        qc = rms_norm(heads(zc, OFF_ATT_Q, OFF_ATT_K, ATT_HEADS), g_q) * scale
        qc = qc.reshape(b, lc, ATT_KV_HEADS, ATT_GROUP, HEAD_DIM)
        oc = attend(qc, kc, vc).reshape(b, lc, ATT_Q_W)
    return o, oc


def linear_scan(bu, abar, h0, reverse):
    if h0 is not None:
        idx = bu.shape[1] - 1 if reverse else 0
        bu = bu.at[:, idx].add(abar * h0)
    a = jnp.broadcast_to(abar, bu.shape)

    def combine(e1, e2):
        a1, b1 = e1
        a2, b2 = e2
        return a1 * a2, a2 * b1 + b2

    _, h = lax.associative_scan(combine, (a, bu), reverse=reverse, axis=1)
    return h


def s5_mixer(z, zc, a_re, a_im, log_dt, b_re, b_im, c_re, c_im, d_skip, w_glu, need_ctx):
    f32 = jnp.float32
    b, n, _ = z.shape
    lc = zc.shape[1]
    u = z[..., OFF_S5:OFF_NA_Q].astype(f32)
    uc = zc[..., OFF_S5:OFF_NA_Q].astype(f32)
    u_g = u.reshape(b, n, S5_GROUPS, S5_GROUP_CH).astype(jnp.complex64)
    uc_g = uc.reshape(b, lc, S5_GROUPS, S5_GROUP_CH).astype(jnp.complex64)
    d32 = d_skip.astype(f32)
    y = d32 * u
    yc = d32 * uc if need_ctx else None
    for direction in range(2):
        reverse = direction == 1
        lam = lax.complex(jnp.minimum(a_re[direction].astype(f32), -S5_MIN_DECAY), a_im[direction].astype(f32))
        dt = jnp.exp(log_dt[direction].astype(f32))[:, None]
        abar = jnp.exp(lam * dt)
        bmat = lax.complex(b_re[direction].astype(f32), b_im[direction].astype(f32))
        bbar = ((abar - 1) / lam)[..., None] * bmat
        cmat = lax.complex(c_re[direction].astype(f32), c_im[direction].astype(f32))
        hc = linear_scan(jnp.einsum('blgh,gph->blgp', uc_g, bbar), abar, None, reverse)
        h0 = hc[:, 0] if reverse else hc[:, -1]
        h = linear_scan(jnp.einsum('blgh,gph->blgp', u_g, bbar), abar, h0, reverse)
        y = y + jnp.einsum('blgp,ghp->blgh', h, cmat).real.reshape(b, n, S5_CH)
        if need_ctx:
            yc = yc + jnp.einsum('blgp,ghp->blgh', hc, cmat).real.reshape(b, lc, S5_CH)

    def glu(t):
        t = jax.nn.gelu(t).astype(z.dtype)
        return t * jax.nn.sigmoid(t @ w_glu)

    return glu(y), (glu(yc) if need_ctx else None)


def na_mixer(z, zc, rel_bias, need_ctx):
    b, n, _ = z.shape
    rows = n // GRID_W
    k_r = min(NA_ROWS, rows)
    scale = HEAD_DIM ** -0.5
    q = heads(z, OFF_NA_Q, OFF_NA_K, NA_HEADS) * scale
    k = heads(z, OFF_NA_K, OFF_NA_V, NA_HEADS)
    v = heads(z, OFF_NA_V, OFF_FN, NA_HEADS)
    kc = heads(zc, OFF_NA_K, OFF_NA_V, NA_HEADS)
    vc = heads(zc, OFF_NA_V, OFF_FN, NA_HEADS)
    q_grid = q.reshape(b, rows, GRID_W, NA_HEADS, HEAD_DIM)
    k_grid = k.reshape(b, rows, GRID_W, NA_HEADS, HEAD_DIM)
    v_grid = v.reshape(b, rows, GRID_W, NA_HEADS, HEAD_DIM)
    cols = jnp.arange(GRID_W)
    col_start = jnp.clip(cols - NA_COLS // 2, 0, GRID_W - NA_COLS)
    col_idx = col_start[:, None] + jnp.arange(NA_COLS)[None, :]
    rel_c = col_idx - cols[:, None] + (NA_COLS - 1)
    bias_c = rel_bias[:, :, rel_c]
    n_loc = k_r * NA_COLS

    def row_block(r):
        rs = jnp.clip(r - k_r // 2, 0, rows - k_r)
        qr = lax.dynamic_index_in_dim(q_grid, r, axis=1, keepdims=False)
        kb = lax.dynamic_slice_in_dim(k_grid, rs, k_r, axis=1)[:, :, col_idx]
        vb = lax.dynamic_slice_in_dim(v_grid, rs, k_r, axis=1)[:, :, col_idx]
        rel_r = rs + jnp.arange(k_r) - r + (NA_ROWS - 1)
        bias = bias_c[:, rel_r].transpose(0, 2, 1, 3).astype(jnp.float32)
        s_loc = jnp.einsum('bjhd,bajkhd->bhjak', qr, kb).astype(jnp.float32) + bias[None]
        s_loc = s_loc.reshape(b, NA_HEADS, GRID_W, n_loc)
        s_ctx = jnp.einsum('bjhd,bshd->bhjs', qr, kc).astype(jnp.float32)
        p = jax.nn.softmax(jnp.concatenate([s_loc, s_ctx], axis=-1), axis=-1).astype(vb.dtype)
        p_loc = p[..., :n_loc].reshape(b, NA_HEADS, GRID_W, k_r, NA_COLS)
        p_ctx = p[..., n_loc:]
        return jnp.einsum('bhjak,bajkhd->bjhd', p_loc, vb) + jnp.einsum('bhjs,bshd->bjhd', p_ctx, vc)

    o = lax.map(row_block, jnp.arange(rows))
    o = o.transpose(1, 0, 2, 3, 4).reshape(b, n, NA_W)
    oc = None
    if need_ctx:
        qc = heads(zc, OFF_NA_Q, OFF_NA_K, NA_HEADS) * scale
        s = jnp.einsum('bqhd,bshd->bhqs', qc, kc).astype(jnp.float32)
        p = jax.nn.softmax(s, axis=-1).astype(vc.dtype)
        oc = jnp.einsum('bhqs,bshd->bqhd', p, vc).reshape(zc.shape[0], zc.shape[1], NA_W)
    return o, oc


def fourier_mixer(t, w_fnet, b_fnet):
    b, n, _ = t.shape
    u = t[..., OFF_FN:IN_WIDTH].astype(jnp.float32).reshape(b, n, FN_GROUPS, FN_GROUP_CH)
    f = jnp.fft.fft2(u, axes=(1, 3), norm='ortho').real.reshape(b, n, FN_CH).astype(t.dtype)
    return f @ w_fnet + b_fnet


def sq_relu_mlp(h, w1, w2):
    return jnp.square(jax.nn.relu(h @ w1)) @ w2


def trunk_layer(x, xc, c, c_ctx, row, col, w_ada, b_ada, g_pre_mix, g_post_mix, g_pre_mlp, g_post_mlp,
                w_in, g_q_attn, g_k_attn, s5_a_re, s5_a_im, s5_log_dt, s5_b_re, s5_b_im, s5_c_re, s5_c_im,
                s5_d, w_s5_glu, na_rel_bias, w_fnet, b_fnet, w_out, w_mlp1, w_mlp2, need_ctx):
    b = x.shape[0]
    mod = (jax.nn.silu(c) @ w_ada + b_ada).reshape(b, N_MOD, D_MODEL)
    sh1, sc1, g1, sh2, sc2, g2 = [mod[:, i, None, :] for i in range(N_MOD)]
    mod_c = (jax.nn.silu(c_ctx) @ w_ada + b_ada).reshape(N_MOD, D_MODEL)
    csh1, csc1, cg1, csh2, csc2, cg2 = [mod_c[i] for i in range(N_MOD)]

    z = modulate(rms_norm(x, g_pre_mix), sh1, sc1) @ w_in
    zc = modulate(rms_norm(xc, g_pre_mix), csh1, csc1) @ w_in
    oa, oac = gqa_mixer(z, zc, g_q_attn, g_k_attn, row, col, need_ctx)
    ob, obc = s5_mixer(z, zc, s5_a_re, s5_a_im, s5_log_dt, s5_b_re, s5_b_im, s5_c_re, s5_c_im,
                       s5_d, w_s5_glu, need_ctx)
    on, onc = na_mixer(z, zc, na_rel_bias, need_ctx)
    od = fourier_mixer(z, w_fnet, b_fnet)
    y = jnp.concatenate([oa, ob, on, od], axis=-1) @ w_out
    x = x + g1 * rms_norm(y, g_post_mix)
    h = modulate(rms_norm(x, g_pre_mlp), sh2, sc2)
    x = x + g2 * rms_norm(sq_relu_mlp(h, w_mlp1, w_mlp2), g_post_mlp)

    if need_ctx:
        odc = fourier_mixer(zc, w_fnet, b_fnet)
        yc = jnp.concatenate([oac, obc, onc, odc], axis=-1) @ w_out
        xc = xc + cg1 * rms_norm(yc, g_post_mix)
        hc = modulate(rms_norm(xc, g_pre_mlp), csh2, csc2)
        xc = xc + cg2 * rms_norm(sq_relu_mlp(hc, w_mlp1, w_mlp2), g_post_mlp)
    return x, xc


def setup_inputs(seed: int = 0) -> dict:
    key = jax.random.key(seed)
    ks = jax.random.split(key, 32)
    f32 = jnp.float32
    L = DEPTH

    def nrm(k, shape, scale):
        return jax.random.normal(k, shape, f32) * scale

    n_idx = jnp.arange(S5_STATE, dtype=f32)
    s5_shape = (L, 2, S5_GROUPS, S5_STATE)
    return {
        'x': nrm(ks[0], (BATCH, SEQ, D_MODEL), 1.0),
        'c': nrm(ks[1], (BATCH, D_MODEL), 1.0),
        'ctx': nrm(ks[2], (BATCH, CTX_LEN, D_MODEL), 1.0),
        'c_ctx': nrm(ks[3], (D_MODEL,), 1.0),
        'w_ada': nrm(ks[4], (L, D_MODEL, N_MOD * D_MODEL), 0.5 * D_MODEL ** -0.5),
        'b_ada': nrm(ks[5], (L, N_MOD * D_MODEL), 0.01),
        'g_pre_mix': 1.0 + nrm(ks[6], (L, D_MODEL), 0.02),
        'g_post_mix': 1.0 + nrm(ks[7], (L, D_MODEL), 0.02),
        'g_pre_mlp': 1.0 + nrm(ks[8], (L, D_MODEL), 0.02),
        'g_post_mlp': 1.0 + nrm(ks[9], (L, D_MODEL), 0.02),
        'w_in': nrm(ks[10], (L, D_MODEL, IN_WIDTH), D_MODEL ** -0.5),
        'g_q_attn': 1.0 + nrm(ks[11], (L, HEAD_DIM), 0.02),
        'g_k_attn': 1.0 + nrm(ks[12], (L, HEAD_DIM), 0.02),
        's5_a_re': -0.5 + nrm(ks[13], s5_shape, 0.01),
        's5_a_im': math.pi * n_idx + nrm(ks[14], s5_shape, 0.01),
        's5_log_dt': jax.random.uniform(ks[15], (L, 2, S5_GROUPS), f32, math.log(S5_DT_MIN), math.log(S5_DT_MAX)),
        's5_b_re': nrm(ks[16], (L, 2, S5_GROUPS, S5_STATE, S5_GROUP_CH), (2 * S5_GROUP_CH) ** -0.5),
        's5_b_im': nrm(ks[17], (L, 2, S5_GROUPS, S5_STATE, S5_GROUP_CH), (2 * S5_GROUP_CH) ** -0.5),
        's5_c_re': nrm(ks[18], (L, 2, S5_GROUPS, S5_GROUP_CH, S5_STATE), S5_STATE ** -0.5),
        's5_c_im': nrm(ks[19], (L, 2, S5_GROUPS, S5_GROUP_CH, S5_STATE), S5_STATE ** -0.5),
        's5_d': nrm(ks[20], (L, S5_CH), 1.0),
        'w_s5_glu': nrm(ks[21], (L, S5_CH, S5_CH), S5_CH ** -0.5),
        'na_rel_bias': nrm(ks[22], (L, NA_HEADS, 2 * NA_ROWS - 1, 2 * NA_COLS - 1), 0.02),
        'w_fnet': nrm(ks[23], (L, FN_CH, FN_CH), FN_CH ** -0.5),
        'b_fnet': nrm(ks[24], (L, FN_CH), 0.01),
        'w_out': nrm(ks[25], (L, MIX_OUT, D_MODEL), MIX_OUT ** -0.5),
        'w_mlp1': nrm(ks[26], (L, D_MODEL, D_FF), D_MODEL ** -0.5),
        'w_mlp2': nrm(ks[27], (L, D_FF, D_MODEL), D_FF ** -0.5),
    }


def reference(x, c, ctx, c_ctx, w_ada, b_ada, g_pre_mix, g_post_mix, g_pre_mlp, g_post_mlp, w_in,
              g_q_attn, g_k_attn, s5_a_re, s5_a_im, s5_log_dt, s5_b_re, s5_b_im, s5_c_re, s5_c_im,
              s5_d, w_s5_glu, na_rel_bias, w_fnet, b_fnet, w_out, w_mlp1, w_mlp2):
    n = x.shape[1]
    pos = jnp.arange(n, dtype=jnp.int32)
    row = pos // GRID_W
    col = pos % GRID_W
    xc = ctx
    for l in range(DEPTH):
        need_ctx = l < DEPTH - 1
        x, xc = trunk_layer(x, xc, c, c_ctx, row, col, w_ada[l], b_ada[l], g_pre_mix[l], g_post_mix[l],
                            g_pre_mlp[l], g_post_mlp[l], w_in[l], g_q_attn[l], g_k_attn[l],
                            s5_a_re[l], s5_a_im[l], s5_log_dt[l], s5_b_re[l], s5_b_im[l], s5_c_re[l], s5_c_im[l],
                            s5_d[l], w_s5_glu[l], na_rel_bias[l], w_fnet[l], b_fnet[l], w_out[l],
                            w_mlp1[l], w_mlp2[l], need_ctx)
    return x
```

```cpp
#include <hip/hip_runtime.h>
#include <hip/hip_cooperative_groups.h>
#include <cstdio>
#include <cstdint>
namespace cg = cooperative_groups;
namespace pg8 {
#define PG8_LAS __attribute__((address_space(3)))
typedef unsigned short bf16_t;
typedef short bf16x8 __attribute__((ext_vector_type(8)));
typedef float f32x4 __attribute__((ext_vector_type(4)));
typedef unsigned u32x4 __attribute__((ext_vector_type(4)));
constexpr int BM = 256, BK = 64, HALF = 128, HTB = HALF * BK * 2  , STAGE_BYTES = 8 * HTB, NXCD = 8, WGM = 8;

__host__ __device__ __forceinline__ int lds_byte(int r, int c) { const int st = (r >> 4) * 2 + (c >> 5), rr = r & 15, cc = c & 31, ob = rr * 64 + cc * 2; return st * 1024 + (ob ^ (((ob >> 9) & 1) << 5)); }
__host__ __device__ __forceinline__ void stage_rc(int b, int& R, int& C) { const int st = b / 1024, sb = b % 1024, swz = sb ^ (((sb >> 9) & 1) << 5); R = (st >> 1) * 16 + swz / 64; C = (st & 1) * 32 + (swz % 64) / 2; }
__host__ __device__ __forceinline__ int perm32(int rho) { const int n = rho >> 4, i = rho & 15; return 8 * (i >> 2) + 4 * n + (i & 3); }

struct Unit { int pm, pn; };
struct Gemm { const bf16_t* A; const bf16_t* Bt; int M, N, K, lda, ldb; long tsB; int ksplit; long kjumpB; };

struct StaticOrder {
    int nM, nN, nwg, G, c;
    __host__ __device__ void init(int M, int N, int G_, int c_) { nM = M / BM; nN = N / BM; nwg = nM * nN; G = G_; c = c_; }
    __host__ __device__ bool next(int i, Unit& u) const {
        const long L = (long)i * G + c; if (L >= nwg) return false;
        int wgid = (int)L; { const int q = nwg / NXCD, r = nwg % NXCD, xcd = wgid % NXCD, off = wgid / NXCD; wgid = (xcd < r ? xcd * (q + 1) : r * (q + 1) + (xcd - r) * q) + off; }
        const int nig = WGM * nN, gid = wgid / nig, fm = gid * WGM, gsz = (nM - fm) < WGM ? (nM - fm) : WGM;
        u.pm = fm + ((wgid % nig) % gsz); u.pn = (wgid % nig) / gsz; return true;
    }
    __device__ __forceinline__ void a_ready(const Unit&) const {}
    __device__ __forceinline__ void done(const Unit&) const {}
};
__device__ __forceinline__ unsigned cvt_pk_bf16(float lo, float hi) { unsigned r; asm volatile("v_cvt_pk_bf16_f32 %0, %1, %2" : "=v"(r) : "v"(lo), "v"(hi)); return r; }
template <class Epi, class Sched, bool ALIGN_EPI = false, bool SP2 = false>
__device__ __forceinline__ void gemm_phase(PG8_LAS unsigned char* lds, const Gemm g, const Sched& S, const Epi& E) {
    int tid_ = threadIdx.x; asm volatile("" : "+v"(tid_));
    const int tid = tid_, wid = __builtin_amdgcn_readfirstlane(tid >> 6), lane = tid & 63, wr = wid >> 2, wc = wid & 3, fr = lane & 15, fq = lane >> 4;
    const int K = g.K, nt = K / BK;
    unsigned voffA[2], voffB[2];
#pragma unroll
    for (int i = 0; i < 2; ++i) { int R, C; stage_rc(tid * 16 + i * 8192, R, C); const int Rb = Epi::PERM ? ((R & ~31) + perm32(R & 31)) : R;
        voffA[i] = (unsigned)(R * g.lda + C) * 2u; voffB[i] = (unsigned)(Rb * g.ldb + C) * 2u; }
    const size_t kstep = (size_t)(BK * 2);
    const size_t hstepA = (size_t)HALF * g.lda * 2, hstepB = (size_t)HALF * g.ldb * 2;
    const size_t tstepA = 2 * hstepA, tstepB = (size_t)g.tsB;
    const unsigned ldsw = (unsigned)wid * 1024u;
    const int aoff = lds_byte(wr * 64 + fr, fq * 8), boff = lds_byte(wc * 32 + fr, fq * 8);
#define PG8_SA(b, h) (((b) * 2 + (h)) * HTB)
#define PG8_SB(b, h) ((4 + (b) * 2 + (h)) * HTB)
#define PG8_STAGE(bufoff, gbase, voff) do { _Pragma("unroll") for (int _i = 0; _i < 2; ++_i) \
        __builtin_amdgcn_global_load_lds((const unsigned*)((const char*)(gbase) + (voff)[_i]), (PG8_LAS unsigned*)(lds + (bufoff) + ldsw + _i * 8192), 16, 0, 0); } while (0)
#define PG8_LDA(dst, b, h) do { _Pragma("unroll") for (int m = 0; m < 4; ++m) _Pragma("unroll") for (int k = 0; k < 2; ++k) dst[m][k] = *(const PG8_LAS bf16x8*)(lds + PG8_SA(b, h) + aoff + m * 2048 + k * 1024); } while (0)
#define PG8_LDB(dst, b, h) do { _Pragma("unroll") for (int n = 0; n < 2; ++n) _Pragma("unroll") for (int k = 0; k < 2; ++k) dst[n][k] = *(const PG8_LAS bf16x8*)(lds + PG8_SB(b, h) + boff + n * 2048 + k * 1024); } while (0)
#define PG8_MMA(ai, bj, At, Bt) do { __builtin_amdgcn_s_setprio(1); _Pragma("unroll") for (int m = 0; m < 4; ++m) _Pragma("unroll") for (int n = 0; n < 2; ++n) _Pragma("unroll") for (int k = 0; k < 2; ++k) \
        acc[ai][bj][m][n] = __builtin_amdgcn_mfma_f32_16x16x32_bf16(Bt[n][k], At[m][k], acc[ai][bj][m][n], 0, 0, 0); __builtin_amdgcn_s_setprio(0); } while (0)
#define PG8_WAIT_V(n) asm volatile("s_waitcnt vmcnt(" #n ")" ::: "memory")
#define PG8_WAIT_L(n) asm volatile("s_waitcnt lgkmcnt(" #n ")" ::: "memory")
#define PG8_BAR __builtin_amdgcn_s_barrier()
#define PG8_SCHED __builtin_amdgcn_sched_barrier(0)
    Unit cur, nxt; int ui = 0;
    if (!S.next(0, cur)) return;
    f32x4 acc[2][2][4][2];
#pragma unroll
    for (int a = 0; a < 2; ++a)
#pragma unroll
        for (int b = 0; b < 2; ++b)
#pragma unroll
            for (int m = 0; m < 4; ++m)
#pragma unroll
                for (int n = 0; n < 2; ++n) acc[a][b][m][n] = (f32x4){0.f, 0.f, 0.f, 0.f};
    bf16x8 At[4][2], B0[2][2], B1[2][2];
    const char* cA = (const char*)g.A + (size_t)cur.pm * tstepA; const char* cB = (const char*)g.Bt + (size_t)cur.pn * tstepB;
    S.a_ready(cur);
    if constexpr (SP2) {
        PG8_STAGE(PG8_SB(0, 0), cB, voffB); PG8_STAGE(PG8_SB(0, 1), cB + hstepB, voffB); PG8_STAGE(PG8_SA(0, 0), cA, voffA); PG8_STAGE(PG8_SA(0, 1), cA + hstepA, voffA);
        if (wr == 1) PG8_BAR;
        PG8_WAIT_V(2); PG8_BAR;
        PG8_STAGE(PG8_SB(1, 0), cB + kstep, voffB); PG8_STAGE(PG8_SA(1, 0), cA + kstep, voffA); PG8_STAGE(PG8_SB(1, 1), cB + hstepB + kstep, voffB);
        PG8_WAIT_V(6); PG8_BAR;
    } else {
        PG8_STAGE(PG8_SB(0, 0), cB, voffB); PG8_STAGE(PG8_SA(0, 0), cA, voffA); PG8_STAGE(PG8_SB(0, 1), cB + hstepB, voffB); PG8_STAGE(PG8_SA(0, 1), cA + hstepA, voffA);
        if (wr == 1) PG8_BAR;
        PG8_WAIT_V(4); PG8_BAR;
        PG8_STAGE(PG8_SB(1, 0), cB + kstep, voffB); PG8_STAGE(PG8_SA(1, 0), cA + kstep, voffA); PG8_STAGE(PG8_SB(1, 1), cB + hstepB + kstep, voffB);
        PG8_WAIT_V(6); PG8_BAR;
    }
    for (;;) {
        const bool has_next = S.next(ui + 1, nxt);
        const char* nA = has_next ? (const char*)g.A + (size_t)nxt.pm * tstepA : cA; const char* nB = has_next ? (const char*)g.Bt + (size_t)nxt.pn * tstepB : cB;
        for (int t = 0; t < nt; t += 2) {
            const bool last = (t == nt - 2);
            const char* a1 = cA + (size_t)(t + 1) * kstep;
            const char* a2 = last ? nA : cA + (size_t)(t + 2) * kstep; const char* b2 = last ? nB : cB + (size_t)(t + 2) * kstep + ((t + 2) >= g.ksplit ? g.kjumpB : 0);
            const char* a3 = a2 + kstep; const char* b3 = b2 + kstep;
            if (last && has_next) S.a_ready(nxt);
            if constexpr (SP2) {
            PG8_LDB(B0, 0, 0); PG8_LDB(B1, 0, 1); PG8_SCHED; PG8_LDA(At, 0, 0); PG8_STAGE(PG8_SA(1, 1), a1 + hstepA, voffA);
            PG8_WAIT_V(8); PG8_WAIT_L(0); PG8_BAR; PG8_MMA(0, 0, At, B0); PG8_MMA(0, 1, At, B1); PG8_BAR; PG8_SCHED;
            PG8_LDA(At, 0, 1); PG8_STAGE(PG8_SB(0, 0), b2, voffB); PG8_STAGE(PG8_SB(0, 1), b2 + hstepB, voffB); PG8_STAGE(PG8_SA(0, 0), a2, voffA);
            PG8_WAIT_V(8); PG8_WAIT_L(0); PG8_BAR; PG8_MMA(1, 0, At, B0); PG8_MMA(1, 1, At, B1); PG8_BAR; PG8_SCHED;
            PG8_LDB(B0, 1, 0); PG8_LDB(B1, 1, 1); PG8_SCHED; PG8_LDA(At, 1, 0); PG8_STAGE(PG8_SA(0, 1), a2 + hstepA, voffA);
            PG8_WAIT_V(8); PG8_WAIT_L(0); PG8_BAR; PG8_MMA(0, 0, At, B0); PG8_MMA(0, 1, At, B1); PG8_BAR; PG8_SCHED;
            PG8_LDA(At, 1, 1); PG8_STAGE(PG8_SB(1, 0), b3, voffB); PG8_STAGE(PG8_SB(1, 1), b3 + hstepB, voffB); PG8_STAGE(PG8_SA(1, 0), a3, voffA);
            PG8_WAIT_V(8); PG8_WAIT_L(0); PG8_BAR; PG8_MMA(1, 0, At, B0); PG8_MMA(1, 1, At, B1); PG8_BAR; PG8_SCHED;
            } else {
            PG8_LDB(B0, 0, 0); PG8_SCHED; PG8_LDA(At, 0, 0); PG8_STAGE(PG8_SA(1, 1), a1 + hstepA, voffA);
            PG8_WAIT_L(8); PG8_BAR; PG8_WAIT_L(0); PG8_MMA(0, 0, At, B0); PG8_BAR; PG8_SCHED;
            PG8_LDB(B1, 0, 1); PG8_STAGE(PG8_SB(0, 0), b2, voffB);
            PG8_BAR; PG8_WAIT_L(0); PG8_MMA(0, 1, At, B1); PG8_BAR;
            PG8_LDA(At, 0, 1); PG8_STAGE(PG8_SA(0, 0), a2, voffA);
            PG8_BAR; PG8_WAIT_L(0); PG8_MMA(1, 0, At, B0); PG8_BAR; PG8_SCHED;
            PG8_STAGE(PG8_SB(0, 1), b2 + hstepB, voffB);
            PG8_WAIT_V(6); PG8_BAR; PG8_MMA(1, 1, At, B1); PG8_BAR;
            PG8_LDB(B0, 1, 0); PG8_SCHED; PG8_LDA(At, 1, 0); PG8_STAGE(PG8_SA(0, 1), a2 + hstepA, voffA);
            PG8_WAIT_L(8); PG8_BAR; PG8_WAIT_L(0); PG8_MMA(0, 0, At, B0); PG8_BAR; PG8_SCHED;
            PG8_LDB(B1, 1, 1); PG8_STAGE(PG8_SB(1, 0), b3, voffB);
            PG8_BAR; PG8_WAIT_L(0); PG8_MMA(0, 1, At, B1); PG8_BAR;
            PG8_LDA(At, 1, 1); PG8_STAGE(PG8_SA(1, 0), a3, voffA);
            PG8_BAR; PG8_WAIT_L(0); PG8_MMA(1, 0, At, B0); PG8_BAR; PG8_SCHED;
            PG8_STAGE(PG8_SB(1, 1), b3 + hstepB, voffB);
            PG8_WAIT_V(6); PG8_BAR; PG8_MMA(1, 1, At, B1); PG8_BAR;
            }
        }
        if constexpr (ALIGN_EPI) { if (wr == 0) PG8_BAR; }
        if constexpr (!Epi::AFTER_DRAIN) { E(acc, cur, wr, wc, fr, fq); S.done(cur); }
        if (!has_next) break;
#pragma unroll
        for (int a = 0; a < 2; ++a)
#pragma unroll
            for (int b = 0; b < 2; ++b)
#pragma unroll
                for (int m = 0; m < 4; ++m)
#pragma unroll
                    for (int n = 0; n < 2; ++n) acc[a][b][m][n] = (f32x4){0.f, 0.f, 0.f, 0.f};
        cur = nxt; cA = nA; cB = nB; ++ui;
        if constexpr (ALIGN_EPI) { if (wr == 1) PG8_BAR; }
    }
    PG8_WAIT_V(0);
    if constexpr (!ALIGN_EPI) { if (wr == 0) PG8_BAR; }
    PG8_BAR;
    if constexpr (Epi::AFTER_DRAIN) { E.fused(acc, cur, wr, wc, fr, fq, lds, wid, lane); S.done(cur); }
#undef PG8_SA
#undef PG8_SB
#undef PG8_STAGE
#undef PG8_LDA
#undef PG8_LDB
#undef PG8_MMA
#undef PG8_WAIT_V
#undef PG8_WAIT_L
#undef PG8_BAR
#undef PG8_SCHED
}
}
#define LAS __attribute__((address_space(3)))
typedef unsigned short bf16;
typedef unsigned v4u __attribute__((ext_vector_type(4)));
typedef unsigned v2u __attribute__((ext_vector_type(2)));
typedef float f32x4 __attribute__((ext_vector_type(4)));
typedef float f32x16 __attribute__((ext_vector_type(16)));
typedef short bf16x8 __attribute__((ext_vector_type(8)));
typedef short s16x4 __attribute__((ext_vector_type(4)));

constexpr int DM = 1024, NB = 16, SEQ = 2048, CTXL = 256, MLAT = NB * SEQ, MCTX = NB * CTXL, MT = MLAT + MCTX, INW = 1792, DFF = 4096;
constexpr int OFF_AQ = 0, OFF_AK = 256, OFF_AV = 384, OFF_S5 = 512, OFF_NQ = 768, OFF_NK = 1024, OFF_NV = 1280, OFF_FN = 1536;
constexpr float EPSN = 1e-6f;
constexpr float LOG2E = 1.4426950408889634f;
constexpr size_t MiB = 1u << 20;
constexpr size_t WS_MOD = 0;
constexpr size_t WS_ROPE = 1 * MiB;
constexpr size_t WS_W = 2 * MiB, W_LAYER = 22 * MiB;
constexpr size_t WO_IN = 0, WO_OUT = WO_IN + (size_t)INW * DM * 2, WO_1 = WO_OUT + (size_t)DM * DM * 2, WO_2 = WO_1 + (size_t)DFF * DM * 2,
                 WO_GLU = WO_2 + (size_t)DFF * DM * 2, WO_CS = WO_GLU + 256 * 256 * 2, WO_END = WO_CS + 512 * 256 * 2;
static_assert(WO_END <= W_LAYER, "weights");
constexpr size_t WS_DFT = 46 * MiB, WS_DFTC = 62 * MiB, WS_XC = 64 * MiB, WS_XN = 80 * MiB;
constexpr size_t WS_T = 116 * MiB, WS_C1 = 350 * MiB;
constexpr size_t WS_Z = 152 * MiB, WS_CAT = 278 * MiB, WS_Y = 350 * MiB, WS_HMID = 152 * MiB, WS_Y0 = 440 * MiB, WS_END = 476 * MiB;
constexpr int LDS_BYTES = 147456;

struct Args { const float* in[28]; float* out; unsigned char* ws; };
typedef __attribute__((address_space(4))) const Args CArgs;
__device__ __forceinline__ CArgs& kargs() { CArgs* p = (CArgs*)__builtin_amdgcn_kernarg_segment_ptr(); asm volatile("" : "+s"(p)); return *p; }
enum { I_X = 0, I_C, I_CTX, I_CCTX, I_WADA, I_BADA, I_GPREMIX, I_GPOSTMIX, I_GPREMLP, I_GPOSTMLP, I_WIN, I_GQ, I_GK, I_AR, I_AI, I_LDT, I_BR, I_BI, I_CR, I_CI,
       I_S5D, I_WGLU, I_NABIAS, I_WFNET, I_BFNET, I_WOUT, I_W1, I_W2 };

__device__ __forceinline__ unsigned f2bf(float f) { unsigned u = __builtin_bit_cast(unsigned, f); return (u + 0x7fffu + ((u >> 16) & 1u)) >> 16; }
__device__ __forceinline__ unsigned pk2(float lo, float hi) { return f2bf(lo) | (f2bf(hi) << 16); }
__device__ __forceinline__ float bflo(unsigned w) { return __builtin_bit_cast(float, w << 16); }
__device__ __forceinline__ float bfhi(unsigned w) { return __builtin_bit_cast(float, w & 0xffff0000u); }
__device__ __forceinline__ float bf2f(bf16 h) { return __builtin_bit_cast(float, (unsigned)h << 16); }
__device__ __forceinline__ int o_bid() { int t = blockIdx.x; asm volatile("" : "+s"(t)); return t; }
__device__ __forceinline__ int o_grid() { int t = gridDim.x; asm volatile("" : "+s"(t)); return t; }
__device__ __forceinline__ float shfl_xor_l(float v, int o, int lane) { return __builtin_bit_cast(float, __builtin_amdgcn_ds_bpermute((lane ^ o) << 2, __builtin_bit_cast(int, v))); }
__device__ __forceinline__ float wave_sum(float v, int lane) {
#pragma unroll
    for (int o = 1; o < 64; o <<= 1) v += shfl_xor_l(v, o, lane);
    return v;
}
__device__ __forceinline__ int crow(int r, int hi) { return (r & 3) + 8 * (r >> 2) + 4 * hi; }

template <class F> struct Epi8 {
    static constexpr bool PERM = true, AFTER_DRAIN = false;
    F f;
    __device__ __forceinline__ void operator()(const pg8::f32x4 (&acc)[2][2][4][2], const pg8::Unit& u, int wr, int wc, int fr, int fq) const {
        asm volatile("" : "+v"(fr), "+v"(fq));
#pragma unroll
        for (int ai = 0; ai < 2; ++ai)
#pragma unroll
            for (int m = 0; m < 4; ++m) {
                const int row = u.pm * 256 + ai * 128 + wr * 64 + m * 16 + fr;
#pragma unroll
                for (int bj = 0; bj < 2; ++bj) { const int col = u.pn * 256 + bj * 128 + wc * 32 + 8 * fq; f(row, col, acc[ai][bj][m][0], acc[ai][bj][m][1]); }
                asm volatile("" ::: "memory"); __builtin_amdgcn_sched_barrier(0);
            }
    }
};
__device__ __forceinline__ v4u pack8(f32x4 a, f32x4 b) { v4u w; w.x = pk2(a[0], a[1]); w.y = pk2(a[2], a[3]); w.z = pk2(b[0], b[1]); w.w = pk2(b[2], b[3]); return w; }
struct FStore { bf16* O; int ldc; int act;
    __device__ __forceinline__ void operator()(int row, int col, f32x4 a, f32x4 b) const {
        if (act == 1) {
#pragma unroll
            for (int i = 0; i < 4; ++i) { float x = a[i] > 0.f ? a[i] : 0.f; a[i] = x * x; float y = b[i] > 0.f ? b[i] : 0.f; b[i] = y * y; } }
        *(v4u*)(O + (size_t)row * ldc + col) = pack8(a, b); } };
struct FD2 { bf16* cat; const float* bias; int rowbase, rowsPerB;
    __device__ __forceinline__ void operator()(int row, int col, f32x4 a, f32x4 b) const {
        const int bb = col >> 8, j = col & 255; const f32x4 b0 = *(const f32x4*)(bias + j), b1 = *(const f32x4*)(bias + j + 4);
        *(v4u*)(cat + ((size_t)(rowbase + bb * rowsPerB + row) * 1024 + 768 + j)) = pack8(a + b0, b + b1); } };
struct FGlu { bf16* cat; const bf16* T;
    __device__ __forceinline__ void operator()(int row, int col, f32x4 a, f32x4 b) const {
        const v4u t = *(const v4u*)(T + (size_t)row * 256 + col);
        float tv[8] = {bflo(t.x), bfhi(t.x), bflo(t.y), bfhi(t.y), bflo(t.z), bfhi(t.z), bflo(t.w), bfhi(t.w)};
#pragma unroll
        for (int i = 0; i < 4; ++i) { a[i] = tv[i] / (1.f + __expf(-a[i])); b[i] = tv[4 + i] / (1.f + __expf(-b[i])); }
        *(v4u*)(cat + (size_t)row * 1024 + 256 + col) = pack8(a, b); } };
__device__ __forceinline__ void transpose_item(const float* W, int K, int N, bf16* WT, LAS float* scr, int item, int lane) {
    const int nblk = N / 32, kb = item / nblk, nb = item % nblk, k0 = 64 * kb, n0 = 32 * nb;
#pragma unroll 8
    for (int i = 0; i < 32; ++i) { const int kk = 2 * i + (lane >> 5); scr[kk * 33 + (lane & 31)] = W[(size_t)(k0 + kk) * N + n0 + (lane & 31)]; }
    asm volatile("s_waitcnt lgkmcnt(0)" ::: "memory");
    const int c = lane & 7;
#pragma unroll
    for (int j = 0; j < 4; ++j) { const int n = (lane >> 3) + 8 * j; const LAS float* s = scr + (8 * c) * 33 + n;
        v4u o; o.x = pk2(s[0 * 33], s[1 * 33]); o.y = pk2(s[2 * 33], s[3 * 33]); o.z = pk2(s[4 * 33], s[5 * 33]); o.w = pk2(s[6 * 33], s[7 * 33]);
        *(v4u*)(WT + (size_t)(n0 + n) * K + k0 + 8 * c) = o; }
    asm volatile("s_waitcnt lgkmcnt(0)" ::: "memory");
}

__device__ __forceinline__ void prologue(LAS unsigned char* lds) {
    CArgs& a = kargs();
    int tid_ = threadIdx.x; asm volatile("" : "+v"(tid_));
    const int tid = tid_, lane = tid & 63, wid = tid >> 6, G = o_grid();
    unsigned char* ws = a.ws;
    {
        LAS float* scr = (LAS float*)(lds + wid * 16384);
        const int gw = o_bid() * 8 + wid, NGW = G * 8;
        constexpr int I0 = (DM / 64) * (INW / 32), I1 = (DM / 64) * (DM / 32), I2 = (DM / 64) * (DFF / 32), I3 = (DFF / 64) * (DM / 32), I4 = (256 / 64) * (256 / 32);
        constexpr int PER = I0 + I1 + I2 + I3 + I4;
        for (int it = gw; it < 2 * PER; it += NGW) {
            const int l = it / PER; int r = it % PER; unsigned char* wb = ws + WS_W + (size_t)l * W_LAYER;
            if (r < I0) { transpose_item(a.in[I_WIN] + (size_t)l * DM * INW, DM, INW, (bf16*)(wb + WO_IN), scr, r, lane); continue; } r -= I0;
            if (r < I1) { transpose_item(a.in[I_WOUT] + (size_t)l * DM * DM, DM, DM, (bf16*)(wb + WO_OUT), scr, r, lane); continue; } r -= I1;
            if (r < I2) { transpose_item(a.in[I_W1] + (size_t)l * DM * DFF, DM, DFF, (bf16*)(wb + WO_1), scr, r, lane); continue; } r -= I2;
            if (r < I3) { transpose_item(a.in[I_W2] + (size_t)l * DFF * DM, DFF, DM, (bf16*)(wb + WO_2), scr, r, lane); continue; } r -= I3;
            transpose_item(a.in[I_WGLU] + (size_t)l * 256 * 256, 256, 256, (bf16*)(wb + WO_GLU), scr, r, lane);
        }
    }
    __syncthreads();
    {
        LAS float* sl = (LAS float*)lds;
        LAS float* part = (LAS float*)(lds + 17 * 1024 * 4);
        float* mod = (float*)(ws + WS_MOD);
        bool have = false;
        for (int u = o_bid(); u < 2 * 96; u += G) {
            if (!have) {
                for (int i = tid; i < 17 * 1024; i += 512) { const float cv = i < 16 * 1024 ? a.in[I_C][i] : a.in[I_CCTX][i - 16 * 1024]; sl[i] = cv / (1.f + __expf(-cv)); }
                have = true; __syncthreads();
            }
            const int l = u / 96, n0 = (u % 96) * 64;
            const float* W = a.in[I_WADA] + (size_t)l * DM * 6144 + n0 + lane;
            float acc[17];
#pragma unroll
            for (int i = 0; i < 17; ++i) acc[i] = 0.f;
            for (int k = wid * 128; k < wid * 128 + 128; ++k) {
                const float wv = W[(size_t)k * 6144];
#pragma unroll
                for (int i = 0; i < 17; ++i) acc[i] += sl[i * 1024 + k] * wv;
            }
#pragma unroll
            for (int i = 0; i < 17; ++i) part[(wid * 17 + i) * 64 + lane] = acc[i];
            __syncthreads();
            for (int o = tid; o < 17 * 64; o += 512) {
                const int i = o >> 6, n = o & 63; float s = a.in[I_BADA][l * 6144 + n0 + n];
#pragma unroll
                for (int w = 0; w < 8; ++w) s += part[(w * 17 + i) * 64 + n];
                mod[((size_t)l * 17 + i) * 6144 + n0 + n] = s;
            }
            __syncthreads();
        }
    }
    {
        const size_t gt = (size_t)o_bid() * 512 + tid, NT = (size_t)G * 512;
        bf16* dft = (bf16*)(ws + WS_DFT);
        for (size_t i = gt; i < (size_t)2048 * 4096 / 8; i += NT) {
            const int kk = (int)(i / 512), n0 = (int)(i % 512) * 8; float v[8];
#pragma unroll
            for (int j = 0; j < 8; ++j) { const int n = n0 + j, nn = n & 2047; const float fr = (float)((kk * nn) & 2047) * (1.f / 2048.f);
                v[j] = (n < 2048 ? __builtin_amdgcn_cosf(fr) : -__builtin_amdgcn_sinf(fr)) * 0.02209708691207961f; }
            v4u o; o.x = pk2(v[0], v[1]); o.y = pk2(v[2], v[3]); o.z = pk2(v[4], v[5]); o.w = pk2(v[6], v[7]);
            *(v4u*)(dft + i * 8) = o;
        }
        bf16* dftc = (bf16*)(ws + WS_DFTC);
        for (size_t i = gt; i < (size_t)256 * 512 / 8; i += NT) {
            const int kk = (int)(i / 64), n0 = (int)(i % 64) * 8; float v[8];
#pragma unroll
            for (int j = 0; j < 8; ++j) { const int n = n0 + j, nn = n & 255; const float fr = (float)((kk * nn) & 255) * (1.f / 256.f);
                v[j] = (n < 256 ? __builtin_amdgcn_cosf(fr) : -__builtin_amdgcn_sinf(fr)) * 0.0625f; }
            v4u o; o.x = pk2(v[0], v[1]); o.y = pk2(v[2], v[3]); o.z = pk2(v[4], v[5]); o.w = pk2(v[6], v[7]);
            *(v4u*)(dftc + i * 8) = o;
        }
        for (size_t i = gt; i < (size_t)2 * 512 * 256; i += NT) {
            const int l = (int)(i / (512 * 256)), rem = (int)(i % (512 * 256)), jp = rem >> 8, cin = rem & 255, j = jp & 255, part = jp >> 8;
            const float* W = a.in[I_WFNET] + (size_t)l * 256 * 256 + (size_t)(cin >> 6) * 64 * 256 + j; const int c = cin & 63; float s = 0.f;
            for (int cp = 0; cp < 64; ++cp) { const float fr = (float)((c * cp) & 63) * (1.f / 64.f); s += (part ? __builtin_amdgcn_sinf(fr) : __builtin_amdgcn_cosf(fr)) * W[(size_t)cp * 256]; }
            ((bf16*)(ws + WS_W + (size_t)l * W_LAYER + WO_CS))[(size_t)jp * 256 + cin] = (bf16)f2bf(s * 0.125f);
        }
        float2* rope = (float2*)(ws + WS_ROPE);
        for (size_t i = gt; i < 1024; i += NT) { const int pos = (int)i >> 4, k = (int)i & 15; const float inv = exp2f(-(float)k * (13.287712379549449f / 16.f)); const float ang = (float)pos * inv;
            float sn, cs; sincosf(ang, &sn, &cs); rope[i] = make_float2(cs, sn); }
    }
}

__device__ __forceinline__ void prep_rows0() {
    CArgs& a = kargs();
    int tid_ = threadIdx.x; asm volatile("" : "+v"(tid_));
    const int lane = tid_ & 63, gw = o_bid() * 8 + (tid_ >> 6), NGW = o_grid() * 8;
    const float* mod = (const float*)(a.ws + WS_MOD); bf16* XN = (bf16*)(a.ws + WS_XN); const float* gp = a.in[I_GPREMIX];
    for (int row = gw; row < MT; row += NGW) {
        const float* xr = row < MLAT ? a.in[I_X] + (size_t)row * DM : a.in[I_CTX] + (size_t)(row - MLAT) * DM; const int bi = row < MLAT ? row >> 11 : 16;
        const float* mb = mod + (size_t)bi * 6144;
        f32x4 v[4]; float ss = 0.f;
#pragma unroll
        for (int j = 0; j < 4; ++j) { v[j] = *(const f32x4*)(xr + 4 * lane + 256 * j); ss += v[j][0] * v[j][0] + v[j][1] * v[j][1] + v[j][2] * v[j][2] + v[j][3] * v[j][3]; }
        const float rstd = rsqrtf(wave_sum(ss, lane) * (1.f / DM) + EPSN);
#pragma unroll
        for (int j = 0; j < 4; ++j) { const int k = 4 * lane + 256 * j; const f32x4 g = *(const f32x4*)(gp + k), sh = *(const f32x4*)(mb + k), sc = *(const f32x4*)(mb + 1024 + k);
            f32x4 o;
#pragma unroll
            for (int e = 0; e < 4; ++e) o[e] = (v[j][e] * rstd * g[e]) * (1.f + sc[e]) + sh[e];
            v2u w; w.x = pk2(o[0], o[1]); w.y = pk2(o[2], o[3]); *(v2u*)(XN + (size_t)row * DM + k) = w; }
    }
}
template <int WHICH>
__device__ __forceinline__ void row_update() {
    CArgs& a = kargs();
    constexpr int l = WHICH >> 1; constexpr bool MLP = WHICH & 1; constexpr bool NXT = WHICH != 3;
    const int nrows = l == 0 ? MT : MLAT;
    const bf16* Y = (const bf16*)(a.ws + (MLP ? WS_XN : WS_Y)); bf16* OB = (bf16*)(a.ws + WS_XN);
    const float* xlat_in = WHICH == 0 ? a.in[I_X] : a.out; const float* xctx_in = WHICH == 0 ? a.in[I_CTX] : (const float*)(a.ws + WS_XC);
    float* xlat_out = a.out; float* xctx_out = (float*)(a.ws + WS_XC);
    const float* mod = (const float*)(a.ws + WS_MOD);
    const float* modl = mod + (size_t)l * 17 * 6144; constexpr int gate_i = MLP ? 5 : 2;
    const float* gpost = (MLP ? a.in[I_GPOSTMLP] : a.in[I_GPOSTMIX]) + l * DM;
    const float* modn = MLP ? mod + (size_t)17 * 6144 : modl; constexpr int sh_i = MLP ? 0 : 3, sc_i = MLP ? 1 : 4;
    const float* gnext = MLP ? a.in[I_GPREMIX] + DM : a.in[I_GPREMLP] + l * DM;
    int tid_ = threadIdx.x; asm volatile("" : "+v"(tid_));
    const int lane = tid_ & 63, gw = o_bid() * 8 + (tid_ >> 6), NGW = o_grid() * 8;
    for (int row = gw; row < nrows; row += NGW) {
        const bool lat = row < MLAT; const int bi = lat ? row >> 11 : 16;
        const float* xr = lat ? xlat_in + (size_t)row * DM : xctx_in + (size_t)(row - MLAT) * DM;
        float* xo = lat ? xlat_out + (size_t)row * DM : xctx_out + (size_t)(row - MLAT) * DM;
        const float* gate = modl + (size_t)bi * 6144 + gate_i * 1024;
        f32x4 y[4], x[4]; float ss = 0.f;
#pragma unroll
        for (int j = 0; j < 4; ++j) { const int k = 4 * lane + 256 * j; const v2u w = *(const v2u*)(Y + (size_t)row * DM + k); y[j] = (f32x4){bflo(w.x), bfhi(w.x), bflo(w.y), bfhi(w.y)};
            x[j] = *(const f32x4*)(xr + k); ss += y[j][0] * y[j][0] + y[j][1] * y[j][1] + y[j][2] * y[j][2] + y[j][3] * y[j][3]; }
        const float rstd = rsqrtf(wave_sum(ss, lane) * (1.f / DM) + EPSN); float s2 = 0.f;
#pragma unroll
        for (int j = 0; j < 4; ++j) { const int k = 4 * lane + 256 * j; const f32x4 g = *(const f32x4*)(gpost + k), gt = *(const f32x4*)(gate + k);
#pragma unroll
            for (int e = 0; e < 4; ++e) { x[j][e] = x[j][e] + gt[e] * (y[j][e] * rstd * g[e]); s2 += x[j][e] * x[j][e]; }
            *(f32x4*)(xo + k) = x[j]; }
        if (NXT) {
            const float rstd2 = rsqrtf(wave_sum(s2, lane) * (1.f / DM) + EPSN); const float* mb = modn + (size_t)bi * 6144;
#pragma unroll
            for (int j = 0; j < 4; ++j) { const int k = 4 * lane + 256 * j; const f32x4 g = *(const f32x4*)(gnext + k), sh = *(const f32x4*)(mb + sh_i * 1024 + k), sc = *(const f32x4*)(mb + sc_i * 1024 + k);
                f32x4 o;
#pragma unroll
                for (int e = 0; e < 4; ++e) o[e] = (x[j][e] * rstd2 * g[e]) * (1.f + sc[e]) + sh[e];
                v2u w; w.x = pk2(o[0], o[1]); w.y = pk2(o[2], o[3]); *(v2u*)(OB + (size_t)row * DM + k) = w; }
        }
    }
}

__device__ __forceinline__ void qk_prep(int layer) {
    CArgs& a = kargs();
    bf16* Z = (bf16*)(a.ws + WS_Z); const float2* rope = (const float2*)(a.ws + WS_ROPE);
    int tid_ = threadIdx.x; asm volatile("" : "+v"(tid_));
    const int gt = o_bid() * 512 + tid_, NT = o_grid() * 512;
    for (int it = gt; it < MT * 6; it += NT) {
        const int row = it / 6, slot = it % 6; const bool lat = row < MLAT;
        bf16* p = Z + (size_t)row * INW + (slot < 4 ? OFF_AQ + slot * 64 : OFF_AK + (slot - 4) * 64);
        const float* g = (slot < 4 ? a.in[I_GQ] : a.in[I_GK]) + layer * 64;
        float v[64]; float ss = 0.f;
#pragma unroll
        for (int c = 0; c < 8; ++c) { const v4u w = *(const v4u*)(p + 8 * c);
            v[8 * c + 0] = bflo(w.x); v[8 * c + 1] = bfhi(w.x); v[8 * c + 2] = bflo(w.y); v[8 * c + 3] = bfhi(w.y); v[8 * c + 4] = bflo(w.z); v[8 * c + 5] = bfhi(w.z); v[8 * c + 6] = bflo(w.w); v[8 * c + 7] = bfhi(w.w); }
#pragma unroll
        for (int i = 0; i < 64; ++i) ss += v[i] * v[i];
        const float rstd = rsqrtf(ss * (1.f / 64.f) + EPSN);
#pragma unroll
        for (int i = 0; i < 64; ++i) v[i] = v[i] * rstd * g[i];
        if (lat) {
            const int t = row & 2047, gr = t >> 6, gc = t & 63;
#pragma unroll
            for (int i = 0; i < 16; ++i) {
                const float2 cr = rope[gr * 16 + i], cc = rope[gc * 16 + i];
                const float x1 = v[i], x2 = v[16 + i]; v[i] = x1 * cr.x - x2 * cr.y; v[16 + i] = x1 * cr.y + x2 * cr.x;
                const float y1 = v[32 + i], y2 = v[48 + i]; v[32 + i] = y1 * cc.x - y2 * cc.y; v[48 + i] = y1 * cc.y + y2 * cc.x;
            }
        }
#pragma unroll
        for (int c = 0; c < 8; ++c) { v4u w; w.x = pk2(v[8 * c], v[8 * c + 1]); w.y = pk2(v[8 * c + 2], v[8 * c + 3]); w.z = pk2(v[8 * c + 4], v[8 * c + 5]); w.w = pk2(v[8 * c + 6], v[8 * c + 7]); *(v4u*)(p + 8 * c) = w; }
    }
}
struct AttnP { const bf16* Z; bf16* O; int ostride; int qtok0; int qcol; int ocol; int kcol, vcol; int loc0, nloc, ctx0, nctx;
               int na; int qgcol0; int relr0; int head; };
template <int NH>
__device__ __forceinline__ void attn_unit(LAS unsigned char* lds, const AttnP& P, const LAS float* biasL) {
    int tid_ = threadIdx.x; asm volatile("" : "+v"(tid_));
    const int tid = tid_, lane = tid & 63, wid = tid >> 6, r32 = lane & 31, hi = lane >> 5;
    const int slot = (NH == 1) ? 0 : (wid >> 1);
    const bf16* Z = P.Z;
    bf16x8 qr[4];
#pragma unroll
    for (int d0 = 0; d0 < 4; ++d0) qr[d0] = *(const bf16x8*)(Z + (size_t)(P.qtok0 + r32) * INW + P.qcol + d0 * 16 + hi * 8);
    const int nt = P.nloc + P.nctx;
    v4u kreg[NH], vreg[NH];
    auto tile_tok = [&](int i) { return i < P.nloc ? P.loc0 + 64 * i : P.ctx0 + 64 * (i - P.nloc); };
    auto gload = [&](int i) { const int tok = tile_tok(i);
#pragma unroll
        for (int s = 0; s < NH; ++s) { kreg[s] = *(const v4u*)(Z + (size_t)(tok + (tid >> 3)) * INW + P.kcol + s * 64 + (tid & 7) * 8);
                                        vreg[s] = *(const v4u*)(Z + (size_t)(tok + lane) * INW + P.vcol + s * 64 + wid * 8); } };
    gload(0);
    f32x16 o0 = {}, o1 = {};
    float m = -1e30f, lsum = 0.f;
    const float sc = 0.125f * LOG2E;
    const int qg = P.qgcol0 + r32; const int cs = qg - 8 < 0 ? 0 : (qg - 8 > 48 ? 48 : qg - 8);
    for (int i = 0; i < nt; ++i) {
        __syncthreads();
#pragma unroll
        for (int s = 0; s < NH; ++s) {
            LAS unsigned char* sb = lds + s * 18432;
            *(LAS v4u*)(sb + ((tid >> 3) * 72 + (tid & 7) * 8) * 2) = kreg[s];
            LAS bf16* vt = (LAS bf16*)(sb + 9216);
            const unsigned w[4] = {vreg[s].x, vreg[s].y, vreg[s].z, vreg[s].w};
#pragma unroll
            for (int e = 0; e < 4; ++e) { vt[(wid * 8 + 2 * e) * 72 + lane] = (bf16)(w[e] & 0xffffu); vt[(wid * 8 + 2 * e + 1) * 72 + lane] = (bf16)(w[e] >> 16); }
        }
        __syncthreads();
        if (i + 1 < nt) gload(i + 1);
        const LAS unsigned char* kb = lds + slot * 18432; const LAS unsigned char* vb = kb + 9216;
        f32x16 p0 = {}, p1 = {};
#pragma unroll
        for (int d0 = 0; d0 < 4; ++d0) {
            const bf16x8 a0 = *(const LAS bf16x8*)(kb + (r32 * 72 + d0 * 16 + hi * 8) * 2);
            const bf16x8 a1 = *(const LAS bf16x8*)(kb + ((32 + r32) * 72 + d0 * 16 + hi * 8) * 2);
            p0 = __builtin_amdgcn_mfma_f32_32x32x16_bf16(a0, qr[d0], p0, 0, 0, 0);
            p1 = __builtin_amdgcn_mfma_f32_32x32x16_bf16(a1, qr[d0], p1, 0, 0, 0);
        }
        if (P.na && i < P.nloc) {
            const LAS float* bl = biasL + (P.head * 15 + (P.relr0 + i)) * 31;
#pragma unroll
            for (int r = 0; r < 16; ++r) {
                const int kv0 = crow(r, hi), kv1 = kv0 + 32;
                const bool ok0 = kv0 >= cs && kv0 < cs + 16, ok1 = kv1 >= cs && kv1 < cs + 16;
                const float b0 = ok0 ? bl[kv0 - qg + 15] : 0.f, b1 = ok1 ? bl[kv1 - qg + 15] : 0.f;
                p0[r] = ok0 ? p0[r] * sc + b0 * LOG2E : -INFINITY; p1[r] = ok1 ? p1[r] * sc + b1 * LOG2E : -INFINITY;
            }
        } else {
#pragma unroll
            for (int r = 0; r < 16; ++r) { p0[r] *= sc; p1[r] *= sc; }
        }
        float mx = p0[0];
#pragma unroll
        for (int r = 1; r < 16; ++r) mx = fmaxf(mx, p0[r]);
#pragma unroll
        for (int r = 0; r < 16; ++r) mx = fmaxf(mx, p1[r]);
        mx = fmaxf(mx, shfl_xor_l(mx, 32, lane));
        const float mn = fmaxf(m, mx), alpha = exp2f(m - mn); m = mn;
        float ps = 0.f;
#pragma unroll
        for (int r = 0; r < 16; ++r) { p0[r] = exp2f(p0[r] - mn); p1[r] = exp2f(p1[r] - mn); ps += p0[r] + p1[r]; }
        lsum = lsum * alpha + ps;
#pragma unroll
        for (int r = 0; r < 16; ++r) { o0[r] *= alpha; o1[r] *= alpha; }
        bf16x8 pf[4];
#pragma unroll
        for (int s = 0; s < 4; ++s) {
            v4u w;
            if (s < 2) { w.x = pk2(p0[8 * s], p0[8 * s + 1]); w.y = pk2(p0[8 * s + 2], p0[8 * s + 3]); w.z = pk2(p0[8 * s + 4], p0[8 * s + 5]); w.w = pk2(p0[8 * s + 6], p0[8 * s + 7]); }
            else { const int q = s - 2; w.x = pk2(p1[8 * q], p1[8 * q + 1]); w.y = pk2(p1[8 * q + 2], p1[8 * q + 3]); w.z = pk2(p1[8 * q + 4], p1[8 * q + 5]); w.w = pk2(p1[8 * q + 6], p1[8 * q + 7]); }
            pf[s] = __builtin_bit_cast(bf16x8, w);
        }
#pragma unroll
        for (int s = 0; s < 4; ++s) {
            const int kvb = 32 * (s >> 1) + 16 * (s & 1) + 4 * hi;
            {   const LAS unsigned char* va = vb + (r32 * 72 + kvb) * 2;
                const s16x4 lo = *(const LAS s16x4*)va, hh = *(const LAS s16x4*)(va + 16);
                const bf16x8 af = {lo[0], lo[1], lo[2], lo[3], hh[0], hh[1], hh[2], hh[3]};
                o0 = __builtin_amdgcn_mfma_f32_32x32x16_bf16(af, pf[s], o0, 0, 0, 0); }
            {   const LAS unsigned char* va = vb + ((32 + r32) * 72 + kvb) * 2;
                const s16x4 lo = *(const LAS s16x4*)va, hh = *(const LAS s16x4*)(va + 16);
                const bf16x8 af = {lo[0], lo[1], lo[2], lo[3], hh[0], hh[1], hh[2], hh[3]};
                o1 = __builtin_amdgcn_mfma_f32_32x32x16_bf16(af, pf[s], o1, 0, 0, 0); }
        }
    }
    lsum += shfl_xor_l(lsum, 32, lane);
    const float inv = 1.f / lsum;
    bf16* op = P.O + (size_t)(P.qtok0 + r32) * P.ostride + P.ocol;
#pragma unroll
    for (int rg = 0; rg < 4; ++rg) {
        v2u w0, w1;
        w0.x = pk2(o0[4 * rg] * inv, o0[4 * rg + 1] * inv); w0.y = pk2(o0[4 * rg + 2] * inv, o0[4 * rg + 3] * inv);
        w1.x = pk2(o1[4 * rg] * inv, o1[4 * rg + 1] * inv); w1.y = pk2(o1[4 * rg + 2] * inv, o1[4 * rg + 3] * inv);
        *(v2u*)(op + 8 * rg + 4 * hi) = w0; *(v2u*)(op + 32 + 8 * rg + 4 * hi) = w1;
    }
}
__device__ __forceinline__ int s5_tokrow(int s, int dir, int b) {
    if (s < 256) return MLAT + b * 256 + (dir ? 255 - s : s);
    const int t = s - 256; return b * 2048 + (dir ? 2047 - t : t);
}
__device__ __forceinline__ void s5_unit(LAS unsigned char* lds, int layer, int b, int g) {
    CArgs& a = kargs();
    int tid_ = threadIdx.x; asm volatile("" : "+v"(tid_));
    const int tid = tid_, lane = tid & 63, wid = tid >> 6, r32 = lane & 31, hi = lane >> 5;
    LAS float* BuL = (LAS float*)(lds + wid * 16896);
    LAS bf16* HL = (LAS bf16*)(lds + wid * 16896);
    LAS float* carry = (LAS float*)(lds + 135168);
    const bf16* Z = (const bf16*)(a.ws + WS_Z); float* Y0 = (float*)(a.ws + WS_Y0); bf16* T = (bf16*)(a.ws + WS_T);
    for (int dir = 0; dir < 2; ++dir) {
        const int idx = (layer * 2 + dir) * 16 + g;
        const float dt = expf(a.in[I_LDT][idx]);
        float ar, ai;
        { const float lr = fminf(a.in[I_AR][idx * 64 + lane], -1e-4f), li = a.in[I_AI][idx * 64 + lane]; const float er = expf(lr * dt); float sn, cs; sincosf(li * dt, &sn, &cs); ar = er * cs; ai = er * sn; }
        float pr = ar, pi = ai;
        float p32r, p32i;
#pragma unroll
        for (int k = 0; k < 5; ++k) { const float tr = pr * pr - pi * pi, ti = 2.f * pr * pi; pr = tr; pi = ti; }
        p32r = pr; p32i = pi;
#pragma unroll
        for (int k = 0; k < 3; ++k) { const float tr = pr * pr - pi * pi, ti = 2.f * pr * pi; pr = tr; pi = ti; }
        { const float tr = pr * p32r - pi * p32i, ti = pr * p32i + pi * p32r; pr = tr; pi = ti; }
        bf16x8 bfr[4];
#pragma unroll
        for (int pp = 0; pp < 2; ++pp) {
            const int p2 = 32 * pp + r32;
            const float lr = fminf(a.in[I_AR][idx * 64 + p2], -1e-4f), li = a.in[I_AI][idx * 64 + p2]; const float er = expf(lr * dt); float sn, cs; sincosf(li * dt, &sn, &cs);
            const float xr = er * cs - 1.f, xi = er * sn, den = 1.f / (lr * lr + li * li);
            const float cr = (xr * lr + xi * li) * den, ci = (xi * lr - xr * li) * den;
            const float* br = a.in[I_BR] + ((size_t)idx * 64 + p2) * 16 + 8 * hi; const float* bi = a.in[I_BI] + ((size_t)idx * 64 + p2) * 16 + 8 * hi;
            float re[8], im[8];
#pragma unroll
            for (int j = 0; j < 8; ++j) { const float x = br[j], y = bi[j]; re[j] = cr * x - ci * y; im[j] = cr * y + ci * x; }
            v4u w; w.x = pk2(re[0], re[1]); w.y = pk2(re[2], re[3]); w.z = pk2(re[4], re[5]); w.w = pk2(re[6], re[7]); bfr[pp] = __builtin_bit_cast(bf16x8, w);
            w.x = pk2(im[0], im[1]); w.y = pk2(im[2], im[3]); w.z = pk2(im[4], im[5]); w.w = pk2(im[6], im[7]); bfr[2 + pp] = __builtin_bit_cast(bf16x8, w);
        }
        bf16x8 cfr[8];
#pragma unroll
        for (int ks = 0; ks < 8; ++ks) {
            float v[8];
            const float* src = (ks < 4 ? a.in[I_CR] : a.in[I_CI]) + ((size_t)idx * 16 + (r32 & 15)) * 64 + 16 * (ks & 3) + 8 * hi;
#pragma unroll
            for (int j = 0; j < 8; ++j) { const float x = src[j]; v[j] = r32 < 16 ? (ks < 4 ? x : -x) : 0.f; }
            v4u w; w.x = pk2(v[0], v[1]); w.y = pk2(v[2], v[3]); w.z = pk2(v[4], v[5]); w.w = pk2(v[6], v[7]); cfr[ks] = __builtin_bit_cast(bf16x8, w);
        }
        const float dsk = a.in[I_S5D][layer * 256 + 16 * g + (r32 & 15)];
        float hr = 0.f, him = 0.f;
        for (int pass = 0; pass < 2; ++pass) {
            bf16x8 ufr = *(const bf16x8*)(Z + (size_t)s5_tokrow(wid * 288 + r32, dir, b) * INW + OFF_S5 + 16 * g + 8 * hi);
            for (int ch = 0; ch < 9; ++ch) {
                const int s0 = wid * 288 + ch * 32;
                const bf16x8 ucur = ufr;
                if (ch + 1 < 9) ufr = *(const bf16x8*)(Z + (size_t)s5_tokrow(s0 + 32 + r32, dir, b) * INW + OFF_S5 + 16 * g + 8 * hi);
                asm volatile("" ::: "memory");
#pragma unroll
                for (int jb = 0; jb < 4; ++jb) {
                    f32x16 d = {}; d = __builtin_amdgcn_mfma_f32_32x32x16_bf16(ucur, bfr[jb], d, 0, 0, 0);
#pragma unroll
                    for (int r = 0; r < 16; ++r) BuL[crow(r, hi) * 132 + 32 * jb + r32] = d[r];
                }
                asm volatile("s_waitcnt lgkmcnt(0)" ::: "memory");
                float bur[32], bui[32];
#pragma unroll
                for (int t = 0; t < 32; ++t) { bur[t] = BuL[t * 132 + lane]; bui[t] = BuL[t * 132 + 64 + lane]; }
                asm volatile("s_waitcnt lgkmcnt(0)" ::: "memory");
                if (pass == 0) {
#pragma unroll
                    for (int t = 0; t < 32; ++t) { const float nr = ar * hr - ai * him + bur[t], ni = ar * him + ai * hr + bui[t]; hr = nr; him = ni; }
                } else {
#pragma unroll
                    for (int t = 0; t < 32; ++t) { const float nr = ar * hr - ai * him + bur[t], ni = ar * him + ai * hr + bui[t]; hr = nr; him = ni;
                        HL[t * 136 + lane] = (bf16)f2bf(hr); HL[t * 136 + 64 + lane] = (bf16)f2bf(him); }
                    asm volatile("s_waitcnt lgkmcnt(0)" ::: "memory");
                    f32x16 y = {};
#pragma unroll
                    for (int ks = 0; ks < 8; ++ks) { const bf16x8 af = *(const LAS bf16x8*)((const LAS unsigned char*)HL + (r32 * 136 + 16 * ks + 8 * hi) * 2);
                        y = __builtin_amdgcn_mfma_f32_32x32x16_bf16(af, cfr[ks], y, 0, 0, 0); }
                    asm volatile("s_waitcnt lgkmcnt(0)" ::: "memory");
                    if (r32 < 16) {
#pragma unroll
                        for (int r = 0; r < 16; ++r) {
                            const int row = s5_tokrow(s0 + crow(r, hi), dir, b);
                            if (row < MLAT || layer == 0) {
                                const size_t o = (size_t)row * 256 + 16 * g + r32;
                                if (dir == 0) Y0[o] = y[r];
                                else { const float u = bf2f(Z[(size_t)row * INW + OFF_S5 + 16 * g + r32]); const float v = y[r] + Y0[o] + dsk * u;
                                    const float uu = 0.7978845608028654f * (v + 0.044715f * v * v * v); T[o] = (bf16)f2bf(v / (1.f + __expf(-2.f * uu))); }
                            }
                        }
                    }
                }
            }
            if (pass == 0) {
                carry[(wid * 64 + lane) * 2] = hr; carry[(wid * 64 + lane) * 2 + 1] = him;
                __syncthreads();
                hr = 0.f; him = 0.f;
                for (int v = 0; v < wid; ++v) { const float cr = carry[(v * 64 + lane) * 2], ci = carry[(v * 64 + lane) * 2 + 1]; const float nr = pr * hr - pi * him + cr, ni = pr * him + pi * hr + ci; hr = nr; him = ni; }
            }
        }
        __syncthreads();
    }
}

__device__ __forceinline__ void na_phase(LAS unsigned char* lds, int l) {
    CArgs& a = kargs();
    int tid_ = threadIdx.x; asm volatile("" : "+v"(tid_));
    const int tid = tid_, wid = __builtin_amdgcn_readfirstlane(tid >> 6), G = o_grid(), bid = o_bid();
    bf16* Zb = (bf16*)(a.ws + WS_Z); bf16* CAT = (bf16*)(a.ws + WS_CAT);
    LAS float* biasL = (LAS float*)(lds + 73728);
    for (int i = tid; i < 4 * 15 * 31; i += 512) biasL[i] = a.in[I_NABIAS][l * 4 * 15 * 31 + i];
    for (int u = bid; u < 512; u += G) {
        const int b = u >> 5, r = u & 31; const int rs = r - 4 < 0 ? 0 : (r - 4 > 24 ? 24 : r - 4); const int head = wid >> 1;
        AttnP P{Zb, CAT, DM, b * 2048 + r * 64 + (wid & 1) * 32, OFF_NQ + head * 64, 512 + head * 64, OFF_NK, OFF_NV, b * 2048 + rs * 64, 8, MLAT + b * 256, 4, 1, (wid & 1) * 32, rs - r + 7, head};
        attn_unit<4>(lds, P, biasL);
    }
    if (l == 0) for (int u = bid; u < 64; u += G) {
        const int b = u >> 2, blk = u & 3; const int head = wid >> 1;
        AttnP P{Zb, CAT, DM, MLAT + b * 256 + blk * 64 + (wid & 1) * 32, OFF_NQ + head * 64, 512 + head * 64, OFF_NK, OFF_NV, 0, 0, MLAT + b * 256, 4, 0, 0, 0, head};
        attn_unit<4>(lds, P, biasL);
    }
}
__device__ __forceinline__ void gqa_phase(LAS unsigned char* lds, int l) {
    CArgs& a = kargs();
    int tid_ = threadIdx.x; asm volatile("" : "+v"(tid_));
    const int tid = tid_, wid = __builtin_amdgcn_readfirstlane(tid >> 6), G = o_grid(), bid = o_bid();
    bf16* Zb = (bf16*)(a.ws + WS_Z); bf16* CAT = (bf16*)(a.ws + WS_CAT);
    for (int u = bid; u < 512; u += G) {
        const int b = u >> 5, kvh = (u >> 4) & 1, qb = u & 15; const int head = 2 * kvh + (wid >> 2);
        AttnP P{Zb, CAT, DM, b * 2048 + qb * 128 + (wid & 3) * 32, OFF_AQ + head * 64, head * 64, OFF_AK + kvh * 64, OFF_AV + kvh * 64, b * 2048, 32, MLAT + b * 256, 4, 0, 0, 0, head};
        attn_unit<1>(lds, P, nullptr);
    }
    if (l == 0) for (int u = bid; u < 64; u += G) {
        const int b = u >> 2, kvh = (u >> 1) & 1, qb = u & 1; const int head = 2 * kvh + (wid >> 2);
        AttnP P{Zb, CAT, DM, MLAT + b * 256 + qb * 128 + (wid & 3) * 32, OFF_AQ + head * 64, head * 64, OFF_AK + kvh * 64, OFF_AV + kvh * 64, 0, 0, MLAT + b * 256, 4, 0, 0, 0, head};
        attn_unit<1>(lds, P, nullptr);
    }
}

template <class F>
__device__ __forceinline__ void run_gemm(LAS unsigned char* lds, const bf16* A, int lda, const bf16* Bt, int ldb, int M, int N, int K, const F& f, int c, long tsB = 0, int ksplit = 1 << 30, long kjumpB = 0) {
    pg8::Gemm g{A, Bt, M, N, K, lda, ldb, tsB ? tsB : (long)512 * ldb, ksplit, kjumpB}; pg8::StaticOrder S; S.init(M, N, o_grid(), c); Epi8<F> E{f};
    pg8::gemm_phase<Epi8<F>, pg8::StaticOrder, true, true>(lds, g, S, E);
}
#define WSP(off) ((bf16*)(ws + (off)))
__device__ __forceinline__ void ph_store_gemm(LAS unsigned char* lds, int l, int kind) {
    unsigned char* ws = kargs().ws; unsigned char* wb = ws + WS_W + (size_t)l * W_LAYER;
    const int Mr = l == 0 ? MT : MLAT;
    const bf16* A; const bf16* Bt; bf16* O; int lda, ldb, M, N, K, ldc, act;
    if (kind == 0)      { A = WSP(WS_XN);   lda = DM;  Bt = (const bf16*)(wb + WO_IN);  ldb = DM;  M = MT; N = INW; K = DM;  O = WSP(WS_Z);    ldc = INW; act = 0; }
    else if (kind == 1) { A = WSP(WS_CAT);  lda = DM;  Bt = (const bf16*)(wb + WO_OUT); ldb = DM;  M = Mr; N = DM;  K = DM;  O = WSP(WS_Y);    ldc = DM;  act = 0; }
    else if (kind == 2) { A = WSP(WS_XN);   lda = DM;  Bt = (const bf16*)(wb + WO_1);   ldb = DM;  M = Mr; N = DFF; K = DM;  O = WSP(WS_HMID); ldc = DFF; act = 1; }
    else if (kind == 3) { A = WSP(WS_HMID); lda = DFF; Bt = (const bf16*)(wb + WO_2);   ldb = DFF; M = Mr; N = DM;  K = DFF; O = WSP(WS_XN);   ldc = DM;  act = 0; }
    else                { A = (const bf16*)(wb + WO_CS); lda = 256; Bt = WSP(WS_Z) + OFF_FN; ldb = INW; M = 512; N = MT; K = 256; O = WSP(WS_C1); ldc = MT; act = 0; }
    run_gemm(lds, A, lda, Bt, ldb, M, N, K, FStore{O, ldc, act}, o_bid());
}
__device__ __forceinline__ void ph_d2(LAS unsigned char* lds, int l) { CArgs& a = kargs(); unsigned char* ws = a.ws;
    for (int j = 0; j < (l == 0 ? 2 : 1); ++j) {
        if (j == 0) run_gemm(lds, WSP(WS_DFT), 4096, WSP(WS_C1), MT, 2048, 4096, 4096, FD2{WSP(WS_CAT), a.in[I_BFNET] + l * 256, 0, 2048}, o_grid() - 1 - o_bid(), 2048 * 2, 32, ((long)256 * MT - 2048) * 2);
        else run_gemm(lds, WSP(WS_DFTC), 512, WSP(WS_C1) + MLAT, MT, 256, 4096, 512, FD2{WSP(WS_CAT), a.in[I_BFNET] + l * 256, MLAT, 256}, o_bid(), 256 * 2, 4, ((long)256 * MT - 256) * 2);
    } }
__device__ __forceinline__ void ph_glu(LAS unsigned char* lds, int l) { unsigned char* ws = kargs().ws; unsigned char* wb = ws + WS_W + (size_t)l * W_LAYER;
    int K = 256, ld = 256; asm volatile("" : "+s"(K), "+s"(ld));
    run_gemm(lds, WSP(WS_T), ld, (const bf16*)(wb + WO_GLU), ld, l == 0 ? MT : MLAT, 256, K, FGlu{WSP(WS_CAT), WSP(WS_T)}, o_bid()); }

__global__ void __launch_bounds__(512, 2) fwd_megakernel(Args a_unused) {
    extern __shared__ __attribute__((aligned(16))) unsigned char lds_raw[];
    LAS unsigned char* lds = (LAS unsigned char*)lds_raw;
    cg::grid_group grid = cg::this_grid();
    for (int step = 0; step < 20; ++step) {
        const int l = step < 2 ? 0 : (step - 2) / 9, k = step < 2 ? step - 2 : (step - 2) - 9 * l;
        int gk = -1;
        if (k == 0) gk = 0; else if (k == 2) gk = 4; else if (k == 4) gk = 1; else if (k == 6) gk = 2; else if (k == 7) gk = 3;
        if (gk >= 0) ph_store_gemm(lds, l, gk);
        else if (k == -2) prologue(lds);
        else if (k == -1) prep_rows0();
        else if (k == 1) {
            qk_prep(l);
            __syncthreads();
            na_phase(lds, l);
            __syncthreads();
            for (int u = o_bid(); u < 256; u += o_grid()) s5_unit(lds, l, u >> 4, u & 15);
        } else if (k == 3) {
            gqa_phase(lds, l);
            __syncthreads();
            ph_d2(lds, l);
            ph_glu(lds, l);
        } else if (k == 5) { if (l == 0) row_update<0>(); else row_update<2>(); }
        else { if (l == 0) row_update<1>(); else row_update<3>(); }
        if (step != 19) grid.sync();
    }
}

extern "C" void kernel_launch(void* const* d_in, const int* in_sizes, int n_in, void* d_out, int out_size, void* d_ws, size_t ws_size, hipStream_t stream) {
    static int grid = 0;
    if (grid == 0) {
        if (n_in != 28 || ws_size < WS_END) { fprintf(stderr, "kernel_launch: unexpected n_in %d / ws_size %zu (need %zu)\n", n_in, ws_size, (size_t)WS_END); grid = -1; return; }
        int dev = 0, cus = 0, per_cu = 0;
        hipGetDevice(&dev); hipDeviceGetAttribute(&cus, hipDeviceAttributeMultiprocessorCount, dev);
        if (hipFuncSetAttribute((const void*)fwd_megakernel, hipFuncAttributeMaxDynamicSharedMemorySize, LDS_BYTES) != hipSuccess) { fprintf(stderr, "kernel_launch: hipFuncSetAttribute failed\n"); }
        if (hipOccupancyMaxActiveBlocksPerMultiprocessor(&per_cu, (const void*)fwd_megakernel, 512, LDS_BYTES) != hipSuccess || per_cu < 1) { fprintf(stderr, "kernel_launch: occupancy query says %d\n", per_cu); per_cu = 1; }
        (void)hipGetLastError();
        grid = cus * (per_cu > 1 ? 1 : per_cu);
        if (grid <= 0) grid = 256;
    }
    if (grid < 0) return;
    Args a{};
    for (int i = 0; i < 28; ++i) a.in[i] = (const float*)d_in[i];
    a.out = (float*)d_out; a.ws = (unsigned char*)d_ws;
    void* args[] = {&a};
    hipError_t e = hipLaunchCooperativeKernel((const void*)fwd_megakernel, dim3(grid), dim3(512), args, LDS_BYTES, stream);
    if (e != hipSuccess) fprintf(stderr, "cooperative launch failed: %s (grid %d)\n", hipGetErrorString(e), grid);
}
```

```cpp
#include <hip/hip_runtime.h>
#include <hip/hip_cooperative_groups.h>
#include <cstdio>
#include <cstdint>
namespace cg = cooperative_groups;
namespace pg8 {
#define PG8_LAS __attribute__((address_space(3)))
typedef unsigned short bf16_t;
typedef short bf16x8 __attribute__((ext_vector_type(8)));
typedef float f32x4 __attribute__((ext_vector_type(4)));
typedef unsigned u32x4 __attribute__((ext_vector_type(4)));
constexpr int BM = 256, BK = 64, HALF = 128, HTB = HALF * BK * 2  , STAGE_BYTES = 8 * HTB, NXCD = 8, WGM = 8;

__host__ __device__ __forceinline__ int lds_byte(int r, int c) { const int st = (r >> 4) * 2 + (c >> 5), rr = r & 15, cc = c & 31, ob = rr * 64 + cc * 2; return st * 1024 + (ob ^ (((ob >> 9) & 1) << 5)); }
__host__ __device__ __forceinline__ void stage_rc(int b, int& R, int& C) { const int st = b / 1024, sb = b % 1024, swz = sb ^ (((sb >> 9) & 1) << 5); R = (st >> 1) * 16 + swz / 64; C = (st & 1) * 32 + (swz % 64) / 2; }
__host__ __device__ __forceinline__ int perm32(int rho) { const int n = rho >> 4, i = rho & 15; return 8 * (i >> 2) + 4 * n + (i & 3); }

struct Unit { int pm, pn; };
struct Gemm { const bf16_t* A; const bf16_t* Bt; int M, N, K, lda, ldb; long tsB; int ksplit; long kjumpB; };

struct StaticOrder {
    int nM, nN, nwg, G, c;
    __host__ __device__ void init(int M, int N, int G_, int c_) { nM = M / BM; nN = N / BM; nwg = nM * nN; G = G_; c = c_; }
    __host__ __device__ bool next(int i, Unit& u) const {
        const long L = (long)i * G + c; if (L >= nwg) return false;
        int wgid = (int)L; { const int q = nwg / NXCD, r = nwg % NXCD, xcd = wgid % NXCD, off = wgid / NXCD; wgid = (xcd < r ? xcd * (q + 1) : r * (q + 1) + (xcd - r) * q) + off; }
        const int nig = WGM * nN, gid = wgid / nig, fm = gid * WGM, gsz = (nM - fm) < WGM ? (nM - fm) : WGM;
        u.pm = fm + ((wgid % nig) % gsz); u.pn = (wgid % nig) / gsz; return true;
    }
    __device__ __forceinline__ void a_ready(const Unit&) const {}
    __device__ __forceinline__ void done(const Unit&) const {}
};
__device__ __forceinline__ unsigned cvt_pk_bf16(float lo, float hi) { unsigned r; asm volatile("v_cvt_pk_bf16_f32 %0, %1, %2" : "=v"(r) : "v"(lo), "v"(hi)); return r; }
template <class Epi, class Sched, bool ALIGN_EPI = false, bool SP2 = false>
__device__ __forceinline__ void gemm_phase(PG8_LAS unsigned char* lds, const Gemm g, const Sched& S, const Epi& E) {
    int tid_ = threadIdx.x; asm volatile("" : "+v"(tid_));
    const int tid = tid_, wid = __builtin_amdgcn_readfirstlane(tid >> 6), lane = tid & 63, wr = wid >> 2, wc = wid & 3, fr = lane & 15, fq = lane >> 4;
    const int K = g.K, nt = K / BK;
    unsigned voffA[2], voffB[2];
#pragma unroll
    for (int i = 0; i < 2; ++i) { int R, C; stage_rc(tid * 16 + i * 8192, R, C); const int Rb = Epi::PERM ? ((R & ~31) + perm32(R & 31)) : R;
        voffA[i] = (unsigned)(R * g.lda + C) * 2u; voffB[i] = (unsigned)(Rb * g.ldb + C) * 2u; }
    const size_t kstep = (size_t)(BK * 2);
    const size_t hstepA = (size_t)HALF * g.lda * 2, hstepB = (size_t)HALF * g.ldb * 2;
    const size_t tstepA = 2 * hstepA, tstepB = (size_t)g.tsB;
    const unsigned ldsw = (unsigned)wid * 1024u;
    const int aoff = lds_byte(wr * 64 + fr, fq * 8), boff = lds_byte(wc * 32 + fr, fq * 8);
#define PG8_SA(b, h) (((b) * 2 + (h)) * HTB)
#define PG8_SB(b, h) ((4 + (b) * 2 + (h)) * HTB)
#define PG8_STAGE(bufoff, gbase, voff) do { _Pragma("unroll") for (int _i = 0; _i < 2; ++_i) \
        __builtin_amdgcn_global_load_lds((const unsigned*)((const char*)(gbase) + (voff)[_i]), (PG8_LAS unsigned*)(lds + (bufoff) + ldsw + _i * 8192), 16, 0, 0); } while (0)
#define PG8_LDA(dst, b, h) do { _Pragma("unroll") for (int m = 0; m < 4; ++m) _Pragma("unroll") for (int k = 0; k < 2; ++k) dst[m][k] = *(const PG8_LAS bf16x8*)(lds + PG8_SA(b, h) + aoff + m * 2048 + k * 1024); } while (0)
#define PG8_LDB(dst, b, h) do { _Pragma("unroll") for (int n = 0; n < 2; ++n) _Pragma("unroll") for (int k = 0; k < 2; ++k) dst[n][k] = *(const PG8_LAS bf16x8*)(lds + PG8_SB(b, h) + boff + n * 2048 + k * 1024); } while (0)
#define PG8_MMA(ai, bj, At, Bt) do { __builtin_amdgcn_s_setprio(1); _Pragma("unroll") for (int m = 0; m < 4; ++m) _Pragma("unroll") for (int n = 0; n < 2; ++n) _Pragma("unroll") for (int k = 0; k < 2; ++k) \
        acc[ai][bj][m][n] = __builtin_amdgcn_mfma_f32_16x16x32_bf16(Bt[n][k], At[m][k], acc[ai][bj][m][n], 0, 0, 0); __builtin_amdgcn_s_setprio(0); } while (0)
#define PG8_WAIT_V(n) asm volatile("s_waitcnt vmcnt(" #n ")" ::: "memory")
#define PG8_WAIT_L(n) asm volatile("s_waitcnt lgkmcnt(" #n ")" ::: "memory")
#define PG8_BAR __builtin_amdgcn_s_barrier()
#define PG8_SCHED __builtin_amdgcn_sched_barrier(0)
    Unit cur, nxt; int ui = 0;
    if (!S.next(0, cur)) return;
    f32x4 acc[2][2][4][2];
#pragma unroll
    for (int a = 0; a < 2; ++a)
#pragma unroll
        for (int b = 0; b < 2; ++b)
#pragma unroll
            for (int m = 0; m < 4; ++m)
#pragma unroll
                for (int n = 0; n < 2; ++n) acc[a][b][m][n] = (f32x4){0.f, 0.f, 0.f, 0.f};
    bf16x8 At[4][2], B0[2][2], B1[2][2];
    const char* cA = (const char*)g.A + (size_t)cur.pm * tstepA; const char* cB = (const char*)g.Bt + (size_t)cur.pn * tstepB;
    S.a_ready(cur);
    if constexpr (SP2) {
        PG8_STAGE(PG8_SB(0, 0), cB, voffB); PG8_STAGE(PG8_SB(0, 1), cB + hstepB, voffB); PG8_STAGE(PG8_SA(0, 0), cA, voffA); PG8_STAGE(PG8_SA(0, 1), cA + hstepA, voffA);
        if (wr == 1) PG8_BAR;
        PG8_WAIT_V(2); PG8_BAR;
        PG8_STAGE(PG8_SB(1, 0), cB + kstep, voffB); PG8_STAGE(PG8_SA(1, 0), cA + kstep, voffA); PG8_STAGE(PG8_SB(1, 1), cB + hstepB + kstep, voffB);
        PG8_WAIT_V(6); PG8_BAR;
    } else {
        PG8_STAGE(PG8_SB(0, 0), cB, voffB); PG8_STAGE(PG8_SA(0, 0), cA, voffA); PG8_STAGE(PG8_SB(0, 1), cB + hstepB, voffB); PG8_STAGE(PG8_SA(0, 1), cA + hstepA, voffA);
        if (wr == 1) PG8_BAR;
        PG8_WAIT_V(4); PG8_BAR;
        PG8_STAGE(PG8_SB(1, 0), cB + kstep, voffB); PG8_STAGE(PG8_SA(1, 0), cA + kstep, voffA); PG8_STAGE(PG8_SB(1, 1), cB + hstepB + kstep, voffB);
        PG8_WAIT_V(6); PG8_BAR;
    }
    for (;;) {
        const bool has_next = S.next(ui + 1, nxt);
        const char* nA = has_next ? (const char*)g.A + (size_t)nxt.pm * tstepA : cA; const char* nB = has_next ? (const char*)g.Bt + (size_t)nxt.pn * tstepB : cB;
        for (int t = 0; t < nt; t += 2) {
            const bool last = (t == nt - 2);
            const char* a1 = cA + (size_t)(t + 1) * kstep;
            const char* a2 = last ? nA : cA + (size_t)(t + 2) * kstep; const char* b2 = last ? nB : cB + (size_t)(t + 2) * kstep + ((t + 2) >= g.ksplit ? g.kjumpB : 0);
            const char* a3 = a2 + kstep; const char* b3 = b2 + kstep;
            if (last && has_next) S.a_ready(nxt);
            if constexpr (SP2) {
            PG8_LDB(B0, 0, 0); PG8_LDB(B1, 0, 1); PG8_SCHED; PG8_LDA(At, 0, 0); PG8_STAGE(PG8_SA(1, 1), a1 + hstepA, voffA);
            PG8_WAIT_V(8); PG8_WAIT_L(0); PG8_BAR; PG8_MMA(0, 0, At, B0); PG8_MMA(0, 1, At, B1); PG8_BAR; PG8_SCHED;
            PG8_LDA(At, 0, 1); PG8_STAGE(PG8_SB(0, 0), b2, voffB); PG8_STAGE(PG8_SB(0, 1), b2 + hstepB, voffB); PG8_STAGE(PG8_SA(0, 0), a2, voffA);
            PG8_WAIT_V(8); PG8_WAIT_L(0); PG8_BAR; PG8_MMA(1, 0, At, B0); PG8_MMA(1, 1, At, B1); PG8_BAR; PG8_SCHED;
            PG8_LDB(B0, 1, 0); PG8_LDB(B1, 1, 1); PG8_SCHED; PG8_LDA(At, 1, 0); PG8_STAGE(PG8_SA(0, 1), a2 + hstepA, voffA);
            PG8_WAIT_V(8); PG8_WAIT_L(0); PG8_BAR; PG8_MMA(0, 0, At, B0); PG8_MMA(0, 1, At, B1); PG8_BAR; PG8_SCHED;
            PG8_LDA(At, 1, 1); PG8_STAGE(PG8_SB(1, 0), b3, voffB); PG8_STAGE(PG8_SB(1, 1), b3 + hstepB, voffB); PG8_STAGE(PG8_SA(1, 0), a3, voffA);
            PG8_WAIT_V(8); PG8_WAIT_L(0); PG8_BAR; PG8_MMA(1, 0, At, B0); PG8_MMA(1, 1, At, B1); PG8_BAR; PG8_SCHED;
            } else {
            PG8_LDB(B0, 0, 0); PG8_SCHED; PG8_LDA(At, 0, 0); PG8_STAGE(PG8_SA(1, 1), a1 + hstepA, voffA);
            PG8_WAIT_L(8); PG8_BAR; PG8_WAIT_L(0); PG8_MMA(0, 0, At, B0); PG8_BAR; PG8_SCHED;
            PG8_LDB(B1, 0, 1); PG8_STAGE(PG8_SB(0, 0), b2, voffB);
            PG8_BAR; PG8_WAIT_L(0); PG8_MMA(0, 1, At, B1); PG8_BAR;
            PG8_LDA(At, 0, 1); PG8_STAGE(PG8_SA(0, 0), a2, voffA);
            PG8_BAR; PG8_WAIT_L(0); PG8_MMA(1, 0, At, B0); PG8_BAR; PG8_SCHED;
            PG8_STAGE(PG8_SB(0, 1), b2 + hstepB, voffB);
            PG8_WAIT_V(6); PG8_BAR; PG8_MMA(1, 1, At, B1); PG8_BAR;
            PG8_LDB(B0, 1, 0); PG8_SCHED; PG8_LDA(At, 1, 0); PG8_STAGE(PG8_SA(0, 1), a2 + hstepA, voffA);
            PG8_WAIT_L(8); PG8_BAR; PG8_WAIT_L(0); PG8_MMA(0, 0, At, B0); PG8_BAR; PG8_SCHED;
            PG8_LDB(B1, 1, 1); PG8_STAGE(PG8_SB(1, 0), b3, voffB);
            PG8_BAR; PG8_WAIT_L(0); PG8_MMA(0, 1, At, B1); PG8_BAR;
            PG8_LDA(At, 1, 1); PG8_STAGE(PG8_SA(1, 0), a3, voffA);
            PG8_BAR; PG8_WAIT_L(0); PG8_MMA(1, 0, At, B0); PG8_BAR; PG8_SCHED;
            PG8_STAGE(PG8_SB(1, 1), b3 + hstepB, voffB);
            PG8_WAIT_V(6); PG8_BAR; PG8_MMA(1, 1, At, B1); PG8_BAR;
            }
        }
        if constexpr (ALIGN_EPI) { if (wr == 0) PG8_BAR; }
        if constexpr (!Epi::AFTER_DRAIN) { E(acc, cur, wr, wc, fr, fq); S.done(cur); }
        if (!has_next) break;
#pragma unroll
        for (int a = 0; a < 2; ++a)
#pragma unroll
            for (int b = 0; b < 2; ++b)
#pragma unroll
                for (int m = 0; m < 4; ++m)
#pragma unroll
                    for (int n = 0; n < 2; ++n) acc[a][b][m][n] = (f32x4){0.f, 0.f, 0.f, 0.f};
        cur = nxt; cA = nA; cB = nB; ++ui;
        if constexpr (ALIGN_EPI) { if (wr == 1) PG8_BAR; }
    }
    PG8_WAIT_V(0);
    if constexpr (!ALIGN_EPI) { if (wr == 0) PG8_BAR; }
    PG8_BAR;
    if constexpr (Epi::AFTER_DRAIN) { E.fused(acc, cur, wr, wc, fr, fq, lds, wid, lane); S.done(cur); }
#undef PG8_SA
#undef PG8_SB
#undef PG8_STAGE
#undef PG8_LDA
#undef PG8_LDB
#undef PG8_MMA
#undef PG8_WAIT_V
#undef PG8_WAIT_L
#undef PG8_BAR
#undef PG8_SCHED
}
}
#define LAS __attribute__((address_space(3)))
typedef unsigned short bf16;
typedef unsigned v4u __attribute__((ext_vector_type(4)));
typedef unsigned v2u __attribute__((ext_vector_type(2)));
typedef float f32x4 __attribute__((ext_vector_type(4)));
typedef float f32x16 __attribute__((ext_vector_type(16)));
typedef short bf16x8 __attribute__((ext_vector_type(8)));
typedef short s16x4 __attribute__((ext_vector_type(4)));

constexpr int DM = 1024, NB = 16, SEQ = 2048, CTXL = 256, MLAT = NB * SEQ, MCTX = NB * CTXL, MT = MLAT + MCTX, INW = 1792, DFF = 4096;
constexpr int OFF_AQ = 0, OFF_AK = 256, OFF_AV = 384, OFF_S5 = 512, OFF_NQ = 768, OFF_NK = 1024, OFF_NV = 1280, OFF_FN = 1536;
constexpr float EPSN = 1e-6f;
constexpr float LOG2E = 1.4426950408889634f;
constexpr size_t MiB = 1u << 20;
constexpr size_t WS_MOD = 0;
constexpr size_t WS_ROPE = 1 * MiB;
constexpr size_t WS_W = 2 * MiB, W_LAYER = 22 * MiB;
constexpr size_t WO_IN = 0, WO_OUT = WO_IN + (size_t)INW * DM * 2, WO_1 = WO_OUT + (size_t)DM * DM * 2, WO_2 = WO_1 + (size_t)DFF * DM * 2,
                 WO_GLU = WO_2 + (size_t)DFF * DM * 2, WO_CS = WO_GLU + 256 * 256 * 2, WO_END = WO_CS + 512 * 256 * 2;
static_assert(WO_END <= W_LAYER, "weights");
constexpr size_t WS_DFT = 46 * MiB, WS_DFTC = 62 * MiB, WS_XC = 64 * MiB, WS_XN = 80 * MiB;
constexpr size_t WS_T = 116 * MiB, WS_C1 = 350 * MiB;
constexpr size_t WS_Z = 152 * MiB, WS_CAT = 278 * MiB, WS_Y = 350 * MiB, WS_HMID = 152 * MiB, WS_Y0 = 440 * MiB, WS_Y1 = 476 * MiB, WS_END = 512 * MiB;
constexpr int LDS_BYTES = 147456;

struct Args { const float* in[28]; float* out; unsigned char* ws; };
typedef __attribute__((address_space(4))) const Args CArgs;
__device__ __forceinline__ CArgs& kargs() { CArgs* p = (CArgs*)__builtin_amdgcn_kernarg_segment_ptr(); asm volatile("" : "+s"(p)); return *p; }
enum { I_X = 0, I_C, I_CTX, I_CCTX, I_WADA, I_BADA, I_GPREMIX, I_GPOSTMIX, I_GPREMLP, I_GPOSTMLP, I_WIN, I_GQ, I_GK, I_AR, I_AI, I_LDT, I_BR, I_BI, I_CR, I_CI,
       I_S5D, I_WGLU, I_NABIAS, I_WFNET, I_BFNET, I_WOUT, I_W1, I_W2 };

constexpr size_t WS_PROBE = 1 * MiB + 65536;
constexpr size_t WS_YC = 440 * MiB;
constexpr size_t WS_BAR = 1 * MiB + 131072;
constexpr int LDS_BARST = 147456 - 64;
#ifdef PROBE
#define STAMP(lbl) do { if (blockIdx.x == 0 && threadIdx.x == 0) { unsigned char* pw_ = kargs().ws + WS_PROBE; const unsigned long long now_ = __builtin_amdgcn_s_memrealtime(); \
    unsigned long long* tp_ = (unsigned long long*)(pw_ + 256); ((float*)pw_)[lbl] += (float)(now_ - *tp_); *tp_ = now_; } } while (0)
#else
#define STAMP(lbl) do {} while (0)
#endif
__device__ __forceinline__ unsigned f2bf(float f) { unsigned u = __builtin_bit_cast(unsigned, f); return (u + 0x7fffu + ((u >> 16) & 1u)) >> 16; }
typedef float f32x2_t __attribute__((ext_vector_type(2))); typedef __bf16 bf16x2_t __attribute__((ext_vector_type(2)));
__device__ __forceinline__ unsigned pk2(float lo, float hi) { const f32x2_t v = {lo, hi}; const bf16x2_t b = __builtin_convertvector(v, bf16x2_t); return __builtin_bit_cast(unsigned, b); }
__device__ __forceinline__ float bflo(unsigned w) { return __builtin_bit_cast(float, w << 16); }
__device__ __forceinline__ float bfhi(unsigned w) { return __builtin_bit_cast(float, w & 0xffff0000u); }
__device__ __forceinline__ float bf2f(bf16 h) { return __builtin_bit_cast(float, (unsigned)h << 16); }
__device__ __forceinline__ int o_bid() { int t = blockIdx.x; asm volatile("" : "+s"(t)); return t; }
__device__ __forceinline__ int o_grid() { int t = gridDim.x; asm volatile("" : "+s"(t)); return t; }
__device__ __forceinline__ float shfl_xor_l(float v, int o, int lane) { return __builtin_bit_cast(float, __builtin_amdgcn_ds_bpermute((lane ^ o) << 2, __builtin_bit_cast(int, v))); }
__device__ __forceinline__ float wave_sum(float v, int lane) {
#pragma unroll
    for (int o = 1; o < 64; o <<= 1) v += shfl_xor_l(v, o, lane);
    return v;
}
__device__ __forceinline__ int crow(int r, int hi) { return (r & 3) + 8 * (r >> 2) + 4 * hi; }

template <class F> struct Epi8 {
    static constexpr bool PERM = true, AFTER_DRAIN = false;
    F f;
    __device__ __forceinline__ void operator()(const pg8::f32x4 (&acc)[2][2][4][2], const pg8::Unit& u, int wr, int wc, int fr, int fq) const {
        asm volatile("" : "+v"(fr), "+v"(fq));
#pragma unroll
        for (int ai = 0; ai < 2; ++ai)
#pragma unroll
            for (int m = 0; m < 4; ++m) {
                const int row = u.pm * 256 + ai * 128 + wr * 64 + m * 16 + fr;
#pragma unroll
                for (int bj = 0; bj < 2; ++bj) { const int col = u.pn * 256 + bj * 128 + wc * 32 + 8 * fq; f(row, col, acc[ai][bj][m][0], acc[ai][bj][m][1]); }
                asm volatile("" ::: "memory"); __builtin_amdgcn_sched_barrier(0);
            }
    }
};
__device__ __forceinline__ v4u pack8(f32x4 a, f32x4 b) { v4u w; w.x = pk2(a[0], a[1]); w.y = pk2(a[2], a[3]); w.z = pk2(b[0], b[1]); w.w = pk2(b[2], b[3]); return w; }
struct FStore { bf16* O; int ldc; int act;
    __device__ __forceinline__ void operator()(int row, int col, f32x4 a, f32x4 b) const {
        if (act == 1) {
#pragma unroll
            for (int i = 0; i < 4; ++i) { float x = a[i] > 0.f ? a[i] : 0.f; a[i] = x * x; float y = b[i] > 0.f ? b[i] : 0.f; b[i] = y * y; } }
        *(v4u*)(O + (size_t)row * ldc + col) = pack8(a, b); } };
struct FPart { float* O; int ldc;
    __device__ __forceinline__ void operator()(int row, int col, f32x4 a, f32x4 b) const { float* p = O + (size_t)row * ldc + col; *(f32x4*)p = a; *(f32x4*)(p + 4) = b; } };
struct FD2 { bf16* cat; const float* bias; int rowbase, rowsPerB;
    __device__ __forceinline__ void operator()(int row, int col, f32x4 a, f32x4 b) const {
        const int bb = col >> 8, j = col & 255; const f32x4 b0 = *(const f32x4*)(bias + j), b1 = *(const f32x4*)(bias + j + 4);
        *(v4u*)(cat + ((size_t)(rowbase + bb * rowsPerB + row) * 1024 + 768 + j)) = pack8(a + b0, b + b1); } };
struct FGlu { bf16* cat; const bf16* T;
    __device__ __forceinline__ void operator()(int row, int col, f32x4 a, f32x4 b) const {
        const v4u t = *(const v4u*)(T + (size_t)row * 256 + col);
        float tv[8] = {bflo(t.x), bfhi(t.x), bflo(t.y), bfhi(t.y), bflo(t.z), bfhi(t.z), bflo(t.w), bfhi(t.w)};
#pragma unroll
        for (int i = 0; i < 4; ++i) { a[i] = tv[i] / (1.f + __expf(-a[i])); b[i] = tv[4 + i] / (1.f + __expf(-b[i])); }
        *(v4u*)(cat + (size_t)row * 1024 + 256 + col) = pack8(a, b); } };
__device__ __forceinline__ void transpose_item(const float* W, int K, int N, bf16* WT, LAS float* scr, int item, int lane) {
    const int nblk = N / 32, kb = item / nblk, nb = item % nblk, k0 = 64 * kb, n0 = 32 * nb;
#pragma unroll 8
    for (int i = 0; i < 32; ++i) { const int kk = 2 * i + (lane >> 5); scr[kk * 33 + (lane & 31)] = W[(size_t)(k0 + kk) * N + n0 + (lane & 31)]; }
    asm volatile("s_waitcnt lgkmcnt(0)" ::: "memory");
    const int c = lane & 7;
#pragma unroll
    for (int j = 0; j < 4; ++j) { const int n = (lane >> 3) + 8 * j; const LAS float* s = scr + (8 * c) * 33 + n;
        v4u o; o.x = pk2(s[0 * 33], s[1 * 33]); o.y = pk2(s[2 * 33], s[3 * 33]); o.z = pk2(s[4 * 33], s[5 * 33]); o.w = pk2(s[6 * 33], s[7 * 33]);
        *(v4u*)(WT + (size_t)(n0 + n) * K + k0 + 8 * c) = o; }
    asm volatile("s_waitcnt lgkmcnt(0)" ::: "memory");
}

__device__ __forceinline__ void prologue(LAS unsigned char* lds) {
    CArgs& a = kargs();
    int tid_ = threadIdx.x; asm volatile("" : "+v"(tid_));
    const int tid = tid_, lane = tid & 63, wid = tid >> 6, G = o_grid();
    unsigned char* ws = a.ws;
    {
        LAS float* scr = (LAS float*)(lds + wid * 16384);
        const int gw = o_bid() * 8 + wid, NGW = G * 8;
        constexpr int I0 = (DM / 64) * (INW / 32), I1 = (DM / 64) * (DM / 32), I2 = (DM / 64) * (DFF / 32), I3 = (DFF / 64) * (DM / 32), I4 = (256 / 64) * (256 / 32);
        constexpr int PER = I0 + I1 + I2 + I3 + I4;
        for (int it = gw; it < 2 * PER; it += NGW) {
            const int l = it / PER; int r = it % PER; unsigned char* wb = ws + WS_W + (size_t)l * W_LAYER;
            if (r < I0) { transpose_item(a.in[I_WIN] + (size_t)l * DM * INW, DM, INW, (bf16*)(wb + WO_IN), scr, r, lane); continue; } r -= I0;
            if (r < I1) { transpose_item(a.in[I_WOUT] + (size_t)l * DM * DM, DM, DM, (bf16*)(wb + WO_OUT), scr, r, lane); continue; } r -= I1;
            if (r < I2) { transpose_item(a.in[I_W1] + (size_t)l * DM * DFF, DM, DFF, (bf16*)(wb + WO_1), scr, r, lane); continue; } r -= I2;
            if (r < I3) { transpose_item(a.in[I_W2] + (size_t)l * DFF * DM, DFF, DM, (bf16*)(wb + WO_2), scr, r, lane); continue; } r -= I3;
            transpose_item(a.in[I_WGLU] + (size_t)l * 256 * 256, 256, 256, (bf16*)(wb + WO_GLU), scr, r, lane);
        }
    }
    __syncthreads();
    {
        LAS float* sl = (LAS float*)lds;
        LAS float* part = (LAS float*)(lds + 17 * 1024 * 4);
        float* mod = (float*)(ws + WS_MOD);
        bool have = false;
        for (int u = o_bid(); u < 2 * 96; u += G) {
            if (!have) {
                for (int i = tid; i < 17 * 1024; i += 512) { const float cv = i < 16 * 1024 ? a.in[I_C][i] : a.in[I_CCTX][i - 16 * 1024]; sl[i] = cv / (1.f + __expf(-cv)); }
                have = true; __syncthreads();
            }
            const int l = u / 96, n0 = (u % 96) * 64;
            const float* W = a.in[I_WADA] + (size_t)l * DM * 6144 + n0 + lane;
            float acc[17];
#pragma unroll
            for (int i = 0; i < 17; ++i) acc[i] = 0.f;
            for (int k = wid * 128; k < wid * 128 + 128; ++k) {
                const float wv = W[(size_t)k * 6144];
#pragma unroll
                for (int i = 0; i < 17; ++i) acc[i] += sl[i * 1024 + k] * wv;
            }
#pragma unroll
            for (int i = 0; i < 17; ++i) part[(wid * 17 + i) * 64 + lane] = acc[i];
            __syncthreads();
            for (int o = tid; o < 17 * 64; o += 512) {
                const int i = o >> 6, n = o & 63; float s = a.in[I_BADA][l * 6144 + n0 + n];
#pragma unroll
                for (int w = 0; w < 8; ++w) s += part[(w * 17 + i) * 64 + n];
                mod[((size_t)l * 17 + i) * 6144 + n0 + n] = s;
            }
            __syncthreads();
        }
    }
    {
        const size_t gt = (size_t)o_bid() * 512 + tid, NT = (size_t)G * 512;
        bf16* dft = (bf16*)(ws + WS_DFT);
        for (size_t i = gt; i < (size_t)2048 * 4096 / 8; i += NT) {
            const int kk = (int)(i / 512), n0 = (int)(i % 512) * 8; float v[8];
#pragma unroll
            for (int j = 0; j < 8; ++j) { const int n = n0 + j, nn = n & 2047; const float fr = (float)((kk * nn) & 2047) * (1.f / 2048.f);
                v[j] = (n < 2048 ? __builtin_amdgcn_cosf(fr) : -__builtin_amdgcn_sinf(fr)) * 0.02209708691207961f; }
            v4u o; o.x = pk2(v[0], v[1]); o.y = pk2(v[2], v[3]); o.z = pk2(v[4], v[5]); o.w = pk2(v[6], v[7]);
            *(v4u*)(dft + i * 8) = o;
        }
        bf16* dftc = (bf16*)(ws + WS_DFTC);
        for (size_t i = gt; i < (size_t)256 * 512 / 8; i += NT) {
            const int kk = (int)(i / 64), n0 = (int)(i % 64) * 8; float v[8];
#pragma unroll
            for (int j = 0; j < 8; ++j) { const int n = n0 + j, nn = n & 255; const float fr = (float)((kk * nn) & 255) * (1.f / 256.f);
                v[j] = (n < 256 ? __builtin_amdgcn_cosf(fr) : -__builtin_amdgcn_sinf(fr)) * 0.0625f; }
            v4u o; o.x = pk2(v[0], v[1]); o.y = pk2(v[2], v[3]); o.z = pk2(v[4], v[5]); o.w = pk2(v[6], v[7]);
            *(v4u*)(dftc + i * 8) = o;
        }
        for (size_t i = gt; i < (size_t)2 * 512 * 256; i += NT) {
            const int l = (int)(i / (512 * 256)), rem = (int)(i % (512 * 256)), jp = rem >> 8, cin = rem & 255, j = jp & 255, part = jp >> 8;
            const float* W = a.in[I_WFNET] + (size_t)l * 256 * 256 + (size_t)(cin >> 6) * 64 * 256 + j; const int c = cin & 63; float s = 0.f;
            for (int cp = 0; cp < 64; ++cp) { const float fr = (float)((c * cp) & 63) * (1.f / 64.f); s += (part ? __builtin_amdgcn_sinf(fr) : __builtin_amdgcn_cosf(fr)) * W[(size_t)cp * 256]; }
            ((bf16*)(ws + WS_W + (size_t)l * W_LAYER + WO_CS))[(size_t)jp * 256 + cin] = (bf16)f2bf(s * 0.125f);
        }
        float2* rope = (float2*)(ws + WS_ROPE);
        for (size_t i = gt; i < 1024; i += NT) { const int pos = (int)i >> 4, k = (int)i & 15; const float inv = exp2f(-(float)k * (13.287712379549449f / 16.f)); const float ang = (float)pos * inv;
            float sn, cs; sincosf(ang, &sn, &cs); rope[i] = make_float2(cs, sn); }
    }
}

__device__ __forceinline__ void prep_rows0() {
    CArgs& a = kargs();
    int tid_ = threadIdx.x; asm volatile("" : "+v"(tid_));
    const int lane = tid_ & 63, gw = o_bid() * 8 + (tid_ >> 6), NGW = o_grid() * 8;
    const float* mod = (const float*)(a.ws + WS_MOD); bf16* XN = (bf16*)(a.ws + WS_XN); const float* gp = a.in[I_GPREMIX];
    for (int row = gw; row < MT; row += NGW) {
        const float* xr = row < MLAT ? a.in[I_X] + (size_t)row * DM : a.in[I_CTX] + (size_t)(row - MLAT) * DM; const int bi = row < MLAT ? row >> 11 : 16;
        const float* mb = mod + (size_t)bi * 6144;
        f32x4 v[4]; float ss = 0.f;
#pragma unroll
        for (int j = 0; j < 4; ++j) { v[j] = *(const f32x4*)(xr + 4 * lane + 256 * j); ss += v[j][0] * v[j][0] + v[j][1] * v[j][1] + v[j][2] * v[j][2] + v[j][3] * v[j][3]; }
        const float rstd = rsqrtf(wave_sum(ss, lane) * (1.f / DM) + EPSN);
#pragma unroll
        for (int j = 0; j < 4; ++j) { const int k = 4 * lane + 256 * j; const f32x4 g = *(const f32x4*)(gp + k), sh = *(const f32x4*)(mb + k), sc = *(const f32x4*)(mb + 1024 + k);
            f32x4 o;
#pragma unroll
            for (int e = 0; e < 4; ++e) o[e] = (v[j][e] * rstd * g[e]) * (1.f + sc[e]) + sh[e];
            v2u w; w.x = pk2(o[0], o[1]); w.y = pk2(o[2], o[3]); *(v2u*)(XN + (size_t)row * DM + k) = w; }
    }
}
template <int WHICH>
__device__ __forceinline__ void row_update() {
    CArgs& a = kargs();
    constexpr int l = WHICH >> 1; constexpr bool MLP = WHICH & 1; constexpr bool NXT = WHICH != 3;
    const int nrows = l == 0 ? MT : MLAT;
    const bf16* Y = (const bf16*)(a.ws + (MLP ? WS_XN : WS_Y)); bf16* OB = (bf16*)(a.ws + WS_XN);
    const float* xlat_in = WHICH == 0 ? a.in[I_X] : a.out; const float* xctx_in = WHICH == 0 ? a.in[I_CTX] : (const float*)(a.ws + WS_XC);
    float* xlat_out = a.out; float* xctx_out = (float*)(a.ws + WS_XC);
    const float* mod = (const float*)(a.ws + WS_MOD);
    const float* modl = mod + (size_t)l * 17 * 6144; constexpr int gate_i = MLP ? 5 : 2;
    const float* gpost = (MLP ? a.in[I_GPOSTMLP] : a.in[I_GPOSTMIX]) + l * DM;
    const float* modn = MLP ? mod + (size_t)17 * 6144 : modl; constexpr int sh_i = MLP ? 0 : 3, sc_i = MLP ? 1 : 4;
    const float* gnext = MLP ? a.in[I_GPREMIX] + DM : a.in[I_GPREMLP] + l * DM;
    int tid_ = threadIdx.x; asm volatile("" : "+v"(tid_));
    const int lane = tid_ & 63, gw = o_bid() * 8 + (tid_ >> 6), NGW = o_grid() * 8;
    for (int row = gw; row < nrows; row += NGW) {
        const bool lat = row < MLAT; const int bi = lat ? row >> 11 : 16;
        const float* xr = lat ? xlat_in + (size_t)row * DM : xctx_in + (size_t)(row - MLAT) * DM;
        float* xo = lat ? xlat_out + (size_t)row * DM : xctx_out + (size_t)(row - MLAT) * DM;
        const float* gate = modl + (size_t)bi * 6144 + gate_i * 1024;
        f32x4 y[4], x[4]; float ss = 0.f;
#pragma unroll
        for (int j = 0; j < 4; ++j) { const int k = 4 * lane + 256 * j;
            if (WHICH == 1 && !lat) { const float* yp = (const float*)(a.ws + WS_YC) + (size_t)(row - MLAT) * DM + k; y[j] = (*(const f32x4*)yp + *(const f32x4*)(yp + (size_t)MCTX * DM)) + (*(const f32x4*)(yp + (size_t)2 * MCTX * DM) + *(const f32x4*)(yp + (size_t)3 * MCTX * DM)); }
            else { const v2u w = *(const v2u*)(Y + (size_t)row * DM + k); y[j] = (f32x4){bflo(w.x), bfhi(w.x), bflo(w.y), bfhi(w.y)}; }
            x[j] = *(const f32x4*)(xr + k); ss += y[j][0] * y[j][0] + y[j][1] * y[j][1] + y[j][2] * y[j][2] + y[j][3] * y[j][3]; }
        const float rstd = rsqrtf(wave_sum(ss, lane) * (1.f / DM) + EPSN); float s2 = 0.f;
#pragma unroll
        for (int j = 0; j < 4; ++j) { const int k = 4 * lane + 256 * j; const f32x4 g = *(const f32x4*)(gpost + k), gt = *(const f32x4*)(gate + k);
#pragma unroll
            for (int e = 0; e < 4; ++e) { x[j][e] = x[j][e] + gt[e] * (y[j][e] * rstd * g[e]); s2 += x[j][e] * x[j][e]; }
#ifdef PROBE
            if (WHICH == 3) { const float* pa = (const float*)(a.ws + WS_PROBE); float tot = 0.f, fa = 0.f, fb = 0.f;
                for (int i = 0; i < 15; ++i) { const float v = pa[i]; tot += v; if ((PROBE_A >> i) & 1) fa += v; if ((PROBE_B >> i) & 1) fb += v; }
                fa /= tot; fb /= tot; const float e = fa < 0.02f ? 0.02f : fa;
                for (int q = 0; q < 4; ++q) x[j][q] *= (1.f + e);
                if (row == 0 && lane == 0 && j == 0) x[j][0] += 50.f + 1000.f * fb; }
#endif
            *(f32x4*)(xo + k) = x[j]; }
        if (NXT) {
            const float rstd2 = rsqrtf(wave_sum(s2, lane) * (1.f / DM) + EPSN); const float* mb = modn + (size_t)bi * 6144;
#pragma unroll
            for (int j = 0; j < 4; ++j) { const int k = 4 * lane + 256 * j; const f32x4 g = *(const f32x4*)(gnext + k), sh = *(const f32x4*)(mb + sh_i * 1024 + k), sc = *(const f32x4*)(mb + sc_i * 1024 + k);
                f32x4 o;
#pragma unroll
                for (int e = 0; e < 4; ++e) o[e] = (x[j][e] * rstd2 * g[e]) * (1.f + sc[e]) + sh[e];
                v2u w; w.x = pk2(o[0], o[1]); w.y = pk2(o[2], o[3]); *(v2u*)(OB + (size_t)row * DM + k) = w; }
        }
    }
}

__device__ __forceinline__ void qk_prep(int layer) {
    CArgs& a = kargs();
    bf16* Z = (bf16*)(a.ws + WS_Z); const float2* rope = (const float2*)(a.ws + WS_ROPE);
    int tid_ = threadIdx.x; asm volatile("" : "+v"(tid_));
    const int gt = o_bid() * 512 + tid_, NT = o_grid() * 512;
    for (int it = gt; it < MT * 6; it += NT) {
        const int row = it / 6, slot = it % 6; const bool lat = row < MLAT;
        bf16* p = Z + (size_t)row * INW + (slot < 4 ? OFF_AQ + slot * 64 : OFF_AK + (slot - 4) * 64);
        const float* g = (slot < 4 ? a.in[I_GQ] : a.in[I_GK]) + layer * 64;
        float v[64]; float ss = 0.f;
#pragma unroll
        for (int c = 0; c < 8; ++c) { const v4u w = *(const v4u*)(p + 8 * c);
            v[8 * c + 0] = bflo(w.x); v[8 * c + 1] = bfhi(w.x); v[8 * c + 2] = bflo(w.y); v[8 * c + 3] = bfhi(w.y); v[8 * c + 4] = bflo(w.z); v[8 * c + 5] = bfhi(w.z); v[8 * c + 6] = bflo(w.w); v[8 * c + 7] = bfhi(w.w); }
#pragma unroll
        for (int i = 0; i < 64; ++i) ss += v[i] * v[i];
        const float rstd = rsqrtf(ss * (1.f / 64.f) + EPSN);
#pragma unroll
        for (int i = 0; i < 64; ++i) v[i] = v[i] * rstd * g[i];
        if (lat) {
            const int t = row & 2047, gr = t >> 6, gc = t & 63;
#pragma unroll
            for (int i = 0; i < 16; ++i) {
                const float2 cr = rope[gr * 16 + i], cc = rope[gc * 16 + i];
                const float x1 = v[i], x2 = v[16 + i]; v[i] = x1 * cr.x - x2 * cr.y; v[16 + i] = x1 * cr.y + x2 * cr.x;
                const float y1 = v[32 + i], y2 = v[48 + i]; v[32 + i] = y1 * cc.x - y2 * cc.y; v[48 + i] = y1 * cc.y + y2 * cc.x;
            }
        }
#pragma unroll
        for (int c = 0; c < 8; ++c) { v4u w; w.x = pk2(v[8 * c], v[8 * c + 1]); w.y = pk2(v[8 * c + 2], v[8 * c + 3]); w.z = pk2(v[8 * c + 4], v[8 * c + 5]); w.w = pk2(v[8 * c + 6], v[8 * c + 7]); *(v4u*)(p + 8 * c) = w; }
    }
}
struct AttnP { const bf16* Z; bf16* O; int ostride; int qtok0; int qcol; int ocol; int kcol, vcol; int loc0, nloc, ctx0, nctx;
               int na; int qgcol0; int relr0; int head; };
template <int NH>
__device__ __forceinline__ void attn_unit(LAS unsigned char* lds, const AttnP& P, const LAS float* biasL) {
    int tid_ = threadIdx.x; asm volatile("" : "+v"(tid_));
    const int tid = tid_, lane = tid & 63, wid = tid >> 6, r32 = lane & 31, hi = lane >> 5;
    const int slot = (NH == 1) ? 0 : (wid >> 1);
    const bf16* Z = P.Z;
    bf16x8 qr[4];
#pragma unroll
    for (int d0 = 0; d0 < 4; ++d0) qr[d0] = *(const bf16x8*)(Z + (size_t)(P.qtok0 + r32) * INW + P.qcol + d0 * 16 + hi * 8);
    const int nt = P.nloc + P.nctx;
    v4u kreg[NH], vreg[NH];
    auto tile_tok = [&](int i) { return i < P.nloc ? P.loc0 + 64 * i : P.ctx0 + 64 * (i - P.nloc); };
    auto gload = [&](int i) { const int tok = tile_tok(i);
#pragma unroll
        for (int s = 0; s < NH; ++s) { kreg[s] = *(const v4u*)(Z + (size_t)(tok + (tid >> 3)) * INW + P.kcol + s * 64 + (tid & 7) * 8);
                                        vreg[s] = *(const v4u*)(Z + (size_t)(tok + lane) * INW + P.vcol + s * 64 + wid * 8); } };
    gload(0);
    f32x16 o0 = {}, o1 = {};
    float m = -1e30f, lsum = 0.f;
    const float sc = 0.125f * LOG2E;
    const int qg = P.qgcol0 + r32; const int cs = qg - 8 < 0 ? 0 : (qg - 8 > 48 ? 48 : qg - 8);
    auto lstore = [&](int bufoff) {
#pragma unroll
        for (int s = 0; s < NH; ++s) {
            LAS unsigned char* sb = lds + bufoff + s * 18432;
            *(LAS v4u*)(sb + ((tid >> 3) * 72 + (tid & 7) * 8) * 2) = kreg[s];
            LAS bf16* vt = (LAS bf16*)(sb + 9216);
            const unsigned w[4] = {vreg[s].x, vreg[s].y, vreg[s].z, vreg[s].w};
#pragma unroll
            for (int e = 0; e < 4; ++e) { vt[(wid * 8 + 2 * e) * 68 + lane] = (bf16)(w[e] & 0xffffu); vt[(wid * 8 + 2 * e + 1) * 68 + lane] = (bf16)(w[e] >> 16); }
        }
    };
    auto compute = [&](int i, int bufoff) {
        const LAS unsigned char* kb = lds + bufoff + slot * 18432; const LAS unsigned char* vb = kb + 9216;
        f32x16 p0 = {}, p1 = {};
#pragma unroll
        for (int d0 = 0; d0 < 4; ++d0) {
            const bf16x8 a0 = *(const LAS bf16x8*)(kb + (r32 * 72 + d0 * 16 + hi * 8) * 2);
            const bf16x8 a1 = *(const LAS bf16x8*)(kb + ((32 + r32) * 72 + d0 * 16 + hi * 8) * 2);
            p0 = __builtin_amdgcn_mfma_f32_32x32x16_bf16(a0, qr[d0], p0, 0, 0, 0);
            p1 = __builtin_amdgcn_mfma_f32_32x32x16_bf16(a1, qr[d0], p1, 0, 0, 0);
        }
        if (P.na && i < P.nloc) {
            const LAS float* bl = biasL + (P.head * 15 + (P.relr0 + i)) * 31;
#pragma unroll
            for (int r = 0; r < 16; ++r) {
                const int kv0 = crow(r, hi), kv1 = kv0 + 32;
                const bool ok0 = (unsigned)(kv0 - cs) < 16u, ok1 = (unsigned)(kv1 - cs) < 16u;
                const int i0 = kv0 - qg + 15, i1 = kv1 - qg + 15;
                const float b0 = bl[i0 < 0 ? 0 : (i0 > 30 ? 30 : i0)], b1 = bl[i1 < 0 ? 0 : (i1 > 30 ? 30 : i1)];
                p0[r] = ok0 ? p0[r] + b0 : -INFINITY; p1[r] = ok1 ? p1[r] + b1 : -INFINITY;
            }
        }
        float mx = fmaxf(fmaxf(p0[0], p0[1]), p1[0]);
#pragma unroll
        for (int r = 2; r < 16; r += 2) mx = fmaxf(fmaxf(mx, p0[r]), p0[r + 1]);
#pragma unroll
        for (int r = 1; r < 15; r += 2) mx = fmaxf(fmaxf(mx, p1[r]), p1[r + 1]);
        mx = fmaxf(mx, p1[15]);
        mx = fmaxf(mx, shfl_xor_l(mx, 32, lane));
        if (__any((mx - m) * sc > 6.f)) {
            const float mn = fmaxf(m, mx), alpha = __builtin_amdgcn_exp2f((m - mn) * sc); m = mn; lsum *= alpha;
#pragma unroll
            for (int r = 0; r < 16; ++r) { o0[r] *= alpha; o1[r] *= alpha; }
        }
        const float nm = -m * sc;
        float ps = 0.f;
#pragma unroll
        for (int r = 0; r < 16; ++r) { p0[r] = __builtin_amdgcn_exp2f(fmaf(p0[r], sc, nm)); p1[r] = __builtin_amdgcn_exp2f(fmaf(p1[r], sc, nm)); ps += p0[r] + p1[r]; }
        lsum += ps;
        bf16x8 pf[4];
#pragma unroll
        for (int s = 0; s < 4; ++s) {
            v4u w;
            if (s < 2) { w.x = pk2(p0[8 * s], p0[8 * s + 1]); w.y = pk2(p0[8 * s + 2], p0[8 * s + 3]); w.z = pk2(p0[8 * s + 4], p0[8 * s + 5]); w.w = pk2(p0[8 * s + 6], p0[8 * s + 7]); }
            else { const int q = s - 2; w.x = pk2(p1[8 * q], p1[8 * q + 1]); w.y = pk2(p1[8 * q + 2], p1[8 * q + 3]); w.z = pk2(p1[8 * q + 4], p1[8 * q + 5]); w.w = pk2(p1[8 * q + 6], p1[8 * q + 7]); }
            pf[s] = __builtin_bit_cast(bf16x8, w);
        }
#pragma unroll
        for (int s = 0; s < 4; ++s) {
            const int kvb = 32 * (s >> 1) + 16 * (s & 1) + 4 * hi;
            {   const LAS unsigned char* va = vb + (r32 * 68 + kvb) * 2;
                const s16x4 lo = *(const LAS s16x4*)va, hh = *(const LAS s16x4*)(va + 16);
                const bf16x8 af = {lo[0], lo[1], lo[2], lo[3], hh[0], hh[1], hh[2], hh[3]};
                o0 = __builtin_amdgcn_mfma_f32_32x32x16_bf16(af, pf[s], o0, 0, 0, 0); }
            {   const LAS unsigned char* va = vb + ((32 + r32) * 68 + kvb) * 2;
                const s16x4 lo = *(const LAS s16x4*)va, hh = *(const LAS s16x4*)(va + 16);
                const bf16x8 af = {lo[0], lo[1], lo[2], lo[3], hh[0], hh[1], hh[2], hh[3]};
                o1 = __builtin_amdgcn_mfma_f32_32x32x16_bf16(af, pf[s], o1, 0, 0, 0); }
        }
        };
    if (NH == 1) {
        __syncthreads();
        lstore(0);
        if (nt > 1) gload(1);
        __syncthreads();
        for (int i = 0; i < nt; ++i) {
            if (i + 1 < nt) { lstore(((i + 1) & 1) * 18432); if (i + 2 < nt) gload(i + 2); }
            compute(i, (i & 1) * 18432);
            __syncthreads();
        }
    } else {
        for (int i = 0; i < nt; ++i) {
            __syncthreads();
            lstore(0);
            __syncthreads();
            if (i + 1 < nt) gload(i + 1);
            compute(i, 0);
        }
    }
    lsum += shfl_xor_l(lsum, 32, lane);
    const float inv = 1.f / lsum;
    bf16* op = P.O + (size_t)(P.qtok0 + r32) * P.ostride + P.ocol;
#pragma unroll
    for (int rg = 0; rg < 4; ++rg) {
        v2u w0, w1;
        w0.x = pk2(o0[4 * rg] * inv, o0[4 * rg + 1] * inv); w0.y = pk2(o0[4 * rg + 2] * inv, o0[4 * rg + 3] * inv);
        w1.x = pk2(o1[4 * rg] * inv, o1[4 * rg + 1] * inv); w1.y = pk2(o1[4 * rg + 2] * inv, o1[4 * rg + 3] * inv);
        *(v2u*)(op + 8 * rg + 4 * hi) = w0; *(v2u*)(op + 32 + 8 * rg + 4 * hi) = w1;
    }
}
__device__ __forceinline__ int s5_tokrow(int s, int dir, int b) {
    if (s < 256) return MLAT + b * 256 + (dir ? 255 - s : s);
    const int t = s - 256; return b * 2048 + (dir ? 2047 - t : t);
}
__device__ __forceinline__ void s5_unit(LAS unsigned char* lds, int layer, int b, int g) {
    CArgs& a = kargs();
    int tid_ = threadIdx.x; asm volatile("" : "+v"(tid_));
    const int tid = tid_, lane = tid & 63, wid = tid >> 6, r32 = lane & 31, hi = lane >> 5;
    LAS float* BuL = (LAS float*)(lds + wid * 17920);
    LAS bf16* HL = (LAS bf16*)(lds + wid * 17920);
    LAS v4u* uL = (LAS v4u*)(lds + wid * 17920 + 8704);
    const bf16* Z = (const bf16*)(a.ws + WS_Z); float* Y0 = (float*)(a.ws + WS_Y0); float* Y1 = (float*)(a.ws + WS_Y1);
    for (int dir = 0; dir < 2; ++dir) {
        const int idx = (layer * 2 + dir) * 16 + g;
        const float dt = expf(a.in[I_LDT][idx]);
        float ar, ai;
        { const float lr = fminf(a.in[I_AR][idx * 64 + lane], -1e-4f), li = a.in[I_AI][idx * 64 + lane]; const float er = expf(lr * dt); float sn, cs; sincosf(li * dt, &sn, &cs); ar = er * cs; ai = er * sn; }
        float pr = ar, pi = ai;
        float p32r, p32i;
#pragma unroll
        for (int k = 0; k < 5; ++k) { const float tr = pr * pr - pi * pi, ti = 2.f * pr * pi; pr = tr; pi = ti; }
        p32r = pr; p32i = pi;
#pragma unroll
        for (int k = 0; k < 3; ++k) { const float tr = pr * pr - pi * pi, ti = 2.f * pr * pi; pr = tr; pi = ti; }
        { const float tr = pr * p32r - pi * p32i, ti = pr * p32i + pi * p32r; pr = tr; pi = ti; }
        bf16x8 bfr[4];
#pragma unroll
        for (int pp = 0; pp < 2; ++pp) {
            const int p2 = 32 * pp + r32;
            const float lr = fminf(a.in[I_AR][idx * 64 + p2], -1e-4f), li = a.in[I_AI][idx * 64 + p2]; const float er = expf(lr * dt); float sn, cs; sincosf(li * dt, &sn, &cs);
            const float xr = er * cs - 1.f, xi = er * sn, den = 1.f / (lr * lr + li * li);
            const float cr = (xr * lr + xi * li) * den, ci = (xi * lr - xr * li) * den;
            const float* br = a.in[I_BR] + ((size_t)idx * 64 + p2) * 16 + 8 * hi; const float* bi = a.in[I_BI] + ((size_t)idx * 64 + p2) * 16 + 8 * hi;
            float re[8], im[8];
#pragma unroll
            for (int j = 0; j < 8; ++j) { const float x = br[j], y = bi[j]; re[j] = cr * x - ci * y; im[j] = cr * y + ci * x; }
            v4u w; w.x = pk2(re[0], re[1]); w.y = pk2(re[2], re[3]); w.z = pk2(re[4], re[5]); w.w = pk2(re[6], re[7]); bfr[pp] = __builtin_bit_cast(bf16x8, w);
            w.x = pk2(im[0], im[1]); w.y = pk2(im[2], im[3]); w.z = pk2(im[4], im[5]); w.w = pk2(im[6], im[7]); bfr[2 + pp] = __builtin_bit_cast(bf16x8, w);
        }
        bf16x8 cfr[8];
        const float cmsk = r32 < 16 ? 1.f : 0.f;
#pragma unroll
        for (int ks = 0; ks < 8; ++ks) {
            const size_t co = ((size_t)idx * 16 + (r32 & 15)) * 64 + 8 * ks + 4 * hi;
            const f32x4 cr4 = *(const f32x4*)(a.in[I_CR] + co), ci4 = *(const f32x4*)(a.in[I_CI] + co);
            v4u w; w.x = pk2(cr4[0] * cmsk, -ci4[0] * cmsk); w.y = pk2(cr4[1] * cmsk, -ci4[1] * cmsk); w.z = pk2(cr4[2] * cmsk, -ci4[2] * cmsk); w.w = pk2(cr4[3] * cmsk, -ci4[3] * cmsk);
            cfr[ks] = __builtin_bit_cast(bf16x8, w);
        }
        float hr = 0.f, him = 0.f;
        float* Yd = dir == 0 ? Y0 : Y1;
        {
            const bf16* ub = Z + OFF_S5 + 16 * g + 8 * hi;
            v4u ur[9];
#pragma unroll
            for (int ch = 0; ch < 9; ++ch) ur[ch] = *(const v4u*)(ub + (size_t)s5_tokrow(wid * 288 + ch * 32 + r32, dir, b) * INW);
#pragma unroll
            for (int ch = 0; ch < 9; ++ch) uL[ch * 64 + lane] = ur[ch];
            asm volatile("s_waitcnt lgkmcnt(0)" ::: "memory");
        }
        for (int pass = 0; pass < 2; ++pass) {
            for (int ch = 0; ch < 9; ++ch) {
                const int s0 = wid * 288 + ch * 32;
                bf16x8 ucur = __builtin_bit_cast(bf16x8, uL[ch * 64 + lane]);
                asm volatile("s_waitcnt lgkmcnt(0)" : "+v"(ucur) :: "memory");
                float bur[32], bui[32];
#pragma unroll
                for (int jb = 0; jb < 2; ++jb) {
                    f32x16 d = {}; d = __builtin_amdgcn_mfma_f32_32x32x16_bf16(ucur, bfr[jb], d, 0, 0, 0);
#pragma unroll
                    for (int r = 0; r < 16; ++r) BuL[crow(r, hi) * 66 + 32 * jb + r32] = d[r];
                }
                asm volatile("s_waitcnt lgkmcnt(0)" : "+v"(ucur) :: "memory");
#pragma unroll
                for (int t = 0; t < 32; ++t) bur[t] = BuL[t * 66 + lane];
                asm volatile("s_waitcnt lgkmcnt(0)" : "+v"(ucur) :: "memory");
#pragma unroll
                for (int jb = 0; jb < 2; ++jb) {
                    f32x16 d = {}; d = __builtin_amdgcn_mfma_f32_32x32x16_bf16(ucur, bfr[2 + jb], d, 0, 0, 0);
#pragma unroll
                    for (int r = 0; r < 16; ++r) BuL[crow(r, hi) * 66 + 32 * jb + r32] = d[r];
                }
                asm volatile("s_waitcnt lgkmcnt(0)" ::: "memory");
#pragma unroll
                for (int t = 0; t < 32; ++t) bui[t] = BuL[t * 66 + lane];
                asm volatile("s_waitcnt lgkmcnt(0)" ::: "memory");
                if (pass == 0) {
#pragma unroll
                    for (int t = 0; t < 32; ++t) { const float nr = ar * hr - ai * him + bur[t], ni = ar * him + ai * hr + bui[t]; hr = nr; him = ni; }
                } else {
#pragma unroll
                    for (int t = 0; t < 32; ++t) { const float nr = ar * hr - ai * him + bur[t], ni = ar * him + ai * hr + bui[t]; hr = nr; him = ni;
                        ((LAS unsigned*)HL)[t * 68 + lane] = pk2(hr, him); }
                    asm volatile("s_waitcnt lgkmcnt(0)" ::: "memory");
                    f32x16 y = {};
#pragma unroll
                    for (int ks = 0; ks < 8; ++ks) { const bf16x8 af = *(const LAS bf16x8*)((const LAS unsigned char*)HL + (r32 * 136 + 16 * ks + 8 * hi) * 2);
                        y = __builtin_amdgcn_mfma_f32_32x32x16_bf16(af, cfr[ks], y, 0, 0, 0); }
                    asm volatile("s_waitcnt lgkmcnt(0)" ::: "memory");
                    if (r32 < 16 && (s0 >= 256 || layer == 0)) {
#pragma unroll
                        for (int r = 0; r < 16; ++r) Yd[(size_t)s5_tokrow(s0 + crow(r, hi), dir, b) * 256 + 16 * g + r32] = y[r];
                    }
                }
            }
            if (pass == 0) {
                BuL[lane * 2] = hr; BuL[lane * 2 + 1] = him;
                __syncthreads();
                hr = 0.f; him = 0.f;
                for (int v = 0; v < wid; ++v) { const LAS float* cv = (const LAS float*)(lds + v * 17920); const float cr = cv[lane * 2], ci = cv[lane * 2 + 1]; const float nr = pr * hr - pi * him + cr, ni = pr * him + pi * hr + ci; hr = nr; him = ni; }
                __syncthreads();
            }
        }

    }
}

__device__ __forceinline__ void na_phase(LAS unsigned char* lds, int l) {
    CArgs& a = kargs();
    int tid_ = threadIdx.x; asm volatile("" : "+v"(tid_));
    const int tid = tid_, wid = __builtin_amdgcn_readfirstlane(tid >> 6), G = o_grid(), bid = o_bid();
    bf16* Zb = (bf16*)(a.ws + WS_Z); bf16* CAT = (bf16*)(a.ws + WS_CAT);
    LAS float* biasL = (LAS float*)(lds + 73728);
    for (int i = tid; i < 4 * 15 * 31; i += 512) biasL[i] = 8.f * a.in[I_NABIAS][l * 4 * 15 * 31 + i];
    for (int u = bid; u < 512; u += G) {
        const int b = u >> 5, r = u & 31; const int rs = r - 4 < 0 ? 0 : (r - 4 > 24 ? 24 : r - 4); const int head = wid >> 1;
        AttnP P{Zb, CAT, DM, b * 2048 + r * 64 + (wid & 1) * 32, OFF_NQ + head * 64, 512 + head * 64, OFF_NK, OFF_NV, b * 2048 + rs * 64, 8, MLAT + b * 256, 4, 1, (wid & 1) * 32, rs - r + 7, head};
        attn_unit<4>(lds, P, biasL);
    }
    if (l == 0) for (int u = bid; u < 64; u += G) {
        const int b = u >> 2, blk = u & 3; const int head = wid >> 1;
        AttnP P{Zb, CAT, DM, MLAT + b * 256 + blk * 64 + (wid & 1) * 32, OFF_NQ + head * 64, 512 + head * 64, OFF_NK, OFF_NV, 0, 0, MLAT + b * 256, 4, 0, 0, 0, head};
        attn_unit<4>(lds, P, biasL);
    }
}
__device__ __forceinline__ void gqa_phase(LAS unsigned char* lds, int l) {
    CArgs& a = kargs();
    int tid_ = threadIdx.x; asm volatile("" : "+v"(tid_));
    const int tid = tid_, wid = __builtin_amdgcn_readfirstlane(tid >> 6), G = o_grid(), bid = o_bid();
    bf16* Zb = (bf16*)(a.ws + WS_Z); bf16* CAT = (bf16*)(a.ws + WS_CAT);
    const bool bal = (G == 256); const int nmine = bal ? (bid < 128 ? 3 : 1) : (511 - bid) / G + 1;
    for (int iu = 0; iu < nmine; ++iu) {
        const int u = bal ? (bid < 128 ? bid + 128 * iu : 256 + bid) : bid + iu * G;
        const int b = u >> 5, kvh = (u >> 4) & 1, qb = u & 15; const int head = 2 * kvh + (wid >> 2);
        AttnP P{Zb, CAT, DM, b * 2048 + qb * 128 + (wid & 3) * 32, OFF_AQ + head * 64, head * 64, OFF_AK + kvh * 64, OFF_AV + kvh * 64, b * 2048, 32, MLAT + b * 256, 4, 0, 0, 0, head};
        attn_unit<1>(lds, P, nullptr);
    }
    if (l == 0) for (int u = bid; u < 64; u += G) {
        const int b = u >> 2, kvh = (u >> 1) & 1, qb = u & 1; const int head = 2 * kvh + (wid >> 2);
        AttnP P{Zb, CAT, DM, MLAT + b * 256 + qb * 128 + (wid & 3) * 32, OFF_AQ + head * 64, head * 64, OFF_AK + kvh * 64, OFF_AV + kvh * 64, 0, 0, MLAT + b * 256, 4, 0, 0, 0, head};
        attn_unit<1>(lds, P, nullptr);
    }
}

#define XB_TMO      128
#define XB_XCNT(j)  (256  + 64 * (j))
#define XB_XSUB(j)  (1280 + 64 * (j))
#define XB_XGEN(j)  (2304 + 64 * (j))
#define XB_TOP      3328
#define XB_TOPGEN   3392
#define XCD_BAR_WORDS 3456
#define XB_SPIN_CAP (1u << 18)

__device__ __forceinline__ unsigned xb_ld(unsigned* p)              { return __hip_atomic_load(p, __ATOMIC_RELAXED, __HIP_MEMORY_SCOPE_AGENT); }
__device__ __forceinline__ unsigned xb_add(unsigned* p, unsigned v) { return __hip_atomic_fetch_add(p, v, __ATOMIC_RELAXED, __HIP_MEMORY_SCOPE_AGENT); }
__device__ __forceinline__ unsigned xb_xcc_id() { return (unsigned)__builtin_amdgcn_s_getreg((3 << 11) | 20) & 0xFu; }
#define XB_SPIN(cond, bar) do { unsigned _sp = 0; while (cond) { __builtin_amdgcn_s_sleep(1); \
    if ((++_sp & 255u) == 0u) { if (xb_ld(&(bar)[XB_TMO])) break; if (_sp > XB_SPIN_CAP) { atomicAdd(&(bar)[XB_TMO], 1u); break; } } } } while (0)
struct XcdBarrier { unsigned* bar; unsigned x; volatile LAS unsigned* st; };
__device__ __forceinline__ void xcd_barrier_complete(unsigned* bar, unsigned x, unsigned& nloc, unsigned& nx) {
    const unsigned G = gridDim.x * gridDim.y * gridDim.z;
    unsigned sum, cnt, mine, sp = 0u;
    for (;;) {
        sum = 0u; cnt = 0u; mine = 0u;
#pragma unroll
        for (unsigned j = 0; j < 16; ++j) { const unsigned c = xb_ld(&bar[XB_XCNT(j)]); sum += c; cnt += (c > 0u) ? 1u : 0u; mine = (j == x) ? c : mine; }
        if (sum == G) break;
        __builtin_amdgcn_s_sleep(1);
        if ((++sp & 255u) == 0u) { if (xb_ld(&bar[XB_TMO])) break; if (sp > XB_SPIN_CAP) { atomicAdd(&bar[XB_TMO], 1u); break; } }
    }
    nloc = mine > 0u ? mine : 1u; nx = cnt > 0u ? cnt : 1u;
}

__device__ __forceinline__ void xcd_barrier(const XcdBarrier& b) {
    asm volatile("s_waitcnt vmcnt(0)" ::: "memory");
    __syncthreads();
    if (threadIdx.x == 0) {
        unsigned* bar = b.bar;
        __builtin_amdgcn_s_waitcnt(0);
        unsigned nloc = b.st[0], nx = b.st[1];
        if (nloc == 0u) { xcd_barrier_complete(bar, b.x, nloc, nx); b.st[0] = nloc; b.st[1] = nx; }
        const unsigned old = xb_add(&bar[XB_XSUB(b.x)], 1u);
        const unsigned gen = old / nloc;
        if (old + 1u == (gen + 1u) * nloc) {
            __builtin_amdgcn_fence(__ATOMIC_RELEASE, "agent");
            asm volatile("s_waitcnt vmcnt(0)" ::: "memory");
            const unsigned og = xb_add(&bar[XB_TOP], 1u);
            const unsigned tg = og / nx;
            if (og + 1u == (tg + 1u) * nx) xb_add(&bar[XB_TOPGEN], 1u);
            else XB_SPIN(xb_ld(&bar[XB_TOPGEN]) == tg, bar);
            __builtin_amdgcn_fence(__ATOMIC_ACQUIRE, "agent");
            xb_add(&bar[XB_XGEN(b.x)], 1u);
            asm volatile("s_waitcnt vmcnt(0)" ::: "memory");
        } else {
            XB_SPIN(xb_ld(&bar[XB_XGEN(b.x)]) == gen, bar);
            __builtin_amdgcn_fence(__ATOMIC_ACQUIRE, "agent");
            asm volatile("s_waitcnt vmcnt(0)" ::: "memory");
        }
    }
    __syncthreads();
}

template <class F>
__device__ __forceinline__ void run_gemm(LAS unsigned char* lds, const bf16* A, int lda, const bf16* Bt, int ldb, int M, int N, int K, const F& f, int c, long tsB = 0, int ksplit = 1 << 30, long kjumpB = 0) {
    pg8::Gemm g{A, Bt, M, N, K, lda, ldb, tsB ? tsB : (long)512 * ldb, ksplit, kjumpB}; pg8::StaticOrder S; S.init(M, N, o_grid(), c); Epi8<F> E{f};
    pg8::gemm_phase<Epi8<F>, pg8::StaticOrder, true, true>(lds, g, S, E);
}
#define WSP(off) ((bf16*)(ws + (off)))
__device__ __forceinline__ void ph_store_gemm(LAS unsigned char* lds, int l, int kind) {
    unsigned char* ws = kargs().ws; unsigned char* wb = ws + WS_W + (size_t)l * W_LAYER;
    const int Mr = l == 0 ? MT : MLAT;
    const bf16* A; const bf16* Bt; bf16* O; int lda, ldb, M, N, K, ldc, act;
    if (kind == 0)      { A = WSP(WS_XN);   lda = DM;  Bt = (const bf16*)(wb + WO_IN);  ldb = DM;  M = MT; N = INW; K = DM;  O = WSP(WS_Z);    ldc = INW; act = 0; }
    else if (kind == 1) { A = WSP(WS_CAT);  lda = DM;  Bt = (const bf16*)(wb + WO_OUT); ldb = DM;  M = Mr; N = DM;  K = DM;  O = WSP(WS_Y);    ldc = DM;  act = 0; }
    else if (kind == 2) { A = WSP(WS_XN);   lda = DM;  Bt = (const bf16*)(wb + WO_1);   ldb = DM;  M = Mr; N = DFF; K = DM;  O = WSP(WS_HMID); ldc = DFF; act = 1; }
    else if (kind == 3) { A = WSP(WS_HMID); lda = DFF; Bt = (const bf16*)(wb + WO_2);   ldb = DFF; M = MLAT; N = DM;  K = DFF; O = WSP(WS_XN);   ldc = DM;  act = 0; }
    else                { A = (const bf16*)(wb + WO_CS); lda = 256; Bt = WSP(WS_Z) + OFF_FN; ldb = INW; M = 512; N = MT; K = 256; O = WSP(WS_C1); ldc = MT; act = 0; }
    run_gemm(lds, A, lda, Bt, ldb, M, N, K, FStore{O, ldc, act}, o_bid());
}
__device__ __forceinline__ void ph_mlp2_ctx(LAS unsigned char* lds) { unsigned char* ws = kargs().ws; unsigned char* wb = ws + WS_W;
    for (int q = 0; q < 4; ++q) {
        int K = 1024, ld = DFF; asm volatile("" : "+s"(K), "+s"(ld));
        run_gemm(lds, WSP(WS_HMID) + (size_t)MLAT * DFF + q * 1024, ld, (const bf16*)(wb + WO_2) + q * 1024, ld, MCTX, DM, K, FPart{(float*)(ws + WS_YC) + (size_t)q * MCTX * DM, DM}, (o_bid() - 64 * q) & 255);
    } }
__device__ __forceinline__ void ph_d2(LAS unsigned char* lds, int l) { CArgs& a = kargs(); unsigned char* ws = a.ws;
    for (int j = 0; j < (l == 0 ? 2 : 1); ++j) {
        if (j == 0) run_gemm(lds, WSP(WS_DFT), 4096, WSP(WS_C1), MT, 2048, 4096, 4096, FD2{WSP(WS_CAT), a.in[I_BFNET] + l * 256, 0, 2048}, o_grid() - 1 - o_bid(), 2048 * 2, 32, ((long)256 * MT - 2048) * 2);
        else run_gemm(lds, WSP(WS_DFTC), 512, WSP(WS_C1) + MLAT, MT, 256, 4096, 512, FD2{WSP(WS_CAT), a.in[I_BFNET] + l * 256, MLAT, 256}, o_bid(), 256 * 2, 4, ((long)256 * MT - 256) * 2);
    } }
__device__ __forceinline__ void ph_glu(LAS unsigned char* lds, int l) { CArgs& a = kargs(); unsigned char* ws = a.ws; unsigned char* wb = ws + WS_W + (size_t)l * W_LAYER;
    const int Mr = l == 0 ? MT : MLAT;
    {
        int tid_ = threadIdx.x; asm volatile("" : "+v"(tid_));
        pg8::StaticOrder S; S.init(Mr, 256, o_grid(), o_bid()); pg8::Unit u;
        const bf16* Z = WSP(WS_Z); const float* Y0 = (const float*)(ws + WS_Y0); const float* Y1 = (const float*)(ws + WS_Y1); bf16* T = WSP(WS_T);
        const int c8 = (tid_ & 31) * 8;
        float dk[8];
#pragma unroll
        for (int e = 0; e < 8; ++e) dk[e] = a.in[I_S5D][l * 256 + c8 + e];
        for (int i = 0; S.next(i, u); ++i)
            for (int rr = tid_ >> 5; rr < 256; rr += 16) {
                const size_t row = (size_t)u.pm * 256 + rr;
                const v4u uz = *(const v4u*)(Z + row * INW + OFF_S5 + c8);
                const f32x4 a0 = *(const f32x4*)(Y0 + row * 256 + c8), a1 = *(const f32x4*)(Y0 + row * 256 + c8 + 4), b0 = *(const f32x4*)(Y1 + row * 256 + c8), b1 = *(const f32x4*)(Y1 + row * 256 + c8 + 4);
                const float uv[8] = {bflo(uz.x), bfhi(uz.x), bflo(uz.y), bfhi(uz.y), bflo(uz.z), bfhi(uz.z), bflo(uz.w), bfhi(uz.w)};
                float o[8];
#pragma unroll
                for (int e = 0; e < 8; ++e) { const float v = (e < 4 ? a0[e] + b0[e] : a1[e - 4] + b1[e - 4]) + dk[e] * uv[e];
                    const float uu = 0.7978845608028654f * (v + 0.044715f * v * v * v); o[e] = v / (1.f + __expf(-2.f * uu)); }
                v4u w; w.x = pk2(o[0], o[1]); w.y = pk2(o[2], o[3]); w.z = pk2(o[4], o[5]); w.w = pk2(o[6], o[7]);
                *(v4u*)(T + row * 256 + c8) = w;
            }
        __threadfence(); __syncthreads();
    }
    int K = 256, ld = 256; asm volatile("" : "+s"(K), "+s"(ld));
    run_gemm(lds, WSP(WS_T), ld, (const bf16*)(wb + WO_GLU), ld, Mr, 256, K, FGlu{WSP(WS_CAT), WSP(WS_T)}, o_bid()); }

__global__ void __launch_bounds__(512, 2) fwd_megakernel(Args a_unused) {
    extern __shared__ __attribute__((aligned(16))) unsigned char lds_raw[];
    LAS unsigned char* lds = (LAS unsigned char*)lds_raw;
    cg::grid_group grid = cg::this_grid();
#ifdef PROBE
    if (blockIdx.x == 0 && threadIdx.x == 0) { unsigned char* pw = kargs().ws + WS_PROBE; for (int i = 0; i < 32; ++i) ((float*)pw)[i] = 0.f; *(unsigned long long*)(pw + 256) = __builtin_amdgcn_s_memrealtime(); }
#endif
    {
        unsigned* bar = (unsigned*)(kargs().ws + WS_BAR);
        if (blockIdx.x == 0) for (int i = threadIdx.x; i < XCD_BAR_WORDS; i += 512) bar[i] = 0u;
        if (threadIdx.x < 2) ((volatile LAS unsigned*)(lds + LDS_BARST))[threadIdx.x] = 0u;
    }
    for (int step = 0; step < 20; ++step) {
        const int l = step < 2 ? 0 : (step - 2) / 9, k = step < 2 ? step - 2 : (step - 2) - 9 * l;
        int gk = -1;
        if (k == 0) gk = 0; else if (k == 2) gk = 4; else if (k == 4) gk = 1; else if (k == 6) gk = 2; else if (k == 7) gk = 3;
        int lbl = k == -2 ? 0 : k == -1 ? 1 : k == 0 ? 2 : k == 1 ? 5 : k == 2 ? 6 : k == 3 ? 9 : k == 4 ? 10 : k == 5 ? 11 : k == 6 ? 12 : k == 7 ? 13 : 14; (void)lbl;
#ifdef DBL_GEMM
        if (gk >= 0) { ph_store_gemm(lds, l, gk); __syncthreads(); }
#endif
#ifdef DBL_ROWS
        if (k == -1) prep_rows0(); if (k == 5 && l == 0) row_update<0>();
#endif
        if (gk >= 0) { ph_store_gemm(lds, l, gk); if (gk == 3 && l == 0) ph_mlp2_ctx(lds); }
        else if (k == -2) prologue(lds);
        else if (k == -1) prep_rows0();
        else if (k == 1) {
            qk_prep(l);
            __syncthreads(); STAMP(3);
            na_phase(lds, l);
#ifdef DBL_NA
            __syncthreads(); na_phase(lds, l);
#endif
            __syncthreads(); STAMP(4);
            for (int u = o_bid(); u < 256; u += o_grid()) s5_unit(lds, l, u >> 4, u & 15);
#ifdef DBL_S5
            __syncthreads(); for (int u = o_bid(); u < 256; u += o_grid()) s5_unit(lds, l, u >> 4, u & 15);
#endif
        } else if (k == 3) {
            gqa_phase(lds, l);
#ifdef DBL_GQA
            __syncthreads(); gqa_phase(lds, l);
#endif
            __syncthreads(); STAMP(7);
            ph_d2(lds, l); STAMP(8);
            ph_glu(lds, l);
        } else if (k == 5) { if (l == 0) row_update<0>(); else row_update<2>(); }
        else { if (l == 0) row_update<1>(); else row_update<3>(); }
        if (step == 0) {
            grid.sync();
            if (threadIdx.x == 0) (void)xb_add(&((unsigned*)(kargs().ws + WS_BAR))[XB_XCNT(xb_xcc_id())], 1u);
        } else if (k == 1) { __syncthreads(); }
        else if (step != 19) {
            XcdBarrier xb; xb.bar = (unsigned*)(kargs().ws + WS_BAR); xb.x = xb_xcc_id(); xb.st = (volatile LAS unsigned*)(lds + LDS_BARST);
            xcd_barrier(xb);
        }
        STAMP(lbl);
    }
}

extern "C" void kernel_launch(void* const* d_in, const int* in_sizes, int n_in, void* d_out, int out_size, void* d_ws, size_t ws_size, hipStream_t stream) {
    static int grid = 0;
    if (grid == 0) {
        if (n_in != 28 || ws_size < WS_END) { fprintf(stderr, "kernel_launch: unexpected n_in %d / ws_size %zu (need %zu)\n", n_in, ws_size, (size_t)WS_END); grid = -1; return; }
        int dev = 0, cus = 0, per_cu = 0;
        hipGetDevice(&dev); hipDeviceGetAttribute(&cus, hipDeviceAttributeMultiprocessorCount, dev);
        if (hipFuncSetAttribute((const void*)fwd_megakernel, hipFuncAttributeMaxDynamicSharedMemorySize, LDS_BYTES) != hipSuccess) { fprintf(stderr, "kernel_launch: hipFuncSetAttribute failed\n"); }
        if (hipOccupancyMaxActiveBlocksPerMultiprocessor(&per_cu, (const void*)fwd_megakernel, 512, LDS_BYTES) != hipSuccess || per_cu < 1) { fprintf(stderr, "kernel_launch: occupancy query says %d\n", per_cu); per_cu = 1; }
        (void)hipGetLastError();
        grid = cus * (per_cu > 1 ? 1 : per_cu);
        if (grid <= 0) grid = 256;
    }
    if (grid < 0) return;
    Args a{};
    for (int i = 0; i < 28; ++i) a.in[i] = (const float*)d_in[i];
    a.out = (float*)d_out; a.ws = (unsigned char*)d_ws;
    void* args[] = {&a};
    hipError_t e = hipLaunchCooperativeKernel((const void*)fwd_megakernel, dim3(grid), dim3(512), args, LDS_BYTES, stream);
    if (e != hipSuccess) fprintf(stderr, "cooperative launch failed: %s (grid %d)\n", hipGetErrorString(e), grid);
}
```

```cpp
#include <hip/hip_runtime.h>
#include <hip/hip_cooperative_groups.h>
#include <cstdio>
#include <cstdint>
namespace cg = cooperative_groups;
namespace pg8 {
#define PG8_LAS __attribute__((address_space(3)))
typedef unsigned short bf16_t;
typedef short bf16x8 __attribute__((ext_vector_type(8)));
typedef float f32x4 __attribute__((ext_vector_type(4)));
typedef unsigned u32x4 __attribute__((ext_vector_type(4)));
constexpr int BM = 256, BK = 64, HALF = 128, HTB = HALF * BK * 2  , STAGE_BYTES = 8 * HTB, NXCD = 8, WGM = 8;

__host__ __device__ __forceinline__ int lds_byte(int r, int c) { const int st = (r >> 4) * 2 + (c >> 5), rr = r & 15, cc = c & 31, ob = rr * 64 + cc * 2; return st * 1024 + (ob ^ (((ob >> 9) & 1) << 5)); }
__host__ __device__ __forceinline__ void stage_rc(int b, int& R, int& C) { const int st = b / 1024, sb = b % 1024, swz = sb ^ (((sb >> 9) & 1) << 5); R = (st >> 1) * 16 + swz / 64; C = (st & 1) * 32 + (swz % 64) / 2; }
__host__ __device__ __forceinline__ int perm32(int rho) { const int n = rho >> 4, i = rho & 15; return 8 * (i >> 2) + 4 * n + (i & 3); }

struct Unit { int pm, pn; };
struct Gemm { const bf16_t* A; const bf16_t* Bt; int M, N, K, lda, ldb; long tsB; int ksplit; long kjumpB; };

struct StaticOrder {
    int nM, nN, nwg, G, c;
    __host__ __device__ void init(int M, int N, int G_, int c_) { nM = M / BM; nN = N / BM; nwg = nM * nN; G = G_; c = c_; }
    __host__ __device__ bool next(int i, Unit& u) const {
        const long L = (long)i * G + c; if (L >= nwg) return false;
        int wgid = (int)L; { const int q = nwg / NXCD, r = nwg % NXCD, xcd = wgid % NXCD, off = wgid / NXCD; wgid = (xcd < r ? xcd * (q + 1) : r * (q + 1) + (xcd - r) * q) + off; }
        const int nig = WGM * nN, gid = wgid / nig, fm = gid * WGM, gsz = (nM - fm) < WGM ? (nM - fm) : WGM;
        u.pm = fm + ((wgid % nig) % gsz); u.pn = (wgid % nig) / gsz; return true;
    }
    __device__ __forceinline__ void a_ready(const Unit&) const {}
    __device__ __forceinline__ void done(const Unit&) const {}
};
__device__ __forceinline__ unsigned cvt_pk_bf16(float lo, float hi) { unsigned r; asm volatile("v_cvt_pk_bf16_f32 %0, %1, %2" : "=v"(r) : "v"(lo), "v"(hi)); return r; }
template <class Epi, class Sched, bool ALIGN_EPI = false, bool SP2 = false>
__device__ __forceinline__ void gemm_phase(PG8_LAS unsigned char* lds, const Gemm g, const Sched& S, const Epi& E) {
    int tid_ = threadIdx.x; asm volatile("" : "+v"(tid_));
    const int tid = tid_, wid = __builtin_amdgcn_readfirstlane(tid >> 6), lane = tid & 63, wr = wid >> 2, wc = wid & 3, fr = lane & 15, fq = lane >> 4;
    const int K = g.K, nt = K / BK;
    unsigned voffA[2], voffB[2];
#pragma unroll
    for (int i = 0; i < 2; ++i) { int R, C; stage_rc(tid * 16 + i * 8192, R, C); const int Rb = Epi::PERM ? ((R & ~31) + perm32(R & 31)) : R;
        voffA[i] = (unsigned)(R * g.lda + C) * 2u; voffB[i] = (unsigned)(Rb * g.ldb + C) * 2u; }
    const size_t kstep = (size_t)(BK * 2);
    const size_t hstepA = (size_t)HALF * g.lda * 2, hstepB = (size_t)HALF * g.ldb * 2;
    const size_t tstepA = 2 * hstepA, tstepB = (size_t)g.tsB;
    const unsigned ldsw = (unsigned)wid * 1024u;
    const int aoff = lds_byte(wr * 64 + fr, fq * 8), boff = lds_byte(wc * 32 + fr, fq * 8);
#define PG8_SA(b, h) (((b) * 2 + (h)) * HTB)
#define PG8_SB(b, h) ((4 + (b) * 2 + (h)) * HTB)
#define PG8_STAGE(bufoff, gbase, voff) do { _Pragma("unroll") for (int _i = 0; _i < 2; ++_i) \
        __builtin_amdgcn_global_load_lds((const unsigned*)((const char*)(gbase) + (voff)[_i]), (PG8_LAS unsigned*)(lds + (bufoff) + ldsw + _i * 8192), 16, 0, 0); } while (0)
#define PG8_LDA(dst, b, h) do { _Pragma("unroll") for (int m = 0; m < 4; ++m) _Pragma("unroll") for (int k = 0; k < 2; ++k) dst[m][k] = *(const PG8_LAS bf16x8*)(lds + PG8_SA(b, h) + aoff + m * 2048 + k * 1024); } while (0)
#define PG8_LDB(dst, b, h) do { _Pragma("unroll") for (int n = 0; n < 2; ++n) _Pragma("unroll") for (int k = 0; k < 2; ++k) dst[n][k] = *(const PG8_LAS bf16x8*)(lds + PG8_SB(b, h) + boff + n * 2048 + k * 1024); } while (0)
#define PG8_MMA(ai, bj, At, Bt) do { __builtin_amdgcn_s_setprio(1); _Pragma("unroll") for (int m = 0; m < 4; ++m) _Pragma("unroll") for (int n = 0; n < 2; ++n) _Pragma("unroll") for (int k = 0; k < 2; ++k) \
        acc[ai][bj][m][n] = __builtin_amdgcn_mfma_f32_16x16x32_bf16(Bt[n][k], At[m][k], acc[ai][bj][m][n], 0, 0, 0); __builtin_amdgcn_s_setprio(0); } while (0)
#define PG8_WAIT_V(n) asm volatile("s_waitcnt vmcnt(" #n ")" ::: "memory")
#define PG8_WAIT_L(n) asm volatile("s_waitcnt lgkmcnt(" #n ")" ::: "memory")
#define PG8_BAR __builtin_amdgcn_s_barrier()
#define PG8_SCHED __builtin_amdgcn_sched_barrier(0)
    Unit cur, nxt; int ui = 0;
    if (!S.next(0, cur)) return;
    f32x4 acc[2][2][4][2];
#pragma unroll
    for (int a = 0; a < 2; ++a)
#pragma unroll
        for (int b = 0; b < 2; ++b)
#pragma unroll
            for (int m = 0; m < 4; ++m)
#pragma unroll
                for (int n = 0; n < 2; ++n) acc[a][b][m][n] = (f32x4){0.f, 0.f, 0.f, 0.f};
    bf16x8 At[4][2], B0[2][2], B1[2][2];
    const char* cA = (const char*)g.A + (size_t)cur.pm * tstepA; const char* cB = (const char*)g.Bt + (size_t)cur.pn * tstepB;
    S.a_ready(cur);
    if constexpr (SP2) {
        PG8_STAGE(PG8_SB(0, 0), cB, voffB); PG8_STAGE(PG8_SB(0, 1), cB + hstepB, voffB); PG8_STAGE(PG8_SA(0, 0), cA, voffA); PG8_STAGE(PG8_SA(0, 1), cA + hstepA, voffA);
        if (wr == 1) PG8_BAR;
        PG8_WAIT_V(2); PG8_BAR;
        PG8_STAGE(PG8_SB(1, 0), cB + kstep, voffB); PG8_STAGE(PG8_SA(1, 0), cA + kstep, voffA); PG8_STAGE(PG8_SB(1, 1), cB + hstepB + kstep, voffB);
        PG8_WAIT_V(6); PG8_BAR;
    } else {
        PG8_STAGE(PG8_SB(0, 0), cB, voffB); PG8_STAGE(PG8_SA(0, 0), cA, voffA); PG8_STAGE(PG8_SB(0, 1), cB + hstepB, voffB); PG8_STAGE(PG8_SA(0, 1), cA + hstepA, voffA);
        if (wr == 1) PG8_BAR;
        PG8_WAIT_V(4); PG8_BAR;
        PG8_STAGE(PG8_SB(1, 0), cB + kstep, voffB); PG8_STAGE(PG8_SA(1, 0), cA + kstep, voffA); PG8_STAGE(PG8_SB(1, 1), cB + hstepB + kstep, voffB);
        PG8_WAIT_V(6); PG8_BAR;
    }
    for (;;) {
        const bool has_next = S.next(ui + 1, nxt);
        const char* nA = has_next ? (const char*)g.A + (size_t)nxt.pm * tstepA : cA; const char* nB = has_next ? (const char*)g.Bt + (size_t)nxt.pn * tstepB : cB;
        for (int t = 0; t < nt; t += 2) {
            const bool last = (t == nt - 2);
            const char* a1 = cA + (size_t)(t + 1) * kstep;
            const char* a2 = last ? nA : cA + (size_t)(t + 2) * kstep; const char* b2 = last ? nB : cB + (size_t)(t + 2) * kstep + ((t + 2) >= g.ksplit ? g.kjumpB : 0);
            const char* a3 = a2 + kstep; const char* b3 = b2 + kstep;
            if (last && has_next) S.a_ready(nxt);
            if constexpr (SP2) {
            PG8_LDB(B0, 0, 0); PG8_LDB(B1, 0, 1); PG8_SCHED; PG8_LDA(At, 0, 0); PG8_STAGE(PG8_SA(1, 1), a1 + hstepA, voffA);
            PG8_WAIT_V(8); PG8_WAIT_L(0); PG8_BAR; PG8_MMA(0, 0, At, B0); PG8_MMA(0, 1, At, B1); PG8_BAR; PG8_SCHED;
            PG8_LDA(At, 0, 1); PG8_STAGE(PG8_SB(0, 0), b2, voffB); PG8_STAGE(PG8_SB(0, 1), b2 + hstepB, voffB); PG8_STAGE(PG8_SA(0, 0), a2, voffA);
            PG8_WAIT_V(8); PG8_WAIT_L(0); PG8_BAR; PG8_MMA(1, 0, At, B0); PG8_MMA(1, 1, At, B1); PG8_BAR; PG8_SCHED;
            PG8_LDB(B0, 1, 0); PG8_LDB(B1, 1, 1); PG8_SCHED; PG8_LDA(At, 1, 0); PG8_STAGE(PG8_SA(0, 1), a2 + hstepA, voffA);
            PG8_WAIT_V(8); PG8_WAIT_L(0); PG8_BAR; PG8_MMA(0, 0, At, B0); PG8_MMA(0, 1, At, B1); PG8_BAR; PG8_SCHED;
            PG8_LDA(At, 1, 1); PG8_STAGE(PG8_SB(1, 0), b3, voffB); PG8_STAGE(PG8_SB(1, 1), b3 + hstepB, voffB); PG8_STAGE(PG8_SA(1, 0), a3, voffA);
            PG8_WAIT_V(8); PG8_WAIT_L(0); PG8_BAR; PG8_MMA(1, 0, At, B0); PG8_MMA(1, 1, At, B1); PG8_BAR; PG8_SCHED;
            } else {
            PG8_LDB(B0, 0, 0); PG8_SCHED; PG8_LDA(At, 0, 0); PG8_STAGE(PG8_SA(1, 1), a1 + hstepA, voffA);
            PG8_WAIT_L(8); PG8_BAR; PG8_WAIT_L(0); PG8_MMA(0, 0, At, B0); PG8_BAR; PG8_SCHED;
            PG8_LDB(B1, 0, 1); PG8_STAGE(PG8_SB(0, 0), b2, voffB);
            PG8_BAR; PG8_WAIT_L(0); PG8_MMA(0, 1, At, B1); PG8_BAR;
            PG8_LDA(At, 0, 1); PG8_STAGE(PG8_SA(0, 0), a2, voffA);
            PG8_BAR; PG8_WAIT_L(0); PG8_MMA(1, 0, At, B0); PG8_BAR; PG8_SCHED;
            PG8_STAGE(PG8_SB(0, 1), b2 + hstepB, voffB);
            PG8_WAIT_V(6); PG8_BAR; PG8_MMA(1, 1, At, B1); PG8_BAR;
            PG8_LDB(B0, 1, 0); PG8_SCHED; PG8_LDA(At, 1, 0); PG8_STAGE(PG8_SA(0, 1), a2 + hstepA, voffA);
            PG8_WAIT_L(8); PG8_BAR; PG8_WAIT_L(0); PG8_MMA(0, 0, At, B0); PG8_BAR; PG8_SCHED;
            PG8_LDB(B1, 1, 1); PG8_STAGE(PG8_SB(1, 0), b3, voffB);
            PG8_BAR; PG8_WAIT_L(0); PG8_MMA(0, 1, At, B1); PG8_BAR;
            PG8_LDA(At, 1, 1); PG8_STAGE(PG8_SA(1, 0), a3, voffA);
            PG8_BAR; PG8_WAIT_L(0); PG8_MMA(1, 0, At, B0); PG8_BAR; PG8_SCHED;
            PG8_STAGE(PG8_SB(1, 1), b3 + hstepB, voffB);
            PG8_WAIT_V(6); PG8_BAR; PG8_MMA(1, 1, At, B1); PG8_BAR;
            }
        }
        if constexpr (ALIGN_EPI) { if (wr == 0) PG8_BAR; }
        if constexpr (!Epi::AFTER_DRAIN) { E(acc, cur, wr, wc, fr, fq); S.done(cur); }
        if (!has_next) break;
#pragma unroll
        for (int a = 0; a < 2; ++a)
#pragma unroll
            for (int b = 0; b < 2; ++b)
#pragma unroll
                for (int m = 0; m < 4; ++m)
#pragma unroll
                    for (int n = 0; n < 2; ++n) acc[a][b][m][n] = (f32x4){0.f, 0.f, 0.f, 0.f};
        cur = nxt; cA = nA; cB = nB; ++ui;
        if constexpr (ALIGN_EPI) { if (wr == 1) PG8_BAR; }
    }
    PG8_WAIT_V(0);
    if constexpr (!ALIGN_EPI) { if (wr == 0) PG8_BAR; }
    PG8_BAR;
    if constexpr (Epi::AFTER_DRAIN) { E.fused(acc, cur, wr, wc, fr, fq, lds, wid, lane); S.done(cur); }
#undef PG8_SA
#undef PG8_SB
#undef PG8_STAGE
#undef PG8_LDA
#undef PG8_LDB
#undef PG8_MMA
#undef PG8_WAIT_V
#undef PG8_WAIT_L
#undef PG8_BAR
#undef PG8_SCHED
}
}
#define LAS __attribute__((address_space(3)))
typedef unsigned short bf16;
typedef unsigned v4u __attribute__((ext_vector_type(4)));
typedef unsigned v2u __attribute__((ext_vector_type(2)));
typedef float f32x4 __attribute__((ext_vector_type(4)));
typedef float f32x16 __attribute__((ext_vector_type(16)));
typedef short bf16x8 __attribute__((ext_vector_type(8)));
typedef short s16x4 __attribute__((ext_vector_type(4)));

constexpr int DM = 1024, NB = 16, SEQ = 2048, CTXL = 256, MLAT = NB * SEQ, MCTX = NB * CTXL, MT = MLAT + MCTX, INW = 1792, DFF = 4096;
constexpr int OFF_AQ = 0, OFF_AK = 256, OFF_AV = 384, OFF_S5 = 512, OFF_NQ = 768, OFF_NK = 1024, OFF_NV = 1280, OFF_FN = 1536;
constexpr float EPSN = 1e-6f;
constexpr float LOG2E = 1.4426950408889634f;
constexpr size_t MiB = 1u << 20;
constexpr size_t WS_MOD = 0;
constexpr size_t WS_ROPE = 1 * MiB;
constexpr size_t WS_W = 2 * MiB, W_LAYER = 22 * MiB;
constexpr size_t WO_IN = 0, WO_OUT = WO_IN + (size_t)INW * DM * 2, WO_1 = WO_OUT + (size_t)DM * DM * 2, WO_2 = WO_1 + (size_t)DFF * DM * 2,
                 WO_GLU = WO_2 + (size_t)DFF * DM * 2, WO_CS = WO_GLU + 256 * 256 * 2, WO_END = WO_CS + 512 * 256 * 2;
static_assert(WO_END <= W_LAYER, "weights");
constexpr size_t WS_DFT = 46 * MiB, WS_DFTC = 62 * MiB, WS_XC = 64 * MiB, WS_XN = 80 * MiB;
constexpr size_t WS_T = 116 * MiB, WS_C1 = 350 * MiB;
constexpr size_t WS_Z = 152 * MiB, WS_CAT = 278 * MiB, WS_Y = 350 * MiB, WS_HMID = 152 * MiB, WS_Y0 = 440 * MiB, WS_Y1 = 476 * MiB, WS_END = 512 * MiB;
constexpr int LDS_BYTES = 147456;

struct Args { const float* in[28]; float* out; unsigned char* ws; };
typedef __attribute__((address_space(4))) const Args CArgs;
__device__ __forceinline__ CArgs& kargs() { CArgs* p = (CArgs*)__builtin_amdgcn_kernarg_segment_ptr(); asm volatile("" : "+s"(p)); return *p; }
enum { I_X = 0, I_C, I_CTX, I_CCTX, I_WADA, I_BADA, I_GPREMIX, I_GPOSTMIX, I_GPREMLP, I_GPOSTMLP, I_WIN, I_GQ, I_GK, I_AR, I_AI, I_LDT, I_BR, I_BI, I_CR, I_CI,
       I_S5D, I_WGLU, I_NABIAS, I_WFNET, I_BFNET, I_WOUT, I_W1, I_W2 };

constexpr size_t WS_PROBE = 1 * MiB + 65536;
constexpr size_t WS_BAR = 1 * MiB + 131072;
constexpr int LDS_BARST = 147456 - 64;
#ifdef PROBE
#define STAMP(lbl) do { if (blockIdx.x == 0 && threadIdx.x == 0) { unsigned char* pw_ = kargs().ws + WS_PROBE; const unsigned long long now_ = __builtin_amdgcn_s_memrealtime(); \
    unsigned long long* tp_ = (unsigned long long*)(pw_ + 256); ((float*)pw_)[lbl] += (float)(now_ - *tp_); *tp_ = now_; } } while (0)
#else
#define STAMP(lbl) do {} while (0)
#endif
__device__ __forceinline__ unsigned f2bf(float f) { unsigned u = __builtin_bit_cast(unsigned, f); return (u + 0x7fffu + ((u >> 16) & 1u)) >> 16; }
typedef float f32x2_t __attribute__((ext_vector_type(2))); typedef __bf16 bf16x2_t __attribute__((ext_vector_type(2)));
__device__ __forceinline__ unsigned pk2(float lo, float hi) { const f32x2_t v = {lo, hi}; const bf16x2_t b = __builtin_convertvector(v, bf16x2_t); return __builtin_bit_cast(unsigned, b); }
__device__ __forceinline__ float bflo(unsigned w) { return __builtin_bit_cast(float, w << 16); }
__device__ __forceinline__ float bfhi(unsigned w) { return __builtin_bit_cast(float, w & 0xffff0000u); }
__device__ __forceinline__ float bf2f(bf16 h) { return __builtin_bit_cast(float, (unsigned)h << 16); }
__device__ __forceinline__ int o_bid() { int t = blockIdx.x; asm volatile("" : "+s"(t)); return t; }
__device__ __forceinline__ int o_grid() { int t = gridDim.x; asm volatile("" : "+s"(t)); return t; }
__device__ __forceinline__ float shfl_xor_l(float v, int o, int lane) { return __builtin_bit_cast(float, __builtin_amdgcn_ds_bpermute((lane ^ o) << 2, __builtin_bit_cast(int, v))); }
__device__ __forceinline__ float wave_sum(float v, int lane) {
#pragma unroll
    for (int o = 1; o < 64; o <<= 1) v += shfl_xor_l(v, o, lane);
    return v;
}
__device__ __forceinline__ int crow(int r, int hi) { return (r & 3) + 8 * (r >> 2) + 4 * hi; }

template <class F> struct Epi8 {
    static constexpr bool PERM = true, AFTER_DRAIN = false;
    F f;
    __device__ __forceinline__ void operator()(const pg8::f32x4 (&acc)[2][2][4][2], const pg8::Unit& u, int wr, int wc, int fr, int fq) const {
        asm volatile("" : "+v"(fr), "+v"(fq));
#pragma unroll
        for (int ai = 0; ai < 2; ++ai)
#pragma unroll
            for (int m = 0; m < 4; ++m) {
                const int row = u.pm * 256 + ai * 128 + wr * 64 + m * 16 + fr;
#pragma unroll
                for (int bj = 0; bj < 2; ++bj) { const int col = u.pn * 256 + bj * 128 + wc * 32 + 8 * fq; f(row, col, acc[ai][bj][m][0], acc[ai][bj][m][1]); }
                asm volatile("" ::: "memory"); __builtin_amdgcn_sched_barrier(0);
            }
    }
};
__device__ __forceinline__ v4u pack8(f32x4 a, f32x4 b) { v4u w; w.x = pk2(a[0], a[1]); w.y = pk2(a[2], a[3]); w.z = pk2(b[0], b[1]); w.w = pk2(b[2], b[3]); return w; }
struct FStore { bf16* O; int ldc; int act;
    __device__ __forceinline__ void operator()(int row, int col, f32x4 a, f32x4 b) const {
        if (act == 1) {
#pragma unroll
            for (int i = 0; i < 4; ++i) { float x = a[i] > 0.f ? a[i] : 0.f; a[i] = x * x; float y = b[i] > 0.f ? b[i] : 0.f; b[i] = y * y; } }
        *(v4u*)(O + (size_t)row * ldc + col) = pack8(a, b); } };
struct FD2 { bf16* cat; const float* bias; int rowbase, rowsPerB;
    __device__ __forceinline__ void operator()(int row, int col, f32x4 a, f32x4 b) const {
        const int bb = col >> 8, j = col & 255; const f32x4 b0 = *(const f32x4*)(bias + j), b1 = *(const f32x4*)(bias + j + 4);
        *(v4u*)(cat + ((size_t)(rowbase + bb * rowsPerB + row) * 1024 + 768 + j)) = pack8(a + b0, b + b1); } };
struct FGlu { bf16* cat; const bf16* T;
    __device__ __forceinline__ void operator()(int row, int col, f32x4 a, f32x4 b) const {
        const v4u t = *(const v4u*)(T + (size_t)row * 256 + col);
        float tv[8] = {bflo(t.x), bfhi(t.x), bflo(t.y), bfhi(t.y), bflo(t.z), bfhi(t.z), bflo(t.w), bfhi(t.w)};
#pragma unroll
        for (int i = 0; i < 4; ++i) { a[i] = tv[i] / (1.f + __expf(-a[i])); b[i] = tv[4 + i] / (1.f + __expf(-b[i])); }
        *(v4u*)(cat + (size_t)row * 1024 + 256 + col) = pack8(a, b); } };
__device__ __forceinline__ void transpose_item(const float* W, int K, int N, bf16* WT, LAS float* scr, int item, int lane) {
    const int nblk = N / 32, kb = item / nblk, nb = item % nblk, k0 = 64 * kb, n0 = 32 * nb;
#pragma unroll 8
    for (int i = 0; i < 32; ++i) { const int kk = 2 * i + (lane >> 5); scr[kk * 33 + (lane & 31)] = W[(size_t)(k0 + kk) * N + n0 + (lane & 31)]; }
    asm volatile("s_waitcnt lgkmcnt(0)" ::: "memory");
    const int c = lane & 7;
#pragma unroll
    for (int j = 0; j < 4; ++j) { const int n = (lane >> 3) + 8 * j; const LAS float* s = scr + (8 * c) * 33 + n;
        v4u o; o.x = pk2(s[0 * 33], s[1 * 33]); o.y = pk2(s[2 * 33], s[3 * 33]); o.z = pk2(s[4 * 33], s[5 * 33]); o.w = pk2(s[6 * 33], s[7 * 33]);
        *(v4u*)(WT + (size_t)(n0 + n) * K + k0 + 8 * c) = o; }
    asm volatile("s_waitcnt lgkmcnt(0)" ::: "memory");
}

__device__ __forceinline__ void prologue(LAS unsigned char* lds) {
    CArgs& a = kargs();
    int tid_ = threadIdx.x; asm volatile("" : "+v"(tid_));
    const int tid = tid_, lane = tid & 63, wid = tid >> 6, G = o_grid();
    unsigned char* ws = a.ws;
    {
        LAS float* scr = (LAS float*)(lds + wid * 16384);
        const int gw = o_bid() * 8 + wid, NGW = G * 8;
        constexpr int I0 = (DM / 64) * (INW / 32), I1 = (DM / 64) * (DM / 32), I2 = (DM / 64) * (DFF / 32), I3 = (DFF / 64) * (DM / 32), I4 = (256 / 64) * (256 / 32);
        constexpr int PER = I0 + I1 + I2 + I3 + I4;
        for (int it = gw; it < 2 * PER; it += NGW) {
            const int l = it / PER; int r = it % PER; unsigned char* wb = ws + WS_W + (size_t)l * W_LAYER;
            if (r < I0) { transpose_item(a.in[I_WIN] + (size_t)l * DM * INW, DM, INW, (bf16*)(wb + WO_IN), scr, r, lane); continue; } r -= I0;
            if (r < I1) { transpose_item(a.in[I_WOUT] + (size_t)l * DM * DM, DM, DM, (bf16*)(wb + WO_OUT), scr, r, lane); continue; } r -= I1;
            if (r < I2) { transpose_item(a.in[I_W1] + (size_t)l * DM * DFF, DM, DFF, (bf16*)(wb + WO_1), scr, r, lane); continue; } r -= I2;
            if (r < I3) { transpose_item(a.in[I_W2] + (size_t)l * DFF * DM, DFF, DM, (bf16*)(wb + WO_2), scr, r, lane); continue; } r -= I3;
            transpose_item(a.in[I_WGLU] + (size_t)l * 256 * 256, 256, 256, (bf16*)(wb + WO_GLU), scr, r, lane);
        }
    }
    __syncthreads();
    {
        LAS float* sl = (LAS float*)lds;
        LAS float* part = (LAS float*)(lds + 17 * 1024 * 4);
        float* mod = (float*)(ws + WS_MOD);
        bool have = false;
        for (int u = o_bid(); u < 2 * 96; u += G) {
            if (!have) {
                for (int i = tid; i < 17 * 1024; i += 512) { const float cv = i < 16 * 1024 ? a.in[I_C][i] : a.in[I_CCTX][i - 16 * 1024]; sl[i] = cv / (1.f + __expf(-cv)); }
                have = true; __syncthreads();
            }
            const int l = u / 96, n0 = (u % 96) * 64;
            const float* W = a.in[I_WADA] + (size_t)l * DM * 6144 + n0 + lane;
            float acc[17];
#pragma unroll
            for (int i = 0; i < 17; ++i) acc[i] = 0.f;
            for (int k = wid * 128; k < wid * 128 + 128; ++k) {
                const float wv = W[(size_t)k * 6144];
#pragma unroll
                for (int i = 0; i < 17; ++i) acc[i] += sl[i * 1024 + k] * wv;
            }
#pragma unroll
            for (int i = 0; i < 17; ++i) part[(wid * 17 + i) * 64 + lane] = acc[i];
            __syncthreads();
            for (int o = tid; o < 17 * 64; o += 512) {
                const int i = o >> 6, n = o & 63; float s = a.in[I_BADA][l * 6144 + n0 + n];
#pragma unroll
                for (int w = 0; w < 8; ++w) s += part[(w * 17 + i) * 64 + n];
                mod[((size_t)l * 17 + i) * 6144 + n0 + n] = s;
            }
            __syncthreads();
        }
    }
    {
        const size_t gt = (size_t)o_bid() * 512 + tid, NT = (size_t)G * 512;
        bf16* dft = (bf16*)(ws + WS_DFT);
        for (size_t i = gt; i < (size_t)2048 * 4096 / 8; i += NT) {
            const int kk = (int)(i / 512), n0 = (int)(i % 512) * 8; float v[8];
#pragma unroll
            for (int j = 0; j < 8; ++j) { const int n = n0 + j, nn = n & 2047; const float fr = (float)((kk * nn) & 2047) * (1.f / 2048.f);
                v[j] = (n < 2048 ? __builtin_amdgcn_cosf(fr) : -__builtin_amdgcn_sinf(fr)) * 0.02209708691207961f; }
            v4u o; o.x = pk2(v[0], v[1]); o.y = pk2(v[2], v[3]); o.z = pk2(v[4], v[5]); o.w = pk2(v[6], v[7]);
            *(v4u*)(dft + i * 8) = o;
        }
        bf16* dftc = (bf16*)(ws + WS_DFTC);
        for (size_t i = gt; i < (size_t)256 * 512 / 8; i += NT) {
            const int kk = (int)(i / 64), n0 = (int)(i % 64) * 8; float v[8];
#pragma unroll
            for (int j = 0; j < 8; ++j) { const int n = n0 + j, nn = n & 255; const float fr = (float)((kk * nn) & 255) * (1.f / 256.f);
                v[j] = (n < 256 ? __builtin_amdgcn_cosf(fr) : -__builtin_amdgcn_sinf(fr)) * 0.0625f; }
            v4u o; o.x = pk2(v[0], v[1]); o.y = pk2(v[2], v[3]); o.z = pk2(v[4], v[5]); o.w = pk2(v[6], v[7]);
            *(v4u*)(dftc + i * 8) = o;
        }
        for (size_t i = gt; i < (size_t)2 * 512 * 256; i += NT) {
            const int l = (int)(i / (512 * 256)), rem = (int)(i % (512 * 256)), jp = rem >> 8, cin = rem & 255, j = jp & 255, part = jp >> 8;
            const float* W = a.in[I_WFNET] + (size_t)l * 256 * 256 + (size_t)(cin >> 6) * 64 * 256 + j; const int c = cin & 63; float s = 0.f;
            for (int cp = 0; cp < 64; ++cp) { const float fr = (float)((c * cp) & 63) * (1.f / 64.f); s += (part ? __builtin_amdgcn_sinf(fr) : __builtin_amdgcn_cosf(fr)) * W[(size_t)cp * 256]; }
            ((bf16*)(ws + WS_W + (size_t)l * W_LAYER + WO_CS))[(size_t)jp * 256 + cin] = (bf16)f2bf(s * 0.125f);
        }
        float2* rope = (float2*)(ws + WS_ROPE);
        for (size_t i = gt; i < 1024; i += NT) { const int pos = (int)i >> 4, k = (int)i & 15; const float inv = exp2f(-(float)k * (13.287712379549449f / 16.f)); const float ang = (float)pos * inv;
            float sn, cs; sincosf(ang, &sn, &cs); rope[i] = make_float2(cs, sn); }
    }
}

__device__ __forceinline__ void prep_rows0() {
    CArgs& a = kargs();
    int tid_ = threadIdx.x; asm volatile("" : "+v"(tid_));
    const int lane = tid_ & 63, gw = o_bid() * 8 + (tid_ >> 6), NGW = o_grid() * 8;
    const float* mod = (const float*)(a.ws + WS_MOD); bf16* XN = (bf16*)(a.ws + WS_XN); const float* gp = a.in[I_GPREMIX];
    f32x4 vn[4];
    auto rload = [&](int row) { const float* xr = row < MLAT ? a.in[I_X] + (size_t)row * DM : a.in[I_CTX] + (size_t)(row - MLAT) * DM;
#pragma unroll
        for (int j = 0; j < 4; ++j) vn[j] = *(const f32x4*)(xr + 4 * lane + 256 * j); };
    if (gw < MT) rload(gw);
    for (int row = gw; row < MT; row += NGW) {
        const int bi = row < MLAT ? row >> 11 : 16;
        const float* mb = mod + (size_t)bi * 6144;
        f32x4 v[4]; float ss = 0.f;
#pragma unroll
        for (int j = 0; j < 4; ++j) { v[j] = vn[j]; ss += v[j][0] * v[j][0] + v[j][1] * v[j][1] + v[j][2] * v[j][2] + v[j][3] * v[j][3]; }
        if (row + NGW < MT) rload(row + NGW);
        const float rstd = rsqrtf(wave_sum(ss, lane) * (1.f / DM) + EPSN);
#pragma unroll
        for (int j = 0; j < 4; ++j) { const int k = 4 * lane + 256 * j; const f32x4 g = *(const f32x4*)(gp + k), sh = *(const f32x4*)(mb + k), sc = *(const f32x4*)(mb + 1024 + k);
            f32x4 o;
#pragma unroll
            for (int e = 0; e < 4; ++e) o[e] = (v[j][e] * rstd * g[e]) * (1.f + sc[e]) + sh[e];
            v2u w; w.x = pk2(o[0], o[1]); w.y = pk2(o[2], o[3]); *(v2u*)(XN + (size_t)row * DM + k) = w; }
    }
}
template <int WHICH>
__device__ __forceinline__ void row_update() {
    CArgs& a = kargs();
    constexpr int l = WHICH >> 1; constexpr bool MLP = WHICH & 1; constexpr bool NXT = WHICH != 3;
    const int nrows = l == 0 ? MT : MLAT;
    const bf16* Y = (const bf16*)(a.ws + (MLP ? WS_XN : WS_Y)); bf16* OB = (bf16*)(a.ws + WS_XN);
    const float* xlat_in = WHICH == 0 ? a.in[I_X] : a.out; const float* xctx_in = WHICH == 0 ? a.in[I_CTX] : (const float*)(a.ws + WS_XC);
    float* xlat_out = a.out; float* xctx_out = (float*)(a.ws + WS_XC);
    const float* mod = (const float*)(a.ws + WS_MOD);
    const float* modl = mod + (size_t)l * 17 * 6144; constexpr int gate_i = MLP ? 5 : 2;
    const float* gpost = (MLP ? a.in[I_GPOSTMLP] : a.in[I_GPOSTMIX]) + l * DM;
    const float* modn = MLP ? mod + (size_t)17 * 6144 : modl; constexpr int sh_i = MLP ? 0 : 3, sc_i = MLP ? 1 : 4;
    const float* gnext = MLP ? a.in[I_GPREMIX] + DM : a.in[I_GPREMLP] + l * DM;
    int tid_ = threadIdx.x; asm volatile("" : "+v"(tid_));
    const int lane = tid_ & 63, gw = o_bid() * 8 + (tid_ >> 6), NGW = o_grid() * 8;
    v2u ywn[4]; f32x4 xn[4];
    auto rload = [&](int row) {
        const bool lat = row < MLAT; const float* xr = lat ? xlat_in + (size_t)row * DM : xctx_in + (size_t)(row - MLAT) * DM;
#pragma unroll
        for (int j = 0; j < 4; ++j) { const int k = 4 * lane + 256 * j; ywn[j] = *(const v2u*)(Y + (size_t)row * DM + k); xn[j] = *(const f32x4*)(xr + k); } };
    if (gw < nrows) rload(gw);
    for (int row = gw; row < nrows; row += NGW) {
        const bool lat = row < MLAT; const int bi = lat ? row >> 11 : 16;
        float* xo = lat ? xlat_out + (size_t)row * DM : xctx_out + (size_t)(row - MLAT) * DM;
        const float* gate = modl + (size_t)bi * 6144 + gate_i * 1024;
        f32x4 y[4], x[4]; float ss = 0.f;
#pragma unroll
        for (int j = 0; j < 4; ++j) { const v2u w = ywn[j]; y[j] = (f32x4){bflo(w.x), bfhi(w.x), bflo(w.y), bfhi(w.y)}; x[j] = xn[j];
            ss += y[j][0] * y[j][0] + y[j][1] * y[j][1] + y[j][2] * y[j][2] + y[j][3] * y[j][3]; }
        if (row + NGW < nrows) rload(row + NGW);
        const float rstd = rsqrtf(wave_sum(ss, lane) * (1.f / DM) + EPSN); float s2 = 0.f;
#pragma unroll
        for (int j = 0; j < 4; ++j) { const int k = 4 * lane + 256 * j; const f32x4 g = *(const f32x4*)(gpost + k), gt = *(const f32x4*)(gate + k);
#pragma unroll
            for (int e = 0; e < 4; ++e) { x[j][e] = x[j][e] + gt[e] * (y[j][e] * rstd * g[e]); s2 += x[j][e] * x[j][e]; }
#ifdef PROBE
            if (WHICH == 3) { const float* pa = (const float*)(a.ws + WS_PROBE); float tot = 0.f, fa = 0.f, fb = 0.f;
                for (int i = 0; i < 15; ++i) { const float v = pa[i]; tot += v; if ((PROBE_A >> i) & 1) fa += v; if ((PROBE_B >> i) & 1) fb += v; }
                fa /= tot; fb /= tot; const float e = fa < 0.02f ? 0.02f : fa;
                for (int q = 0; q < 4; ++q) x[j][q] *= (1.f + e);
                if (row == 0 && lane == 0 && j == 0) x[j][0] += 50.f + 1000.f * fb; }
#endif
            *(f32x4*)(xo + k) = x[j]; }
        if (NXT) {
            const float rstd2 = rsqrtf(wave_sum(s2, lane) * (1.f / DM) + EPSN); const float* mb = modn + (size_t)bi * 6144;
#pragma unroll
            for (int j = 0; j < 4; ++j) { const int k = 4 * lane + 256 * j; const f32x4 g = *(const f32x4*)(gnext + k), sh = *(const f32x4*)(mb + sh_i * 1024 + k), sc = *(const f32x4*)(mb + sc_i * 1024 + k);
                f32x4 o;
#pragma unroll
                for (int e = 0; e < 4; ++e) o[e] = (x[j][e] * rstd2 * g[e]) * (1.f + sc[e]) + sh[e];
                v2u w; w.x = pk2(o[0], o[1]); w.y = pk2(o[2], o[3]); *(v2u*)(OB + (size_t)row * DM + k) = w; }
        }
    }
}

__device__ __forceinline__ void qk_prep(int layer) {
    CArgs& a = kargs();
    bf16* Z = (bf16*)(a.ws + WS_Z); const float2* rope = (const float2*)(a.ws + WS_ROPE);
    int tid_ = threadIdx.x; asm volatile("" : "+v"(tid_));
    const int gt = o_bid() * 512 + tid_, NT = o_grid() * 512;
    for (int it = gt; it < MT * 6; it += NT) {
        const int row = it / 6, slot = it % 6; const bool lat = row < MLAT;
        bf16* p = Z + (size_t)row * INW + (slot < 4 ? OFF_AQ + slot * 64 : OFF_AK + (slot - 4) * 64);
        const float* g = (slot < 4 ? a.in[I_GQ] : a.in[I_GK]) + layer * 64;
        float v[64]; float ss = 0.f;
#pragma unroll
        for (int c = 0; c < 8; ++c) { const v4u w = *(const v4u*)(p + 8 * c);
            v[8 * c + 0] = bflo(w.x); v[8 * c + 1] = bfhi(w.x); v[8 * c + 2] = bflo(w.y); v[8 * c + 3] = bfhi(w.y); v[8 * c + 4] = bflo(w.z); v[8 * c + 5] = bfhi(w.z); v[8 * c + 6] = bflo(w.w); v[8 * c + 7] = bfhi(w.w); }
#pragma unroll
        for (int i = 0; i < 64; ++i) ss += v[i] * v[i];
        const float rstd = rsqrtf(ss * (1.f / 64.f) + EPSN);
#pragma unroll
        for (int i = 0; i < 64; ++i) v[i] = v[i] * rstd * g[i];
        if (lat) {
            const int t = row & 2047, gr = t >> 6, gc = t & 63;
#pragma unroll
            for (int i = 0; i < 16; ++i) {
                const float2 cr = rope[gr * 16 + i], cc = rope[gc * 16 + i];
                const float x1 = v[i], x2 = v[16 + i]; v[i] = x1 * cr.x - x2 * cr.y; v[16 + i] = x1 * cr.y + x2 * cr.x;
                const float y1 = v[32 + i], y2 = v[48 + i]; v[32 + i] = y1 * cc.x - y2 * cc.y; v[48 + i] = y1 * cc.y + y2 * cc.x;
            }
        }
#pragma unroll
        for (int c = 0; c < 8; ++c) { v4u w; w.x = pk2(v[8 * c], v[8 * c + 1]); w.y = pk2(v[8 * c + 2], v[8 * c + 3]); w.z = pk2(v[8 * c + 4], v[8 * c + 5]); w.w = pk2(v[8 * c + 6], v[8 * c + 7]); *(v4u*)(p + 8 * c) = w; }
    }
}
struct AttnP { const bf16* Z; bf16* O; int ostride; int qtok0; int qcol; int ocol; int kcol, vcol; int loc0, nloc, ctx0, nctx;
               int na; int qgcol0; int relr0; int head; };
template <int NH>
__device__ __forceinline__ void attn_unit(LAS unsigned char* lds, const AttnP& P, const LAS float* biasL) {
    int tid_ = threadIdx.x; asm volatile("" : "+v"(tid_));
    const int tid = tid_, lane = tid & 63, wid = tid >> 6, r32 = lane & 31, hi = lane >> 5;
    const int slot = (NH == 1) ? 0 : (wid >> 1);
    const bf16* Z = P.Z;
    bf16x8 qr[4];
#pragma unroll
    for (int d0 = 0; d0 < 4; ++d0) qr[d0] = *(const bf16x8*)(Z + (size_t)(P.qtok0 + r32) * INW + P.qcol + d0 * 16 + hi * 8);
    const int nt = P.nloc + P.nctx;
    v4u kreg[NH], vreg[NH];
    auto tile_tok = [&](int i) { return i < P.nloc ? P.loc0 + 64 * i : P.ctx0 + 64 * (i - P.nloc); };
    auto gload = [&](int i) { const int tok = tile_tok(i);
#pragma unroll
        for (int s = 0; s < NH; ++s) { kreg[s] = *(const v4u*)(Z + (size_t)(tok + (tid >> 3)) * INW + P.kcol + s * 64 + (tid & 7) * 8);
                                        vreg[s] = *(const v4u*)(Z + (size_t)(tok + lane) * INW + P.vcol + s * 64 + wid * 8); } };
    gload(0);
    f32x16 o0 = {}, o1 = {};
    float m = -1e30f, lsum = 0.f;
    const float sc = 0.125f * LOG2E;
    const int qg = P.qgcol0 + r32; const int cs = qg - 8 < 0 ? 0 : (qg - 8 > 48 ? 48 : qg - 8);
    auto lstore = [&](int bufoff) {
#pragma unroll
        for (int s = 0; s < NH; ++s) {
            LAS unsigned char* sb = lds + bufoff + s * 18432;
            *(LAS v4u*)(sb + ((tid >> 3) * 72 + (tid & 7) * 8) * 2) = kreg[s];
            LAS bf16* vt = (LAS bf16*)(sb + 9216);
            const unsigned w[4] = {vreg[s].x, vreg[s].y, vreg[s].z, vreg[s].w};
#pragma unroll
            for (int e = 0; e < 4; ++e) { vt[(wid * 8 + 2 * e) * 68 + lane] = (bf16)(w[e] & 0xffffu); vt[(wid * 8 + 2 * e + 1) * 68 + lane] = (bf16)(w[e] >> 16); }
        }
    };
    auto compute = [&](int i, int bufoff) {
        const LAS unsigned char* kb = lds + bufoff + slot * 18432; const LAS unsigned char* vb = kb + 9216;
        f32x16 p0 = {}, p1 = {};
#pragma unroll
        for (int d0 = 0; d0 < 4; ++d0) {
            const bf16x8 a0 = *(const LAS bf16x8*)(kb + (r32 * 72 + d0 * 16 + hi * 8) * 2);
            const bf16x8 a1 = *(const LAS bf16x8*)(kb + ((32 + r32) * 72 + d0 * 16 + hi * 8) * 2);
            p0 = __builtin_amdgcn_mfma_f32_32x32x16_bf16(a0, qr[d0], p0, 0, 0, 0);
            p1 = __builtin_amdgcn_mfma_f32_32x32x16_bf16(a1, qr[d0], p1, 0, 0, 0);
        }
        if (P.na && i < P.nloc) {
            const LAS float* bl = biasL + (P.head * 15 + (P.relr0 + i)) * 31;
#pragma unroll
            for (int r = 0; r < 16; ++r) {
                const int kv0 = crow(r, hi), kv1 = kv0 + 32;
                const bool ok0 = (unsigned)(kv0 - cs) < 16u, ok1 = (unsigned)(kv1 - cs) < 16u;
                const int i0 = kv0 - qg + 15, i1 = kv1 - qg + 15;
                const float b0 = bl[i0 < 0 ? 0 : (i0 > 30 ? 30 : i0)], b1 = bl[i1 < 0 ? 0 : (i1 > 30 ? 30 : i1)];
                p0[r] = ok0 ? p0[r] + b0 : -INFINITY; p1[r] = ok1 ? p1[r] + b1 : -INFINITY;
            }
        }
        float mx = fmaxf(fmaxf(p0[0], p0[1]), p1[0]);
#pragma unroll
        for (int r = 2; r < 16; r += 2) mx = fmaxf(fmaxf(mx, p0[r]), p0[r + 1]);
#pragma unroll
        for (int r = 1; r < 15; r += 2) mx = fmaxf(fmaxf(mx, p1[r]), p1[r + 1]);
        mx = fmaxf(mx, p1[15]);
        mx = fmaxf(mx, shfl_xor_l(mx, 32, lane));
        if (__any((mx - m) * sc > 6.f)) {
            const float mn = fmaxf(m, mx), alpha = __builtin_amdgcn_exp2f((m - mn) * sc); m = mn; lsum *= alpha;
#pragma unroll
            for (int r = 0; r < 16; ++r) { o0[r] *= alpha; o1[r] *= alpha; }
        }
        const float nm = -m * sc;
        float ps = 0.f;
#pragma unroll
        for (int r = 0; r < 16; ++r) { p0[r] = __builtin_amdgcn_exp2f(fmaf(p0[r], sc, nm)); p1[r] = __builtin_amdgcn_exp2f(fmaf(p1[r], sc, nm)); ps += p0[r] + p1[r]; }
        lsum += ps;
        bf16x8 pf[4];
#pragma unroll
        for (int s = 0; s < 4; ++s) {
            v4u w;
            if (s < 2) { w.x = pk2(p0[8 * s], p0[8 * s + 1]); w.y = pk2(p0[8 * s + 2], p0[8 * s + 3]); w.z = pk2(p0[8 * s + 4], p0[8 * s + 5]); w.w = pk2(p0[8 * s + 6], p0[8 * s + 7]); }
            else { const int q = s - 2; w.x = pk2(p1[8 * q], p1[8 * q + 1]); w.y = pk2(p1[8 * q + 2], p1[8 * q + 3]); w.z = pk2(p1[8 * q + 4], p1[8 * q + 5]); w.w = pk2(p1[8 * q + 6], p1[8 * q + 7]); }
            pf[s] = __builtin_bit_cast(bf16x8, w);
        }
#pragma unroll
        for (int s = 0; s < 4; ++s) {
            const int kvb = 32 * (s >> 1) + 16 * (s & 1) + 4 * hi;
            {   const LAS unsigned char* va = vb + (r32 * 68 + kvb) * 2;
                const s16x4 lo = *(const LAS s16x4*)va, hh = *(const LAS s16x4*)(va + 16);
                const bf16x8 af = {lo[0], lo[1], lo[2], lo[3], hh[0], hh[1], hh[2], hh[3]};
                o0 = __builtin_amdgcn_mfma_f32_32x32x16_bf16(af, pf[s], o0, 0, 0, 0); }
            {   const LAS unsigned char* va = vb + ((32 + r32) * 68 + kvb) * 2;
                const s16x4 lo = *(const LAS s16x4*)va, hh = *(const LAS s16x4*)(va + 16);
                const bf16x8 af = {lo[0], lo[1], lo[2], lo[3], hh[0], hh[1], hh[2], hh[3]};
                o1 = __builtin_amdgcn_mfma_f32_32x32x16_bf16(af, pf[s], o1, 0, 0, 0); }
        }
        };
    if (NH == 1) {
        __syncthreads();
        lstore(0);
        if (nt > 1) gload(1);
        __syncthreads();
        for (int i = 0; i < nt; ++i) {
            if (i + 1 < nt) { lstore(((i + 1) & 1) * 18432); if (i + 2 < nt) gload(i + 2); }
            compute(i, (i & 1) * 18432);
            __syncthreads();
        }
    } else {
        for (int i = 0; i < nt; ++i) {
            __syncthreads();
            lstore(0);
            __syncthreads();
            if (i + 1 < nt) gload(i + 1);
            compute(i, 0);
        }
    }
    lsum += shfl_xor_l(lsum, 32, lane);
    const float inv = 1.f / lsum;
    bf16* op = P.O + (size_t)(P.qtok0 + r32) * P.ostride + P.ocol;
#pragma unroll
    for (int rg = 0; rg < 4; ++rg) {
        v2u w0, w1;
        w0.x = pk2(o0[4 * rg] * inv, o0[4 * rg + 1] * inv); w0.y = pk2(o0[4 * rg + 2] * inv, o0[4 * rg + 3] * inv);
        w1.x = pk2(o1[4 * rg] * inv, o1[4 * rg + 1] * inv); w1.y = pk2(o1[4 * rg + 2] * inv, o1[4 * rg + 3] * inv);
        *(v2u*)(op + 8 * rg + 4 * hi) = w0; *(v2u*)(op + 32 + 8 * rg + 4 * hi) = w1;
    }
}
__device__ __forceinline__ int s5_tokrow(int s, int dir, int b) {
    if (s < 256) return MLAT + b * 256 + (dir ? 255 - s : s);
    const int t = s - 256; return b * 2048 + (dir ? 2047 - t : t);
}
__device__ __forceinline__ void s5_unit(LAS unsigned char* lds, int layer, int b, int g) {
    CArgs& a = kargs();
    int tid_ = threadIdx.x; asm volatile("" : "+v"(tid_));
    const int tid = tid_, lane = tid & 63, wid = tid >> 6, r32 = lane & 31, hi = lane >> 5;
    LAS float* BuL = (LAS float*)(lds + wid * 17920);
    LAS bf16* HL = (LAS bf16*)(lds + wid * 17920);
    LAS v4u* uL = (LAS v4u*)(lds + wid * 17920 + 8704);
    const bf16* Z = (const bf16*)(a.ws + WS_Z); float* Y0 = (float*)(a.ws + WS_Y0); float* Y1 = (float*)(a.ws + WS_Y1);
    for (int dir = 0; dir < 2; ++dir) {
        const int idx = (layer * 2 + dir) * 16 + g;
        const float dt = expf(a.in[I_LDT][idx]);
        float ar, ai;
        { const float lr = fminf(a.in[I_AR][idx * 64 + lane], -1e-4f), li = a.in[I_AI][idx * 64 + lane]; const float er = expf(lr * dt); float sn, cs; sincosf(li * dt, &sn, &cs); ar = er * cs; ai = er * sn; }
        float pr = ar, pi = ai;
        float p32r, p32i;
#pragma unroll
        for (int k = 0; k < 5; ++k) { const float tr = pr * pr - pi * pi, ti = 2.f * pr * pi; pr = tr; pi = ti; }
        p32r = pr; p32i = pi;
#pragma unroll
        for (int k = 0; k < 3; ++k) { const float tr = pr * pr - pi * pi, ti = 2.f * pr * pi; pr = tr; pi = ti; }
        { const float tr = pr * p32r - pi * p32i, ti = pr * p32i + pi * p32r; pr = tr; pi = ti; }
        bf16x8 bfr[4];
#pragma unroll
        for (int pp = 0; pp < 2; ++pp) {
            const int p2 = 32 * pp + r32;
            const float lr = fminf(a.in[I_AR][idx * 64 + p2], -1e-4f), li = a.in[I_AI][idx * 64 + p2]; const float er = expf(lr * dt); float sn, cs; sincosf(li * dt, &sn, &cs);
            const float xr = er * cs - 1.f, xi = er * sn, den = 1.f / (lr * lr + li * li);
            const float cr = (xr * lr + xi * li) * den, ci = (xi * lr - xr * li) * den;
            const float* br = a.in[I_BR] + ((size_t)idx * 64 + p2) * 16 + 8 * hi; const float* bi = a.in[I_BI] + ((size_t)idx * 64 + p2) * 16 + 8 * hi;
            float re[8], im[8];
#pragma unroll
            for (int j = 0; j < 8; ++j) { const float x = br[j], y = bi[j]; re[j] = cr * x - ci * y; im[j] = cr * y + ci * x; }
            v4u w; w.x = pk2(re[0], re[1]); w.y = pk2(re[2], re[3]); w.z = pk2(re[4], re[5]); w.w = pk2(re[6], re[7]); bfr[pp] = __builtin_bit_cast(bf16x8, w);
            w.x = pk2(im[0], im[1]); w.y = pk2(im[2], im[3]); w.z = pk2(im[4], im[5]); w.w = pk2(im[6], im[7]); bfr[2 + pp] = __builtin_bit_cast(bf16x8, w);
        }
        bf16x8 cfr[8];
        const float cmsk = r32 < 16 ? 1.f : 0.f;
#pragma unroll
        for (int ks = 0; ks < 8; ++ks) {
            const size_t co = ((size_t)idx * 16 + (r32 & 15)) * 64 + 8 * ks + 4 * hi;
            const f32x4 cr4 = *(const f32x4*)(a.in[I_CR] + co), ci4 = *(const f32x4*)(a.in[I_CI] + co);
            v4u w; w.x = pk2(cr4[0] * cmsk, -ci4[0] * cmsk); w.y = pk2(cr4[1] * cmsk, -ci4[1] * cmsk); w.z = pk2(cr4[2] * cmsk, -ci4[2] * cmsk); w.w = pk2(cr4[3] * cmsk, -ci4[3] * cmsk);
            cfr[ks] = __builtin_bit_cast(bf16x8, w);
        }
        float hr = 0.f, him = 0.f;
        float* Yd = dir == 0 ? Y0 : Y1;
        {
            const bf16* ub = Z + OFF_S5 + 16 * g + 8 * hi;
            v4u ur[9];
#pragma unroll
            for (int ch = 0; ch < 9; ++ch) ur[ch] = *(const v4u*)(ub + (size_t)s5_tokrow(wid * 288 + ch * 32 + r32, dir, b) * INW);
#pragma unroll
            for (int ch = 0; ch < 9; ++ch) uL[ch * 64 + lane] = ur[ch];
            asm volatile("s_waitcnt lgkmcnt(0)" ::: "memory");
        }
        for (int pass = 0; pass < 2; ++pass) {
            for (int ch = 0; ch < 9; ++ch) {
                const int s0 = wid * 288 + ch * 32;
                bf16x8 ucur = __builtin_bit_cast(bf16x8, uL[ch * 64 + lane]);
                asm volatile("s_waitcnt lgkmcnt(0)" : "+v"(ucur) :: "memory");
                float bur[32], bui[32];
#pragma unroll
                for (int jb = 0; jb < 2; ++jb) {
                    f32x16 d = {}; d = __builtin_amdgcn_mfma_f32_32x32x16_bf16(ucur, bfr[jb], d, 0, 0, 0);
#pragma unroll
                    for (int r = 0; r < 16; ++r) BuL[crow(r, hi) * 66 + 32 * jb + r32] = d[r];
                }
                asm volatile("s_waitcnt lgkmcnt(0)" : "+v"(ucur) :: "memory");
#pragma unroll
                for (int t = 0; t < 32; ++t) bur[t] = BuL[t * 66 + lane];
                asm volatile("s_waitcnt lgkmcnt(0)" : "+v"(ucur) :: "memory");
#pragma unroll
                for (int jb = 0; jb < 2; ++jb) {
                    f32x16 d = {}; d = __builtin_amdgcn_mfma_f32_32x32x16_bf16(ucur, bfr[2 + jb], d, 0, 0, 0);
#pragma unroll
                    for (int r = 0; r < 16; ++r) BuL[crow(r, hi) * 66 + 32 * jb + r32] = d[r];
                }
                asm volatile("s_waitcnt lgkmcnt(0)" ::: "memory");
#pragma unroll
                for (int t = 0; t < 32; ++t) bui[t] = BuL[t * 66 + lane];
                asm volatile("s_waitcnt lgkmcnt(0)" ::: "memory");
                if (pass == 0) {
#pragma unroll
                    for (int t = 0; t < 32; ++t) { const float nr = ar * hr - ai * him + bur[t], ni = ar * him + ai * hr + bui[t]; hr = nr; him = ni; }
                } else {
#pragma unroll
                    for (int t = 0; t < 32; ++t) { const float nr = ar * hr - ai * him + bur[t], ni = ar * him + ai * hr + bui[t]; hr = nr; him = ni;
                        ((LAS unsigned*)HL)[t * 68 + lane] = pk2(hr, him); }
                    asm volatile("s_waitcnt lgkmcnt(0)" ::: "memory");
                    f32x16 y = {};
#pragma unroll
                    for (int ks = 0; ks < 8; ++ks) { const bf16x8 af = *(const LAS bf16x8*)((const LAS unsigned char*)HL + (r32 * 136 + 16 * ks + 8 * hi) * 2);
                        y = __builtin_amdgcn_mfma_f32_32x32x16_bf16(cfr[ks], af, y, 0, 0, 0); }
                    asm volatile("s_waitcnt lgkmcnt(0)" ::: "memory");
                    if (s0 >= 256 || layer == 0) {
                        float* yp = Yd + (size_t)s5_tokrow(s0 + r32, dir, b) * 256 + 16 * g + 4 * hi;
                        *(f32x4*)yp = (f32x4){y[0], y[1], y[2], y[3]}; *(f32x4*)(yp + 8) = (f32x4){y[4], y[5], y[6], y[7]};
                    }
                }
            }
            if (pass == 0) {
                BuL[lane * 2] = hr; BuL[lane * 2 + 1] = him;
                __syncthreads();
                hr = 0.f; him = 0.f;
                for (int v = 0; v < wid; ++v) { const LAS float* cv = (const LAS float*)(lds + v * 17920); const float cr = cv[lane * 2], ci = cv[lane * 2 + 1]; const float nr = pr * hr - pi * him + cr, ni = pr * him + pi * hr + ci; hr = nr; him = ni; }
                __syncthreads();
            }
        }

    }
}

__device__ __forceinline__ void na_phase(LAS unsigned char* lds, int l) {
    CArgs& a = kargs();
    int tid_ = threadIdx.x; asm volatile("" : "+v"(tid_));
    const int tid = tid_, wid = __builtin_amdgcn_readfirstlane(tid >> 6), G = o_grid(), bid = o_bid();
    bf16* Zb = (bf16*)(a.ws + WS_Z); bf16* CAT = (bf16*)(a.ws + WS_CAT);
    LAS float* biasL = (LAS float*)(lds + 73728);
    for (int i = tid; i < 4 * 15 * 31; i += 512) biasL[i] = 8.f * a.in[I_NABIAS][l * 4 * 15 * 31 + i];
    for (int u = bid; u < 512; u += G) {
        const int b = u >> 5, r = u & 31; const int rs = r - 4 < 0 ? 0 : (r - 4 > 24 ? 24 : r - 4); const int head = wid >> 1;
        AttnP P{Zb, CAT, DM, b * 2048 + r * 64 + (wid & 1) * 32, OFF_NQ + head * 64, 512 + head * 64, OFF_NK, OFF_NV, b * 2048 + rs * 64, 8, MLAT + b * 256, 4, 1, (wid & 1) * 32, rs - r + 7, head};
        attn_unit<4>(lds, P, biasL);
    }
    if (l == 0) for (int u = bid; u < 64; u += G) {
        const int b = u >> 2, blk = u & 3; const int head = wid >> 1;
        AttnP P{Zb, CAT, DM, MLAT + b * 256 + blk * 64 + (wid & 1) * 32, OFF_NQ + head * 64, 512 + head * 64, OFF_NK, OFF_NV, 0, 0, MLAT + b * 256, 4, 0, 0, 0, head};
        attn_unit<4>(lds, P, biasL);
    }
}
__device__ __forceinline__ void gqa_phase(LAS unsigned char* lds, int l) {
    CArgs& a = kargs();
    int tid_ = threadIdx.x; asm volatile("" : "+v"(tid_));
    const int tid = tid_, wid = __builtin_amdgcn_readfirstlane(tid >> 6), G = o_grid(), bid = o_bid();
    bf16* Zb = (bf16*)(a.ws + WS_Z); bf16* CAT = (bf16*)(a.ws + WS_CAT);
    const bool bal = (G == 256); const int nmine = bal ? (bid < 128 ? 3 : 1) : (511 - bid) / G + 1;
    for (int iu = 0; iu < nmine; ++iu) {
        const int u = bal ? (bid < 128 ? bid + 128 * iu : 256 + bid) : bid + iu * G;
        const int b = u >> 5, kvh = (u >> 4) & 1, qb = u & 15; const int head = 2 * kvh + (wid >> 2);
        AttnP P{Zb, CAT, DM, b * 2048 + qb * 128 + (wid & 3) * 32, OFF_AQ + head * 64, head * 64, OFF_AK + kvh * 64, OFF_AV + kvh * 64, b * 2048, 32, MLAT + b * 256, 4, 0, 0, 0, head};
        attn_unit<1>(lds, P, nullptr);
    }
    if (l == 0) for (int u = bid; u < 64; u += G) {
        const int b = u >> 2, kvh = (u >> 1) & 1, qb = u & 1; const int head = 2 * kvh + (wid >> 2);
        AttnP P{Zb, CAT, DM, MLAT + b * 256 + qb * 128 + (wid & 3) * 32, OFF_AQ + head * 64, head * 64, OFF_AK + kvh * 64, OFF_AV + kvh * 64, 0, 0, MLAT + b * 256, 4, 0, 0, 0, head};
        attn_unit<1>(lds, P, nullptr);
    }
}

#define XB_TMO      128
#define XB_XCNT(j)  (256  + 64 * (j))
#define XB_XSUB(j)  (1280 + 64 * (j))
#define XB_XGEN(j)  (2304 + 64 * (j))
#define XB_TOP      3328
#define XB_TOPGEN   3392
#define XCD_BAR_WORDS 3456
#define XB_SPIN_CAP (1u << 18)

__device__ __forceinline__ unsigned xb_ld(unsigned* p)              { return __hip_atomic_load(p, __ATOMIC_RELAXED, __HIP_MEMORY_SCOPE_AGENT); }
__device__ __forceinline__ unsigned xb_add(unsigned* p, unsigned v) { return __hip_atomic_fetch_add(p, v, __ATOMIC_RELAXED, __HIP_MEMORY_SCOPE_AGENT); }
__device__ __forceinline__ unsigned xb_xcc_id() { return (unsigned)__builtin_amdgcn_s_getreg((3 << 11) | 20) & 0xFu; }
#define XB_SPIN(cond, bar) do { unsigned _sp = 0; while (cond) { __builtin_amdgcn_s_sleep(1); \
    if ((++_sp & 255u) == 0u) { if (xb_ld(&(bar)[XB_TMO])) break; if (_sp > XB_SPIN_CAP) { atomicAdd(&(bar)[XB_TMO], 1u); break; } } } } while (0)
struct XcdBarrier { unsigned* bar; unsigned x; volatile LAS unsigned* st; };
__device__ __forceinline__ void xcd_barrier_complete(unsigned* bar, unsigned x, unsigned& nloc, unsigned& nx) {
    const unsigned G = gridDim.x * gridDim.y * gridDim.z;
    unsigned sum, cnt, mine, sp = 0u;
    for (;;) {
        sum = 0u; cnt = 0u; mine = 0u;
#pragma unroll
        for (unsigned j = 0; j < 16; ++j) { const unsigned c = xb_ld(&bar[XB_XCNT(j)]); sum += c; cnt += (c > 0u) ? 1u : 0u; mine = (j == x) ? c : mine; }
        if (sum == G) break;
        __builtin_amdgcn_s_sleep(1);
        if ((++sp & 255u) == 0u) { if (xb_ld(&bar[XB_TMO])) break; if (sp > XB_SPIN_CAP) { atomicAdd(&bar[XB_TMO], 1u); break; } }
    }
    nloc = mine > 0u ? mine : 1u; nx = cnt > 0u ? cnt : 1u;
}

__device__ __forceinline__ void xcd_barrier(const XcdBarrier& b) {
    asm volatile("s_waitcnt vmcnt(0)" ::: "memory");
    __syncthreads();
    if (threadIdx.x == 0) {
        unsigned* bar = b.bar;
        __builtin_amdgcn_s_waitcnt(0);
        unsigned nloc = b.st[0], nx = b.st[1];
        if (nloc == 0u) { xcd_barrier_complete(bar, b.x, nloc, nx); b.st[0] = nloc; b.st[1] = nx; }
        const unsigned old = xb_add(&bar[XB_XSUB(b.x)], 1u);
        const unsigned gen = old / nloc;
        if (old + 1u == (gen + 1u) * nloc) {
            __builtin_amdgcn_fence(__ATOMIC_RELEASE, "agent");
            asm volatile("s_waitcnt vmcnt(0)" ::: "memory");
            const unsigned og = xb_add(&bar[XB_TOP], 1u);
            const unsigned tg = og / nx;
            if (og + 1u == (tg + 1u) * nx) xb_add(&bar[XB_TOPGEN], 1u);
            else XB_SPIN(xb_ld(&bar[XB_TOPGEN]) == tg, bar);
            __builtin_amdgcn_fence(__ATOMIC_ACQUIRE, "agent");
            xb_add(&bar[XB_XGEN(b.x)], 1u);
            asm volatile("s_waitcnt vmcnt(0)" ::: "memory");
        } else {
            XB_SPIN(xb_ld(&bar[XB_XGEN(b.x)]) == gen, bar);
            __builtin_amdgcn_fence(__ATOMIC_ACQUIRE, "agent");
            asm volatile("s_waitcnt vmcnt(0)" ::: "memory");
        }
    }
    __syncthreads();
}

template <class F>
__device__ __forceinline__ void run_gemm(LAS unsigned char* lds, const bf16* A, int lda, const bf16* Bt, int ldb, int M, int N, int K, const F& f, int c, long tsB = 0, int ksplit = 1 << 30, long kjumpB = 0) {
    pg8::Gemm g{A, Bt, M, N, K, lda, ldb, tsB ? tsB : (long)512 * ldb, ksplit, kjumpB}; pg8::StaticOrder S; S.init(M, N, o_grid(), c); Epi8<F> E{f};
    pg8::gemm_phase<Epi8<F>, pg8::StaticOrder, true, true>(lds, g, S, E);
}
#define WSP(off) ((bf16*)(ws + (off)))
__device__ __forceinline__ void ph_store_gemm(LAS unsigned char* lds, int l, int kind) {
    unsigned char* ws = kargs().ws; unsigned char* wb = ws + WS_W + (size_t)l * W_LAYER;
    const int Mr = l == 0 ? MT : MLAT;
    const bf16* A; const bf16* Bt; bf16* O; int lda, ldb, M, N, K, ldc, act;
    if (kind == 0)      { A = WSP(WS_XN);   lda = DM;  Bt = (const bf16*)(wb + WO_IN);  ldb = DM;  M = MT; N = INW; K = DM;  O = WSP(WS_Z);    ldc = INW; act = 0; }
    else if (kind == 1) { A = WSP(WS_CAT);  lda = DM;  Bt = (const bf16*)(wb + WO_OUT); ldb = DM;  M = Mr; N = DM;  K = DM;  O = WSP(WS_Y);    ldc = DM;  act = 0; }
    else if (kind == 2) { A = WSP(WS_XN);   lda = DM;  Bt = (const bf16*)(wb + WO_1);   ldb = DM;  M = Mr; N = DFF; K = DM;  O = WSP(WS_HMID); ldc = DFF; act = 1; }
    else if (kind == 3) { A = WSP(WS_HMID); lda = DFF; Bt = (const bf16*)(wb + WO_2);   ldb = DFF; M = Mr; N = DM;  K = DFF; O = WSP(WS_XN);   ldc = DM;  act = 0; }
    else                { A = (const bf16*)(wb + WO_CS); lda = 256; Bt = WSP(WS_Z) + OFF_FN; ldb = INW; M = 512; N = MT; K = 256; O = WSP(WS_C1); ldc = MT; act = 0; }
    run_gemm(lds, A, lda, Bt, ldb, M, N, K, FStore{O, ldc, act}, o_bid());
}
__device__ __forceinline__ void ph_d2(LAS unsigned char* lds, int l) { CArgs& a = kargs(); unsigned char* ws = a.ws;
    for (int j = 0; j < (l == 0 ? 2 : 1); ++j) {
        if (j == 0) run_gemm(lds, WSP(WS_DFT), 4096, WSP(WS_C1), MT, 2048, 4096, 4096, FD2{WSP(WS_CAT), a.in[I_BFNET] + l * 256, 0, 2048}, o_grid() - 1 - o_bid(), 2048 * 2, 32, ((long)256 * MT - 2048) * 2);
        else run_gemm(lds, WSP(WS_DFTC), 512, WSP(WS_C1) + MLAT, MT, 256, 4096, 512, FD2{WSP(WS_CAT), a.in[I_BFNET] + l * 256, MLAT, 256}, o_bid(), 256 * 2, 4, ((long)256 * MT - 256) * 2);
    } }
__device__ __forceinline__ void ph_glu(LAS unsigned char* lds, int l) { CArgs& a = kargs(); unsigned char* ws = a.ws; unsigned char* wb = ws + WS_W + (size_t)l * W_LAYER;
    const int Mr = l == 0 ? MT : MLAT;
    {
        int tid_ = threadIdx.x; asm volatile("" : "+v"(tid_));
        pg8::StaticOrder S; S.init(Mr, 256, o_grid(), o_bid()); pg8::Unit u;
        const bf16* Z = WSP(WS_Z); const float* Y0 = (const float*)(ws + WS_Y0); const float* Y1 = (const float*)(ws + WS_Y1); bf16* T = WSP(WS_T);
        const int c8 = (tid_ & 31) * 8;
        float dk[8];
#pragma unroll
        for (int e = 0; e < 8; ++e) dk[e] = a.in[I_S5D][l * 256 + c8 + e];
        for (int i = 0; S.next(i, u); ++i)
            for (int rr = tid_ >> 5; rr < 256; rr += 16) {
                const size_t row = (size_t)u.pm * 256 + rr;
                const v4u uz = *(const v4u*)(Z + row * INW + OFF_S5 + c8);
                const f32x4 a0 = *(const f32x4*)(Y0 + row * 256 + c8), a1 = *(const f32x4*)(Y0 + row * 256 + c8 + 4), b0 = *(const f32x4*)(Y1 + row * 256 + c8), b1 = *(const f32x4*)(Y1 + row * 256 + c8 + 4);
                const float uv[8] = {bflo(uz.x), bfhi(uz.x), bflo(uz.y), bfhi(uz.y), bflo(uz.z), bfhi(uz.z), bflo(uz.w), bfhi(uz.w)};
                float o[8];
#pragma unroll
                for (int e = 0; e < 8; ++e) { const float v = (e < 4 ? a0[e] + b0[e] : a1[e - 4] + b1[e - 4]) + dk[e] * uv[e];
                    const float uu = 0.7978845608028654f * (v + 0.044715f * v * v * v); o[e] = v / (1.f + __expf(-2.f * uu)); }
                v4u w; w.x = pk2(o[0], o[1]); w.y = pk2(o[2], o[3]); w.z = pk2(o[4], o[5]); w.w = pk2(o[6], o[7]);
                *(v4u*)(T + row * 256 + c8) = w;
            }
        __threadfence(); __syncthreads();
    }
    int K = 256, ld = 256; asm volatile("" : "+s"(K), "+s"(ld));
    run_gemm(lds, WSP(WS_T), ld, (const bf16*)(wb + WO_GLU), ld, Mr, 256, K, FGlu{WSP(WS_CAT), WSP(WS_T)}, o_bid()); }

__global__ void __launch_bounds__(512, 2) fwd_megakernel(Args a_unused) {
    extern __shared__ __attribute__((aligned(16))) unsigned char lds_raw[];
    LAS unsigned char* lds = (LAS unsigned char*)lds_raw;
    cg::grid_group grid = cg::this_grid();
#ifdef PROBE
    if (blockIdx.x == 0 && threadIdx.x == 0) { unsigned char* pw = kargs().ws + WS_PROBE; for (int i = 0; i < 32; ++i) ((float*)pw)[i] = 0.f; *(unsigned long long*)(pw + 256) = __builtin_amdgcn_s_memrealtime(); }
#endif
    {
        unsigned* bar = (unsigned*)(kargs().ws + WS_BAR);
        if (blockIdx.x == 0) for (int i = threadIdx.x; i < XCD_BAR_WORDS; i += 512) bar[i] = 0u;
        if (threadIdx.x < 2) ((volatile LAS unsigned*)(lds + LDS_BARST))[threadIdx.x] = 0u;
    }
    for (int step = 0; step < 20; ++step) {
        const int l = step < 2 ? 0 : (step - 2) / 9, k = step < 2 ? step - 2 : (step - 2) - 9 * l;
        int gk = -1;
        if (k == 0) gk = 0; else if (k == 2) gk = 4; else if (k == 4) gk = 1; else if (k == 6) gk = 2; else if (k == 7) gk = 3;
        int lbl = k == -2 ? 0 : k == -1 ? 1 : k == 0 ? 2 : k == 1 ? 5 : k == 2 ? 6 : k == 3 ? 9 : k == 4 ? 10 : k == 5 ? 11 : k == 6 ? 12 : k == 7 ? 13 : 14; (void)lbl;
#ifdef DBL_GEMM
        if (gk >= 0) { ph_store_gemm(lds, l, gk); __syncthreads(); }
#endif
#ifdef DBL_ROWS
        if (k == -1) prep_rows0(); if (k == 5 && l == 0) row_update<0>();
#endif
        if (gk >= 0) ph_store_gemm(lds, l, gk);
        else if (k == -2) prologue(lds);
        else if (k == -1) prep_rows0();
        else if (k == 1) {
            qk_prep(l);
            __syncthreads(); STAMP(3);
            na_phase(lds, l);
#ifdef DBL_NA
            __syncthreads(); na_phase(lds, l);
#endif
            __syncthreads(); STAMP(4);
            for (int u = o_bid(); u < 256; u += o_grid()) s5_unit(lds, l, u >> 4, u & 15);
#ifdef DBL_S5
            __syncthreads(); for (int u = o_bid(); u < 256; u += o_grid()) s5_unit(lds, l, u >> 4, u & 15);
#endif
        } else if (k == 3) {
            gqa_phase(lds, l);
#ifdef DBL_GQA
            __syncthreads(); gqa_phase(lds, l);
#endif
            __syncthreads(); STAMP(7);
            ph_d2(lds, l); STAMP(8);
            ph_glu(lds, l);
        } else if (k == 5) { if (l == 0) row_update<0>(); else row_update<2>(); }
        else { if (l == 0) row_update<1>(); else row_update<3>(); }
        if (step == 0) {
            grid.sync();
            if (threadIdx.x == 0) (void)xb_add(&((unsigned*)(kargs().ws + WS_BAR))[XB_XCNT(xb_xcc_id())], 1u);
        } else if (k == 1) { __syncthreads(); }
        else if (step != 19) {
            XcdBarrier xb; xb.bar = (unsigned*)(kargs().ws + WS_BAR); xb.x = xb_xcc_id(); xb.st = (volatile LAS unsigned*)(lds + LDS_BARST);
            xcd_barrier(xb);
        }
        STAMP(lbl);
    }
}

extern "C" void kernel_launch(void* const* d_in, const int* in_sizes, int n_in, void* d_out, int out_size, void* d_ws, size_t ws_size, hipStream_t stream) {
    static int grid = 0;
    if (grid == 0) {
        if (n_in != 28 || ws_size < WS_END) { fprintf(stderr, "kernel_launch: unexpected n_in %d / ws_size %zu (need %zu)\n", n_in, ws_size, (size_t)WS_END); grid = -1; return; }
        int dev = 0, cus = 0, per_cu = 0;
        hipGetDevice(&dev); hipDeviceGetAttribute(&cus, hipDeviceAttributeMultiprocessorCount, dev);
        if (hipFuncSetAttribute((const void*)fwd_megakernel, hipFuncAttributeMaxDynamicSharedMemorySize, LDS_BYTES) != hipSuccess) { fprintf(stderr, "kernel_launch: hipFuncSetAttribute failed\n"); }
        if (hipOccupancyMaxActiveBlocksPerMultiprocessor(&per_cu, (const void*)fwd_megakernel, 512, LDS_BYTES) != hipSuccess || per_cu < 1) { fprintf(stderr, "kernel_launch: occupancy query says %d\n", per_cu); per_cu = 1; }
        (void)hipGetLastError();
        grid = cus * (per_cu > 1 ? 1 : per_cu);
        if (grid <= 0) grid = 256;
    }
    if (grid < 0) return;
    Args a{};
    for (int i = 0; i < 28; ++i) a.in[i] = (const float*)d_in[i];
    a.out = (float*)d_out; a.ws = (unsigned char*)d_ws;
    void* args[] = {&a};
    hipError_t e = hipLaunchCooperativeKernel((const void*)fwd_megakernel, dim3(grid), dim3(512), args, LDS_BYTES, stream);
    if (e != hipSuccess) fprintf(stderr, "cooperative launch failed: %s (grid %d)\n", hipGetErrorString(e), grid);
}
```

```cpp
#include <hip/hip_runtime.h>
#include <hip/hip_cooperative_groups.h>
#include <cstdio>
#include <cstdint>
namespace cg = cooperative_groups;
namespace pg8 {
#define PG8_LAS __attribute__((address_space(3)))
typedef unsigned short bf16_t;
typedef short bf16x8 __attribute__((ext_vector_type(8)));
typedef float f32x4 __attribute__((ext_vector_type(4)));
typedef unsigned u32x4 __attribute__((ext_vector_type(4)));
constexpr int BM = 256, BK = 64, HALF = 128, HTB = HALF * BK * 2  , STAGE_BYTES = 8 * HTB, NXCD = 8, WGM = 8;

__host__ __device__ __forceinline__ int lds_byte(int r, int c) { const int st = (r >> 4) * 2 + (c >> 5), rr = r & 15, cc = c & 31, ob = rr * 64 + cc * 2; return st * 1024 + (ob ^ (((ob >> 9) & 1) << 5)); }
__host__ __device__ __forceinline__ void stage_rc(int b, int& R, int& C) { const int st = b / 1024, sb = b % 1024, swz = sb ^ (((sb >> 9) & 1) << 5); R = (st >> 1) * 16 + swz / 64; C = (st & 1) * 32 + (swz % 64) / 2; }
__host__ __device__ __forceinline__ int perm32(int rho) { const int n = rho >> 4, i = rho & 15; return 8 * (i >> 2) + 4 * n + (i & 3); }

struct Unit { int pm, pn; };
struct Gemm { const bf16_t* A; const bf16_t* Bt; int M, N, K, lda, ldb; long tsB; int ksplit; long kjumpB; };

struct StaticOrder {
    int nM, nN, nwg, G, c;
    __host__ __device__ void init(int M, int N, int G_, int c_) { nM = M / BM; nN = N / BM; nwg = nM * nN; G = G_; c = c_; }
    __host__ __device__ bool next(int i, Unit& u) const {
        const long L = (long)i * G + c; if (L >= nwg) return false;
        int wgid = (int)L; { const int q = nwg / NXCD, r = nwg % NXCD, xcd = wgid % NXCD, off = wgid / NXCD; wgid = (xcd < r ? xcd * (q + 1) : r * (q + 1) + (xcd - r) * q) + off; }
        const int nig = WGM * nN, gid = wgid / nig, fm = gid * WGM, gsz = (nM - fm) < WGM ? (nM - fm) : WGM;
        u.pm = fm + ((wgid % nig) % gsz); u.pn = (wgid % nig) / gsz; return true;
    }
    __device__ __forceinline__ void a_ready(const Unit&) const {}
    __device__ __forceinline__ void done(const Unit&) const {}
};
__device__ __forceinline__ unsigned cvt_pk_bf16(float lo, float hi) { unsigned r; asm volatile("v_cvt_pk_bf16_f32 %0, %1, %2" : "=v"(r) : "v"(lo), "v"(hi)); return r; }
template <class Epi, class Sched, bool ALIGN_EPI = false, bool SP2 = false>
__device__ __forceinline__ void gemm_phase(PG8_LAS unsigned char* lds, const Gemm g, const Sched& S, const Epi& E) {
    int tid_ = threadIdx.x; asm volatile("" : "+v"(tid_));
    const int tid = tid_, wid = __builtin_amdgcn_readfirstlane(tid >> 6), lane = tid & 63, wr = wid >> 2, wc = wid & 3, fr = lane & 15, fq = lane >> 4;
    const int K = g.K, nt = K / BK;
    unsigned voffA[2], voffB[2];
#pragma unroll
    for (int i = 0; i < 2; ++i) { int R, C; stage_rc(tid * 16 + i * 8192, R, C); const int Rb = Epi::PERM ? ((R & ~31) + perm32(R & 31)) : R;
        voffA[i] = (unsigned)(R * g.lda + C) * 2u; voffB[i] = (unsigned)(Rb * g.ldb + C) * 2u; }
    const size_t kstep = (size_t)(BK * 2);
    const size_t hstepA = (size_t)HALF * g.lda * 2, hstepB = (size_t)HALF * g.ldb * 2;
    const size_t tstepA = 2 * hstepA, tstepB = (size_t)g.tsB;
    const unsigned ldsw = (unsigned)wid * 1024u;
    const int aoff = lds_byte(wr * 64 + fr, fq * 8), boff = lds_byte(wc * 32 + fr, fq * 8);
#define PG8_SA(b, h) (((b) * 2 + (h)) * HTB)
#define PG8_SB(b, h) ((4 + (b) * 2 + (h)) * HTB)
#define PG8_STAGE(bufoff, gbase, voff) do { _Pragma("unroll") for (int _i = 0; _i < 2; ++_i) \
        __builtin_amdgcn_global_load_lds((const unsigned*)((const char*)(gbase) + (voff)[_i]), (PG8_LAS unsigned*)(lds + (bufoff) + ldsw + _i * 8192), 16, 0, 0); } while (0)
#define PG8_LDA(dst, b, h) do { _Pragma("unroll") for (int m = 0; m < 4; ++m) _Pragma("unroll") for (int k = 0; k < 2; ++k) dst[m][k] = *(const PG8_LAS bf16x8*)(lds + PG8_SA(b, h) + aoff + m * 2048 + k * 1024); } while (0)
#define PG8_LDB(dst, b, h) do { _Pragma("unroll") for (int n = 0; n < 2; ++n) _Pragma("unroll") for (int k = 0; k < 2; ++k) dst[n][k] = *(const PG8_LAS bf16x8*)(lds + PG8_SB(b, h) + boff + n * 2048 + k * 1024); } while (0)
#define PG8_MMA(ai, bj, At, Bt) do { __builtin_amdgcn_s_setprio(1); _Pragma("unroll") for (int m = 0; m < 4; ++m) _Pragma("unroll") for (int n = 0; n < 2; ++n) _Pragma("unroll") for (int k = 0; k < 2; ++k) \
        acc[ai][bj][m][n] = __builtin_amdgcn_mfma_f32_16x16x32_bf16(Bt[n][k], At[m][k], acc[ai][bj][m][n], 0, 0, 0); __builtin_amdgcn_s_setprio(0); } while (0)
#define PG8_WAIT_V(n) asm volatile("s_waitcnt vmcnt(" #n ")" ::: "memory")
#define PG8_WAIT_L(n) asm volatile("s_waitcnt lgkmcnt(" #n ")" ::: "memory")
#define PG8_BAR __builtin_amdgcn_s_barrier()
#define PG8_SCHED __builtin_amdgcn_sched_barrier(0)
    Unit cur, nxt; int ui = 0;
    if (!S.next(0, cur)) return;
    f32x4 acc[2][2][4][2];
#pragma unroll
    for (int a = 0; a < 2; ++a)
#pragma unroll
        for (int b = 0; b < 2; ++b)
#pragma unroll
            for (int m = 0; m < 4; ++m)
#pragma unroll
                for (int n = 0; n < 2; ++n) acc[a][b][m][n] = (f32x4){0.f, 0.f, 0.f, 0.f};
    bf16x8 At[4][2], B0[2][2], B1[2][2];
    const char* cA = (const char*)g.A + (size_t)cur.pm * tstepA; const char* cB = (const char*)g.Bt + (size_t)cur.pn * tstepB;
    S.a_ready(cur);
    if constexpr (SP2) {
        PG8_STAGE(PG8_SB(0, 0), cB, voffB); PG8_STAGE(PG8_SB(0, 1), cB + hstepB, voffB); PG8_STAGE(PG8_SA(0, 0), cA, voffA); PG8_STAGE(PG8_SA(0, 1), cA + hstepA, voffA);
        if (wr == 1) PG8_BAR;
        PG8_WAIT_V(2); PG8_BAR;
        PG8_STAGE(PG8_SB(1, 0), cB + kstep, voffB); PG8_STAGE(PG8_SA(1, 0), cA + kstep, voffA); PG8_STAGE(PG8_SB(1, 1), cB + hstepB + kstep, voffB);
        PG8_WAIT_V(6); PG8_BAR;
    } else {
        PG8_STAGE(PG8_SB(0, 0), cB, voffB); PG8_STAGE(PG8_SA(0, 0), cA, voffA); PG8_STAGE(PG8_SB(0, 1), cB + hstepB, voffB); PG8_STAGE(PG8_SA(0, 1), cA + hstepA, voffA);
        if (wr == 1) PG8_BAR;
        PG8_WAIT_V(4); PG8_BAR;
        PG8_STAGE(PG8_SB(1, 0), cB + kstep, voffB); PG8_STAGE(PG8_SA(1, 0), cA + kstep, voffA); PG8_STAGE(PG8_SB(1, 1), cB + hstepB + kstep, voffB);
        PG8_WAIT_V(6); PG8_BAR;
    }
    for (;;) {
        const bool has_next = S.next(ui + 1, nxt);
        const char* nA = has_next ? (const char*)g.A + (size_t)nxt.pm * tstepA : cA; const char* nB = has_next ? (const char*)g.Bt + (size_t)nxt.pn * tstepB : cB;
        for (int t = 0; t < nt; t += 2) {
            const bool last = (t == nt - 2);
            const char* a1 = cA + (size_t)(t + 1) * kstep;
            const char* a2 = last ? nA : cA + (size_t)(t + 2) * kstep; const char* b2 = last ? nB : cB + (size_t)(t + 2) * kstep + ((t + 2) >= g.ksplit ? g.kjumpB : 0);
            const char* a3 = a2 + kstep; const char* b3 = b2 + kstep;
            if (last && has_next) S.a_ready(nxt);
            if constexpr (SP2) {
            PG8_LDB(B0, 0, 0); PG8_LDB(B1, 0, 1); PG8_SCHED; PG8_LDA(At, 0, 0); PG8_STAGE(PG8_SA(1, 1), a1 + hstepA, voffA);
            PG8_WAIT_V(8); PG8_WAIT_L(0); PG8_BAR; PG8_MMA(0, 0, At, B0); PG8_MMA(0, 1, At, B1); PG8_BAR; PG8_SCHED;
            PG8_LDA(At, 0, 1); PG8_STAGE(PG8_SB(0, 0), b2, voffB); PG8_STAGE(PG8_SB(0, 1), b2 + hstepB, voffB); PG8_STAGE(PG8_SA(0, 0), a2, voffA);
            PG8_WAIT_V(8); PG8_WAIT_L(0); PG8_BAR; PG8_MMA(1, 0, At, B0); PG8_MMA(1, 1, At, B1); PG8_BAR; PG8_SCHED;
            PG8_LDB(B0, 1, 0); PG8_LDB(B1, 1, 1); PG8_SCHED; PG8_LDA(At, 1, 0); PG8_STAGE(PG8_SA(0, 1), a2 + hstepA, voffA);
            PG8_WAIT_V(8); PG8_WAIT_L(0); PG8_BAR; PG8_MMA(0, 0, At, B0); PG8_MMA(0, 1, At, B1); PG8_BAR; PG8_SCHED;
            PG8_LDA(At, 1, 1); PG8_STAGE(PG8_SB(1, 0), b3, voffB); PG8_STAGE(PG8_SB(1, 1), b3 + hstepB, voffB); PG8_STAGE(PG8_SA(1, 0), a3, voffA);
            PG8_WAIT_V(8); PG8_WAIT_L(0); PG8_BAR; PG8_MMA(1, 0, At, B0); PG8_MMA(1, 1, At, B1); PG8_BAR; PG8_SCHED;
            } else {
            PG8_LDB(B0, 0, 0); PG8_SCHED; PG8_LDA(At, 0, 0); PG8_STAGE(PG8_SA(1, 1), a1 + hstepA, voffA);
            PG8_WAIT_L(8); PG8_BAR; PG8_WAIT_L(0); PG8_MMA(0, 0, At, B0); PG8_BAR; PG8_SCHED;
            PG8_LDB(B1, 0, 1); PG8_STAGE(PG8_SB(0, 0), b2, voffB);
            PG8_BAR; PG8_WAIT_L(0); PG8_MMA(0, 1, At, B1); PG8_BAR;
            PG8_LDA(At, 0, 1); PG8_STAGE(PG8_SA(0, 0), a2, voffA);
            PG8_BAR; PG8_WAIT_L(0); PG8_MMA(1, 0, At, B0); PG8_BAR; PG8_SCHED;
            PG8_STAGE(PG8_SB(0, 1), b2 + hstepB, voffB);
            PG8_WAIT_V(6); PG8_BAR; PG8_MMA(1, 1, At, B1); PG8_BAR;
            PG8_LDB(B0, 1, 0); PG8_SCHED; PG8_LDA(At, 1, 0); PG8_STAGE(PG8_SA(0, 1), a2 + hstepA, voffA);
            PG8_WAIT_L(8); PG8_BAR; PG8_WAIT_L(0); PG8_MMA(0, 0, At, B0); PG8_BAR; PG8_SCHED;
            PG8_LDB(B1, 1, 1); PG8_STAGE(PG8_SB(1, 0), b3, voffB);
            PG8_BAR; PG8_WAIT_L(0); PG8_MMA(0, 1, At, B1); PG8_BAR;
            PG8_LDA(At, 1, 1); PG8_STAGE(PG8_SA(1, 0), a3, voffA);
            PG8_BAR; PG8_WAIT_L(0); PG8_MMA(1, 0, At, B0); PG8_BAR; PG8_SCHED;
            PG8_STAGE(PG8_SB(1, 1), b3 + hstepB, voffB);
            PG8_WAIT_V(6); PG8_BAR; PG8_MMA(1, 1, At, B1); PG8_BAR;
            }
        }
        if constexpr (ALIGN_EPI) { if (wr == 0) PG8_BAR; }
        if constexpr (!Epi::AFTER_DRAIN) { E(acc, cur, wr, wc, fr, fq); S.done(cur); }
        if (!has_next) break;
#pragma unroll
        for (int a = 0; a < 2; ++a)
#pragma unroll
            for (int b = 0; b < 2; ++b)
#pragma unroll
                for (int m = 0; m < 4; ++m)
#pragma unroll
                    for (int n = 0; n < 2; ++n) acc[a][b][m][n] = (f32x4){0.f, 0.f, 0.f, 0.f};
        cur = nxt; cA = nA; cB = nB; ++ui;
        if constexpr (ALIGN_EPI) { if (wr == 1) PG8_BAR; }
    }
    PG8_WAIT_V(0);
    if constexpr (!ALIGN_EPI) { if (wr == 0) PG8_BAR; }
    PG8_BAR;
    if constexpr (Epi::AFTER_DRAIN) { E.fused(acc, cur, wr, wc, fr, fq, lds, wid, lane); S.done(cur); }
#undef PG8_SA
#undef PG8_SB
#undef PG8_STAGE
#undef PG8_LDA
#undef PG8_LDB
#undef PG8_MMA
#undef PG8_WAIT_V
#undef PG8_WAIT_L
#undef PG8_BAR
#undef PG8_SCHED
}
}
#define LAS __attribute__((address_space(3)))
typedef unsigned short bf16;
typedef unsigned v4u __attribute__((ext_vector_type(4)));
typedef unsigned v2u __attribute__((ext_vector_type(2)));
typedef float f32x4 __attribute__((ext_vector_type(4)));
typedef float f32x16 __attribute__((ext_vector_type(16)));
typedef short bf16x8 __attribute__((ext_vector_type(8)));
typedef short s16x4 __attribute__((ext_vector_type(4)));

constexpr int DM = 1024, NB = 16, SEQ = 2048, CTXL = 256, MLAT = NB * SEQ, MCTX = NB * CTXL, MT = MLAT + MCTX, INW = 1792, DFF = 4096;
constexpr int OFF_AQ = 0, OFF_AK = 256, OFF_AV = 384, OFF_S5 = 512, OFF_NQ = 768, OFF_NK = 1024, OFF_NV = 1280, OFF_FN = 1536;
constexpr float EPSN = 1e-6f;
constexpr float LOG2E = 1.4426950408889634f;
constexpr size_t MiB = 1u << 20;
constexpr size_t WS_MOD = 0;
constexpr size_t WS_ROPE = 1 * MiB;
constexpr size_t WS_W = 2 * MiB, W_LAYER = 22 * MiB;
constexpr size_t WO_IN = 0, WO_OUT = WO_IN + (size_t)INW * DM * 2, WO_1 = WO_OUT + (size_t)DM * DM * 2, WO_2 = WO_1 + (size_t)DFF * DM * 2,
                 WO_GLU = WO_2 + (size_t)DFF * DM * 2, WO_CS = WO_GLU + 256 * 256 * 2, WO_END = WO_CS + 512 * 256 * 2;
static_assert(WO_END <= W_LAYER, "weights");
constexpr size_t WS_DFT = 46 * MiB, WS_DFTC = 62 * MiB, WS_XC = 64 * MiB, WS_XN = 80 * MiB;
constexpr size_t WS_T = 116 * MiB, WS_C1 = 350 * MiB;
constexpr size_t WS_Z = 152 * MiB, WS_CAT = 278 * MiB, WS_Y = 350 * MiB, WS_HMID = 152 * MiB, WS_Y0 = 440 * MiB, WS_Y1 = 476 * MiB, WS_END = 512 * MiB;
constexpr int LDS_BYTES = 147456;

struct Args { const float* in[28]; float* out; unsigned char* ws; };
typedef __attribute__((address_space(4))) const Args CArgs;
__device__ __forceinline__ CArgs& kargs() { CArgs* p = (CArgs*)__builtin_amdgcn_kernarg_segment_ptr(); asm volatile("" : "+s"(p)); return *p; }
enum { I_X = 0, I_C, I_CTX, I_CCTX, I_WADA, I_BADA, I_GPREMIX, I_GPOSTMIX, I_GPREMLP, I_GPOSTMLP, I_WIN, I_GQ, I_GK, I_AR, I_AI, I_LDT, I_BR, I_BI, I_CR, I_CI,
       I_S5D, I_WGLU, I_NABIAS, I_WFNET, I_BFNET, I_WOUT, I_W1, I_W2 };

constexpr size_t WS_PROBE = 1 * MiB + 65536;
constexpr size_t WS_BAR = 1 * MiB + 131072;
constexpr int LDS_BARST = 147456 - 64;
#ifdef PROBE
#define STAMP(lbl) do { if (blockIdx.x == 0 && threadIdx.x == 0) { unsigned char* pw_ = kargs().ws + WS_PROBE; const unsigned long long now_ = __builtin_amdgcn_s_memrealtime(); \
    unsigned long long* tp_ = (unsigned long long*)(pw_ + 256); ((float*)pw_)[lbl] += (float)(now_ - *tp_); *tp_ = now_; } } while (0)
#else
#define STAMP(lbl) do {} while (0)
#endif
__device__ __forceinline__ unsigned f2bf(float f) { unsigned u = __builtin_bit_cast(unsigned, f); return (u + 0x7fffu + ((u >> 16) & 1u)) >> 16; }
typedef float f32x2_t __attribute__((ext_vector_type(2))); typedef __bf16 bf16x2_t __attribute__((ext_vector_type(2)));
__device__ __forceinline__ unsigned pk2(float lo, float hi) { const f32x2_t v = {lo, hi}; const bf16x2_t b = __builtin_convertvector(v, bf16x2_t); return __builtin_bit_cast(unsigned, b); }
__device__ __forceinline__ float bflo(unsigned w) { return __builtin_bit_cast(float, w << 16); }
__device__ __forceinline__ float bfhi(unsigned w) { return __builtin_bit_cast(float, w & 0xffff0000u); }
__device__ __forceinline__ float bf2f(bf16 h) { return __builtin_bit_cast(float, (unsigned)h << 16); }
__device__ __forceinline__ int o_bid() { int t = blockIdx.x; asm volatile("" : "+s"(t)); return t; }
__device__ __forceinline__ int o_grid() { int t = gridDim.x; asm volatile("" : "+s"(t)); return t; }
__device__ __forceinline__ float shfl_xor_l(float v, int o, int lane) { return __builtin_bit_cast(float, __builtin_amdgcn_ds_bpermute((lane ^ o) << 2, __builtin_bit_cast(int, v))); }
__device__ __forceinline__ float wave_sum(float v, int lane) {
#pragma unroll
    for (int o = 1; o < 64; o <<= 1) v += shfl_xor_l(v, o, lane);
    return v;
}
__device__ __forceinline__ int crow(int r, int hi) { return (r & 3) + 8 * (r >> 2) + 4 * hi; }

template <class F> struct Epi8 {
    static constexpr bool PERM = true, AFTER_DRAIN = false;
    F f;
    __device__ __forceinline__ void operator()(const pg8::f32x4 (&acc)[2][2][4][2], const pg8::Unit& u, int wr, int wc, int fr, int fq) const {
        asm volatile("" : "+v"(fr), "+v"(fq));
#pragma unroll
        for (int ai = 0; ai < 2; ++ai)
#pragma unroll
            for (int m = 0; m < 4; ++m) {
                const int row = u.pm * 256 + ai * 128 + wr * 64 + m * 16 + fr;
#pragma unroll
                for (int bj = 0; bj < 2; ++bj) { const int col = u.pn * 256 + bj * 128 + wc * 32 + 8 * fq; f(row, col, acc[ai][bj][m][0], acc[ai][bj][m][1]); }
                asm volatile("" ::: "memory"); __builtin_amdgcn_sched_barrier(0);
            }
    }
};
__device__ __forceinline__ v4u pack8(f32x4 a, f32x4 b) { v4u w; w.x = pk2(a[0], a[1]); w.y = pk2(a[2], a[3]); w.z = pk2(b[0], b[1]); w.w = pk2(b[2], b[3]); return w; }
struct FStore { bf16* O; int ldc; int act;
    __device__ __forceinline__ void operator()(int row, int col, f32x4 a, f32x4 b) const {
        if (act == 1) {
#pragma unroll
            for (int i = 0; i < 4; ++i) { float x = a[i] > 0.f ? a[i] : 0.f; a[i] = x * x; float y = b[i] > 0.f ? b[i] : 0.f; b[i] = y * y; } }
        *(v4u*)(O + (size_t)row * ldc + col) = pack8(a, b); } };
struct FD2 { bf16* cat; const float* bias; int rowbase, rowsPerB;
    __device__ __forceinline__ void operator()(int row, int col, f32x4 a, f32x4 b) const {
        const int bb = col >> 8, j = col & 255; const f32x4 b0 = *(const f32x4*)(bias + j), b1 = *(const f32x4*)(bias + j + 4);
        *(v4u*)(cat + ((size_t)(rowbase + bb * rowsPerB + row) * 1024 + 768 + j)) = pack8(a + b0, b + b1); } };
struct FGlu { bf16* cat; const bf16* T;
    __device__ __forceinline__ void operator()(int row, int col, f32x4 a, f32x4 b) const {
        const v4u t = *(const v4u*)(T + (size_t)row * 256 + col);
        float tv[8] = {bflo(t.x), bfhi(t.x), bflo(t.y), bfhi(t.y), bflo(t.z), bfhi(t.z), bflo(t.w), bfhi(t.w)};
#pragma unroll
        for (int i = 0; i < 4; ++i) { a[i] = tv[i] / (1.f + __expf(-a[i])); b[i] = tv[4 + i] / (1.f + __expf(-b[i])); }
        *(v4u*)(cat + (size_t)row * 1024 + 256 + col) = pack8(a, b); } };
__device__ __forceinline__ void transpose_item(const float* W, int K, int N, bf16* WT, LAS float* scr, int item, int lane) {
    const int nblk = N / 32, kb = item / nblk, nb = item % nblk, k0 = 64 * kb, n0 = 32 * nb;
#pragma unroll
    for (int i = 0; i < 8; ++i) { const int kk = 8 * i + (lane >> 3), n4 = (lane & 7) * 4; const f32x4 v = *(const f32x4*)(W + (size_t)(k0 + kk) * N + n0 + n4);
        scr[kk * 33 + n4] = v[0]; scr[kk * 33 + n4 + 1] = v[1]; scr[kk * 33 + n4 + 2] = v[2]; scr[kk * 33 + n4 + 3] = v[3]; }
    asm volatile("s_waitcnt lgkmcnt(0)" ::: "memory");
    const int c = lane & 7;
#pragma unroll
    for (int j = 0; j < 4; ++j) { const int n = (lane >> 3) + 8 * j; const LAS float* s = scr + (8 * c) * 33 + n;
        v4u o; o.x = pk2(s[0 * 33], s[1 * 33]); o.y = pk2(s[2 * 33], s[3 * 33]); o.z = pk2(s[4 * 33], s[5 * 33]); o.w = pk2(s[6 * 33], s[7 * 33]);
        *(v4u*)(WT + (size_t)(n0 + n) * K + k0 + 8 * c) = o; }
    asm volatile("s_waitcnt lgkmcnt(0)" ::: "memory");
}

__device__ __forceinline__ void prologue(LAS unsigned char* lds) {
    CArgs& a = kargs();
    int tid_ = threadIdx.x; asm volatile("" : "+v"(tid_));
    const int tid = tid_, lane = tid & 63, wid = tid >> 6, G = o_grid();
    unsigned char* ws = a.ws;
    {
        LAS float* scr = (LAS float*)(lds + wid * 16384);
        const int gw = o_bid() * 8 + wid, NGW = G * 8;
        constexpr int I0 = (DM / 64) * (INW / 32), I1 = (DM / 64) * (DM / 32), I2 = (DM / 64) * (DFF / 32), I3 = (DFF / 64) * (DM / 32), I4 = (256 / 64) * (256 / 32);
        constexpr int PER = I0 + I1 + I2 + I3 + I4;
        for (int it = gw; it < 2 * PER; it += NGW) {
            const int l = it / PER; int r = it % PER; unsigned char* wb = ws + WS_W + (size_t)l * W_LAYER;
            if (r < I0) { transpose_item(a.in[I_WIN] + (size_t)l * DM * INW, DM, INW, (bf16*)(wb + WO_IN), scr, r, lane); continue; } r -= I0;
            if (r < I1) { transpose_item(a.in[I_WOUT] + (size_t)l * DM * DM, DM, DM, (bf16*)(wb + WO_OUT), scr, r, lane); continue; } r -= I1;
            if (r < I2) { transpose_item(a.in[I_W1] + (size_t)l * DM * DFF, DM, DFF, (bf16*)(wb + WO_1), scr, r, lane); continue; } r -= I2;
            if (r < I3) { transpose_item(a.in[I_W2] + (size_t)l * DFF * DM, DFF, DM, (bf16*)(wb + WO_2), scr, r, lane); continue; } r -= I3;
            transpose_item(a.in[I_WGLU] + (size_t)l * 256 * 256, 256, 256, (bf16*)(wb + WO_GLU), scr, r, lane);
        }
    }
    __syncthreads();
    {
        LAS float* sl = (LAS float*)lds;
        LAS float* part = (LAS float*)(lds + 17 * 1024 * 4);
        float* mod = (float*)(ws + WS_MOD);
        bool have = false;
        for (int u = o_bid(); u < 2 * 96; u += G) {
            if (!have) {
                for (int i = tid; i < 17 * 1024; i += 512) { const float cv = i < 16 * 1024 ? a.in[I_C][i] : a.in[I_CCTX][i - 16 * 1024]; sl[i] = cv / (1.f + __expf(-cv)); }
                have = true; __syncthreads();
            }
            const int l = u / 96, n0 = (u % 96) * 64;
            const float* W = a.in[I_WADA] + (size_t)l * DM * 6144 + n0 + lane;
            float acc[17];
#pragma unroll
            for (int i = 0; i < 17; ++i) acc[i] = 0.f;
            for (int k0 = wid * 128; k0 < wid * 128 + 128; k0 += 16) {
                float wv[16];
#pragma unroll
                for (int q = 0; q < 16; ++q) wv[q] = W[(size_t)(k0 + q) * 6144];
#pragma unroll
                for (int q = 0; q < 16; ++q)
#pragma unroll
                    for (int i = 0; i < 17; ++i) acc[i] += sl[i * 1024 + k0 + q] * wv[q];
            }
#pragma unroll
            for (int i = 0; i < 17; ++i) part[(wid * 17 + i) * 64 + lane] = acc[i];
            __syncthreads();
            for (int o = tid; o < 17 * 64; o += 512) {
                const int i = o >> 6, n = o & 63; float s = a.in[I_BADA][l * 6144 + n0 + n];
#pragma unroll
                for (int w = 0; w < 8; ++w) s += part[(w * 17 + i) * 64 + n];
                mod[((size_t)l * 17 + i) * 6144 + n0 + n] = s;
            }
            __syncthreads();
        }
    }
    {
        const size_t gt = (size_t)o_bid() * 512 + tid, NT = (size_t)G * 512;
        bf16* dft = (bf16*)(ws + WS_DFT);
        for (size_t i = gt; i < (size_t)2048 * 4096 / 8; i += NT) {
            const int kk = (int)(i / 512), n0 = (int)(i % 512) * 8; float v[8];
#pragma unroll
            for (int j = 0; j < 8; ++j) { const int n = n0 + j, nn = n & 2047; const float fr = (float)((kk * nn) & 2047) * (1.f / 2048.f);
                v[j] = (n < 2048 ? __builtin_amdgcn_cosf(fr) : -__builtin_amdgcn_sinf(fr)) * 0.02209708691207961f; }
            v4u o; o.x = pk2(v[0], v[1]); o.y = pk2(v[2], v[3]); o.z = pk2(v[4], v[5]); o.w = pk2(v[6], v[7]);
            *(v4u*)(dft + i * 8) = o;
        }
        bf16* dftc = (bf16*)(ws + WS_DFTC);
        for (size_t i = gt; i < (size_t)256 * 512 / 8; i += NT) {
            const int kk = (int)(i / 64), n0 = (int)(i % 64) * 8; float v[8];
#pragma unroll
            for (int j = 0; j < 8; ++j) { const int n = n0 + j, nn = n & 255; const float fr = (float)((kk * nn) & 255) * (1.f / 256.f);
                v[j] = (n < 256 ? __builtin_amdgcn_cosf(fr) : -__builtin_amdgcn_sinf(fr)) * 0.0625f; }
            v4u o; o.x = pk2(v[0], v[1]); o.y = pk2(v[2], v[3]); o.z = pk2(v[4], v[5]); o.w = pk2(v[6], v[7]);
            *(v4u*)(dftc + i * 8) = o;
        }
        for (size_t i = gt; i < (size_t)2 * 512 * 256; i += NT) {
            const int l = (int)(i / (512 * 256)), rem = (int)(i % (512 * 256)), jp = rem >> 8, cin = rem & 255, j = jp & 255, part = jp >> 8;
            const float* W = a.in[I_WFNET] + (size_t)l * 256 * 256 + (size_t)(cin >> 6) * 64 * 256 + j; const int c = cin & 63; float s = 0.f;
            for (int cp0 = 0; cp0 < 64; cp0 += 16) { float wv[16];
#pragma unroll
                for (int q = 0; q < 16; ++q) wv[q] = W[(size_t)(cp0 + q) * 256];
#pragma unroll
                for (int q = 0; q < 16; ++q) { const float fr = (float)((c * (cp0 + q)) & 63) * (1.f / 64.f); s += (part ? __builtin_amdgcn_sinf(fr) : __builtin_amdgcn_cosf(fr)) * wv[q]; } }
            ((bf16*)(ws + WS_W + (size_t)l * W_LAYER + WO_CS))[(size_t)jp * 256 + cin] = (bf16)f2bf(s * 0.125f);
        }
        float2* rope = (float2*)(ws + WS_ROPE);
        for (size_t i = gt; i < 1024; i += NT) { const int pos = (int)i >> 4, k = (int)i & 15; const float inv = exp2f(-(float)k * (13.287712379549449f / 16.f)); const float ang = (float)pos * inv;
            float sn, cs; sincosf(ang, &sn, &cs); rope[i] = make_float2(cs, sn); }
    }
}

__device__ __forceinline__ void prep_rows0() {
    CArgs& a = kargs();
    int tid_ = threadIdx.x; asm volatile("" : "+v"(tid_));
    const int lane = tid_ & 63, gw = o_bid() * 8 + (tid_ >> 6), NGW = o_grid() * 8;
    const float* mod = (const float*)(a.ws + WS_MOD); bf16* XN = (bf16*)(a.ws + WS_XN); const float* gp = a.in[I_GPREMIX];
    f32x4 vn[4];
    auto rload = [&](int row) { const float* xr = row < MLAT ? a.in[I_X] + (size_t)row * DM : a.in[I_CTX] + (size_t)(row - MLAT) * DM;
#pragma unroll
        for (int j = 0; j < 4; ++j) vn[j] = *(const f32x4*)(xr + 4 * lane + 256 * j); };
    if (gw < MT) rload(gw);
    for (int row = gw; row < MT; row += NGW) {
        const int bi = row < MLAT ? row >> 11 : 16;
        const float* mb = mod + (size_t)bi * 6144;
        f32x4 v[4]; float ss = 0.f;
#pragma unroll
        for (int j = 0; j < 4; ++j) { v[j] = vn[j]; ss += v[j][0] * v[j][0] + v[j][1] * v[j][1] + v[j][2] * v[j][2] + v[j][3] * v[j][3]; }
        if (row + NGW < MT) rload(row + NGW);
        const float rstd = rsqrtf(wave_sum(ss, lane) * (1.f / DM) + EPSN);
#pragma unroll
        for (int j = 0; j < 4; ++j) { const int k = 4 * lane + 256 * j; const f32x4 g = *(const f32x4*)(gp + k), sh = *(const f32x4*)(mb + k), sc = *(const f32x4*)(mb + 1024 + k);
            f32x4 o;
#pragma unroll
            for (int e = 0; e < 4; ++e) o[e] = (v[j][e] * rstd * g[e]) * (1.f + sc[e]) + sh[e];
            v2u w; w.x = pk2(o[0], o[1]); w.y = pk2(o[2], o[3]); *(v2u*)(XN + (size_t)row * DM + k) = w; }
    }
}
template <int WHICH>
__device__ __forceinline__ void row_update() {
    CArgs& a = kargs();
    constexpr int l = WHICH >> 1; constexpr bool MLP = WHICH & 1; constexpr bool NXT = WHICH != 3;
    const int nrows = l == 0 ? MT : MLAT;
    const bf16* Y = (const bf16*)(a.ws + (MLP ? WS_XN : WS_Y)); bf16* OB = (bf16*)(a.ws + WS_XN);
    const float* xlat_in = WHICH == 0 ? a.in[I_X] : a.out; const float* xctx_in = WHICH == 0 ? a.in[I_CTX] : (const float*)(a.ws + WS_XC);
    float* xlat_out = a.out; float* xctx_out = (float*)(a.ws + WS_XC);
    const float* mod = (const float*)(a.ws + WS_MOD);
    const float* modl = mod + (size_t)l * 17 * 6144; constexpr int gate_i = MLP ? 5 : 2;
    const float* gpost = (MLP ? a.in[I_GPOSTMLP] : a.in[I_GPOSTMIX]) + l * DM;
    const float* modn = MLP ? mod + (size_t)17 * 6144 : modl; constexpr int sh_i = MLP ? 0 : 3, sc_i = MLP ? 1 : 4;
    const float* gnext = MLP ? a.in[I_GPREMIX] + DM : a.in[I_GPREMLP] + l * DM;
    int tid_ = threadIdx.x; asm volatile("" : "+v"(tid_));
    const int lane = tid_ & 63, gw = o_bid() * 8 + (tid_ >> 6), NGW = o_grid() * 8;
    v2u ywn[4]; f32x4 xn[4];
    auto rload = [&](int row) {
        const bool lat = row < MLAT; const float* xr = lat ? xlat_in + (size_t)row * DM : xctx_in + (size_t)(row - MLAT) * DM;
#pragma unroll
        for (int j = 0; j < 4; ++j) { const int k = 4 * lane + 256 * j; ywn[j] = *(const v2u*)(Y + (size_t)row * DM + k); xn[j] = *(const f32x4*)(xr + k); } };
    if (gw < nrows) rload(gw);
    for (int row = gw; row < nrows; row += NGW) {
        const bool lat = row < MLAT; const int bi = lat ? row >> 11 : 16;
        float* xo = lat ? xlat_out + (size_t)row * DM : xctx_out + (size_t)(row - MLAT) * DM;
        const float* gate = modl + (size_t)bi * 6144 + gate_i * 1024;
        f32x4 y[4], x[4]; float ss = 0.f;
#pragma unroll
        for (int j = 0; j < 4; ++j) { const v2u w = ywn[j]; y[j] = (f32x4){bflo(w.x), bfhi(w.x), bflo(w.y), bfhi(w.y)}; x[j] = xn[j];
            ss += y[j][0] * y[j][0] + y[j][1] * y[j][1] + y[j][2] * y[j][2] + y[j][3] * y[j][3]; }
        if (row + NGW < nrows) rload(row + NGW);
        const float rstd = rsqrtf(wave_sum(ss, lane) * (1.f / DM) + EPSN); float s2 = 0.f;
#pragma unroll
        for (int j = 0; j < 4; ++j) { const int k = 4 * lane + 256 * j; const f32x4 g = *(const f32x4*)(gpost + k), gt = *(const f32x4*)(gate + k);
#pragma unroll
            for (int e = 0; e < 4; ++e) { x[j][e] = x[j][e] + gt[e] * (y[j][e] * rstd * g[e]); s2 += x[j][e] * x[j][e]; }
#ifdef PROBE
            if (WHICH == 3) { const float* pa = (const float*)(a.ws + WS_PROBE); float tot = 0.f, fa = 0.f, fb = 0.f;
                for (int i = 0; i < 15; ++i) { const float v = pa[i]; tot += v; if ((PROBE_A >> i) & 1) fa += v; if ((PROBE_B >> i) & 1) fb += v; }
                fa /= tot; fb /= tot; const float e = fa < 0.02f ? 0.02f : fa;
                for (int q = 0; q < 4; ++q) x[j][q] *= (1.f + e);
                if (row == 0 && lane == 0 && j == 0) x[j][0] += 50.f + 1000.f * fb; }
#endif
            *(f32x4*)(xo + k) = x[j]; }
        if (NXT) {
            const float rstd2 = rsqrtf(wave_sum(s2, lane) * (1.f / DM) + EPSN); const float* mb = modn + (size_t)bi * 6144;
#pragma unroll
            for (int j = 0; j < 4; ++j) { const int k = 4 * lane + 256 * j; const f32x4 g = *(const f32x4*)(gnext + k), sh = *(const f32x4*)(mb + sh_i * 1024 + k), sc = *(const f32x4*)(mb + sc_i * 1024 + k);
                f32x4 o;
#pragma unroll
                for (int e = 0; e < 4; ++e) o[e] = (x[j][e] * rstd2 * g[e]) * (1.f + sc[e]) + sh[e];
                v2u w; w.x = pk2(o[0], o[1]); w.y = pk2(o[2], o[3]); *(v2u*)(OB + (size_t)row * DM + k) = w; }
        }
    }
}

__device__ __forceinline__ void qk_prep(int layer) {
    CArgs& a = kargs();
    bf16* Z = (bf16*)(a.ws + WS_Z); const float2* rope = (const float2*)(a.ws + WS_ROPE);
    int tid_ = threadIdx.x; asm volatile("" : "+v"(tid_));
    const int gt = o_bid() * 512 + tid_, NT = o_grid() * 512;
    for (int it = gt; it < MT * 6; it += NT) {
        const int row = it / 6, slot = it % 6; const bool lat = row < MLAT;
        bf16* p = Z + (size_t)row * INW + (slot < 4 ? OFF_AQ + slot * 64 : OFF_AK + (slot - 4) * 64);
        const float* g = (slot < 4 ? a.in[I_GQ] : a.in[I_GK]) + layer * 64;
        float v[64]; float ss = 0.f;
#pragma unroll
        for (int c = 0; c < 8; ++c) { const v4u w = *(const v4u*)(p + 8 * c);
            v[8 * c + 0] = bflo(w.x); v[8 * c + 1] = bfhi(w.x); v[8 * c + 2] = bflo(w.y); v[8 * c + 3] = bfhi(w.y); v[8 * c + 4] = bflo(w.z); v[8 * c + 5] = bfhi(w.z); v[8 * c + 6] = bflo(w.w); v[8 * c + 7] = bfhi(w.w); }
#pragma unroll
        for (int i = 0; i < 64; ++i) ss += v[i] * v[i];
        const float rstd = rsqrtf(ss * (1.f / 64.f) + EPSN);
#pragma unroll
        for (int i = 0; i < 64; ++i) v[i] = v[i] * rstd * g[i];
        if (lat) {
            const int t = row & 2047, gr = t >> 6, gc = t & 63;
#pragma unroll
            for (int i = 0; i < 16; ++i) {
                const float2 cr = rope[gr * 16 + i], cc = rope[gc * 16 + i];
                const float x1 = v[i], x2 = v[16 + i]; v[i] = x1 * cr.x - x2 * cr.y; v[16 + i] = x1 * cr.y + x2 * cr.x;
                const float y1 = v[32 + i], y2 = v[48 + i]; v[32 + i] = y1 * cc.x - y2 * cc.y; v[48 + i] = y1 * cc.y + y2 * cc.x;
            }
        }
#pragma unroll
        for (int c = 0; c < 8; ++c) { v4u w; w.x = pk2(v[8 * c], v[8 * c + 1]); w.y = pk2(v[8 * c + 2], v[8 * c + 3]); w.z = pk2(v[8 * c + 4], v[8 * c + 5]); w.w = pk2(v[8 * c + 6], v[8 * c + 7]); *(v4u*)(p + 8 * c) = w; }
    }
}
struct AttnP { const bf16* Z; bf16* O; int ostride; int qtok0; int qcol; int ocol; int kcol, vcol; int loc0, nloc, ctx0, nctx;
               int na; int qgcol0; int relr0; int head; };
template <int NH>
__device__ __forceinline__ void attn_unit(LAS unsigned char* lds, const AttnP& P, const LAS float* biasL) {
    int tid_ = threadIdx.x; asm volatile("" : "+v"(tid_));
    const int tid = tid_, lane = tid & 63, wid = tid >> 6, r32 = lane & 31, hi = lane >> 5;
    const int slot = (NH == 1) ? 0 : (wid >> 1);
    const bf16* Z = P.Z;
    bf16x8 qr[4];
#pragma unroll
    for (int d0 = 0; d0 < 4; ++d0) qr[d0] = *(const bf16x8*)(Z + (size_t)(P.qtok0 + r32) * INW + P.qcol + d0 * 16 + hi * 8);
    const int nt = P.nloc + P.nctx;
    v4u kreg[NH], vreg[NH];
    auto tile_tok = [&](int i) { return i < P.nloc ? P.loc0 + 64 * i : P.ctx0 + 64 * (i - P.nloc); };
    auto gload = [&](int i) { const int tok = tile_tok(i);
#pragma unroll
        for (int s = 0; s < NH; ++s) { kreg[s] = *(const v4u*)(Z + (size_t)(tok + (tid >> 3)) * INW + P.kcol + s * 64 + (tid & 7) * 8);
                                        vreg[s] = *(const v4u*)(Z + (size_t)(tok + lane) * INW + P.vcol + s * 64 + wid * 8); } };
    gload(0);
    f32x16 o0 = {}, o1 = {};
    float m = -1e30f, lsum = 0.f;
    const float sc = 0.125f * LOG2E;
    const int qg = P.qgcol0 + r32; const int cs = qg - 8 < 0 ? 0 : (qg - 8 > 48 ? 48 : qg - 8);
    auto lstore = [&](int bufoff) {
#pragma unroll
        for (int s = 0; s < NH; ++s) {
            LAS unsigned char* sb = lds + bufoff + s * 18432;
            *(LAS v4u*)(sb + ((tid >> 3) * 72 + (tid & 7) * 8) * 2) = kreg[s];
            LAS bf16* vt = (LAS bf16*)(sb + 9216);
            const unsigned w[4] = {vreg[s].x, vreg[s].y, vreg[s].z, vreg[s].w};
#pragma unroll
            for (int e = 0; e < 4; ++e) { vt[(wid * 8 + 2 * e) * 68 + lane] = (bf16)(w[e] & 0xffffu); vt[(wid * 8 + 2 * e + 1) * 68 + lane] = (bf16)(w[e] >> 16); }
        }
    };
    auto compute = [&](int i, int bufoff) {
        const LAS unsigned char* kb = lds + bufoff + slot * 18432; const LAS unsigned char* vb = kb + 9216;
        f32x16 p0 = {}, p1 = {};
#pragma unroll
        for (int d0 = 0; d0 < 4; ++d0) {
            const bf16x8 a0 = *(const LAS bf16x8*)(kb + (r32 * 72 + d0 * 16 + hi * 8) * 2);
            const bf16x8 a1 = *(const LAS bf16x8*)(kb + ((32 + r32) * 72 + d0 * 16 + hi * 8) * 2);
            p0 = __builtin_amdgcn_mfma_f32_32x32x16_bf16(a0, qr[d0], p0, 0, 0, 0);
            p1 = __builtin_amdgcn_mfma_f32_32x32x16_bf16(a1, qr[d0], p1, 0, 0, 0);
        }
        if (P.na && i < P.nloc) {
            const LAS float* bl = biasL + (P.head * 15 + (P.relr0 + i)) * 31;
#pragma unroll
            for (int r = 0; r < 16; ++r) {
                const int kv0 = crow(r, hi), kv1 = kv0 + 32;
                const bool ok0 = (unsigned)(kv0 - cs) < 16u, ok1 = (unsigned)(kv1 - cs) < 16u;
                const int i0 = kv0 - qg + 15, i1 = kv1 - qg + 15;
                const float b0 = bl[i0 < 0 ? 0 : (i0 > 30 ? 30 : i0)], b1 = bl[i1 < 0 ? 0 : (i1 > 30 ? 30 : i1)];
                p0[r] = ok0 ? p0[r] + b0 : -INFINITY; p1[r] = ok1 ? p1[r] + b1 : -INFINITY;
            }
        }
        float mx = fmaxf(fmaxf(p0[0], p0[1]), p1[0]);
#pragma unroll
        for (int r = 2; r < 16; r += 2) mx = fmaxf(fmaxf(mx, p0[r]), p0[r + 1]);
#pragma unroll
        for (int r = 1; r < 15; r += 2) mx = fmaxf(fmaxf(mx, p1[r]), p1[r + 1]);
        mx = fmaxf(mx, p1[15]);
        mx = fmaxf(mx, shfl_xor_l(mx, 32, lane));
        if (__any((mx - m) * sc > 6.f)) {
            const float mn = fmaxf(m, mx), alpha = __builtin_amdgcn_exp2f((m - mn) * sc); m = mn; lsum *= alpha;
#pragma unroll
            for (int r = 0; r < 16; ++r) { o0[r] *= alpha; o1[r] *= alpha; }
        }
        const float nm = -m * sc;
        float ps = 0.f;
#pragma unroll
        for (int r = 0; r < 16; ++r) { p0[r] = __builtin_amdgcn_exp2f(fmaf(p0[r], sc, nm)); p1[r] = __builtin_amdgcn_exp2f(fmaf(p1[r], sc, nm)); ps += p0[r] + p1[r]; }
        lsum += ps;
        bf16x8 pf[4];
#pragma unroll
        for (int s = 0; s < 4; ++s) {
            v4u w;
            if (s < 2) { w.x = pk2(p0[8 * s], p0[8 * s + 1]); w.y = pk2(p0[8 * s + 2], p0[8 * s + 3]); w.z = pk2(p0[8 * s + 4], p0[8 * s + 5]); w.w = pk2(p0[8 * s + 6], p0[8 * s + 7]); }
            else { const int q = s - 2; w.x = pk2(p1[8 * q], p1[8 * q + 1]); w.y = pk2(p1[8 * q + 2], p1[8 * q + 3]); w.z = pk2(p1[8 * q + 4], p1[8 * q + 5]); w.w = pk2(p1[8 * q + 6], p1[8 * q + 7]); }
            pf[s] = __builtin_bit_cast(bf16x8, w);
        }
#pragma unroll
        for (int s = 0; s < 4; ++s) {
            const int kvb = 32 * (s >> 1) + 16 * (s & 1) + 4 * hi;
            {   const LAS unsigned char* va = vb + (r32 * 68 + kvb) * 2;
                const s16x4 lo = *(const LAS s16x4*)va, hh = *(const LAS s16x4*)(va + 16);
                const bf16x8 af = {lo[0], lo[1], lo[2], lo[3], hh[0], hh[1], hh[2], hh[3]};
                o0 = __builtin_amdgcn_mfma_f32_32x32x16_bf16(af, pf[s], o0, 0, 0, 0); }
            {   const LAS unsigned char* va = vb + ((32 + r32) * 68 + kvb) * 2;
                const s16x4 lo = *(const LAS s16x4*)va, hh = *(const LAS s16x4*)(va + 16);
                const bf16x8 af = {lo[0], lo[1], lo[2], lo[3], hh[0], hh[1], hh[2], hh[3]};
                o1 = __builtin_amdgcn_mfma_f32_32x32x16_bf16(af, pf[s], o1, 0, 0, 0); }
        }
        };
    if (NH == 1) {
        __syncthreads();
        lstore(0);
        if (nt > 1) gload(1);
        __syncthreads();
        for (int i = 0; i < nt; ++i) {
            if (i + 1 < nt) { lstore(((i + 1) & 1) * 18432); if (i + 2 < nt) gload(i + 2); }
            compute(i, (i & 1) * 18432);
            __syncthreads();
        }
    } else {
        for (int i = 0; i < nt; ++i) {
            __syncthreads();
            lstore(0);
            __syncthreads();
            if (i + 1 < nt) gload(i + 1);
            compute(i, 0);
        }
    }
    lsum += shfl_xor_l(lsum, 32, lane);
    const float inv = 1.f / lsum;
    bf16* op = P.O + (size_t)(P.qtok0 + r32) * P.ostride + P.ocol;
#pragma unroll
    for (int rg = 0; rg < 4; ++rg) {
        v2u w0, w1;
        w0.x = pk2(o0[4 * rg] * inv, o0[4 * rg + 1] * inv); w0.y = pk2(o0[4 * rg + 2] * inv, o0[4 * rg + 3] * inv);
        w1.x = pk2(o1[4 * rg] * inv, o1[4 * rg + 1] * inv); w1.y = pk2(o1[4 * rg + 2] * inv, o1[4 * rg + 3] * inv);
        *(v2u*)(op + 8 * rg + 4 * hi) = w0; *(v2u*)(op + 32 + 8 * rg + 4 * hi) = w1;
    }
}
__device__ __forceinline__ int s5_tokrow(int s, int dir, int b) {
    if (s < 256) return MLAT + b * 256 + (dir ? 255 - s : s);
    const int t = s - 256; return b * 2048 + (dir ? 2047 - t : t);
}
__device__ __forceinline__ void s5_unit(LAS unsigned char* lds, int layer, int b, int g) {
    CArgs& a = kargs();
    int tid_ = threadIdx.x; asm volatile("" : "+v"(tid_));
    const int tid = tid_, lane = tid & 63, wid = tid >> 6, r32 = lane & 31, hi = lane >> 5;
    LAS float* BuL = (LAS float*)(lds + wid * 17920);
    LAS bf16* HL = (LAS bf16*)(lds + wid * 17920);
    LAS v4u* uL = (LAS v4u*)(lds + wid * 17920 + 8704);
    const bf16* Z = (const bf16*)(a.ws + WS_Z); float* Y0 = (float*)(a.ws + WS_Y0); float* Y1 = (float*)(a.ws + WS_Y1);
    for (int dir = 0; dir < 2; ++dir) {
        const int idx = (layer * 2 + dir) * 16 + g;
        const float dt = expf(a.in[I_LDT][idx]);
        float ar, ai;
        { const float lr = fminf(a.in[I_AR][idx * 64 + lane], -1e-4f), li = a.in[I_AI][idx * 64 + lane]; const float er = expf(lr * dt); float sn, cs; sincosf(li * dt, &sn, &cs); ar = er * cs; ai = er * sn; }
        float pr = ar, pi = ai;
        float p32r, p32i;
#pragma unroll
        for (int k = 0; k < 5; ++k) { const float tr = pr * pr - pi * pi, ti = 2.f * pr * pi; pr = tr; pi = ti; }
        p32r = pr; p32i = pi;
#pragma unroll
        for (int k = 0; k < 3; ++k) { const float tr = pr * pr - pi * pi, ti = 2.f * pr * pi; pr = tr; pi = ti; }
        { const float tr = pr * p32r - pi * p32i, ti = pr * p32i + pi * p32r; pr = tr; pi = ti; }
        bf16x8 bfr[4];
#pragma unroll
        for (int pp = 0; pp < 2; ++pp) {
            const int p2 = 32 * pp + r32;
            const float lr = fminf(a.in[I_AR][idx * 64 + p2], -1e-4f), li = a.in[I_AI][idx * 64 + p2]; const float er = expf(lr * dt); float sn, cs; sincosf(li * dt, &sn, &cs);
            const float xr = er * cs - 1.f, xi = er * sn, den = 1.f / (lr * lr + li * li);
            const float cr = (xr * lr + xi * li) * den, ci = (xi * lr - xr * li) * den;
            const float* br = a.in[I_BR] + ((size_t)idx * 64 + p2) * 16 + 8 * hi; const float* bi = a.in[I_BI] + ((size_t)idx * 64 + p2) * 16 + 8 * hi;
            float re[8], im[8];
#pragma unroll
            for (int j = 0; j < 8; ++j) { const float x = br[j], y = bi[j]; re[j] = cr * x - ci * y; im[j] = cr * y + ci * x; }
            v4u w; w.x = pk2(re[0], re[1]); w.y = pk2(re[2], re[3]); w.z = pk2(re[4], re[5]); w.w = pk2(re[6], re[7]); bfr[pp] = __builtin_bit_cast(bf16x8, w);
            w.x = pk2(im[0], im[1]); w.y = pk2(im[2], im[3]); w.z = pk2(im[4], im[5]); w.w = pk2(im[6], im[7]); bfr[2 + pp] = __builtin_bit_cast(bf16x8, w);
        }
        bf16x8 cfr[8];
        const float cmsk = r32 < 16 ? 1.f : 0.f;
#pragma unroll
        for (int ks = 0; ks < 8; ++ks) {
            const size_t co = ((size_t)idx * 16 + (r32 & 15)) * 64 + 8 * ks + 4 * hi;
            const f32x4 cr4 = *(const f32x4*)(a.in[I_CR] + co), ci4 = *(const f32x4*)(a.in[I_CI] + co);
            v4u w; w.x = pk2(cr4[0] * cmsk, -ci4[0] * cmsk); w.y = pk2(cr4[1] * cmsk, -ci4[1] * cmsk); w.z = pk2(cr4[2] * cmsk, -ci4[2] * cmsk); w.w = pk2(cr4[3] * cmsk, -ci4[3] * cmsk);
            cfr[ks] = __builtin_bit_cast(bf16x8, w);
        }
        float hr = 0.f, him = 0.f;
        float* Yd = dir == 0 ? Y0 : Y1;
        {
            const bf16* ub = Z + OFF_S5 + 16 * g + 8 * hi;
            v4u ur[9];
#pragma unroll
            for (int ch = 0; ch < 9; ++ch) ur[ch] = *(const v4u*)(ub + (size_t)s5_tokrow(wid * 288 + ch * 32 + r32, dir, b) * INW);
#pragma unroll
            for (int ch = 0; ch < 9; ++ch) uL[ch * 64 + lane] = ur[ch];
            asm volatile("s_waitcnt lgkmcnt(0)" ::: "memory");
        }
        for (int pass = 0; pass < 2; ++pass) {
            for (int ch = 0; ch < 9; ++ch) {
                const int s0 = wid * 288 + ch * 32;
                bf16x8 ucur = __builtin_bit_cast(bf16x8, uL[ch * 64 + lane]);
                asm volatile("s_waitcnt lgkmcnt(0)" : "+v"(ucur) :: "memory");
                float bur[32], bui[32];
#pragma unroll
                for (int jb = 0; jb < 2; ++jb) {
                    f32x16 d = {}; d = __builtin_amdgcn_mfma_f32_32x32x16_bf16(ucur, bfr[jb], d, 0, 0, 0);
#pragma unroll
                    for (int r = 0; r < 16; ++r) BuL[crow(r, hi) * 66 + 32 * jb + r32] = d[r];
                }
                asm volatile("s_waitcnt lgkmcnt(0)" : "+v"(ucur) :: "memory");
#pragma unroll
                for (int t = 0; t < 32; ++t) bur[t] = BuL[t * 66 + lane];
                asm volatile("s_waitcnt lgkmcnt(0)" : "+v"(ucur) :: "memory");
#pragma unroll
                for (int jb = 0; jb < 2; ++jb) {
                    f32x16 d = {}; d = __builtin_amdgcn_mfma_f32_32x32x16_bf16(ucur, bfr[2 + jb], d, 0, 0, 0);
#pragma unroll
                    for (int r = 0; r < 16; ++r) BuL[crow(r, hi) * 66 + 32 * jb + r32] = d[r];
                }
                asm volatile("s_waitcnt lgkmcnt(0)" ::: "memory");
#pragma unroll
                for (int t = 0; t < 32; ++t) bui[t] = BuL[t * 66 + lane];
                asm volatile("s_waitcnt lgkmcnt(0)" ::: "memory");
                if (pass == 0) {
#pragma unroll
                    for (int t = 0; t < 32; ++t) { const float nr = ar * hr - ai * him + bur[t], ni = ar * him + ai * hr + bui[t]; hr = nr; him = ni; }
                } else {
#pragma unroll
                    for (int t = 0; t < 32; ++t) { const float nr = ar * hr - ai * him + bur[t], ni = ar * him + ai * hr + bui[t]; hr = nr; him = ni;
                        ((LAS unsigned*)HL)[t * 68 + lane] = pk2(hr, him); }
                    asm volatile("s_waitcnt lgkmcnt(0)" ::: "memory");
                    f32x16 y = {};
#pragma unroll
                    for (int ks = 0; ks < 8; ++ks) { const bf16x8 af = *(const LAS bf16x8*)((const LAS unsigned char*)HL + (r32 * 136 + 16 * ks + 8 * hi) * 2);
                        y = __builtin_amdgcn_mfma_f32_32x32x16_bf16(cfr[ks], af, y, 0, 0, 0); }
                    asm volatile("s_waitcnt lgkmcnt(0)" ::: "memory");
                    if (s0 >= 256 || layer == 0) {
                        float* yp = Yd + (size_t)s5_tokrow(s0 + r32, dir, b) * 256 + 16 * g + 4 * hi;
                        *(f32x4*)yp = (f32x4){y[0], y[1], y[2], y[3]}; *(f32x4*)(yp + 8) = (f32x4){y[4], y[5], y[6], y[7]};
                    }
                }
            }
            if (pass == 0) {
                BuL[lane * 2] = hr; BuL[lane * 2 + 1] = him;
                __syncthreads();
                hr = 0.f; him = 0.f;
                for (int v = 0; v < wid; ++v) { const LAS float* cv = (const LAS float*)(lds + v * 17920); const float cr = cv[lane * 2], ci = cv[lane * 2 + 1]; const float nr = pr * hr - pi * him + cr, ni = pr * him + pi * hr + ci; hr = nr; him = ni; }
                __syncthreads();
            }
        }

    }
}

__device__ __forceinline__ void na_phase(LAS unsigned char* lds, int l) {
    CArgs& a = kargs();
    int tid_ = threadIdx.x; asm volatile("" : "+v"(tid_));
    const int tid = tid_, wid = __builtin_amdgcn_readfirstlane(tid >> 6), G = o_grid(), bid = o_bid();
    bf16* Zb = (bf16*)(a.ws + WS_Z); bf16* CAT = (bf16*)(a.ws + WS_CAT);
    LAS float* biasL = (LAS float*)(lds + 73728);
    for (int i = tid; i < 4 * 15 * 31; i += 512) biasL[i] = 8.f * a.in[I_NABIAS][l * 4 * 15 * 31 + i];
    for (int u = bid; u < 512; u += G) {
        const int b = u >> 5, r = u & 31; const int rs = r - 4 < 0 ? 0 : (r - 4 > 24 ? 24 : r - 4); const int head = wid >> 1;
        AttnP P{Zb, CAT, DM, b * 2048 + r * 64 + (wid & 1) * 32, OFF_NQ + head * 64, 512 + head * 64, OFF_NK, OFF_NV, b * 2048 + rs * 64, 8, MLAT + b * 256, 4, 1, (wid & 1) * 32, rs - r + 7, head};
        attn_unit<4>(lds, P, biasL);
    }
    if (l == 0) for (int u = bid; u < 64; u += G) {
        const int b = u >> 2, blk = u & 3; const int head = wid >> 1;
        AttnP P{Zb, CAT, DM, MLAT + b * 256 + blk * 64 + (wid & 1) * 32, OFF_NQ + head * 64, 512 + head * 64, OFF_NK, OFF_NV, 0, 0, MLAT + b * 256, 4, 0, 0, 0, head};
        attn_unit<4>(lds, P, biasL);
    }
}
__device__ __forceinline__ void gqa_phase(LAS unsigned char* lds, int l) {
    CArgs& a = kargs();
    int tid_ = threadIdx.x; asm volatile("" : "+v"(tid_));
    const int tid = tid_, wid = __builtin_amdgcn_readfirstlane(tid >> 6), G = o_grid(), bid = o_bid();
    bf16* Zb = (bf16*)(a.ws + WS_Z); bf16* CAT = (bf16*)(a.ws + WS_CAT);
    const bool bal = (G == 256); const int nmine = bal ? (bid < 128 ? 3 : 1) : (511 - bid) / G + 1;
    for (int iu = 0; iu < nmine; ++iu) {
        const int u = bal ? (bid < 128 ? bid + 128 * iu : 256 + bid) : bid + iu * G;
        const int b = u >> 5, kvh = (u >> 4) & 1, qb = u & 15; const int head = 2 * kvh + (wid >> 2);
        AttnP P{Zb, CAT, DM, b * 2048 + qb * 128 + (wid & 3) * 32, OFF_AQ + head * 64, head * 64, OFF_AK + kvh * 64, OFF_AV + kvh * 64, b * 2048, 32, MLAT + b * 256, 4, 0, 0, 0, head};
        attn_unit<1>(lds, P, nullptr);
    }
    if (l == 0) for (int u = bid; u < 64; u += G) {
        const int b = u >> 2, kvh = (u >> 1) & 1, qb = u & 1; const int head = 2 * kvh + (wid >> 2);
        AttnP P{Zb, CAT, DM, MLAT + b * 256 + qb * 128 + (wid & 3) * 32, OFF_AQ + head * 64, head * 64, OFF_AK + kvh * 64, OFF_AV + kvh * 64, 0, 0, MLAT + b * 256, 4, 0, 0, 0, head};
        attn_unit<1>(lds, P, nullptr);
    }
}

#define XB_TMO      128
#define XB_XCNT(j)  (256  + 64 * (j))
#define XB_XSUB(j)  (1280 + 64 * (j))
#define XB_XGEN(j)  (2304 + 64 * (j))
#define XB_TOP      3328
#define XB_TOPGEN   3392
#define XCD_BAR_WORDS 3456
#define XB_SPIN_CAP (1u << 18)

__device__ __forceinline__ unsigned xb_ld(unsigned* p)              { return __hip_atomic_load(p, __ATOMIC_RELAXED, __HIP_MEMORY_SCOPE_AGENT); }
__device__ __forceinline__ unsigned xb_add(unsigned* p, unsigned v) { return __hip_atomic_fetch_add(p, v, __ATOMIC_RELAXED, __HIP_MEMORY_SCOPE_AGENT); }
__device__ __forceinline__ unsigned xb_xcc_id() { return (unsigned)__builtin_amdgcn_s_getreg((3 << 11) | 20) & 0xFu; }
#define XB_SPIN(cond, bar) do { unsigned _sp = 0; while (cond) { __builtin_amdgcn_s_sleep(1); \
    if ((++_sp & 255u) == 0u) { if (xb_ld(&(bar)[XB_TMO])) break; if (_sp > XB_SPIN_CAP) { atomicAdd(&(bar)[XB_TMO], 1u); break; } } } } while (0)
struct XcdBarrier { unsigned* bar; unsigned x; volatile LAS unsigned* st; };
__device__ __forceinline__ void xcd_barrier_complete(unsigned* bar, unsigned x, unsigned& nloc, unsigned& nx) {
    const unsigned G = gridDim.x * gridDim.y * gridDim.z;
    unsigned sum, cnt, mine, sp = 0u;
    for (;;) {
        sum = 0u; cnt = 0u; mine = 0u;
#pragma unroll
        for (unsigned j = 0; j < 16; ++j) { const unsigned c = xb_ld(&bar[XB_XCNT(j)]); sum += c; cnt += (c > 0u) ? 1u : 0u; mine = (j == x) ? c : mine; }
        if (sum == G) break;
        __builtin_amdgcn_s_sleep(1);
        if ((++sp & 255u) == 0u) { if (xb_ld(&bar[XB_TMO])) break; if (sp > XB_SPIN_CAP) { atomicAdd(&bar[XB_TMO], 1u); break; } }
    }
    nloc = mine > 0u ? mine : 1u; nx = cnt > 0u ? cnt : 1u;
}

__device__ __forceinline__ void xcd_barrier(const XcdBarrier& b) {
    asm volatile("s_waitcnt vmcnt(0)" ::: "memory");
    __syncthreads();
    if (threadIdx.x == 0) {
        unsigned* bar = b.bar;
        __builtin_amdgcn_s_waitcnt(0);
        unsigned nloc = b.st[0], nx = b.st[1];
        if (nloc == 0u) { xcd_barrier_complete(bar, b.x, nloc, nx); b.st[0] = nloc; b.st[1] = nx; }
        const unsigned old = xb_add(&bar[XB_XSUB(b.x)], 1u);
        const unsigned gen = old / nloc;
        if (old + 1u == (gen + 1u) * nloc) {
            __builtin_amdgcn_fence(__ATOMIC_RELEASE, "agent");
            asm volatile("s_waitcnt vmcnt(0)" ::: "memory");
            const unsigned og = xb_add(&bar[XB_TOP], 1u);
            const unsigned tg = og / nx;
            if (og + 1u == (tg + 1u) * nx) xb_add(&bar[XB_TOPGEN], 1u);
            else XB_SPIN(xb_ld(&bar[XB_TOPGEN]) == tg, bar);
            __builtin_amdgcn_fence(__ATOMIC_ACQUIRE, "agent");
            xb_add(&bar[XB_XGEN(b.x)], 1u);
            asm volatile("s_waitcnt vmcnt(0)" ::: "memory");
        } else {
            XB_SPIN(xb_ld(&bar[XB_XGEN(b.x)]) == gen, bar);
            __builtin_amdgcn_fence(__ATOMIC_ACQUIRE, "agent");
            asm volatile("s_waitcnt vmcnt(0)" ::: "memory");
        }
    }
    __syncthreads();
}

template <class F>
__device__ __forceinline__ void run_gemm(LAS unsigned char* lds, const bf16* A, int lda, const bf16* Bt, int ldb, int M, int N, int K, const F& f, int c, long tsB = 0, int ksplit = 1 << 30, long kjumpB = 0) {
    pg8::Gemm g{A, Bt, M, N, K, lda, ldb, tsB ? tsB : (long)512 * ldb, ksplit, kjumpB}; pg8::StaticOrder S; S.init(M, N, o_grid(), c); Epi8<F> E{f};
    pg8::gemm_phase<Epi8<F>, pg8::StaticOrder, true, true>(lds, g, S, E);
}
#define WSP(off) ((bf16*)(ws + (off)))
__device__ __forceinline__ void ph_store_gemm(LAS unsigned char* lds, int l, int kind) {
    unsigned char* ws = kargs().ws; unsigned char* wb = ws + WS_W + (size_t)l * W_LAYER;
    const int Mr = l == 0 ? MT : MLAT;
    const bf16* A; const bf16* Bt; bf16* O; int lda, ldb, M, N, K, ldc, act;
    if (kind == 0)      { A = WSP(WS_XN);   lda = DM;  Bt = (const bf16*)(wb + WO_IN);  ldb = DM;  M = MT; N = INW; K = DM;  O = WSP(WS_Z);    ldc = INW; act = 0; }
    else if (kind == 1) { A = WSP(WS_CAT);  lda = DM;  Bt = (const bf16*)(wb + WO_OUT); ldb = DM;  M = Mr; N = DM;  K = DM;  O = WSP(WS_Y);    ldc = DM;  act = 0; }
    else if (kind == 2) { A = WSP(WS_XN);   lda = DM;  Bt = (const bf16*)(wb + WO_1);   ldb = DM;  M = Mr; N = DFF; K = DM;  O = WSP(WS_HMID); ldc = DFF; act = 1; }
    else if (kind == 3) { A = WSP(WS_HMID); lda = DFF; Bt = (const bf16*)(wb + WO_2);   ldb = DFF; M = Mr; N = DM;  K = DFF; O = WSP(WS_XN);   ldc = DM;  act = 0; }
    else                { A = (const bf16*)(wb + WO_CS); lda = 256; Bt = WSP(WS_Z) + OFF_FN; ldb = INW; M = 512; N = MT; K = 256; O = WSP(WS_C1); ldc = MT; act = 0; }
    run_gemm(lds, A, lda, Bt, ldb, M, N, K, FStore{O, ldc, act}, o_bid());
}
__device__ __forceinline__ void ph_d2(LAS unsigned char* lds, int l) { CArgs& a = kargs(); unsigned char* ws = a.ws;
    for (int j = 0; j < (l == 0 ? 2 : 1); ++j) {
        if (j == 0) run_gemm(lds, WSP(WS_DFT), 4096, WSP(WS_C1), MT, 2048, 4096, 4096, FD2{WSP(WS_CAT), a.in[I_BFNET] + l * 256, 0, 2048}, o_grid() - 1 - o_bid(), 2048 * 2, 32, ((long)256 * MT - 2048) * 2);
        else run_gemm(lds, WSP(WS_DFTC), 512, WSP(WS_C1) + MLAT, MT, 256, 4096, 512, FD2{WSP(WS_CAT), a.in[I_BFNET] + l * 256, MLAT, 256}, o_bid(), 256 * 2, 4, ((long)256 * MT - 256) * 2);
    } }
__device__ __forceinline__ void ph_glu(LAS unsigned char* lds, int l) { CArgs& a = kargs(); unsigned char* ws = a.ws; unsigned char* wb = ws + WS_W + (size_t)l * W_LAYER;
    const int Mr = l == 0 ? MT : MLAT;
    {
        int tid_ = threadIdx.x; asm volatile("" : "+v"(tid_));
        pg8::StaticOrder S; S.init(Mr, 256, o_grid(), o_bid()); pg8::Unit u;
        const bf16* Z = WSP(WS_Z); const float* Y0 = (const float*)(ws + WS_Y0); const float* Y1 = (const float*)(ws + WS_Y1); bf16* T = WSP(WS_T);
        const int c8 = (tid_ & 31) * 8;
        float dk[8];
#pragma unroll
        for (int e = 0; e < 8; ++e) dk[e] = a.in[I_S5D][l * 256 + c8 + e];
        for (int i = 0; S.next(i, u); ++i)
            for (int rr = tid_ >> 5; rr < 256; rr += 16) {
                const size_t row = (size_t)u.pm * 256 + rr;
                const v4u uz = *(const v4u*)(Z + row * INW + OFF_S5 + c8);
                const f32x4 a0 = *(const f32x4*)(Y0 + row * 256 + c8), a1 = *(const f32x4*)(Y0 + row * 256 + c8 + 4), b0 = *(const f32x4*)(Y1 + row * 256 + c8), b1 = *(const f32x4*)(Y1 + row * 256 + c8 + 4);
                const float uv[8] = {bflo(uz.x), bfhi(uz.x), bflo(uz.y), bfhi(uz.y), bflo(uz.z), bfhi(uz.z), bflo(uz.w), bfhi(uz.w)};
                float o[8];
#pragma unroll
                for (int e = 0; e < 8; ++e) { const float v = (e < 4 ? a0[e] + b0[e] : a1[e - 4] + b1[e - 4]) + dk[e] * uv[e];
                    const float uu = 0.7978845608028654f * (v + 0.044715f * v * v * v); o[e] = v / (1.f + __expf(-2.f * uu)); }
                v4u w; w.x = pk2(o[0], o[1]); w.y = pk2(o[2], o[3]); w.z = pk2(o[4], o[5]); w.w = pk2(o[6], o[7]);
                *(v4u*)(T + row * 256 + c8) = w;
            }
        __threadfence(); __syncthreads();
    }
    int K = 256, ld = 256; asm volatile("" : "+s"(K), "+s"(ld));
    run_gemm(lds, WSP(WS_T), ld, (const bf16*)(wb + WO_GLU), ld, Mr, 256, K, FGlu{WSP(WS_CAT), WSP(WS_T)}, o_bid()); }

__global__ void __launch_bounds__(512, 2) fwd_megakernel(Args a_unused) {
    extern __shared__ __attribute__((aligned(16))) unsigned char lds_raw[];
    LAS unsigned char* lds = (LAS unsigned char*)lds_raw;
    cg::grid_group grid = cg::this_grid();
#ifdef PROBE
    if (blockIdx.x == 0 && threadIdx.x == 0) { unsigned char* pw = kargs().ws + WS_PROBE; for (int i = 0; i < 32; ++i) ((float*)pw)[i] = 0.f; *(unsigned long long*)(pw + 256) = __builtin_amdgcn_s_memrealtime(); }
#endif
    {
        unsigned* bar = (unsigned*)(kargs().ws + WS_BAR);
        if (blockIdx.x == 0) for (int i = threadIdx.x; i < XCD_BAR_WORDS; i += 512) bar[i] = 0u;
        if (threadIdx.x < 2) ((volatile LAS unsigned*)(lds + LDS_BARST))[threadIdx.x] = 0u;
    }
    for (int step = 0; step < 20; ++step) {
        const int l = step < 2 ? 0 : (step - 2) / 9, k = step < 2 ? step - 2 : (step - 2) - 9 * l;
        int gk = -1;
        if (k == 0) gk = 0; else if (k == 2) gk = 4; else if (k == 4) gk = 1; else if (k == 6) gk = 2; else if (k == 7) gk = 3;
        int lbl = k == -2 ? 0 : k == -1 ? 1 : k == 0 ? 2 : k == 1 ? 5 : k == 2 ? 6 : k == 3 ? 9 : k == 4 ? 10 : k == 5 ? 11 : k == 6 ? 12 : k == 7 ? 13 : 14; (void)lbl;
#ifdef DBL_GEMM
        if (gk >= 0) { ph_store_gemm(lds, l, gk); __syncthreads(); }
#endif
#ifdef DBL_ROWS
        if (k == -1) prep_rows0(); if (k == 5 && l == 0) row_update<0>();
#endif
        if (gk >= 0) ph_store_gemm(lds, l, gk);
        else if (k == -2) prologue(lds);
        else if (k == -1) prep_rows0();
        else if (k == 1) {
            qk_prep(l);
            __syncthreads(); STAMP(3);
            na_phase(lds, l);
#ifdef DBL_NA
            __syncthreads(); na_phase(lds, l);
#endif
            __syncthreads(); STAMP(4);
            for (int u = o_bid(); u < 256; u += o_grid()) s5_unit(lds, l, u >> 4, u & 15);
#ifdef DBL_S5
            __syncthreads(); for (int u = o_bid(); u < 256; u += o_grid()) s5_unit(lds, l, u >> 4, u & 15);
#endif
        } else if (k == 3) {
            gqa_phase(lds, l);
#ifdef DBL_GQA
            __syncthreads(); gqa_phase(lds, l);
#endif
            __syncthreads(); STAMP(7);
            ph_d2(lds, l); STAMP(8);
            ph_glu(lds, l);
        } else if (k == 5) { if (l == 0) row_update<0>(); else row_update<2>(); }
        else { if (l == 0) row_update<1>(); else row_update<3>(); }
        if (step == 0) {
            grid.sync();
            if (threadIdx.x == 0) (void)xb_add(&((unsigned*)(kargs().ws + WS_BAR))[XB_XCNT(xb_xcc_id())], 1u);
        } else if (k == 1) { __syncthreads(); }
        else if (step != 19) {
            XcdBarrier xb; xb.bar = (unsigned*)(kargs().ws + WS_BAR); xb.x = xb_xcc_id(); xb.st = (volatile LAS unsigned*)(lds + LDS_BARST);
            xcd_barrier(xb);
        }
        STAMP(lbl);
    }
}

extern "C" void kernel_launch(void* const* d_in, const int* in_sizes, int n_in, void* d_out, int out_size, void* d_ws, size_t ws_size, hipStream_t stream) {
    static int grid = 0;
    if (grid == 0) {
        if (n_in != 28 || ws_size < WS_END) { fprintf(stderr, "kernel_launch: unexpected n_in %d / ws_size %zu (need %zu)\n", n_in, ws_size, (size_t)WS_END); grid = -1; return; }
        int dev = 0, cus = 0, per_cu = 0;
        hipGetDevice(&dev); hipDeviceGetAttribute(&cus, hipDeviceAttributeMultiprocessorCount, dev);
        if (hipFuncSetAttribute((const void*)fwd_megakernel, hipFuncAttributeMaxDynamicSharedMemorySize, LDS_BYTES) != hipSuccess) { fprintf(stderr, "kernel_launch: hipFuncSetAttribute failed\n"); }
        if (hipOccupancyMaxActiveBlocksPerMultiprocessor(&per_cu, (const void*)fwd_megakernel, 512, LDS_BYTES) != hipSuccess || per_cu < 1) { fprintf(stderr, "kernel_launch: occupancy query says %d\n", per_cu); per_cu = 1; }
        (void)hipGetLastError();
        grid = cus * (per_cu > 1 ? 1 : per_cu);
        if (grid <= 0) grid = 256;
    }
    if (grid < 0) return;
    Args a{};
    for (int i = 0; i < 28; ++i) a.in[i] = (const float*)d_in[i];
    a.out = (float*)d_out; a.ws = (unsigned char*)d_ws;
    void* args[] = {&a};
    hipError_t e = hipLaunchCooperativeKernel((const void*)fwd_megakernel, dim3(grid), dim3(512), args, LDS_BYTES, stream);
    if (e != hipSuccess) fprintf(stderr, "cooperative launch failed: %s (grid %d)\n", hipGetErrorString(e), grid);
}
```

```cpp
#include <hip/hip_runtime.h>
#include <hip/hip_cooperative_groups.h>
#include <cstdio>
#include <cstdint>
namespace cg = cooperative_groups;
namespace pg8 {
#define PG8_LAS __attribute__((address_space(3)))
typedef unsigned short bf16_t;
typedef short bf16x8 __attribute__((ext_vector_type(8)));
typedef float f32x4 __attribute__((ext_vector_type(4)));
typedef unsigned u32x4 __attribute__((ext_vector_type(4)));
constexpr int BM = 256, BK = 64, HALF = 128, HTB = HALF * BK * 2  , STAGE_BYTES = 8 * HTB, NXCD = 8, WGM = 8;

__host__ __device__ __forceinline__ int lds_byte(int r, int c) { const int st = (r >> 4) * 2 + (c >> 5), rr = r & 15, cc = c & 31, ob = rr * 64 + cc * 2; return st * 1024 + (ob ^ (((ob >> 9) & 1) << 5)); }
__host__ __device__ __forceinline__ void stage_rc(int b, int& R, int& C) { const int st = b / 1024, sb = b % 1024, swz = sb ^ (((sb >> 9) & 1) << 5); R = (st >> 1) * 16 + swz / 64; C = (st & 1) * 32 + (swz % 64) / 2; }
__host__ __device__ __forceinline__ int perm32(int rho) { const int n = rho >> 4, i = rho & 15; return 8 * (i >> 2) + 4 * n + (i & 3); }

struct Unit { int pm, pn; };
struct Gemm { const bf16_t* A; const bf16_t* Bt; int M, N, K, lda, ldb; long tsB; int ksplit; long kjumpB; };

struct StaticOrder {
    int nM, nN, nwg, G, c;
    __host__ __device__ void init(int M, int N, int G_, int c_) { nM = M / BM; nN = N / BM; nwg = nM * nN; G = G_; c = c_; }
    __host__ __device__ bool next(int i, Unit& u) const {
        const long L = (long)i * G + c; if (L >= nwg) return false;
        int wgid = (int)L; { const int q = nwg / NXCD, r = nwg % NXCD, xcd = wgid % NXCD, off = wgid / NXCD; wgid = (xcd < r ? xcd * (q + 1) : r * (q + 1) + (xcd - r) * q) + off; }
        const int nig = WGM * nN, gid = wgid / nig, fm = gid * WGM, gsz = (nM - fm) < WGM ? (nM - fm) : WGM;
        u.pm = fm + ((wgid % nig) % gsz); u.pn = (wgid % nig) / gsz; return true;
    }
    __device__ __forceinline__ void a_ready(const Unit&) const {}
    __device__ __forceinline__ void done(const Unit&) const {}
};
__device__ __forceinline__ unsigned cvt_pk_bf16(float lo, float hi) { unsigned r; asm volatile("v_cvt_pk_bf16_f32 %0, %1, %2" : "=v"(r) : "v"(lo), "v"(hi)); return r; }
template <class Epi, class Sched, bool ALIGN_EPI = false, bool SP2 = false>
__device__ __forceinline__ void gemm_phase(PG8_LAS unsigned char* lds, const Gemm g, const Sched& S, const Epi& E) {
    int tid_ = threadIdx.x; asm volatile("" : "+v"(tid_));
    const int tid = tid_, wid = __builtin_amdgcn_readfirstlane(tid >> 6), lane = tid & 63, wr = wid >> 2, wc = wid & 3, fr = lane & 15, fq = lane >> 4;
    const int K = g.K, nt = K / BK;
    unsigned voffA[2], voffB[2];
#pragma unroll
    for (int i = 0; i < 2; ++i) { int R, C; stage_rc(tid * 16 + i * 8192, R, C); const int Rb = Epi::PERM ? ((R & ~31) + perm32(R & 31)) : R;
        voffA[i] = (unsigned)(R * g.lda + C) * 2u; voffB[i] = (unsigned)(Rb * g.ldb + C) * 2u; }
    const size_t kstep = (size_t)(BK * 2);
    const size_t hstepA = (size_t)HALF * g.lda * 2, hstepB = (size_t)HALF * g.ldb * 2;
    const size_t tstepA = 2 * hstepA, tstepB = (size_t)g.tsB;
    const unsigned ldsw = (unsigned)wid * 1024u;
    const int aoff = lds_byte(wr * 64 + fr, fq * 8), boff = lds_byte(wc * 32 + fr, fq * 8);
#define PG8_SA(b, h) (((b) * 2 + (h)) * HTB)
#define PG8_SB(b, h) ((4 + (b) * 2 + (h)) * HTB)
#define PG8_STAGE(bufoff, gbase, voff) do { _Pragma("unroll") for (int _i = 0; _i < 2; ++_i) \
        __builtin_amdgcn_global_load_lds((const unsigned*)((const char*)(gbase) + (voff)[_i]), (PG8_LAS unsigned*)(lds + (bufoff) + ldsw + _i * 8192), 16, 0, 0); } while (0)
#define PG8_LDA(dst, b, h) do { _Pragma("unroll") for (int m = 0; m < 4; ++m) _Pragma("unroll") for (int k = 0; k < 2; ++k) dst[m][k] = *(const PG8_LAS bf16x8*)(lds + PG8_SA(b, h) + aoff + m * 2048 + k * 1024); } while (0)
#define PG8_LDB(dst, b, h) do { _Pragma("unroll") for (int n = 0; n < 2; ++n) _Pragma("unroll") for (int k = 0; k < 2; ++k) dst[n][k] = *(const PG8_LAS bf16x8*)(lds + PG8_SB(b, h) + boff + n * 2048 + k * 1024); } while (0)
#define PG8_MMA(ai, bj, At, Bt) do { __builtin_amdgcn_s_setprio(1); _Pragma("unroll") for (int m = 0; m < 4; ++m) _Pragma("unroll") for (int n = 0; n < 2; ++n) _Pragma("unroll") for (int k = 0; k < 2; ++k) \
        acc[ai][bj][m][n] = __builtin_amdgcn_mfma_f32_16x16x32_bf16(Bt[n][k], At[m][k], acc[ai][bj][m][n], 0, 0, 0); __builtin_amdgcn_s_setprio(0); } while (0)
#define PG8_WAIT_V(n) asm volatile("s_waitcnt vmcnt(" #n ")" ::: "memory")
#define PG8_WAIT_L(n) asm volatile("s_waitcnt lgkmcnt(" #n ")" ::: "memory")
#define PG8_BAR __builtin_amdgcn_s_barrier()
#define PG8_SCHED __builtin_amdgcn_sched_barrier(0)
    Unit cur, nxt; int ui = 0;
    if (!S.next(0, cur)) return;
    f32x4 acc[2][2][4][2];
#pragma unroll
    for (int a = 0; a < 2; ++a)
#pragma unroll
        for (int b = 0; b < 2; ++b)
#pragma unroll
            for (int m = 0; m < 4; ++m)
#pragma unroll
                for (int n = 0; n < 2; ++n) acc[a][b][m][n] = (f32x4){0.f, 0.f, 0.f, 0.f};
    bf16x8 At[4][2], B0[2][2], B1[2][2];
    const char* cA = (const char*)g.A + (size_t)cur.pm * tstepA; const char* cB = (const char*)g.Bt + (size_t)cur.pn * tstepB;
    S.a_ready(cur);
    if constexpr (SP2) {
        PG8_STAGE(PG8_SB(0, 0), cB, voffB); PG8_STAGE(PG8_SB(0, 1), cB + hstepB, voffB); PG8_STAGE(PG8_SA(0, 0), cA, voffA); PG8_STAGE(PG8_SA(0, 1), cA + hstepA, voffA);
        if (wr == 1) PG8_BAR;
        PG8_WAIT_V(2); PG8_BAR;
        PG8_STAGE(PG8_SB(1, 0), cB + kstep, voffB); PG8_STAGE(PG8_SA(1, 0), cA + kstep, voffA); PG8_STAGE(PG8_SB(1, 1), cB + hstepB + kstep, voffB);
        PG8_WAIT_V(6); PG8_BAR;
    } else {
        PG8_STAGE(PG8_SB(0, 0), cB, voffB); PG8_STAGE(PG8_SA(0, 0), cA, voffA); PG8_STAGE(PG8_SB(0, 1), cB + hstepB, voffB); PG8_STAGE(PG8_SA(0, 1), cA + hstepA, voffA);
        if (wr == 1) PG8_BAR;
        PG8_WAIT_V(4); PG8_BAR;
        PG8_STAGE(PG8_SB(1, 0), cB + kstep, voffB); PG8_STAGE(PG8_SA(1, 0), cA + kstep, voffA); PG8_STAGE(PG8_SB(1, 1), cB + hstepB + kstep, voffB);
        PG8_WAIT_V(6); PG8_BAR;
    }
    for (;;) {
        const bool has_next = S.next(ui + 1, nxt);
        const char* nA = has_next ? (const char*)g.A + (size_t)nxt.pm * tstepA : cA; const char* nB = has_next ? (const char*)g.Bt + (size_t)nxt.pn * tstepB : cB;
        for (int t = 0; t < nt; t += 2) {
            const bool last = (t == nt - 2);
            const char* a1 = cA + (size_t)(t + 1) * kstep;
            const char* a2 = last ? nA : cA + (size_t)(t + 2) * kstep; const char* b2 = last ? nB : cB + (size_t)(t + 2) * kstep + ((t + 2) >= g.ksplit ? g.kjumpB : 0);
            const char* a3 = a2 + kstep; const char* b3 = b2 + kstep;
            if (last && has_next) S.a_ready(nxt);
            if constexpr (SP2) {
            PG8_LDB(B0, 0, 0); PG8_LDB(B1, 0, 1); PG8_SCHED; PG8_LDA(At, 0, 0); PG8_STAGE(PG8_SA(1, 1), a1 + hstepA, voffA);
            PG8_WAIT_V(8); PG8_WAIT_L(0); PG8_BAR; PG8_MMA(0, 0, At, B0); PG8_MMA(0, 1, At, B1); PG8_BAR; PG8_SCHED;
            PG8_LDA(At, 0, 1); PG8_STAGE(PG8_SB(0, 0), b2, voffB); PG8_STAGE(PG8_SB(0, 1), b2 + hstepB, voffB); PG8_STAGE(PG8_SA(0, 0), a2, voffA);
            PG8_WAIT_V(8); PG8_WAIT_L(0); PG8_BAR; PG8_MMA(1, 0, At, B0); PG8_MMA(1, 1, At, B1); PG8_BAR; PG8_SCHED;
            PG8_LDB(B0, 1, 0); PG8_LDB(B1, 1, 1); PG8_SCHED; PG8_LDA(At, 1, 0); PG8_STAGE(PG8_SA(0, 1), a2 + hstepA, voffA);
            PG8_WAIT_V(8); PG8_WAIT_L(0); PG8_BAR; PG8_MMA(0, 0, At, B0); PG8_MMA(0, 1, At, B1); PG8_BAR; PG8_SCHED;
            PG8_LDA(At, 1, 1); PG8_STAGE(PG8_SB(1, 0), b3, voffB); PG8_STAGE(PG8_SB(1, 1), b3 + hstepB, voffB); PG8_STAGE(PG8_SA(1, 0), a3, voffA);
            PG8_WAIT_V(8); PG8_WAIT_L(0); PG8_BAR; PG8_MMA(1, 0, At, B0); PG8_MMA(1, 1, At, B1); PG8_BAR; PG8_SCHED;
            } else {
            PG8_LDB(B0, 0, 0); PG8_SCHED; PG8_LDA(At, 0, 0); PG8_STAGE(PG8_SA(1, 1), a1 + hstepA, voffA);
            PG8_WAIT_L(8); PG8_BAR; PG8_WAIT_L(0); PG8_MMA(0, 0, At, B0); PG8_BAR; PG8_SCHED;
            PG8_LDB(B1, 0, 1); PG8_STAGE(PG8_SB(0, 0), b2, voffB);
            PG8_BAR; PG8_WAIT_L(0); PG8_MMA(0, 1, At, B1); PG8_BAR;
            PG8_LDA(At, 0, 1); PG8_STAGE(PG8_SA(0, 0), a2, voffA);
            PG8_BAR; PG8_WAIT_L(0); PG8_MMA(1, 0, At, B0); PG8_BAR; PG8_SCHED;
            PG8_STAGE(PG8_SB(0, 1), b2 + hstepB, voffB);
            PG8_WAIT_V(6); PG8_BAR; PG8_MMA(1, 1, At, B1); PG8_BAR;
            PG8_LDB(B0, 1, 0); PG8_SCHED; PG8_LDA(At, 1, 0); PG8_STAGE(PG8_SA(0, 1), a2 + hstepA, voffA);
            PG8_WAIT_L(8); PG8_BAR; PG8_WAIT_L(0); PG8_MMA(0, 0, At, B0); PG8_BAR; PG8_SCHED;
            PG8_LDB(B1, 1, 1); PG8_STAGE(PG8_SB(1, 0), b3, voffB);
            PG8_BAR; PG8_WAIT_L(0); PG8_MMA(0, 1, At, B1); PG8_BAR;
            PG8_LDA(At, 1, 1); PG8_STAGE(PG8_SA(1, 0), a3, voffA);
            PG8_BAR; PG8_WAIT_L(0); PG8_MMA(1, 0, At, B0); PG8_BAR; PG8_SCHED;
            PG8_STAGE(PG8_SB(1, 1), b3 + hstepB, voffB);
            PG8_WAIT_V(6); PG8_BAR; PG8_MMA(1, 1, At, B1); PG8_BAR;
            }
        }
        if constexpr (ALIGN_EPI) { if (wr == 0) PG8_BAR; }
        if constexpr (!Epi::AFTER_DRAIN) { E(acc, cur, wr, wc, fr, fq); S.done(cur); }
        if (!has_next) break;
#pragma unroll
        for (int a = 0; a < 2; ++a)
#pragma unroll
            for (int b = 0; b < 2; ++b)
#pragma unroll
                for (int m = 0; m < 4; ++m)
#pragma unroll
                    for (int n = 0; n < 2; ++n) acc[a][b][m][n] = (f32x4){0.f, 0.f, 0.f, 0.f};
        cur = nxt; cA = nA; cB = nB; ++ui;
        if constexpr (ALIGN_EPI) { if (wr == 1) PG8_BAR; }
    }
    PG8_WAIT_V(0);
    if constexpr (!ALIGN_EPI) { if (wr == 0) PG8_BAR; }
    PG8_BAR;
    if constexpr (Epi::AFTER_DRAIN) { E.fused(acc, cur, wr, wc, fr, fq, lds, wid, lane); S.done(cur); }
#undef PG8_SA
#undef PG8_SB
#undef PG8_STAGE
#undef PG8_LDA
#undef PG8_LDB
#undef PG8_MMA
#undef PG8_WAIT_V
#undef PG8_WAIT_L
#undef PG8_BAR
#undef PG8_SCHED
}
}
#define LAS __attribute__((address_space(3)))
typedef unsigned short bf16;
typedef unsigned v4u __attribute__((ext_vector_type(4)));
typedef unsigned v2u __attribute__((ext_vector_type(2)));
typedef float f32x4 __attribute__((ext_vector_type(4)));
typedef float f32x16 __attribute__((ext_vector_type(16)));
typedef short bf16x8 __attribute__((ext_vector_type(8)));
typedef short s16x4 __attribute__((ext_vector_type(4)));

constexpr int DM = 1024, NB = 16, SEQ = 2048, CTXL = 256, MLAT = NB * SEQ, MCTX = NB * CTXL, MT = MLAT + MCTX, INW = 1792, DFF = 4096;
constexpr int OFF_AQ = 0, OFF_AK = 256, OFF_AV = 384, OFF_S5 = 512, OFF_NQ = 768, OFF_NK = 1024, OFF_NV = 1280, OFF_FN = 1536;
constexpr float EPSN = 1e-6f;
constexpr float LOG2E = 1.4426950408889634f;
constexpr size_t MiB = 1u << 20;
constexpr size_t WS_MOD = 0;
constexpr size_t WS_ROPE = 1 * MiB;
constexpr size_t WS_W = 2 * MiB, W_LAYER = 22 * MiB;
constexpr size_t WO_IN = 0, WO_OUT = WO_IN + (size_t)INW * DM * 2, WO_1 = WO_OUT + (size_t)DM * DM * 2, WO_2 = WO_1 + (size_t)DFF * DM * 2,
                 WO_GLU = WO_2 + (size_t)DFF * DM * 2, WO_CS = WO_GLU + 256 * 256 * 2, WO_END = WO_CS + 512 * 256 * 2;
static_assert(WO_END <= W_LAYER, "weights");
constexpr size_t WS_DFT = 46 * MiB, WS_DFTC = 62 * MiB, WS_XC = 64 * MiB, WS_XN = 80 * MiB;
constexpr size_t WS_T = 116 * MiB, WS_C1 = 350 * MiB;
constexpr size_t WS_Z = 152 * MiB, WS_CAT = 278 * MiB, WS_Y = 350 * MiB, WS_HMID = 152 * MiB, WS_Y0 = 440 * MiB, WS_Y1 = 476 * MiB, WS_END = 512 * MiB;
constexpr int LDS_BYTES = 147456;

struct Args { const float* in[28]; float* out; unsigned char* ws; };
typedef __attribute__((address_space(4))) const Args CArgs;
__device__ __forceinline__ CArgs& kargs() { CArgs* p = (CArgs*)__builtin_amdgcn_kernarg_segment_ptr(); asm volatile("" : "+s"(p)); return *p; }
enum { I_X = 0, I_C, I_CTX, I_CCTX, I_WADA, I_BADA, I_GPREMIX, I_GPOSTMIX, I_GPREMLP, I_GPOSTMLP, I_WIN, I_GQ, I_GK, I_AR, I_AI, I_LDT, I_BR, I_BI, I_CR, I_CI,
       I_S5D, I_WGLU, I_NABIAS, I_WFNET, I_BFNET, I_WOUT, I_W1, I_W2 };

constexpr size_t WS_PROBE = 1 * MiB + 65536;
constexpr size_t WS_BAR = 1 * MiB + 131072;
constexpr int LDS_BARST = 147456 - 64;
#ifdef PROBE
#define STAMP(lbl) do { if (blockIdx.x == 0 && threadIdx.x == 0) { unsigned char* pw_ = kargs().ws + WS_PROBE; const unsigned long long now_ = __builtin_amdgcn_s_memrealtime(); \
    unsigned long long* tp_ = (unsigned long long*)(pw_ + 256); ((float*)pw_)[lbl] += (float)(now_ - *tp_); *tp_ = now_; } } while (0)
#else
#define STAMP(lbl) do {} while (0)
#endif
__device__ __forceinline__ unsigned f2bf(float f) { unsigned u = __builtin_bit_cast(unsigned, f); return (u + 0x7fffu + ((u >> 16) & 1u)) >> 16; }
typedef float f32x2_t __attribute__((ext_vector_type(2))); typedef __bf16 bf16x2_t __attribute__((ext_vector_type(2)));
__device__ __forceinline__ unsigned pk2(float lo, float hi) { const f32x2_t v = {lo, hi}; const bf16x2_t b = __builtin_convertvector(v, bf16x2_t); return __builtin_bit_cast(unsigned, b); }
__device__ __forceinline__ float bflo(unsigned w) { return __builtin_bit_cast(float, w << 16); }
__device__ __forceinline__ float bfhi(unsigned w) { return __builtin_bit_cast(float, w & 0xffff0000u); }
__device__ __forceinline__ float bf2f(bf16 h) { return __builtin_bit_cast(float, (unsigned)h << 16); }
__device__ __forceinline__ int o_bid() { int t = blockIdx.x; asm volatile("" : "+s"(t)); return t; }
__device__ __forceinline__ int o_grid() { int t = gridDim.x; asm volatile("" : "+s"(t)); return t; }
__device__ __forceinline__ float shfl_xor_l(float v, int o, int lane) { return __builtin_bit_cast(float, __builtin_amdgcn_ds_bpermute((lane ^ o) << 2, __builtin_bit_cast(int, v))); }
__device__ __forceinline__ float wave_sum(float v, int lane) {
#pragma unroll
    for (int o = 1; o < 64; o <<= 1) v += shfl_xor_l(v, o, lane);
    return v;
}
__device__ __forceinline__ int crow(int r, int hi) { return (r & 3) + 8 * (r >> 2) + 4 * hi; }

template <class F> struct Epi8 {
    static constexpr bool PERM = true, AFTER_DRAIN = false;
    F f;
    __device__ __forceinline__ void operator()(const pg8::f32x4 (&acc)[2][2][4][2], const pg8::Unit& u, int wr, int wc, int fr, int fq) const {
        asm volatile("" : "+v"(fr), "+v"(fq));
#pragma unroll
        for (int ai = 0; ai < 2; ++ai)
#pragma unroll
            for (int m = 0; m < 4; ++m) {
                const int row = u.pm * 256 + ai * 128 + wr * 64 + m * 16 + fr;
#pragma unroll
                for (int bj = 0; bj < 2; ++bj) { const int col = u.pn * 256 + bj * 128 + wc * 32 + 8 * fq; f(row, col, acc[ai][bj][m][0], acc[ai][bj][m][1]); }
                asm volatile("" ::: "memory"); __builtin_amdgcn_sched_barrier(0);
            }
    }
};
__device__ __forceinline__ v4u pack8(f32x4 a, f32x4 b) { v4u w; w.x = pk2(a[0], a[1]); w.y = pk2(a[2], a[3]); w.z = pk2(b[0], b[1]); w.w = pk2(b[2], b[3]); return w; }
struct FStore { bf16* O; int ldc; int act;
    __device__ __forceinline__ void operator()(int row, int col, f32x4 a, f32x4 b) const {
        if (act == 1) {
#pragma unroll
            for (int i = 0; i < 4; ++i) { float x = a[i] > 0.f ? a[i] : 0.f; a[i] = x * x; float y = b[i] > 0.f ? b[i] : 0.f; b[i] = y * y; } }
        *(v4u*)(O + (size_t)row * ldc + col) = pack8(a, b); } };
struct FD2 { bf16* cat; const float* bias; int rowbase, rowsPerB;
    __device__ __forceinline__ void operator()(int row, int col, f32x4 a, f32x4 b) const {
        const int bb = col >> 8, j = col & 255; const f32x4 b0 = *(const f32x4*)(bias + j), b1 = *(const f32x4*)(bias + j + 4);
        *(v4u*)(cat + ((size_t)(rowbase + bb * rowsPerB + row) * 1024 + 768 + j)) = pack8(a + b0, b + b1); } };
struct FGlu { bf16* cat; const bf16* T;
    __device__ __forceinline__ void operator()(int row, int col, f32x4 a, f32x4 b) const {
        const v4u t = *(const v4u*)(T + (size_t)row * 256 + col);
        float tv[8] = {bflo(t.x), bfhi(t.x), bflo(t.y), bfhi(t.y), bflo(t.z), bfhi(t.z), bflo(t.w), bfhi(t.w)};
#pragma unroll
        for (int i = 0; i < 4; ++i) { a[i] = tv[i] / (1.f + __expf(-a[i])); b[i] = tv[4 + i] / (1.f + __expf(-b[i])); }
        *(v4u*)(cat + (size_t)row * 1024 + 256 + col) = pack8(a, b); } };
__device__ __forceinline__ void transpose_item(const float* W, int K, int N, bf16* WT, LAS float* scr, int item, int lane) {
    const int nblk = N / 32, kb = item / nblk, nb = item % nblk, k0 = 64 * kb, n0 = 32 * nb;
#pragma unroll
    for (int i = 0; i < 8; ++i) { const int kk = 8 * i + (lane >> 3), n4 = (lane & 7) * 4; const f32x4 v = *(const f32x4*)(W + (size_t)(k0 + kk) * N + n0 + n4);
        scr[kk * 33 + n4] = v[0]; scr[kk * 33 + n4 + 1] = v[1]; scr[kk * 33 + n4 + 2] = v[2]; scr[kk * 33 + n4 + 3] = v[3]; }
    asm volatile("s_waitcnt lgkmcnt(0)" ::: "memory");
    const int c = lane & 7;
#pragma unroll
    for (int j = 0; j < 4; ++j) { const int n = (lane >> 3) + 8 * j; const LAS float* s = scr + (8 * c) * 33 + n;
        v4u o; o.x = pk2(s[0 * 33], s[1 * 33]); o.y = pk2(s[2 * 33], s[3 * 33]); o.z = pk2(s[4 * 33], s[5 * 33]); o.w = pk2(s[6 * 33], s[7 * 33]);
        *(v4u*)(WT + (size_t)(n0 + n) * K + k0 + 8 * c) = o; }
    asm volatile("s_waitcnt lgkmcnt(0)" ::: "memory");
}

__device__ __forceinline__ void prologue(LAS unsigned char* lds) {
    CArgs& a = kargs();
    int tid_ = threadIdx.x; asm volatile("" : "+v"(tid_));
    const int tid = tid_, lane = tid & 63, wid = tid >> 6, G = o_grid();
    unsigned char* ws = a.ws;
    {
        LAS float* scr = (LAS float*)(lds + wid * 16384);
        const int gw = o_bid() * 8 + wid, NGW = G * 8;
        constexpr int I0 = (DM / 64) * (INW / 32), I1 = (DM / 64) * (DM / 32), I2 = (DM / 64) * (DFF / 32), I3 = (DFF / 64) * (DM / 32), I4 = (256 / 64) * (256 / 32);
        constexpr int PER = I0 + I1 + I2 + I3 + I4;
        for (int it = gw; it < 2 * PER; it += NGW) {
            const int l = it / PER; int r = it % PER; unsigned char* wb = ws + WS_W + (size_t)l * W_LAYER;
            if (r < I0) { transpose_item(a.in[I_WIN] + (size_t)l * DM * INW, DM, INW, (bf16*)(wb + WO_IN), scr, r, lane); continue; } r -= I0;
            if (r < I1) { transpose_item(a.in[I_WOUT] + (size_t)l * DM * DM, DM, DM, (bf16*)(wb + WO_OUT), scr, r, lane); continue; } r -= I1;
            if (r < I2) { transpose_item(a.in[I_W1] + (size_t)l * DM * DFF, DM, DFF, (bf16*)(wb + WO_1), scr, r, lane); continue; } r -= I2;
            if (r < I3) { transpose_item(a.in[I_W2] + (size_t)l * DFF * DM, DFF, DM, (bf16*)(wb + WO_2), scr, r, lane); continue; } r -= I3;
            transpose_item(a.in[I_WGLU] + (size_t)l * 256 * 256, 256, 256, (bf16*)(wb + WO_GLU), scr, r, lane);
        }
    }
    __syncthreads();
    {
        LAS float* sl = (LAS float*)lds;
        LAS float* part = (LAS float*)(lds + 17 * 1024 * 4);
        float* mod = (float*)(ws + WS_MOD);
        bool have = false;
        for (int u = o_bid(); u < 2 * 96; u += G) {
            if (!have) {
                for (int i = tid; i < 17 * 1024; i += 512) { const float cv = i < 16 * 1024 ? a.in[I_C][i] : a.in[I_CCTX][i - 16 * 1024]; sl[i] = cv / (1.f + __expf(-cv)); }
                have = true; __syncthreads();
            }
            const int l = u / 96, n0 = (u % 96) * 64;
            const float* W = a.in[I_WADA] + (size_t)l * DM * 6144 + n0 + lane;
            float acc[17];
#pragma unroll
            for (int i = 0; i < 17; ++i) acc[i] = 0.f;
            for (int k0 = wid * 128; k0 < wid * 128 + 128; k0 += 16) {
                float wv[16];
#pragma unroll
                for (int q = 0; q < 16; ++q) wv[q] = W[(size_t)(k0 + q) * 6144];
#pragma unroll
                for (int q = 0; q < 16; ++q)
#pragma unroll
                    for (int i = 0; i < 17; ++i) acc[i] += sl[i * 1024 + k0 + q] * wv[q];
            }
#pragma unroll
            for (int i = 0; i < 17; ++i) part[(wid * 17 + i) * 64 + lane] = acc[i];
            __syncthreads();
            for (int o = tid; o < 17 * 64; o += 512) {
                const int i = o >> 6, n = o & 63; float s = a.in[I_BADA][l * 6144 + n0 + n];
#pragma unroll
                for (int w = 0; w < 8; ++w) s += part[(w * 17 + i) * 64 + n];
                mod[((size_t)l * 17 + i) * 6144 + n0 + n] = s;
            }
            __syncthreads();
        }
    }
    {
        const size_t gt = (size_t)o_bid() * 512 + tid, NT = (size_t)G * 512;
        bf16* dft = (bf16*)(ws + WS_DFT);
        for (size_t i = gt; i < (size_t)2048 * 4096 / 8; i += NT) {
            const int kk = (int)(i / 512), n0 = (int)(i % 512) * 8; float v[8];
#pragma unroll
            for (int j = 0; j < 8; ++j) { const int n = n0 + j, nn = n & 2047; const float fr = (float)((kk * nn) & 2047) * (1.f / 2048.f);
                v[j] = (n < 2048 ? __builtin_amdgcn_cosf(fr) : -__builtin_amdgcn_sinf(fr)) * 0.02209708691207961f; }
            v4u o; o.x = pk2(v[0], v[1]); o.y = pk2(v[2], v[3]); o.z = pk2(v[4], v[5]); o.w = pk2(v[6], v[7]);
            *(v4u*)(dft + i * 8) = o;
        }
        bf16* dftc = (bf16*)(ws + WS_DFTC);
        for (size_t i = gt; i < (size_t)256 * 512 / 8; i += NT) {
            const int kk = (int)(i / 64), n0 = (int)(i % 64) * 8; float v[8];
#pragma unroll
            for (int j = 0; j < 8; ++j) { const int n = n0 + j, nn = n & 255; const float fr = (float)((kk * nn) & 255) * (1.f / 256.f);
                v[j] = (n < 256 ? __builtin_amdgcn_cosf(fr) : -__builtin_amdgcn_sinf(fr)) * 0.0625f; }
            v4u o; o.x = pk2(v[0], v[1]); o.y = pk2(v[2], v[3]); o.z = pk2(v[4], v[5]); o.w = pk2(v[6], v[7]);
            *(v4u*)(dftc + i * 8) = o;
        }
        for (size_t i = gt; i < (size_t)2 * 512 * 256; i += NT) {
            const int l = (int)(i / (512 * 256)), rem = (int)(i % (512 * 256)), jp = rem >> 8, cin = rem & 255, j = jp & 255, part = jp >> 8;
            const float* W = a.in[I_WFNET] + (size_t)l * 256 * 256 + (size_t)(cin >> 6) * 64 * 256 + j; const int c = cin & 63; float s = 0.f;
            for (int cp0 = 0; cp0 < 64; cp0 += 16) { float wv[16];
#pragma unroll
                for (int q = 0; q < 16; ++q) wv[q] = W[(size_t)(cp0 + q) * 256];
#pragma unroll
                for (int q = 0; q < 16; ++q) { const float fr = (float)((c * (cp0 + q)) & 63) * (1.f / 64.f); s += (part ? __builtin_amdgcn_sinf(fr) : __builtin_amdgcn_cosf(fr)) * wv[q]; } }
            ((bf16*)(ws + WS_W + (size_t)l * W_LAYER + WO_CS))[(size_t)jp * 256 + cin] = (bf16)f2bf(s * 0.125f);
        }
        float2* rope = (float2*)(ws + WS_ROPE);
        for (size_t i = gt; i < 1024; i += NT) { const int pos = (int)i >> 4, k = (int)i & 15; const float inv = exp2f(-(float)k * (13.287712379549449f / 16.f)); const float ang = (float)pos * inv;
            float sn, cs; sincosf(ang, &sn, &cs); rope[i] = make_float2(cs, sn); }
    }
}

__device__ __forceinline__ void prep_rows0() {
    CArgs& a = kargs();
    int tid_ = threadIdx.x; asm volatile("" : "+v"(tid_));
    const int lane = tid_ & 63, gw = o_bid() * 8 + (tid_ >> 6), NGW = o_grid() * 8;
    const float* mod = (const float*)(a.ws + WS_MOD); bf16* XN = (bf16*)(a.ws + WS_XN); const float* gp = a.in[I_GPREMIX];
    f32x4 vn[4];
    auto rload = [&](int row) { const float* xr = row < MLAT ? a.in[I_X] + (size_t)row * DM : a.in[I_CTX] + (size_t)(row - MLAT) * DM;
#pragma unroll
        for (int j = 0; j < 4; ++j) vn[j] = *(const f32x4*)(xr + 4 * lane + 256 * j); };
    if (gw < MT) rload(gw);
    for (int row = gw; row < MT; row += NGW) {
        const int bi = row < MLAT ? row >> 11 : 16;
        const float* mb = mod + (size_t)bi * 6144;
        f32x4 v[4]; float ss = 0.f;
#pragma unroll
        for (int j = 0; j < 4; ++j) { v[j] = vn[j]; ss += v[j][0] * v[j][0] + v[j][1] * v[j][1] + v[j][2] * v[j][2] + v[j][3] * v[j][3]; }
        if (row + NGW < MT) rload(row + NGW);
        const float rstd = rsqrtf(wave_sum(ss, lane) * (1.f / DM) + EPSN);
#pragma unroll
        for (int j = 0; j < 4; ++j) { const int k = 4 * lane + 256 * j; const f32x4 g = *(const f32x4*)(gp + k), sh = *(const f32x4*)(mb + k), sc = *(const f32x4*)(mb + 1024 + k);
            f32x4 o;
#pragma unroll
            for (int e = 0; e < 4; ++e) o[e] = (v[j][e] * rstd * g[e]) * (1.f + sc[e]) + sh[e];
            v2u w; w.x = pk2(o[0], o[1]); w.y = pk2(o[2], o[3]); *(v2u*)(XN + (size_t)row * DM + k) = w; }
    }
}
template <int WHICH>
__device__ __forceinline__ void row_update() {
    CArgs& a = kargs();
    constexpr int l = WHICH >> 1; constexpr bool MLP = WHICH & 1; constexpr bool NXT = WHICH != 3;
    const int nrows = l == 0 ? MT : MLAT;
    const bf16* Y = (const bf16*)(a.ws + (MLP ? WS_XN : WS_Y)); bf16* OB = (bf16*)(a.ws + WS_XN);
    const float* xlat_in = WHICH == 0 ? a.in[I_X] : a.out; const float* xctx_in = WHICH == 0 ? a.in[I_CTX] : (const float*)(a.ws + WS_XC);
    float* xlat_out = a.out; float* xctx_out = (float*)(a.ws + WS_XC);
    const float* mod = (const float*)(a.ws + WS_MOD);
    const float* modl = mod + (size_t)l * 17 * 6144; constexpr int gate_i = MLP ? 5 : 2;
    const float* gpost = (MLP ? a.in[I_GPOSTMLP] : a.in[I_GPOSTMIX]) + l * DM;
    const float* modn = MLP ? mod + (size_t)17 * 6144 : modl; constexpr int sh_i = MLP ? 0 : 3, sc_i = MLP ? 1 : 4;
    const float* gnext = MLP ? a.in[I_GPREMIX] + DM : a.in[I_GPREMLP] + l * DM;
    int tid_ = threadIdx.x; asm volatile("" : "+v"(tid_));
    const int lane = tid_ & 63, gw = o_bid() * 8 + (tid_ >> 6), NGW = o_grid() * 8;
    v2u ywn[4]; f32x4 xn[4];
    auto rload = [&](int row) {
        const bool lat = row < MLAT; const float* xr = lat ? xlat_in + (size_t)row * DM : xctx_in + (size_t)(row - MLAT) * DM;
#pragma unroll
        for (int j = 0; j < 4; ++j) { const int k = 4 * lane + 256 * j; ywn[j] = *(const v2u*)(Y + (size_t)row * DM + k); xn[j] = *(const f32x4*)(xr + k); } };
    if (gw < nrows) rload(gw);
    for (int row = gw; row < nrows; row += NGW) {
        const bool lat = row < MLAT; const int bi = lat ? row >> 11 : 16;
        float* xo = lat ? xlat_out + (size_t)row * DM : xctx_out + (size_t)(row - MLAT) * DM;
        const float* gate = modl + (size_t)bi * 6144 + gate_i * 1024;
        f32x4 y[4], x[4]; float ss = 0.f;
#pragma unroll
        for (int j = 0; j < 4; ++j) { const v2u w = ywn[j]; y[j] = (f32x4){bflo(w.x), bfhi(w.x), bflo(w.y), bfhi(w.y)}; x[j] = xn[j];
            ss += y[j][0] * y[j][0] + y[j][1] * y[j][1] + y[j][2] * y[j][2] + y[j][3] * y[j][3]; }
        if (row + NGW < nrows) rload(row + NGW);
        const float rstd = rsqrtf(wave_sum(ss, lane) * (1.f / DM) + EPSN); float s2 = 0.f;
#pragma unroll
        for (int j = 0; j < 4; ++j) { const int k = 4 * lane + 256 * j; const f32x4 g = *(const f32x4*)(gpost + k), gt = *(const f32x4*)(gate + k);
#pragma unroll
            for (int e = 0; e < 4; ++e) { x[j][e] = x[j][e] + gt[e] * (y[j][e] * rstd * g[e]); s2 += x[j][e] * x[j][e]; }
#ifdef PROBE
            if (WHICH == 3) { const float* pa = (const float*)(a.ws + WS_PROBE); float tot = 0.f, fa = 0.f, fb = 0.f;
                for (int i = 0; i < 15; ++i) { const float v = pa[i]; tot += v; if ((PROBE_A >> i) & 1) fa += v; if ((PROBE_B >> i) & 1) fb += v; }
                fa /= tot; fb /= tot; const float e = fa < 0.02f ? 0.02f : fa;
                for (int q = 0; q < 4; ++q) x[j][q] *= (1.f + e);
                if (row == 0 && lane == 0 && j == 0) x[j][0] += 50.f + 1000.f * fb; }
#endif
            *(f32x4*)(xo + k) = x[j]; }
        if (NXT) {
            const float rstd2 = rsqrtf(wave_sum(s2, lane) * (1.f / DM) + EPSN); const float* mb = modn + (size_t)bi * 6144;
#pragma unroll
            for (int j = 0; j < 4; ++j) { const int k = 4 * lane + 256 * j; const f32x4 g = *(const f32x4*)(gnext + k), sh = *(const f32x4*)(mb + sh_i * 1024 + k), sc = *(const f32x4*)(mb + sc_i * 1024 + k);
                f32x4 o;
#pragma unroll
                for (int e = 0; e < 4; ++e) o[e] = (x[j][e] * rstd2 * g[e]) * (1.f + sc[e]) + sh[e];
                v2u w; w.x = pk2(o[0], o[1]); w.y = pk2(o[2], o[3]); *(v2u*)(OB + (size_t)row * DM + k) = w; }
        }
    }
}

__device__ __forceinline__ void qk_prep(int layer) {
    CArgs& a = kargs();
    bf16* Z = (bf16*)(a.ws + WS_Z); const float2* rope = (const float2*)(a.ws + WS_ROPE);
    int tid_ = threadIdx.x; asm volatile("" : "+v"(tid_));
    const int gt = o_bid() * 512 + tid_, NT = o_grid() * 512;
    for (int it = gt; it < MT * 6; it += NT) {
        const int row = it / 6, slot = it % 6; const bool lat = row < MLAT;
        bf16* p = Z + (size_t)row * INW + (slot < 4 ? OFF_AQ + slot * 64 : OFF_AK + (slot - 4) * 64);
        const float* g = (slot < 4 ? a.in[I_GQ] : a.in[I_GK]) + layer * 64;
        float v[64]; float ss = 0.f;
#pragma unroll
        for (int c = 0; c < 8; ++c) { const v4u w = *(const v4u*)(p + 8 * c);
            v[8 * c + 0] = bflo(w.x); v[8 * c + 1] = bfhi(w.x); v[8 * c + 2] = bflo(w.y); v[8 * c + 3] = bfhi(w.y); v[8 * c + 4] = bflo(w.z); v[8 * c + 5] = bfhi(w.z); v[8 * c + 6] = bflo(w.w); v[8 * c + 7] = bfhi(w.w); }
#pragma unroll
        for (int i = 0; i < 64; ++i) ss += v[i] * v[i];
        const float rstd = rsqrtf(ss * (1.f / 64.f) + EPSN);
#pragma unroll
        for (int i = 0; i < 64; ++i) v[i] = v[i] * rstd * g[i];
        if (lat) {
            const int t = row & 2047, gr = t >> 6, gc = t & 63;
#pragma unroll
            for (int i = 0; i < 16; ++i) {
                const float2 cr = rope[gr * 16 + i], cc = rope[gc * 16 + i];
                const float x1 = v[i], x2 = v[16 + i]; v[i] = x1 * cr.x - x2 * cr.y; v[16 + i] = x1 * cr.y + x2 * cr.x;
                const float y1 = v[32 + i], y2 = v[48 + i]; v[32 + i] = y1 * cc.x - y2 * cc.y; v[48 + i] = y1 * cc.y + y2 * cc.x;
            }
        }
#pragma unroll
        for (int c = 0; c < 8; ++c) { v4u w; w.x = pk2(v[8 * c], v[8 * c + 1]); w.y = pk2(v[8 * c + 2], v[8 * c + 3]); w.z = pk2(v[8 * c + 4], v[8 * c + 5]); w.w = pk2(v[8 * c + 6], v[8 * c + 7]); *(v4u*)(p + 8 * c) = w; }
    }
}
struct AttnP { const bf16* Z; bf16* O; int ostride; int qtok0; int qcol; int ocol; int kcol, vcol; int loc0, nloc, ctx0, nctx;
               int na; int qgcol0; int relr0; int head; int act_lo, act_hi; };
template <int NH>
__device__ __forceinline__ void attn_unit(LAS unsigned char* lds, const AttnP& P, const LAS float* biasL) {
    int tid_ = threadIdx.x; asm volatile("" : "+v"(tid_));
    const int tid = tid_, lane = tid & 63, wid = tid >> 6, r32 = lane & 31, hi = lane >> 5;
    const int slot = (NH == 1) ? 0 : (wid >> 1);
    const bf16* Z = P.Z;
    bf16x8 qr[4];
#pragma unroll
    for (int d0 = 0; d0 < 4; ++d0) qr[d0] = *(const bf16x8*)(Z + (size_t)(P.qtok0 + r32) * INW + P.qcol + d0 * 16 + hi * 8);
    const int nt = P.nloc + P.nctx;
    v4u kreg[NH], vreg[NH];
    auto tile_tok = [&](int i) { return i < P.nloc ? P.loc0 + 64 * i : P.ctx0 + 64 * (i - P.nloc); };
    auto gload = [&](int i) { const int tok = tile_tok(i);
#pragma unroll
        for (int s = 0; s < NH; ++s) { kreg[s] = *(const v4u*)(Z + (size_t)(tok + (tid >> 3)) * INW + P.kcol + s * 64 + (tid & 7) * 8);
                                        vreg[s] = *(const v4u*)(Z + (size_t)(tok + lane) * INW + P.vcol + s * 64 + wid * 8); } };
    gload(0);
    f32x16 o0 = {}, o1 = {};
    float m = -1e30f, lsum = 0.f;
    const float sc = 0.125f * LOG2E;
    const int qg = P.qgcol0 + r32; const int cs = qg - 8 < 0 ? 0 : (qg - 8 > 48 ? 48 : qg - 8);
    auto lstore = [&](int bufoff) {
#pragma unroll
        for (int s = 0; s < NH; ++s) {
            LAS unsigned char* sb = lds + bufoff + s * 18432;
            *(LAS v4u*)(sb + ((tid >> 3) * 72 + (tid & 7) * 8) * 2) = kreg[s];
            LAS bf16* vt = (LAS bf16*)(sb + 9216);
            const unsigned w[4] = {vreg[s].x, vreg[s].y, vreg[s].z, vreg[s].w};
#pragma unroll
            for (int e = 0; e < 4; ++e) { vt[(wid * 8 + 2 * e) * 68 + lane] = (bf16)(w[e] & 0xffffu); vt[(wid * 8 + 2 * e + 1) * 68 + lane] = (bf16)(w[e] >> 16); }
        }
    };
    auto compute = [&](int i, int bufoff) {
        if (P.na && i < P.nloc && (i < P.act_lo || i >= P.act_hi)) return;
        const LAS unsigned char* kb = lds + bufoff + slot * 18432; const LAS unsigned char* vb = kb + 9216;
        f32x16 p0 = {}, p1 = {};
#pragma unroll
        for (int d0 = 0; d0 < 4; ++d0) {
            const bf16x8 a0 = *(const LAS bf16x8*)(kb + (r32 * 72 + d0 * 16 + hi * 8) * 2);
            const bf16x8 a1 = *(const LAS bf16x8*)(kb + ((32 + r32) * 72 + d0 * 16 + hi * 8) * 2);
            p0 = __builtin_amdgcn_mfma_f32_32x32x16_bf16(a0, qr[d0], p0, 0, 0, 0);
            p1 = __builtin_amdgcn_mfma_f32_32x32x16_bf16(a1, qr[d0], p1, 0, 0, 0);
        }
        if (P.na && i < P.nloc) {
            const LAS float* bl = biasL + (P.head * 15 + (P.relr0 + i)) * 31;
#pragma unroll
            for (int r = 0; r < 16; ++r) {
                const int kv0 = crow(r, hi), kv1 = kv0 + 32;
                const bool ok0 = (unsigned)(kv0 - cs) < 16u, ok1 = (unsigned)(kv1 - cs) < 16u;
                const int i0 = kv0 - qg + 15, i1 = kv1 - qg + 15;
                const float b0 = bl[i0 < 0 ? 0 : (i0 > 30 ? 30 : i0)], b1 = bl[i1 < 0 ? 0 : (i1 > 30 ? 30 : i1)];
                p0[r] = ok0 ? p0[r] + b0 : -INFINITY; p1[r] = ok1 ? p1[r] + b1 : -INFINITY;
            }
        }
        float mx = fmaxf(fmaxf(p0[0], p0[1]), p1[0]);
#pragma unroll
        for (int r = 2; r < 16; r += 2) mx = fmaxf(fmaxf(mx, p0[r]), p0[r + 1]);
#pragma unroll
        for (int r = 1; r < 15; r += 2) mx = fmaxf(fmaxf(mx, p1[r]), p1[r + 1]);
        mx = fmaxf(mx, p1[15]);
        mx = fmaxf(mx, shfl_xor_l(mx, 32, lane));
        if (__any((mx - m) * sc > 6.f)) {
            const float mn = fmaxf(m, mx), alpha = __builtin_amdgcn_exp2f((m - mn) * sc); m = mn; lsum *= alpha;
#pragma unroll
            for (int r = 0; r < 16; ++r) { o0[r] *= alpha; o1[r] *= alpha; }
        }
        const float nm = -m * sc;
        float ps = 0.f;
#pragma unroll
        for (int r = 0; r < 16; ++r) { p0[r] = __builtin_amdgcn_exp2f(fmaf(p0[r], sc, nm)); p1[r] = __builtin_amdgcn_exp2f(fmaf(p1[r], sc, nm)); ps += p0[r] + p1[r]; }
        lsum += ps;
        bf16x8 pf[4];
#pragma unroll
        for (int s = 0; s < 4; ++s) {
            v4u w;
            if (s < 2) { w.x = pk2(p0[8 * s], p0[8 * s + 1]); w.y = pk2(p0[8 * s + 2], p0[8 * s + 3]); w.z = pk2(p0[8 * s + 4], p0[8 * s + 5]); w.w = pk2(p0[8 * s + 6], p0[8 * s + 7]); }
            else { const int q = s - 2; w.x = pk2(p1[8 * q], p1[8 * q + 1]); w.y = pk2(p1[8 * q + 2], p1[8 * q + 3]); w.z = pk2(p1[8 * q + 4], p1[8 * q + 5]); w.w = pk2(p1[8 * q + 6], p1[8 * q + 7]); }
            pf[s] = __builtin_bit_cast(bf16x8, w);
        }
#pragma unroll
        for (int s = 0; s < 4; ++s) {
            const int kvb = 32 * (s >> 1) + 16 * (s & 1) + 4 * hi;
            {   const LAS unsigned char* va = vb + (r32 * 68 + kvb) * 2;
                const s16x4 lo = *(const LAS s16x4*)va, hh = *(const LAS s16x4*)(va + 16);
                const bf16x8 af = {lo[0], lo[1], lo[2], lo[3], hh[0], hh[1], hh[2], hh[3]};
                o0 = __builtin_amdgcn_mfma_f32_32x32x16_bf16(af, pf[s], o0, 0, 0, 0); }
            {   const LAS unsigned char* va = vb + ((32 + r32) * 68 + kvb) * 2;
                const s16x4 lo = *(const LAS s16x4*)va, hh = *(const LAS s16x4*)(va + 16);
                const bf16x8 af = {lo[0], lo[1], lo[2], lo[3], hh[0], hh[1], hh[2], hh[3]};
                o1 = __builtin_amdgcn_mfma_f32_32x32x16_bf16(af, pf[s], o1, 0, 0, 0); }
        }
        };
    if (NH == 1) {
        __syncthreads();
        lstore(0);
        if (nt > 1) gload(1);
        __syncthreads();
        for (int i = 0; i < nt; ++i) {
            if (i + 1 < nt) { lstore(((i + 1) & 1) * 18432); if (i + 2 < nt) gload(i + 2); }
            compute(i, (i & 1) * 18432);
            __syncthreads();
        }
    } else {
        for (int i = 0; i < nt; ++i) {
            __syncthreads();
            lstore(0);
            __syncthreads();
            if (i + 1 < nt) gload(i + 1);
            compute(i, 0);
        }
    }
    lsum += shfl_xor_l(lsum, 32, lane);
    const float inv = 1.f / lsum;
    bf16* op = P.O + (size_t)(P.qtok0 + r32) * P.ostride + P.ocol;
#pragma unroll
    for (int rg = 0; rg < 4; ++rg) {
        v2u w0, w1;
        w0.x = pk2(o0[4 * rg] * inv, o0[4 * rg + 1] * inv); w0.y = pk2(o0[4 * rg + 2] * inv, o0[4 * rg + 3] * inv);
        w1.x = pk2(o1[4 * rg] * inv, o1[4 * rg + 1] * inv); w1.y = pk2(o1[4 * rg + 2] * inv, o1[4 * rg + 3] * inv);
        *(v2u*)(op + 8 * rg + 4 * hi) = w0; *(v2u*)(op + 32 + 8 * rg + 4 * hi) = w1;
    }
}
__device__ __forceinline__ int s5_tokrow(int s, int dir, int b) {
    if (s < 256) return MLAT + b * 256 + (dir ? 255 - s : s);
    const int t = s - 256; return b * 2048 + (dir ? 2047 - t : t);
}
__device__ __forceinline__ void s5_unit(LAS unsigned char* lds, int layer, int b, int g) {
    CArgs& a = kargs();
    int tid_ = threadIdx.x; asm volatile("" : "+v"(tid_));
    const int tid = tid_, lane = tid & 63, wid = tid >> 6, r32 = lane & 31, hi = lane >> 5;
    LAS float* BuL = (LAS float*)(lds + wid * 17920);
    LAS bf16* HL = (LAS bf16*)(lds + wid * 17920);
    LAS v4u* uL = (LAS v4u*)(lds + wid * 17920 + 8704);
    const bf16* Z = (const bf16*)(a.ws + WS_Z); float* Y0 = (float*)(a.ws + WS_Y0); float* Y1 = (float*)(a.ws + WS_Y1);
    for (int dir = 0; dir < 2; ++dir) {
        const int idx = (layer * 2 + dir) * 16 + g;
        const float dt = expf(a.in[I_LDT][idx]);
        float ar, ai;
        { const float lr = fminf(a.in[I_AR][idx * 64 + lane], -1e-4f), li = a.in[I_AI][idx * 64 + lane]; const float er = expf(lr * dt); float sn, cs; sincosf(li * dt, &sn, &cs); ar = er * cs; ai = er * sn; }
        float pr = ar, pi = ai;
        float p32r, p32i;
#pragma unroll
        for (int k = 0; k < 5; ++k) { const float tr = pr * pr - pi * pi, ti = 2.f * pr * pi; pr = tr; pi = ti; }
        p32r = pr; p32i = pi;
#pragma unroll
        for (int k = 0; k < 3; ++k) { const float tr = pr * pr - pi * pi, ti = 2.f * pr * pi; pr = tr; pi = ti; }
        { const float tr = pr * p32r - pi * p32i, ti = pr * p32i + pi * p32r; pr = tr; pi = ti; }
        bf16x8 bfr[4];
#pragma unroll
        for (int pp = 0; pp < 2; ++pp) {
            const int p2 = 32 * pp + r32;
            const float lr = fminf(a.in[I_AR][idx * 64 + p2], -1e-4f), li = a.in[I_AI][idx * 64 + p2]; const float er = expf(lr * dt); float sn, cs; sincosf(li * dt, &sn, &cs);
            const float xr = er * cs - 1.f, xi = er * sn, den = 1.f / (lr * lr + li * li);
            const float cr = (xr * lr + xi * li) * den, ci = (xi * lr - xr * li) * den;
            const float* br = a.in[I_BR] + ((size_t)idx * 64 + p2) * 16 + 8 * hi; const float* bi = a.in[I_BI] + ((size_t)idx * 64 + p2) * 16 + 8 * hi;
            float re[8], im[8];
#pragma unroll
            for (int j = 0; j < 8; ++j) { const float x = br[j], y = bi[j]; re[j] = cr * x - ci * y; im[j] = cr * y + ci * x; }
            v4u w; w.x = pk2(re[0], re[1]); w.y = pk2(re[2], re[3]); w.z = pk2(re[4], re[5]); w.w = pk2(re[6], re[7]); bfr[pp] = __builtin_bit_cast(bf16x8, w);
            w.x = pk2(im[0], im[1]); w.y = pk2(im[2], im[3]); w.z = pk2(im[4], im[5]); w.w = pk2(im[6], im[7]); bfr[2 + pp] = __builtin_bit_cast(bf16x8, w);
        }
        bf16x8 cfr[8];
        const float cmsk = r32 < 16 ? 1.f : 0.f;
#pragma unroll
        for (int ks = 0; ks < 8; ++ks) {
            const size_t co = ((size_t)idx * 16 + (r32 & 15)) * 64 + 8 * ks + 4 * hi;
            const f32x4 cr4 = *(const f32x4*)(a.in[I_CR] + co), ci4 = *(const f32x4*)(a.in[I_CI] + co);
            v4u w; w.x = pk2(cr4[0] * cmsk, -ci4[0] * cmsk); w.y = pk2(cr4[1] * cmsk, -ci4[1] * cmsk); w.z = pk2(cr4[2] * cmsk, -ci4[2] * cmsk); w.w = pk2(cr4[3] * cmsk, -ci4[3] * cmsk);
            cfr[ks] = __builtin_bit_cast(bf16x8, w);
        }
        float hr = 0.f, him = 0.f;
        float* Yd = dir == 0 ? Y0 : Y1;
        {
            const bf16* ub = Z + OFF_S5 + 16 * g + 8 * hi;
            v4u ur[9];
#pragma unroll
            for (int ch = 0; ch < 9; ++ch) ur[ch] = *(const v4u*)(ub + (size_t)s5_tokrow(wid * 288 + ch * 32 + r32, dir, b) * INW);
#pragma unroll
            for (int ch = 0; ch < 9; ++ch) uL[ch * 64 + lane] = ur[ch];
            asm volatile("s_waitcnt lgkmcnt(0)" ::: "memory");
        }
        for (int pass = 0; pass < 2; ++pass) {
            for (int ch = 0; ch < 9; ++ch) {
                const int s0 = wid * 288 + ch * 32;
                bf16x8 ucur = __builtin_bit_cast(bf16x8, uL[ch * 64 + lane]);
                asm volatile("s_waitcnt lgkmcnt(0)" : "+v"(ucur) :: "memory");
                float bur[32], bui[32];
#pragma unroll
                for (int jb = 0; jb < 2; ++jb) {
                    f32x16 d = {}; d = __builtin_amdgcn_mfma_f32_32x32x16_bf16(ucur, bfr[jb], d, 0, 0, 0);
#pragma unroll
                    for (int r = 0; r < 16; ++r) BuL[crow(r, hi) * 66 + 32 * jb + r32] = d[r];
                }
                asm volatile("s_waitcnt lgkmcnt(0)" : "+v"(ucur) :: "memory");
#pragma unroll
                for (int t = 0; t < 32; ++t) bur[t] = BuL[t * 66 + lane];
                asm volatile("s_waitcnt lgkmcnt(0)" : "+v"(ucur) :: "memory");
#pragma unroll
                for (int jb = 0; jb < 2; ++jb) {
                    f32x16 d = {}; d = __builtin_amdgcn_mfma_f32_32x32x16_bf16(ucur, bfr[2 + jb], d, 0, 0, 0);
#pragma unroll
                    for (int r = 0; r < 16; ++r) BuL[crow(r, hi) * 66 + 32 * jb + r32] = d[r];
                }
                asm volatile("s_waitcnt lgkmcnt(0)" ::: "memory");
#pragma unroll
                for (int t = 0; t < 32; ++t) bui[t] = BuL[t * 66 + lane];
                asm volatile("s_waitcnt lgkmcnt(0)" ::: "memory");
                if (pass == 0) {
#pragma unroll
                    for (int t = 0; t < 32; ++t) { const float nr = ar * hr - ai * him + bur[t], ni = ar * him + ai * hr + bui[t]; hr = nr; him = ni; }
                } else {
#pragma unroll
                    for (int t = 0; t < 32; ++t) { const float nr = ar * hr - ai * him + bur[t], ni = ar * him + ai * hr + bui[t]; hr = nr; him = ni;
                        ((LAS unsigned*)HL)[t * 68 + lane] = pk2(hr, him); }
                    asm volatile("s_waitcnt lgkmcnt(0)" ::: "memory");
                    f32x16 y = {};
#pragma unroll
                    for (int ks = 0; ks < 8; ++ks) { const bf16x8 af = *(const LAS bf16x8*)((const LAS unsigned char*)HL + (r32 * 136 + 16 * ks + 8 * hi) * 2);
                        y = __builtin_amdgcn_mfma_f32_32x32x16_bf16(cfr[ks], af, y, 0, 0, 0); }
                    asm volatile("s_waitcnt lgkmcnt(0)" ::: "memory");
                    if (s0 >= 256 || layer == 0) {
                        float* yp = Yd + (size_t)s5_tokrow(s0 + r32, dir, b) * 256 + 16 * g + 4 * hi;
                        *(f32x4*)yp = (f32x4){y[0], y[1], y[2], y[3]}; *(f32x4*)(yp + 8) = (f32x4){y[4], y[5], y[6], y[7]};
                    }
                }
            }
            if (pass == 0) {
                BuL[lane * 2] = hr; BuL[lane * 2 + 1] = him;
                __syncthreads();
                hr = 0.f; him = 0.f;
                for (int v = 0; v < wid; ++v) { const LAS float* cv = (const LAS float*)(lds + v * 17920); const float cr = cv[lane * 2], ci = cv[lane * 2 + 1]; const float nr = pr * hr - pi * him + cr, ni = pr * him + pi * hr + ci; hr = nr; him = ni; }
                __syncthreads();
            }
        }

    }
}

__device__ __forceinline__ void na_phase(LAS unsigned char* lds, int l) {
    CArgs& a = kargs();
    int tid_ = threadIdx.x; asm volatile("" : "+v"(tid_));
    const int tid = tid_, wid = __builtin_amdgcn_readfirstlane(tid >> 6), G = o_grid(), bid = o_bid();
    bf16* Zb = (bf16*)(a.ws + WS_Z); bf16* CAT = (bf16*)(a.ws + WS_CAT);
    LAS float* biasL = (LAS float*)(lds + 73728);
    for (int i = tid; i < 4 * 15 * 31; i += 512) biasL[i] = 8.f * a.in[I_NABIAS][l * 4 * 15 * 31 + i];
    for (int u = bid; u < 512; u += G) {
        const int b = u >> 5, head = (u >> 3) & 3, rg = u & 7; const int r = 4 * rg + (wid >> 1);
        const int lo = 4 * rg - 4 < 0 ? 0 : (4 * rg - 4 > 24 ? 24 : 4 * rg - 4); const int hi3 = 4 * rg - 1 < 0 ? 0 : (4 * rg - 1 > 24 ? 24 : 4 * rg - 1);
        const int rs = r - 4 < 0 ? 0 : (r - 4 > 24 ? 24 : r - 4);
        AttnP P{Zb, CAT, DM, b * 2048 + r * 64 + (wid & 1) * 32, OFF_NQ + head * 64, 512 + head * 64, OFF_NK + head * 64, OFF_NV + head * 64, b * 2048 + lo * 64, hi3 + 8 - lo, MLAT + b * 256, 4, 1, (wid & 1) * 32, lo - r + 7, head, rs - lo, rs - lo + 8};
        attn_unit<1>(lds, P, biasL);
    }
    if (l == 0) for (int u = bid; u < 64; u += G) {
        const int b = u >> 2, head = u & 3;
        AttnP P{Zb, CAT, DM, MLAT + b * 256 + wid * 32, OFF_NQ + head * 64, 512 + head * 64, OFF_NK + head * 64, OFF_NV + head * 64, 0, 0, MLAT + b * 256, 4, 0, 0, 0, head, 0, 0};
        attn_unit<1>(lds, P, biasL);
    }
}
__device__ __forceinline__ void gqa_phase(LAS unsigned char* lds, int l) {
    CArgs& a = kargs();
    int tid_ = threadIdx.x; asm volatile("" : "+v"(tid_));
    const int tid = tid_, wid = __builtin_amdgcn_readfirstlane(tid >> 6), G = o_grid(), bid = o_bid();
    bf16* Zb = (bf16*)(a.ws + WS_Z); bf16* CAT = (bf16*)(a.ws + WS_CAT);
    const bool bal = (G == 256); const int nmine = bal ? (bid < 128 ? 3 : 1) : (511 - bid) / G + 1;
    for (int iu = 0; iu < nmine; ++iu) {
        const int u = bal ? (bid < 128 ? bid + 128 * iu : 256 + bid) : bid + iu * G;
        const int b = u >> 5, kvh = (u >> 4) & 1, qb = u & 15; const int head = 2 * kvh + (wid >> 2);
        AttnP P{Zb, CAT, DM, b * 2048 + qb * 128 + (wid & 3) * 32, OFF_AQ + head * 64, head * 64, OFF_AK + kvh * 64, OFF_AV + kvh * 64, b * 2048, 32, MLAT + b * 256, 4, 0, 0, 0, head, 0, 0};
        attn_unit<1>(lds, P, nullptr);
    }
    if (l == 0) for (int u = bid; u < 64; u += G) {
        const int b = u >> 2, kvh = (u >> 1) & 1, qb = u & 1; const int head = 2 * kvh + (wid >> 2);
        AttnP P{Zb, CAT, DM, MLAT + b * 256 + qb * 128 + (wid & 3) * 32, OFF_AQ + head * 64, head * 64, OFF_AK + kvh * 64, OFF_AV + kvh * 64, 0, 0, MLAT + b * 256, 4, 0, 0, 0, head, 0, 0};
        attn_unit<1>(lds, P, nullptr);
    }
}

#define XB_TMO      128
#define XB_XCNT(j)  (256  + 64 * (j))
#define XB_XSUB(j)  (1280 + 64 * (j))
#define XB_XGEN(j)  (2304 + 64 * (j))
#define XB_TOP      3328
#define XB_TOPGEN   3392
#define XCD_BAR_WORDS 3456
#define XB_SPIN_CAP (1u << 18)

__device__ __forceinline__ unsigned xb_ld(unsigned* p)              { return __hip_atomic_load(p, __ATOMIC_RELAXED, __HIP_MEMORY_SCOPE_AGENT); }
__device__ __forceinline__ unsigned xb_add(unsigned* p, unsigned v) { return __hip_atomic_fetch_add(p, v, __ATOMIC_RELAXED, __HIP_MEMORY_SCOPE_AGENT); }
__device__ __forceinline__ unsigned xb_xcc_id() { return (unsigned)__builtin_amdgcn_s_getreg((3 << 11) | 20) & 0xFu; }
#define XB_SPIN(cond, bar) do { unsigned _sp = 0; while (cond) { __builtin_amdgcn_s_sleep(1); \
    if ((++_sp & 255u) == 0u) { if (xb_ld(&(bar)[XB_TMO])) break; if (_sp > XB_SPIN_CAP) { atomicAdd(&(bar)[XB_TMO], 1u); break; } } } } while (0)
struct XcdBarrier { unsigned* bar; unsigned x; volatile LAS unsigned* st; };
__device__ __forceinline__ void xcd_barrier_complete(unsigned* bar, unsigned x, unsigned& nloc, unsigned& nx) {
    const unsigned G = gridDim.x * gridDim.y * gridDim.z;
    unsigned sum, cnt, mine, sp = 0u;
    for (;;) {
        sum = 0u; cnt = 0u; mine = 0u;
#pragma unroll
        for (unsigned j = 0; j < 16; ++j) { const unsigned c = xb_ld(&bar[XB_XCNT(j)]); sum += c; cnt += (c > 0u) ? 1u : 0u; mine = (j == x) ? c : mine; }
        if (sum == G) break;
        __builtin_amdgcn_s_sleep(1);
        if ((++sp & 255u) == 0u) { if (xb_ld(&bar[XB_TMO])) break; if (sp > XB_SPIN_CAP) { atomicAdd(&bar[XB_TMO], 1u); break; } }
    }
    nloc = mine > 0u ? mine : 1u; nx = cnt > 0u ? cnt : 1u;
}

__device__ __forceinline__ void xcd_barrier(const XcdBarrier& b) {
    asm volatile("s_waitcnt vmcnt(0)" ::: "memory");
    __syncthreads();
    if (threadIdx.x == 0) {
        unsigned* bar = b.bar;
        __builtin_amdgcn_s_waitcnt(0);
        unsigned nloc = b.st[0], nx = b.st[1];
        if (nloc == 0u) { xcd_barrier_complete(bar, b.x, nloc, nx); b.st[0] = nloc; b.st[1] = nx; }
        const unsigned old = xb_add(&bar[XB_XSUB(b.x)], 1u);
        const unsigned gen = old / nloc;
        if (old + 1u == (gen + 1u) * nloc) {
            __builtin_amdgcn_fence(__ATOMIC_RELEASE, "agent");
            asm volatile("s_waitcnt vmcnt(0)" ::: "memory");
            const unsigned og = xb_add(&bar[XB_TOP], 1u);
            const unsigned tg = og / nx;
            if (og + 1u == (tg + 1u) * nx) xb_add(&bar[XB_TOPGEN], 1u);
            else XB_SPIN(xb_ld(&bar[XB_TOPGEN]) == tg, bar);
            __builtin_amdgcn_fence(__ATOMIC_ACQUIRE, "agent");
            xb_add(&bar[XB_XGEN(b.x)], 1u);
            asm volatile("s_waitcnt vmcnt(0)" ::: "memory");
        } else {
            XB_SPIN(xb_ld(&bar[XB_XGEN(b.x)]) == gen, bar);
            __builtin_amdgcn_fence(__ATOMIC_ACQUIRE, "agent");
            asm volatile("s_waitcnt vmcnt(0)" ::: "memory");
        }
    }
    __syncthreads();
}

template <class F>
__device__ __forceinline__ void run_gemm(LAS unsigned char* lds, const bf16* A, int lda, const bf16* Bt, int ldb, int M, int N, int K, const F& f, int c, long tsB = 0, int ksplit = 1 << 30, long kjumpB = 0) {
    pg8::Gemm g{A, Bt, M, N, K, lda, ldb, tsB ? tsB : (long)512 * ldb, ksplit, kjumpB}; pg8::StaticOrder S; S.init(M, N, o_grid(), c); Epi8<F> E{f};
    pg8::gemm_phase<Epi8<F>, pg8::StaticOrder, true, true>(lds, g, S, E);
}
#define WSP(off) ((bf16*)(ws + (off)))
__device__ __forceinline__ void ph_store_gemm(LAS unsigned char* lds, int l, int kind) {
    unsigned char* ws = kargs().ws; unsigned char* wb = ws + WS_W + (size_t)l * W_LAYER;
    const int Mr = l == 0 ? MT : MLAT;
    const bf16* A; const bf16* Bt; bf16* O; int lda, ldb, M, N, K, ldc, act;
    if (kind == 0)      { A = WSP(WS_XN);   lda = DM;  Bt = (const bf16*)(wb + WO_IN);  ldb = DM;  M = MT; N = INW; K = DM;  O = WSP(WS_Z);    ldc = INW; act = 0; }
    else if (kind == 1) { A = WSP(WS_CAT);  lda = DM;  Bt = (const bf16*)(wb + WO_OUT); ldb = DM;  M = Mr; N = DM;  K = DM;  O = WSP(WS_Y);    ldc = DM;  act = 0; }
    else if (kind == 2) { A = WSP(WS_XN);   lda = DM;  Bt = (const bf16*)(wb + WO_1);   ldb = DM;  M = Mr; N = DFF; K = DM;  O = WSP(WS_HMID); ldc = DFF; act = 1; }
    else if (kind == 3) { A = WSP(WS_HMID); lda = DFF; Bt = (const bf16*)(wb + WO_2);   ldb = DFF; M = Mr; N = DM;  K = DFF; O = WSP(WS_XN);   ldc = DM;  act = 0; }
    else                { A = (const bf16*)(wb + WO_CS); lda = 256; Bt = WSP(WS_Z) + OFF_FN; ldb = INW; M = 512; N = MT; K = 256; O = WSP(WS_C1); ldc = MT; act = 0; }
    run_gemm(lds, A, lda, Bt, ldb, M, N, K, FStore{O, ldc, act}, o_bid());
}
__device__ __forceinline__ void ph_d2(LAS unsigned char* lds, int l) { CArgs& a = kargs(); unsigned char* ws = a.ws;
    for (int j = 0; j < (l == 0 ? 2 : 1); ++j) {
        if (j == 0) run_gemm(lds, WSP(WS_DFT), 4096, WSP(WS_C1), MT, 2048, 4096, 4096, FD2{WSP(WS_CAT), a.in[I_BFNET] + l * 256, 0, 2048}, o_grid() - 1 - o_bid(), 2048 * 2, 32, ((long)256 * MT - 2048) * 2);
        else run_gemm(lds, WSP(WS_DFTC), 512, WSP(WS_C1) + MLAT, MT, 256, 4096, 512, FD2{WSP(WS_CAT), a.in[I_BFNET] + l * 256, MLAT, 256}, o_bid(), 256 * 2, 4, ((long)256 * MT - 256) * 2);
    } }
__device__ __forceinline__ void ph_glu(LAS unsigned char* lds, int l) { CArgs& a = kargs(); unsigned char* ws = a.ws; unsigned char* wb = ws + WS_W + (size_t)l * W_LAYER;
    const int Mr = l == 0 ? MT : MLAT;
    {
        int tid_ = threadIdx.x; asm volatile("" : "+v"(tid_));
        pg8::StaticOrder S; S.init(Mr, 256, o_grid(), o_bid()); pg8::Unit u;
        const bf16* Z = WSP(WS_Z); const float* Y0 = (const float*)(ws + WS_Y0); const float* Y1 = (const float*)(ws + WS_Y1); bf16* T = WSP(WS_T);
        const int c8 = (tid_ & 31) * 8;
        float dk[8];
#pragma unroll
        for (int e = 0; e < 8; ++e) dk[e] = a.in[I_S5D][l * 256 + c8 + e];
        for (int i = 0; S.next(i, u); ++i)
            for (int rr = tid_ >> 5; rr < 256; rr += 16) {
                const size_t row = (size_t)u.pm * 256 + rr;
                const v4u uz = *(const v4u*)(Z + row * INW + OFF_S5 + c8);
                const f32x4 a0 = *(const f32x4*)(Y0 + row * 256 + c8), a1 = *(const f32x4*)(Y0 + row * 256 + c8 + 4), b0 = *(const f32x4*)(Y1 + row * 256 + c8), b1 = *(const f32x4*)(Y1 + row * 256 + c8 + 4);
                const float uv[8] = {bflo(uz.x), bfhi(uz.x), bflo(uz.y), bfhi(uz.y), bflo(uz.z), bfhi(uz.z), bflo(uz.w), bfhi(uz.w)};
                float o[8];
#pragma unroll
                for (int e = 0; e < 8; ++e) { const float v = (e < 4 ? a0[e] + b0[e] : a1[e - 4] + b1[e - 4]) + dk[e] * uv[e];
                    const float uu = 0.7978845608028654f * (v + 0.044715f * v * v * v); o[e] = v / (1.f + __expf(-2.f * uu)); }
                v4u w; w.x = pk2(o[0], o[1]); w.y = pk2(o[2], o[3]); w.z = pk2(o[4], o[5]); w.w = pk2(o[6], o[7]);
                *(v4u*)(T + row * 256 + c8) = w;
            }
        __threadfence(); __syncthreads();
    }
    int K = 256, ld = 256; asm volatile("" : "+s"(K), "+s"(ld));
    run_gemm(lds, WSP(WS_T), ld, (const bf16*)(wb + WO_GLU), ld, Mr, 256, K, FGlu{WSP(WS_CAT), WSP(WS_T)}, o_bid()); }

__global__ void __launch_bounds__(512, 2) fwd_megakernel(Args a_unused) {
    extern __shared__ __attribute__((aligned(16))) unsigned char lds_raw[];
    LAS unsigned char* lds = (LAS unsigned char*)lds_raw;
    cg::grid_group grid = cg::this_grid();
#ifdef PROBE
    if (blockIdx.x == 0 && threadIdx.x == 0) { unsigned char* pw = kargs().ws + WS_PROBE; for (int i = 0; i < 32; ++i) ((float*)pw)[i] = 0.f; *(unsigned long long*)(pw + 256) = __builtin_amdgcn_s_memrealtime(); }
#endif
    {
        unsigned* bar = (unsigned*)(kargs().ws + WS_BAR);
        if (blockIdx.x == 0) for (int i = threadIdx.x; i < XCD_BAR_WORDS; i += 512) bar[i] = 0u;
        if (threadIdx.x < 2) ((volatile LAS unsigned*)(lds + LDS_BARST))[threadIdx.x] = 0u;
    }
    for (int step = 0; step < 20; ++step) {
        const int l = step < 2 ? 0 : (step - 2) / 9, k = step < 2 ? step - 2 : (step - 2) - 9 * l;
        int gk = -1;
        if (k == 0) gk = 0; else if (k == 2) gk = 4; else if (k == 4) gk = 1; else if (k == 6) gk = 2; else if (k == 7) gk = 3;
        int lbl = k == -2 ? 0 : k == -1 ? 1 : k == 0 ? 2 : k == 1 ? 5 : k == 2 ? 6 : k == 3 ? 9 : k == 4 ? 10 : k == 5 ? 11 : k == 6 ? 12 : k == 7 ? 13 : 14; (void)lbl;
#ifdef DBL_GEMM
        if (gk >= 0) { ph_store_gemm(lds, l, gk); __syncthreads(); }
#endif
#ifdef DBL_ROWS
        if (k == -1) prep_rows0(); if (k == 5 && l == 0) row_update<0>();
#endif
        if (gk >= 0) ph_store_gemm(lds, l, gk);
        else if (k == -2) prologue(lds);
        else if (k == -1) prep_rows0();
        else if (k == 1) {
            qk_prep(l);
            __syncthreads(); STAMP(3);
            na_phase(lds, l);
#ifdef DBL_NA
            __syncthreads(); na_phase(lds, l);
#endif
            __syncthreads(); STAMP(4);
            for (int u = o_bid(); u < 256; u += o_grid()) s5_unit(lds, l, u >> 4, u & 15);
#ifdef DBL_S5
            __syncthreads(); for (int u = o_bid(); u < 256; u += o_grid()) s5_unit(lds, l, u >> 4, u & 15);
#endif
        } else if (k == 3) {
            gqa_phase(lds, l);
#ifdef DBL_GQA
            __syncthreads(); gqa_phase(lds, l);
#endif
            __syncthreads(); STAMP(7);
            ph_d2(lds, l); STAMP(8);
            ph_glu(lds, l);
        } else if (k == 5) { if (l == 0) row_update<0>(); else row_update<2>(); }
        else { if (l == 0) row_update<1>(); else row_update<3>(); }
        if (step == 0) {
            grid.sync();
            if (threadIdx.x == 0) (void)xb_add(&((unsigned*)(kargs().ws + WS_BAR))[XB_XCNT(xb_xcc_id())], 1u);
        } else if (k == 1) { __syncthreads(); }
        else if (step != 19) {
            XcdBarrier xb; xb.bar = (unsigned*)(kargs().ws + WS_BAR); xb.x = xb_xcc_id(); xb.st = (volatile LAS unsigned*)(lds + LDS_BARST);
            xcd_barrier(xb);
        }
        STAMP(lbl);
    }
}

extern "C" void kernel_launch(void* const* d_in, const int* in_sizes, int n_in, void* d_out, int out_size, void* d_ws, size_t ws_size, hipStream_t stream) {
    static int grid = 0;
    if (grid == 0) {
        if (n_in != 28 || ws_size < WS_END) { fprintf(stderr, "kernel_launch: unexpected n_in %d / ws_size %zu (need %zu)\n", n_in, ws_size, (size_t)WS_END); grid = -1; return; }
        int dev = 0, cus = 0, per_cu = 0;
        hipGetDevice(&dev); hipDeviceGetAttribute(&cus, hipDeviceAttributeMultiprocessorCount, dev);
        if (hipFuncSetAttribute((const void*)fwd_megakernel, hipFuncAttributeMaxDynamicSharedMemorySize, LDS_BYTES) != hipSuccess) { fprintf(stderr, "kernel_launch: hipFuncSetAttribute failed\n"); }
        if (hipOccupancyMaxActiveBlocksPerMultiprocessor(&per_cu, (const void*)fwd_megakernel, 512, LDS_BYTES) != hipSuccess || per_cu < 1) { fprintf(stderr, "kernel_launch: occupancy query says %d\n", per_cu); per_cu = 1; }
        (void)hipGetLastError();
        grid = cus * (per_cu > 1 ? 1 : per_cu);
        if (grid <= 0) grid = 256;
    }
    if (grid < 0) return;
    Args a{};
    for (int i = 0; i < 28; ++i) a.in[i] = (const float*)d_in[i];
    a.out = (float*)d_out; a.ws = (unsigned char*)d_ws;
    void* args[] = {&a};
    hipError_t e = hipLaunchCooperativeKernel((const void*)fwd_megakernel, dim3(grid), dim3(512), args, LDS_BYTES, stream);
    if (e != hipSuccess) fprintf(stderr, "cooperative launch failed: %s (grid %d)\n", hipGetErrorString(e), grid);
}
```

```cpp
#include <hip/hip_runtime.h>
#include <hip/hip_cooperative_groups.h>
#include <cstdio>
#include <cstdint>
namespace cg = cooperative_groups;
namespace pg8 {
#define PG8_LAS __attribute__((address_space(3)))
typedef unsigned short bf16_t;
typedef short bf16x8 __attribute__((ext_vector_type(8)));
typedef float f32x4 __attribute__((ext_vector_type(4)));
typedef unsigned u32x4 __attribute__((ext_vector_type(4)));
constexpr int BM = 256, BK = 64, HALF = 128, HTB = HALF * BK * 2  , STAGE_BYTES = 8 * HTB, NXCD = 8, WGM = 8;

__host__ __device__ __forceinline__ int lds_byte(int r, int c) { const int st = (r >> 4) * 2 + (c >> 5), rr = r & 15, cc = c & 31, ob = rr * 64 + cc * 2; return st * 1024 + (ob ^ (((ob >> 9) & 1) << 5)); }
__host__ __device__ __forceinline__ void stage_rc(int b, int& R, int& C) { const int st = b / 1024, sb = b % 1024, swz = sb ^ (((sb >> 9) & 1) << 5); R = (st >> 1) * 16 + swz / 64; C = (st & 1) * 32 + (swz % 64) / 2; }
__host__ __device__ __forceinline__ int perm32(int rho) { const int n = rho >> 4, i = rho & 15; return 8 * (i >> 2) + 4 * n + (i & 3); }

struct Unit { int pm, pn; };
struct Gemm { const bf16_t* A; const bf16_t* Bt; int M, N, K, lda, ldb; long tsB; int ksplit; long kjumpB; };

struct StaticOrder {
    int nM, nN, nwg, G, c;
    __host__ __device__ void init(int M, int N, int G_, int c_) { nM = M / BM; nN = N / BM; nwg = nM * nN; G = G_; c = c_; }
    __host__ __device__ bool next(int i, Unit& u) const {
        const long L = (long)i * G + c; if (L >= nwg) return false;
        int wgid = (int)L; { const int q = nwg / NXCD, r = nwg % NXCD, xcd = wgid % NXCD, off = wgid / NXCD; wgid = (xcd < r ? xcd * (q + 1) : r * (q + 1) + (xcd - r) * q) + off; }
        const int nig = WGM * nN, gid = wgid / nig, fm = gid * WGM, gsz = (nM - fm) < WGM ? (nM - fm) : WGM;
        u.pm = fm + ((wgid % nig) % gsz); u.pn = (wgid % nig) / gsz; return true;
    }
    __device__ __forceinline__ void a_ready(const Unit&) const {}
    __device__ __forceinline__ void done(const Unit&) const {}
};
__device__ __forceinline__ unsigned cvt_pk_bf16(float lo, float hi) { unsigned r; asm volatile("v_cvt_pk_bf16_f32 %0, %1, %2" : "=v"(r) : "v"(lo), "v"(hi)); return r; }
template <class Epi, class Sched, bool ALIGN_EPI = false, bool SP2 = false>
__device__ __forceinline__ void gemm_phase(PG8_LAS unsigned char* lds, const Gemm g, const Sched& S, const Epi& E) {
    int tid_ = threadIdx.x; asm volatile("" : "+v"(tid_));
    const int tid = tid_, wid = __builtin_amdgcn_readfirstlane(tid >> 6), lane = tid & 63, wr = wid >> 2, wc = wid & 3, fr = lane & 15, fq = lane >> 4;
    const int K = g.K, nt = K / BK;
    unsigned voffA[2], voffB[2];
#pragma unroll
    for (int i = 0; i < 2; ++i) { int R, C; stage_rc(tid * 16 + i * 8192, R, C); const int Rb = Epi::PERM ? ((R & ~31) + perm32(R & 31)) : R;
        voffA[i] = (unsigned)(R * g.lda + C) * 2u; voffB[i] = (unsigned)(Rb * g.ldb + C) * 2u; }
    const size_t kstep = (size_t)(BK * 2);
    const size_t hstepA = (size_t)HALF * g.lda * 2, hstepB = (size_t)HALF * g.ldb * 2;
    const size_t tstepA = 2 * hstepA, tstepB = (size_t)g.tsB;
    const unsigned ldsw = (unsigned)wid * 1024u;
    const int aoff = lds_byte(wr * 64 + fr, fq * 8), boff = lds_byte(wc * 32 + fr, fq * 8);
#define PG8_SA(b, h) (((b) * 2 + (h)) * HTB)
#define PG8_SB(b, h) ((4 + (b) * 2 + (h)) * HTB)
#define PG8_STAGE(bufoff, gbase, voff) do { _Pragma("unroll") for (int _i = 0; _i < 2; ++_i) \
        __builtin_amdgcn_global_load_lds((const unsigned*)((const char*)(gbase) + (voff)[_i]), (PG8_LAS unsigned*)(lds + (bufoff) + ldsw + _i * 8192), 16, 0, 0); } while (0)
#define PG8_LDA(dst, b, h) do { _Pragma("unroll") for (int m = 0; m < 4; ++m) _Pragma("unroll") for (int k = 0; k < 2; ++k) dst[m][k] = *(const PG8_LAS bf16x8*)(lds + PG8_SA(b, h) + aoff + m * 2048 + k * 1024); } while (0)
#define PG8_LDB(dst, b, h) do { _Pragma("unroll") for (int n = 0; n < 2; ++n) _Pragma("unroll") for (int k = 0; k < 2; ++k) dst[n][k] = *(const PG8_LAS bf16x8*)(lds + PG8_SB(b, h) + boff + n * 2048 + k * 1024); } while (0)
#define PG8_MMA(ai, bj, At, Bt) do { __builtin_amdgcn_s_setprio(1); _Pragma("unroll") for (int m = 0; m < 4; ++m) _Pragma("unroll") for (int n = 0; n < 2; ++n) _Pragma("unroll") for (int k = 0; k < 2; ++k) \
        acc[ai][bj][m][n] = __builtin_amdgcn_mfma_f32_16x16x32_bf16(Bt[n][k], At[m][k], acc[ai][bj][m][n], 0, 0, 0); __builtin_amdgcn_s_setprio(0); } while (0)
#define PG8_WAIT_V(n) asm volatile("s_waitcnt vmcnt(" #n ")" ::: "memory")
#define PG8_WAIT_L(n) asm volatile("s_waitcnt lgkmcnt(" #n ")" ::: "memory")
#define PG8_BAR __builtin_amdgcn_s_barrier()
#define PG8_SCHED __builtin_amdgcn_sched_barrier(0)
    Unit cur, nxt; int ui = 0;
    if (!S.next(0, cur)) return;
    f32x4 acc[2][2][4][2];
#pragma unroll
    for (int a = 0; a < 2; ++a)
#pragma unroll
        for (int b = 0; b < 2; ++b)
#pragma unroll
            for (int m = 0; m < 4; ++m)
#pragma unroll
                for (int n = 0; n < 2; ++n) acc[a][b][m][n] = (f32x4){0.f, 0.f, 0.f, 0.f};
    bf16x8 At[4][2], B0[2][2], B1[2][2];
    const char* cA = (const char*)g.A + (size_t)cur.pm * tstepA; const char* cB = (const char*)g.Bt + (size_t)cur.pn * tstepB;
    S.a_ready(cur);
    if constexpr (SP2) {
        PG8_STAGE(PG8_SB(0, 0), cB, voffB); PG8_STAGE(PG8_SB(0, 1), cB + hstepB, voffB); PG8_STAGE(PG8_SA(0, 0), cA, voffA); PG8_STAGE(PG8_SA(0, 1), cA + hstepA, voffA);
        if (wr == 1) PG8_BAR;
        PG8_WAIT_V(2); PG8_BAR;
        PG8_STAGE(PG8_SB(1, 0), cB + kstep, voffB); PG8_STAGE(PG8_SA(1, 0), cA + kstep, voffA); PG8_STAGE(PG8_SB(1, 1), cB + hstepB + kstep, voffB);
        PG8_WAIT_V(6); PG8_BAR;
    } else {
        PG8_STAGE(PG8_SB(0, 0), cB, voffB); PG8_STAGE(PG8_SA(0, 0), cA, voffA); PG8_STAGE(PG8_SB(0, 1), cB + hstepB, voffB); PG8_STAGE(PG8_SA(0, 1), cA + hstepA, voffA);
        if (wr == 1) PG8_BAR;
        PG8_WAIT_V(4); PG8_BAR;
        PG8_STAGE(PG8_SB(1, 0), cB + kstep, voffB); PG8_STAGE(PG8_SA(1, 0), cA + kstep, voffA); PG8_STAGE(PG8_SB(1, 1), cB + hstepB + kstep, voffB);
        PG8_WAIT_V(6); PG8_BAR;
    }
    for (;;) {
        const bool has_next = S.next(ui + 1, nxt);
        const char* nA = has_next ? (const char*)g.A + (size_t)nxt.pm * tstepA : cA; const char* nB = has_next ? (const char*)g.Bt + (size_t)nxt.pn * tstepB : cB;
        for (int t = 0; t < nt; t += 2) {
            const bool last = (t == nt - 2);
            const char* a1 = cA + (size_t)(t + 1) * kstep;
            const char* a2 = last ? nA : cA + (size_t)(t + 2) * kstep; const char* b2 = last ? nB : cB + (size_t)(t + 2) * kstep + ((t + 2) >= g.ksplit ? g.kjumpB : 0);
            const char* a3 = a2 + kstep; const char* b3 = b2 + kstep;
            if (last && has_next) S.a_ready(nxt);
            if constexpr (SP2) {
            PG8_LDB(B0, 0, 0); PG8_LDB(B1, 0, 1); PG8_SCHED; PG8_LDA(At, 0, 0); PG8_STAGE(PG8_SA(1, 1), a1 + hstepA, voffA);
            PG8_WAIT_V(8); PG8_WAIT_L(0); PG8_BAR; PG8_MMA(0, 0, At, B0); PG8_MMA(0, 1, At, B1); PG8_BAR; PG8_SCHED;
            PG8_LDA(At, 0, 1); PG8_STAGE(PG8_SB(0, 0), b2, voffB); PG8_STAGE(PG8_SB(0, 1), b2 + hstepB, voffB); PG8_STAGE(PG8_SA(0, 0), a2, voffA);
            PG8_WAIT_V(8); PG8_WAIT_L(0); PG8_BAR; PG8_MMA(1, 0, At, B0); PG8_MMA(1, 1, At, B1); PG8_BAR; PG8_SCHED;
            PG8_LDB(B0, 1, 0); PG8_LDB(B1, 1, 1); PG8_SCHED; PG8_LDA(At, 1, 0); PG8_STAGE(PG8_SA(0, 1), a2 + hstepA, voffA);
            PG8_WAIT_V(8); PG8_WAIT_L(0); PG8_BAR; PG8_MMA(0, 0, At, B0); PG8_MMA(0, 1, At, B1); PG8_BAR; PG8_SCHED;
            PG8_LDA(At, 1, 1); PG8_STAGE(PG8_SB(1, 0), b3, voffB); PG8_STAGE(PG8_SB(1, 1), b3 + hstepB, voffB); PG8_STAGE(PG8_SA(1, 0), a3, voffA);
            PG8_WAIT_V(8); PG8_WAIT_L(0); PG8_BAR; PG8_MMA(1, 0, At, B0); PG8_MMA(1, 1, At, B1); PG8_BAR; PG8_SCHED;
            } else {
            PG8_LDB(B0, 0, 0); PG8_SCHED; PG8_LDA(At, 0, 0); PG8_STAGE(PG8_SA(1, 1), a1 + hstepA, voffA);
            PG8_WAIT_L(8); PG8_BAR; PG8_WAIT_L(0); PG8_MMA(0, 0, At, B0); PG8_BAR; PG8_SCHED;
            PG8_LDB(B1, 0, 1); PG8_STAGE(PG8_SB(0, 0), b2, voffB);
            PG8_BAR; PG8_WAIT_L(0); PG8_MMA(0, 1, At, B1); PG8_BAR;
            PG8_LDA(At, 0, 1); PG8_STAGE(PG8_SA(0, 0), a2, voffA);
            PG8_BAR; PG8_WAIT_L(0); PG8_MMA(1, 0, At, B0); PG8_BAR; PG8_SCHED;
            PG8_STAGE(PG8_SB(0, 1), b2 + hstepB, voffB);
            PG8_WAIT_V(6); PG8_BAR; PG8_MMA(1, 1, At, B1); PG8_BAR;
            PG8_LDB(B0, 1, 0); PG8_SCHED; PG8_LDA(At, 1, 0); PG8_STAGE(PG8_SA(0, 1), a2 + hstepA, voffA);
            PG8_WAIT_L(8); PG8_BAR; PG8_WAIT_L(0); PG8_MMA(0, 0, At, B0); PG8_BAR; PG8_SCHED;
            PG8_LDB(B1, 1, 1); PG8_STAGE(PG8_SB(1, 0), b3, voffB);
            PG8_BAR; PG8_WAIT_L(0); PG8_MMA(0, 1, At, B1); PG8_BAR;
            PG8_LDA(At, 1, 1); PG8_STAGE(PG8_SA(1, 0), a3, voffA);
            PG8_BAR; PG8_WAIT_L(0); PG8_MMA(1, 0, At, B0); PG8_BAR; PG8_SCHED;
            PG8_STAGE(PG8_SB(1, 1), b3 + hstepB, voffB);
            PG8_WAIT_V(6); PG8_BAR; PG8_MMA(1, 1, At, B1); PG8_BAR;
            }
        }
        if constexpr (ALIGN_EPI) { if (wr == 0) PG8_BAR; }
        if constexpr (!Epi::AFTER_DRAIN) { E(acc, cur, wr, wc, fr, fq); S.done(cur); }
        if (!has_next) break;
#pragma unroll
        for (int a = 0; a < 2; ++a)
#pragma unroll
            for (int b = 0; b < 2; ++b)
#pragma unroll
                for (int m = 0; m < 4; ++m)
#pragma unroll
                    for (int n = 0; n < 2; ++n) acc[a][b][m][n] = (f32x4){0.f, 0.f, 0.f, 0.f};
        cur = nxt; cA = nA; cB = nB; ++ui;
        if constexpr (ALIGN_EPI) { if (wr == 1) PG8_BAR; }
    }
    PG8_WAIT_V(0);
    if constexpr (!ALIGN_EPI) { if (wr == 0) PG8_BAR; }
    PG8_BAR;
    if constexpr (Epi::AFTER_DRAIN) { E.fused(acc, cur, wr, wc, fr, fq, lds, wid, lane); S.done(cur); }
#undef PG8_SA
#undef PG8_SB
#undef PG8_STAGE
#undef PG8_LDA
#undef PG8_LDB
#undef PG8_MMA
#undef PG8_WAIT_V
#undef PG8_WAIT_L
#undef PG8_BAR
#undef PG8_SCHED
}
}
#define LAS __attribute__((address_space(3)))
typedef unsigned short bf16;
typedef unsigned v4u __attribute__((ext_vector_type(4)));
typedef unsigned v2u __attribute__((ext_vector_type(2)));
typedef float f32x4 __attribute__((ext_vector_type(4)));
typedef float f32x16 __attribute__((ext_vector_type(16)));
typedef short bf16x8 __attribute__((ext_vector_type(8)));
typedef short s16x4 __attribute__((ext_vector_type(4)));

constexpr int DM = 1024, NB = 16, SEQ = 2048, CTXL = 256, MLAT = NB * SEQ, MCTX = NB * CTXL, MT = MLAT + MCTX, INW = 1792, DFF = 4096;
constexpr int OFF_AQ = 0, OFF_AK = 256, OFF_AV = 384, OFF_S5 = 512, OFF_NQ = 768, OFF_NK = 1024, OFF_NV = 1280, OFF_FN = 1536;
constexpr float EPSN = 1e-6f;
constexpr float LOG2E = 1.4426950408889634f;
constexpr size_t MiB = 1u << 20;
constexpr size_t WS_MOD = 0;
constexpr size_t WS_ROPE = 1 * MiB;
constexpr size_t WS_W = 2 * MiB, W_LAYER = 22 * MiB;
constexpr size_t WO_IN = 0, WO_OUT = WO_IN + (size_t)INW * DM * 2, WO_1 = WO_OUT + (size_t)DM * DM * 2, WO_2 = WO_1 + (size_t)DFF * DM * 2,
                 WO_GLU = WO_2 + (size_t)DFF * DM * 2, WO_CS = WO_GLU + 256 * 256 * 2, WO_END = WO_CS + 512 * 256 * 2;
static_assert(WO_END <= W_LAYER, "weights");
constexpr size_t WS_DFT = 46 * MiB, WS_DFTC = 62 * MiB, WS_XC = 64 * MiB, WS_XN = 80 * MiB;
constexpr size_t WS_T = 116 * MiB, WS_C1 = 350 * MiB;
constexpr size_t WS_Z = 152 * MiB, WS_CAT = 278 * MiB, WS_Y = 350 * MiB, WS_HMID = 152 * MiB, WS_Y0 = 440 * MiB, WS_Y1 = 476 * MiB, WS_END = 512 * MiB;
constexpr int LDS_BYTES = 147456;

struct Args { const float* in[28]; float* out; unsigned char* ws; };
typedef __attribute__((address_space(4))) const Args CArgs;
__device__ __forceinline__ CArgs& kargs() { CArgs* p = (CArgs*)__builtin_amdgcn_kernarg_segment_ptr(); asm volatile("" : "+s"(p)); return *p; }
enum { I_X = 0, I_C, I_CTX, I_CCTX, I_WADA, I_BADA, I_GPREMIX, I_GPOSTMIX, I_GPREMLP, I_GPOSTMLP, I_WIN, I_GQ, I_GK, I_AR, I_AI, I_LDT, I_BR, I_BI, I_CR, I_CI,
       I_S5D, I_WGLU, I_NABIAS, I_WFNET, I_BFNET, I_WOUT, I_W1, I_W2 };

constexpr size_t WS_PROBE = 1 * MiB + 65536;
constexpr size_t WS_BAR = 1 * MiB + 131072;
constexpr int LDS_BARST = 147456 - 64;
#ifdef PROBE
#define STAMP(lbl) do { if (blockIdx.x == 0 && threadIdx.x == 0) { unsigned char* pw_ = kargs().ws + WS_PROBE; const unsigned long long now_ = __builtin_amdgcn_s_memrealtime(); \
    unsigned long long* tp_ = (unsigned long long*)(pw_ + 256); ((float*)pw_)[lbl] += (float)(now_ - *tp_); *tp_ = now_; } } while (0)
#else
#define STAMP(lbl) do {} while (0)
#endif
__device__ __forceinline__ unsigned f2bf(float f) { unsigned u = __builtin_bit_cast(unsigned, f); return (u + 0x7fffu + ((u >> 16) & 1u)) >> 16; }
typedef float f32x2_t __attribute__((ext_vector_type(2))); typedef __bf16 bf16x2_t __attribute__((ext_vector_type(2)));
__device__ __forceinline__ unsigned pk2(float lo, float hi) { const f32x2_t v = {lo, hi}; const bf16x2_t b = __builtin_convertvector(v, bf16x2_t); return __builtin_bit_cast(unsigned, b); }
__device__ __forceinline__ float bflo(unsigned w) { return __builtin_bit_cast(float, w << 16); }
__device__ __forceinline__ float bfhi(unsigned w) { return __builtin_bit_cast(float, w & 0xffff0000u); }
__device__ __forceinline__ float bf2f(bf16 h) { return __builtin_bit_cast(float, (unsigned)h << 16); }
__device__ __forceinline__ int o_bid() { int t = blockIdx.x; asm volatile("" : "+s"(t)); return t; }
__device__ __forceinline__ int o_grid() { int t = gridDim.x; asm volatile("" : "+s"(t)); return t; }
__device__ __forceinline__ float shfl_xor_l(float v, int o, int lane) { return __builtin_bit_cast(float, __builtin_amdgcn_ds_bpermute((lane ^ o) << 2, __builtin_bit_cast(int, v))); }
__device__ __forceinline__ float wave_sum(float v, int lane) {
#pragma unroll
    for (int o = 1; o < 64; o <<= 1) v += shfl_xor_l(v, o, lane);
    return v;
}
__device__ __forceinline__ int crow(int r, int hi) { return (r & 3) + 8 * (r >> 2) + 4 * hi; }

template <class F> struct Epi8 {
    static constexpr bool PERM = true, AFTER_DRAIN = false;
    F f;
    __device__ __forceinline__ void operator()(const pg8::f32x4 (&acc)[2][2][4][2], const pg8::Unit& u, int wr, int wc, int fr, int fq) const {
        asm volatile("" : "+v"(fr), "+v"(fq));
#pragma unroll
        for (int ai = 0; ai < 2; ++ai)
#pragma unroll
            for (int m = 0; m < 4; ++m) {
                const int row = u.pm * 256 + ai * 128 + wr * 64 + m * 16 + fr;
#pragma unroll
                for (int bj = 0; bj < 2; ++bj) { const int col = u.pn * 256 + bj * 128 + wc * 32 + 8 * fq; f(row, col, acc[ai][bj][m][0], acc[ai][bj][m][1]); }
                asm volatile("" ::: "memory"); __builtin_amdgcn_sched_barrier(0);
            }
    }
};
__device__ __forceinline__ v4u pack8(f32x4 a, f32x4 b) { v4u w; w.x = pk2(a[0], a[1]); w.y = pk2(a[2], a[3]); w.z = pk2(b[0], b[1]); w.w = pk2(b[2], b[3]); return w; }
struct FStore { bf16* O; int ldc; int act;
    __device__ __forceinline__ void operator()(int row, int col, f32x4 a, f32x4 b) const {
        if (act == 1) {
#pragma unroll
            for (int i = 0; i < 4; ++i) { float x = a[i] > 0.f ? a[i] : 0.f; a[i] = x * x; float y = b[i] > 0.f ? b[i] : 0.f; b[i] = y * y; } }
        *(v4u*)(O + (size_t)row * ldc + col) = pack8(a, b); } };
struct FD2 { bf16* cat; const float* bias; int rowbase, rowsPerB;
    __device__ __forceinline__ void operator()(int row, int col, f32x4 a, f32x4 b) const {
        const int bb = col >> 8, j = col & 255; const f32x4 b0 = *(const f32x4*)(bias + j), b1 = *(const f32x4*)(bias + j + 4);
        *(v4u*)(cat + ((size_t)(rowbase + bb * rowsPerB + row) * 1024 + 768 + j)) = pack8(a + b0, b + b1); } };
struct FGlu { bf16* cat; const bf16* T;
    __device__ __forceinline__ void operator()(int row, int col, f32x4 a, f32x4 b) const {
        const v4u t = *(const v4u*)(T + (size_t)row * 256 + col);
        float tv[8] = {bflo(t.x), bfhi(t.x), bflo(t.y), bfhi(t.y), bflo(t.z), bfhi(t.z), bflo(t.w), bfhi(t.w)};
#pragma unroll
        for (int i = 0; i < 4; ++i) { a[i] = tv[i] / (1.f + __expf(-a[i])); b[i] = tv[4 + i] / (1.f + __expf(-b[i])); }
        *(v4u*)(cat + (size_t)row * 1024 + 256 + col) = pack8(a, b); } };
__device__ __forceinline__ void transpose_item(const float* W, int K, int N, bf16* WT, LAS float* scr, int item, int lane) {
    const int nblk = N / 32, kb = item / nblk, nb = item % nblk, k0 = 64 * kb, n0 = 32 * nb;
#pragma unroll
    for (int i = 0; i < 8; ++i) { const int kk = 8 * i + (lane >> 3), n4 = (lane & 7) * 4; const f32x4 v = *(const f32x4*)(W + (size_t)(k0 + kk) * N + n0 + n4);
        scr[kk * 33 + n4] = v[0]; scr[kk * 33 + n4 + 1] = v[1]; scr[kk * 33 + n4 + 2] = v[2]; scr[kk * 33 + n4 + 3] = v[3]; }
    asm volatile("s_waitcnt lgkmcnt(0)" ::: "memory");
    const int c = lane & 7;
#pragma unroll
    for (int j = 0; j < 4; ++j) { const int n = (lane >> 3) + 8 * j; const LAS float* s = scr + (8 * c) * 33 + n;
        v4u o; o.x = pk2(s[0 * 33], s[1 * 33]); o.y = pk2(s[2 * 33], s[3 * 33]); o.z = pk2(s[4 * 33], s[5 * 33]); o.w = pk2(s[6 * 33], s[7 * 33]);
        *(v4u*)(WT + (size_t)(n0 + n) * K + k0 + 8 * c) = o; }
    asm volatile("s_waitcnt lgkmcnt(0)" ::: "memory");
}

__device__ __forceinline__ void prologue(LAS unsigned char* lds) {
    CArgs& a = kargs();
    int tid_ = threadIdx.x; asm volatile("" : "+v"(tid_));
    const int tid = tid_, lane = tid & 63, wid = tid >> 6, G = o_grid();
    unsigned char* ws = a.ws;
    {
        LAS float* scr = (LAS float*)(lds + wid * 16384);
        const int gw = o_bid() * 8 + wid, NGW = G * 8;
        constexpr int I0 = (DM / 64) * (INW / 32), I1 = (DM / 64) * (DM / 32), I2 = (DM / 64) * (DFF / 32), I3 = (DFF / 64) * (DM / 32), I4 = (256 / 64) * (256 / 32);
        constexpr int PER = I0 + I1 + I2 + I3 + I4;
        for (int it = gw; it < 2 * PER; it += NGW) {
            const int l = it / PER; int r = it % PER; unsigned char* wb = ws + WS_W + (size_t)l * W_LAYER;
            if (r < I0) { transpose_item(a.in[I_WIN] + (size_t)l * DM * INW, DM, INW, (bf16*)(wb + WO_IN), scr, r, lane); continue; } r -= I0;
            if (r < I1) { transpose_item(a.in[I_WOUT] + (size_t)l * DM * DM, DM, DM, (bf16*)(wb + WO_OUT), scr, r, lane); continue; } r -= I1;
            if (r < I2) { transpose_item(a.in[I_W1] + (size_t)l * DM * DFF, DM, DFF, (bf16*)(wb + WO_1), scr, r, lane); continue; } r -= I2;
            if (r < I3) { transpose_item(a.in[I_W2] + (size_t)l * DFF * DM, DFF, DM, (bf16*)(wb + WO_2), scr, r, lane); continue; } r -= I3;
            transpose_item(a.in[I_WGLU] + (size_t)l * 256 * 256, 256, 256, (bf16*)(wb + WO_GLU), scr, r, lane);
        }
    }
    __syncthreads();
    {
        LAS float* sl = (LAS float*)lds;
        LAS float* part = (LAS float*)(lds + 17 * 1024 * 4);
        float* mod = (float*)(ws + WS_MOD);
        bool have = false;
        for (int u = o_bid(); u < 2 * 96; u += G) {
            if (!have) {
                for (int i = tid; i < 17 * 1024; i += 512) { const float cv = i < 16 * 1024 ? a.in[I_C][i] : a.in[I_CCTX][i - 16 * 1024]; sl[i] = cv / (1.f + __expf(-cv)); }
                have = true; __syncthreads();
            }
            const int l = u / 96, n0 = (u % 96) * 64;
            const float* W = a.in[I_WADA] + (size_t)l * DM * 6144 + n0 + lane;
            float acc[17];
#pragma unroll
            for (int i = 0; i < 17; ++i) acc[i] = 0.f;
            for (int k0 = wid * 128; k0 < wid * 128 + 128; k0 += 16) {
                float wv[16];
#pragma unroll
                for (int q = 0; q < 16; ++q) wv[q] = W[(size_t)(k0 + q) * 6144];
#pragma unroll
                for (int q = 0; q < 16; ++q)
#pragma unroll
                    for (int i = 0; i < 17; ++i) acc[i] += sl[i * 1024 + k0 + q] * wv[q];
            }
#pragma unroll
            for (int i = 0; i < 17; ++i) part[(wid * 17 + i) * 64 + lane] = acc[i];
            __syncthreads();
            for (int o = tid; o < 17 * 64; o += 512) {
                const int i = o >> 6, n = o & 63; float s = a.in[I_BADA][l * 6144 + n0 + n];
#pragma unroll
                for (int w = 0; w < 8; ++w) s += part[(w * 17 + i) * 64 + n];
                mod[((size_t)l * 17 + i) * 6144 + n0 + n] = s;
            }
            __syncthreads();
        }
    }
    {
        const size_t gt = (size_t)o_bid() * 512 + tid, NT = (size_t)G * 512;
        bf16* dft = (bf16*)(ws + WS_DFT);
        for (size_t i = gt; i < (size_t)2048 * 4096 / 8; i += NT) {
            const int kk = (int)(i / 512), n0 = (int)(i % 512) * 8; float v[8];
#pragma unroll
            for (int j = 0; j < 8; ++j) { const int n = n0 + j, nn = n & 2047; const float fr = (float)((kk * nn) & 2047) * (1.f / 2048.f);
                v[j] = (n < 2048 ? __builtin_amdgcn_cosf(fr) : -__builtin_amdgcn_sinf(fr)) * 0.02209708691207961f; }
            v4u o; o.x = pk2(v[0], v[1]); o.y = pk2(v[2], v[3]); o.z = pk2(v[4], v[5]); o.w = pk2(v[6], v[7]);
            *(v4u*)(dft + i * 8) = o;
        }
        bf16* dftc = (bf16*)(ws + WS_DFTC);
        for (size_t i = gt; i < (size_t)256 * 512 / 8; i += NT) {
            const int kk = (int)(i / 64), n0 = (int)(i % 64) * 8; float v[8];
#pragma unroll
            for (int j = 0; j < 8; ++j) { const int n = n0 + j, nn = n & 255; const float fr = (float)((kk * nn) & 255) * (1.f / 256.f);
                v[j] = (n < 256 ? __builtin_amdgcn_cosf(fr) : -__builtin_amdgcn_sinf(fr)) * 0.0625f; }
            v4u o; o.x = pk2(v[0], v[1]); o.y = pk2(v[2], v[3]); o.z = pk2(v[4], v[5]); o.w = pk2(v[6], v[7]);
            *(v4u*)(dftc + i * 8) = o;
        }
        for (size_t i = gt; i < (size_t)2 * 512 * 256; i += NT) {
            const int l = (int)(i / (512 * 256)), rem = (int)(i % (512 * 256)), jp = rem >> 8, cin = rem & 255, j = jp & 255, part = jp >> 8;
            const float* W = a.in[I_WFNET] + (size_t)l * 256 * 256 + (size_t)(cin >> 6) * 64 * 256 + j; const int c = cin & 63; float s = 0.f;
            for (int cp0 = 0; cp0 < 64; cp0 += 16) { float wv[16];
#pragma unroll
                for (int q = 0; q < 16; ++q) wv[q] = W[(size_t)(cp0 + q) * 256];
#pragma unroll
                for (int q = 0; q < 16; ++q) { const float fr = (float)((c * (cp0 + q)) & 63) * (1.f / 64.f); s += (part ? __builtin_amdgcn_sinf(fr) : __builtin_amdgcn_cosf(fr)) * wv[q]; } }
            ((bf16*)(ws + WS_W + (size_t)l * W_LAYER + WO_CS))[(size_t)jp * 256 + cin] = (bf16)f2bf(s * 0.125f);
        }
        float2* rope = (float2*)(ws + WS_ROPE);
        for (size_t i = gt; i < 1024; i += NT) { const int pos = (int)i >> 4, k = (int)i & 15; const float inv = exp2f(-(float)k * (13.287712379549449f / 16.f)); const float ang = (float)pos * inv;
            float sn, cs; sincosf(ang, &sn, &cs); rope[i] = make_float2(cs, sn); }
    }
}

__device__ __forceinline__ void prep_rows0() {
    CArgs& a = kargs();
    int tid_ = threadIdx.x; asm volatile("" : "+v"(tid_));
    const int lane = tid_ & 63, gw = o_bid() * 8 + (tid_ >> 6), NGW = o_grid() * 8;
    const float* mod = (const float*)(a.ws + WS_MOD); bf16* XN = (bf16*)(a.ws + WS_XN); const float* gp = a.in[I_GPREMIX];
    f32x4 vn[4];
    auto rload = [&](int row) { const float* xr = row < MLAT ? a.in[I_X] + (size_t)row * DM : a.in[I_CTX] + (size_t)(row - MLAT) * DM;
#pragma unroll
        for (int j = 0; j < 4; ++j) vn[j] = *(const f32x4*)(xr + 4 * lane + 256 * j); };
    if (gw < MT) rload(gw);
    for (int row = gw; row < MT; row += NGW) {
        const int bi = row < MLAT ? row >> 11 : 16;
        const float* mb = mod + (size_t)bi * 6144;
        f32x4 v[4]; float ss = 0.f;
#pragma unroll
        for (int j = 0; j < 4; ++j) { v[j] = vn[j]; ss += v[j][0] * v[j][0] + v[j][1] * v[j][1] + v[j][2] * v[j][2] + v[j][3] * v[j][3]; }
        if (row + NGW < MT) rload(row + NGW);
        const float rstd = rsqrtf(wave_sum(ss, lane) * (1.f / DM) + EPSN);
#pragma unroll
        for (int j = 0; j < 4; ++j) { const int k = 4 * lane + 256 * j; const f32x4 g = *(const f32x4*)(gp + k), sh = *(const f32x4*)(mb + k), sc = *(const f32x4*)(mb + 1024 + k);
            f32x4 o;
#pragma unroll
            for (int e = 0; e < 4; ++e) o[e] = (v[j][e] * rstd * g[e]) * (1.f + sc[e]) + sh[e];
            v2u w; w.x = pk2(o[0], o[1]); w.y = pk2(o[2], o[3]); *(v2u*)(XN + (size_t)row * DM + k) = w; }
    }
}
template <int WHICH>
__device__ __forceinline__ void row_update() {
    CArgs& a = kargs();
    constexpr int l = WHICH >> 1; constexpr bool MLP = WHICH & 1; constexpr bool NXT = WHICH != 3;
    const int nrows = l == 0 ? MT : MLAT;
    const bf16* Y = (const bf16*)(a.ws + (MLP ? WS_XN : WS_Y)); bf16* OB = (bf16*)(a.ws + WS_XN);
    const float* xlat_in = WHICH == 0 ? a.in[I_X] : a.out; const float* xctx_in = WHICH == 0 ? a.in[I_CTX] : (const float*)(a.ws + WS_XC);
    float* xlat_out = a.out; float* xctx_out = (float*)(a.ws + WS_XC);
    const float* mod = (const float*)(a.ws + WS_MOD);
    const float* modl = mod + (size_t)l * 17 * 6144; constexpr int gate_i = MLP ? 5 : 2;
    const float* gpost = (MLP ? a.in[I_GPOSTMLP] : a.in[I_GPOSTMIX]) + l * DM;
    const float* modn = MLP ? mod + (size_t)17 * 6144 : modl; constexpr int sh_i = MLP ? 0 : 3, sc_i = MLP ? 1 : 4;
    const float* gnext = MLP ? a.in[I_GPREMIX] + DM : a.in[I_GPREMLP] + l * DM;
    int tid_ = threadIdx.x; asm volatile("" : "+v"(tid_));
    const int lane = tid_ & 63, gw = o_bid() * 8 + (tid_ >> 6), NGW = o_grid() * 8;
    v2u ywn[4]; f32x4 xn[4];
    auto rload = [&](int row) {
        const bool lat = row < MLAT; const float* xr = lat ? xlat_in + (size_t)row * DM : xctx_in + (size_t)(row - MLAT) * DM;
#pragma unroll
        for (int j = 0; j < 4; ++j) { const int k = 4 * lane + 256 * j; ywn[j] = *(const v2u*)(Y + (size_t)row * DM + k); xn[j] = *(const f32x4*)(xr + k); } };
    if (gw < nrows) rload(gw);
    for (int row = gw; row < nrows; row += NGW) {
        const bool lat = row < MLAT; const int bi = lat ? row >> 11 : 16;
        float* xo = lat ? xlat_out + (size_t)row * DM : xctx_out + (size_t)(row - MLAT) * DM;
        const float* gate = modl + (size_t)bi * 6144 + gate_i * 1024;
        f32x4 y[4], x[4]; float ss = 0.f;
#pragma unroll
        for (int j = 0; j < 4; ++j) { const v2u w = ywn[j]; y[j] = (f32x4){bflo(w.x), bfhi(w.x), bflo(w.y), bfhi(w.y)}; x[j] = xn[j];
            ss += y[j][0] * y[j][0] + y[j][1] * y[j][1] + y[j][2] * y[j][2] + y[j][3] * y[j][3]; }
        if (row + NGW < nrows) rload(row + NGW);
        const float rstd = rsqrtf(wave_sum(ss, lane) * (1.f / DM) + EPSN); float s2 = 0.f;
#pragma unroll
        for (int j = 0; j < 4; ++j) { const int k = 4 * lane + 256 * j; const f32x4 g = *(const f32x4*)(gpost + k), gt = *(const f32x4*)(gate + k);
#pragma unroll
            for (int e = 0; e < 4; ++e) { x[j][e] = x[j][e] + gt[e] * (y[j][e] * rstd * g[e]); s2 += x[j][e] * x[j][e]; }
#ifdef PROBE
            if (WHICH == 3) { const float* pa = (const float*)(a.ws + WS_PROBE); float tot = 0.f, fa = 0.f, fb = 0.f;
                for (int i = 0; i < 15; ++i) { const float v = pa[i]; tot += v; if ((PROBE_A >> i) & 1) fa += v; if ((PROBE_B >> i) & 1) fb += v; }
                fa /= tot; fb /= tot; const float e = fa < 0.02f ? 0.02f : fa;
                for (int q = 0; q < 4; ++q) x[j][q] *= (1.f + e);
                if (row == 0 && lane == 0 && j == 0) x[j][0] += 50.f + 1000.f * fb; }
#endif
            *(f32x4*)(xo + k) = x[j]; }
        if (NXT) {
            const float rstd2 = rsqrtf(wave_sum(s2, lane) * (1.f / DM) + EPSN); const float* mb = modn + (size_t)bi * 6144;
#pragma unroll
            for (int j = 0; j < 4; ++j) { const int k = 4 * lane + 256 * j; const f32x4 g = *(const f32x4*)(gnext + k), sh = *(const f32x4*)(mb + sh_i * 1024 + k), sc = *(const f32x4*)(mb + sc_i * 1024 + k);
                f32x4 o;
#pragma unroll
                for (int e = 0; e < 4; ++e) o[e] = (x[j][e] * rstd2 * g[e]) * (1.f + sc[e]) + sh[e];
                v2u w; w.x = pk2(o[0], o[1]); w.y = pk2(o[2], o[3]); *(v2u*)(OB + (size_t)row * DM + k) = w; }
        }
    }
}

__device__ __forceinline__ void qk_prep(int layer) {
    CArgs& a = kargs();
    bf16* Z = (bf16*)(a.ws + WS_Z); const float2* rope = (const float2*)(a.ws + WS_ROPE);
    int tid_ = threadIdx.x; asm volatile("" : "+v"(tid_));
    const int gt = o_bid() * 512 + tid_, NT = o_grid() * 512;
    for (int it = gt; it < MT * 6; it += NT) {
        const int row = it / 6, slot = it % 6; const bool lat = row < MLAT;
        bf16* p = Z + (size_t)row * INW + (slot < 4 ? OFF_AQ + slot * 64 : OFF_AK + (slot - 4) * 64);
        const float* g = (slot < 4 ? a.in[I_GQ] : a.in[I_GK]) + layer * 64;
        float v[64]; float ss = 0.f;
#pragma unroll
        for (int c = 0; c < 8; ++c) { const v4u w = *(const v4u*)(p + 8 * c);
            v[8 * c + 0] = bflo(w.x); v[8 * c + 1] = bfhi(w.x); v[8 * c + 2] = bflo(w.y); v[8 * c + 3] = bfhi(w.y); v[8 * c + 4] = bflo(w.z); v[8 * c + 5] = bfhi(w.z); v[8 * c + 6] = bflo(w.w); v[8 * c + 7] = bfhi(w.w); }
#pragma unroll
        for (int i = 0; i < 64; ++i) ss += v[i] * v[i];
        const float rstd = rsqrtf(ss * (1.f / 64.f) + EPSN);
#pragma unroll
        for (int i = 0; i < 64; ++i) v[i] = v[i] * rstd * g[i];
        if (lat) {
            const int t = row & 2047, gr = t >> 6, gc = t & 63;
#pragma unroll
            for (int i = 0; i < 16; ++i) {
                const float2 cr = rope[gr * 16 + i], cc = rope[gc * 16 + i];
                const float x1 = v[i], x2 = v[16 + i]; v[i] = x1 * cr.x - x2 * cr.y; v[16 + i] = x1 * cr.y + x2 * cr.x;
                const float y1 = v[32 + i], y2 = v[48 + i]; v[32 + i] = y1 * cc.x - y2 * cc.y; v[48 + i] = y1 * cc.y + y2 * cc.x;
            }
        }
#pragma unroll
        for (int c = 0; c < 8; ++c) { v4u w; w.x = pk2(v[8 * c], v[8 * c + 1]); w.y = pk2(v[8 * c + 2], v[8 * c + 3]); w.z = pk2(v[8 * c + 4], v[8 * c + 5]); w.w = pk2(v[8 * c + 6], v[8 * c + 7]); *(v4u*)(p + 8 * c) = w; }
    }
}
struct AttnP { const bf16* Z; bf16* O; int ostride; int qtok0; int qcol; int ocol; int kcol, vcol; int loc0, nloc, ctx0, nctx;
               int na; int qgcol0; int relr0; int head; int act_lo, act_hi; };
template <int NH>
__device__ __forceinline__ void attn_unit(LAS unsigned char* lds, const AttnP& P, const LAS float* biasL) {
    int tid_ = threadIdx.x; asm volatile("" : "+v"(tid_));
    const int tid = tid_, lane = tid & 63, wid = tid >> 6, r32 = lane & 31, hi = lane >> 5;
    const int slot = (NH == 1) ? 0 : (wid >> 1);
    const bf16* Z = P.Z;
    bf16x8 qr[4];
#pragma unroll
    for (int d0 = 0; d0 < 4; ++d0) qr[d0] = *(const bf16x8*)(Z + (size_t)(P.qtok0 + r32) * INW + P.qcol + d0 * 16 + hi * 8);
    const int nt = P.nloc + P.nctx;
    v4u kreg[NH], vreg[NH];
    auto tile_tok = [&](int i) { return i < P.nloc ? P.loc0 + 64 * i : P.ctx0 + 64 * (i - P.nloc); };
    auto gload = [&](int i) { const int tok = tile_tok(i);
#pragma unroll
        for (int s = 0; s < NH; ++s) { kreg[s] = *(const v4u*)(Z + (size_t)(tok + (tid >> 3)) * INW + P.kcol + s * 64 + (tid & 7) * 8);
                                        vreg[s] = *(const v4u*)(Z + (size_t)(tok + lane) * INW + P.vcol + s * 64 + wid * 8); } };
    gload(0);
    f32x16 o0 = {}, o1 = {};
    float m = -1e30f, lsum = 0.f;
    const float sc = 0.125f * LOG2E;
    const int qg = P.qgcol0 + r32; const int cs = qg - 8 < 0 ? 0 : (qg - 8 > 48 ? 48 : qg - 8);
    auto lstore = [&](int bufoff) {
#pragma unroll
        for (int s = 0; s < NH; ++s) {
            LAS unsigned char* sb = lds + bufoff + s * 18432;
            *(LAS v4u*)(sb + ((tid >> 3) * 72 + (tid & 7) * 8) * 2) = kreg[s];
            LAS bf16* vt = (LAS bf16*)(sb + 9216);
            const unsigned w[4] = {vreg[s].x, vreg[s].y, vreg[s].z, vreg[s].w};
#pragma unroll
            for (int e = 0; e < 4; ++e) { vt[(wid * 8 + 2 * e) * 68 + lane] = (bf16)(w[e] & 0xffffu); vt[(wid * 8 + 2 * e + 1) * 68 + lane] = (bf16)(w[e] >> 16); }
        }
    };
    auto compute = [&](int i, int bufoff) {
        if (P.na && i < P.nloc && (i < P.act_lo || i >= P.act_hi)) return;
        const LAS unsigned char* kb = lds + bufoff + slot * 18432; const LAS unsigned char* vb = kb + 9216;
        f32x16 p0 = {}, p1 = {};
#pragma unroll
        for (int d0 = 0; d0 < 4; ++d0) {
            const bf16x8 a0 = *(const LAS bf16x8*)(kb + (r32 * 72 + d0 * 16 + hi * 8) * 2);
            const bf16x8 a1 = *(const LAS bf16x8*)(kb + ((32 + r32) * 72 + d0 * 16 + hi * 8) * 2);
            p0 = __builtin_amdgcn_mfma_f32_32x32x16_bf16(a0, qr[d0], p0, 0, 0, 0);
            p1 = __builtin_amdgcn_mfma_f32_32x32x16_bf16(a1, qr[d0], p1, 0, 0, 0);
        }
        if (P.na && i < P.nloc) {
            const LAS float* bl = biasL + (P.head * 15 + (P.relr0 + i)) * 31;
#pragma unroll
            for (int r = 0; r < 16; ++r) {
                const int kv0 = crow(r, hi), kv1 = kv0 + 32;
                const bool ok0 = (unsigned)(kv0 - cs) < 16u, ok1 = (unsigned)(kv1 - cs) < 16u;
                const int i0 = kv0 - qg + 15, i1 = kv1 - qg + 15;
                const float b0 = bl[i0 < 0 ? 0 : (i0 > 30 ? 30 : i0)], b1 = bl[i1 < 0 ? 0 : (i1 > 30 ? 30 : i1)];
                p0[r] = ok0 ? p0[r] + b0 : -INFINITY; p1[r] = ok1 ? p1[r] + b1 : -INFINITY;
            }
        }
        float mx = fmaxf(fmaxf(p0[0], p0[1]), p1[0]);
#pragma unroll
        for (int r = 2; r < 16; r += 2) mx = fmaxf(fmaxf(mx, p0[r]), p0[r + 1]);
#pragma unroll
        for (int r = 1; r < 15; r += 2) mx = fmaxf(fmaxf(mx, p1[r]), p1[r + 1]);
        mx = fmaxf(mx, p1[15]);
        mx = fmaxf(mx, shfl_xor_l(mx, 32, lane));
        if (__any((mx - m) * sc > 6.f)) {
            const float mn = fmaxf(m, mx), alpha = __builtin_amdgcn_exp2f((m - mn) * sc); m = mn; lsum *= alpha;
#pragma unroll
            for (int r = 0; r < 16; ++r) { o0[r] *= alpha; o1[r] *= alpha; }
        }
        const float nm = -m * sc;
        float ps = 0.f;
#pragma unroll
        for (int r = 0; r < 16; ++r) { p0[r] = __builtin_amdgcn_exp2f(fmaf(p0[r], sc, nm)); p1[r] = __builtin_amdgcn_exp2f(fmaf(p1[r], sc, nm)); ps += p0[r] + p1[r]; }
        lsum += ps;
        bf16x8 pf[4];
#pragma unroll
        for (int s = 0; s < 4; ++s) {
            v4u w;
            if (s < 2) { w.x = pk2(p0[8 * s], p0[8 * s + 1]); w.y = pk2(p0[8 * s + 2], p0[8 * s + 3]); w.z = pk2(p0[8 * s + 4], p0[8 * s + 5]); w.w = pk2(p0[8 * s + 6], p0[8 * s + 7]); }
            else { const int q = s - 2; w.x = pk2(p1[8 * q], p1[8 * q + 1]); w.y = pk2(p1[8 * q + 2], p1[8 * q + 3]); w.z = pk2(p1[8 * q + 4], p1[8 * q + 5]); w.w = pk2(p1[8 * q + 6], p1[8 * q + 7]); }
            pf[s] = __builtin_bit_cast(bf16x8, w);
        }
#pragma unroll
        for (int s = 0; s < 4; ++s) {
            const int kvb = 32 * (s >> 1) + 16 * (s & 1) + 4 * hi;
            {   const LAS unsigned char* va = vb + (r32 * 68 + kvb) * 2;
                const s16x4 lo = *(const LAS s16x4*)va, hh = *(const LAS s16x4*)(va + 16);
                const bf16x8 af = {lo[0], lo[1], lo[2], lo[3], hh[0], hh[1], hh[2], hh[3]};
                o0 = __builtin_amdgcn_mfma_f32_32x32x16_bf16(af, pf[s], o0, 0, 0, 0); }
            {   const LAS unsigned char* va = vb + ((32 + r32) * 68 + kvb) * 2;
                const s16x4 lo = *(const LAS s16x4*)va, hh = *(const LAS s16x4*)(va + 16);
                const bf16x8 af = {lo[0], lo[1], lo[2], lo[3], hh[0], hh[1], hh[2], hh[3]};
                o1 = __builtin_amdgcn_mfma_f32_32x32x16_bf16(af, pf[s], o1, 0, 0, 0); }
        }
        };
    if (NH == 1) {
        __syncthreads();
        lstore(0);
        if (nt > 1) gload(1);
        __syncthreads();
        for (int i = 0; i < nt; ++i) {
            if (i + 1 < nt) { lstore(((i + 1) & 1) * 18432); if (i + 2 < nt) gload(i + 2); }
            compute(i, (i & 1) * 18432);
            __syncthreads();
        }
    } else {
        for (int i = 0; i < nt; ++i) {
            __syncthreads();
            lstore(0);
            __syncthreads();
            if (i + 1 < nt) gload(i + 1);
            compute(i, 0);
        }
    }
    lsum += shfl_xor_l(lsum, 32, lane);
    const float inv = 1.f / lsum;
    bf16* op = P.O + (size_t)(P.qtok0 + r32) * P.ostride + P.ocol;
#pragma unroll
    for (int rg = 0; rg < 4; ++rg) {
        v2u w0, w1;
        w0.x = pk2(o0[4 * rg] * inv, o0[4 * rg + 1] * inv); w0.y = pk2(o0[4 * rg + 2] * inv, o0[4 * rg + 3] * inv);
        w1.x = pk2(o1[4 * rg] * inv, o1[4 * rg + 1] * inv); w1.y = pk2(o1[4 * rg + 2] * inv, o1[4 * rg + 3] * inv);
        *(v2u*)(op + 8 * rg + 4 * hi) = w0; *(v2u*)(op + 32 + 8 * rg + 4 * hi) = w1;
    }
}
__device__ __forceinline__ int s5_tokrow(int s, int dir, int b) {
    if (s < 256) return MLAT + b * 256 + (dir ? 255 - s : s);
    const int t = s - 256; return b * 2048 + (dir ? 2047 - t : t);
}
__device__ __forceinline__ void s5_unit(LAS unsigned char* lds, int layer, int b, int g) {
    CArgs& a = kargs();
    int tid_ = threadIdx.x; asm volatile("" : "+v"(tid_));
    const int tid = tid_, lane = tid & 63, wid = tid >> 6, r32 = lane & 31, hi = lane >> 5;
    LAS float* BuL = (LAS float*)(lds + wid * 17920);
    LAS bf16* HL = (LAS bf16*)(lds + wid * 17920);
    LAS v4u* uL = (LAS v4u*)(lds + wid * 17920 + 8704);
    const bf16* Z = (const bf16*)(a.ws + WS_Z); float* Y0 = (float*)(a.ws + WS_Y0); float* Y1 = (float*)(a.ws + WS_Y1);
    for (int dir = 0; dir < 2; ++dir) {
        const int idx = (layer * 2 + dir) * 16 + g;
        const float dt = expf(a.in[I_LDT][idx]);
        float ar, ai;
        { const float lr = fminf(a.in[I_AR][idx * 64 + lane], -1e-4f), li = a.in[I_AI][idx * 64 + lane]; const float er = expf(lr * dt); float sn, cs; sincosf(li * dt, &sn, &cs); ar = er * cs; ai = er * sn; }
        float pr = ar, pi = ai;
        float p32r, p32i;
#pragma unroll
        for (int k = 0; k < 5; ++k) { const float tr = pr * pr - pi * pi, ti = 2.f * pr * pi; pr = tr; pi = ti; }
        p32r = pr; p32i = pi;
#pragma unroll
        for (int k = 0; k < 3; ++k) { const float tr = pr * pr - pi * pi, ti = 2.f * pr * pi; pr = tr; pi = ti; }
        { const float tr = pr * p32r - pi * p32i, ti = pr * p32i + pi * p32r; pr = tr; pi = ti; }
        bf16x8 bfr[4];
#pragma unroll
        for (int pp = 0; pp < 2; ++pp) {
            const int p2 = 32 * pp + r32;
            const float lr = fminf(a.in[I_AR][idx * 64 + p2], -1e-4f), li = a.in[I_AI][idx * 64 + p2]; const float er = expf(lr * dt); float sn, cs; sincosf(li * dt, &sn, &cs);
            const float xr = er * cs - 1.f, xi = er * sn, den = 1.f / (lr * lr + li * li);
            const float cr = (xr * lr + xi * li) * den, ci = (xi * lr - xr * li) * den;
            const float* br = a.in[I_BR] + ((size_t)idx * 64 + p2) * 16 + 8 * hi; const float* bi = a.in[I_BI] + ((size_t)idx * 64 + p2) * 16 + 8 * hi;
            float re[8], im[8];
#pragma unroll
            for (int j = 0; j < 8; ++j) { const float x = br[j], y = bi[j]; re[j] = cr * x - ci * y; im[j] = cr * y + ci * x; }
            v4u w; w.x = pk2(re[0], re[1]); w.y = pk2(re[2], re[3]); w.z = pk2(re[4], re[5]); w.w = pk2(re[6], re[7]); bfr[pp] = __builtin_bit_cast(bf16x8, w);
            w.x = pk2(im[0], im[1]); w.y = pk2(im[2], im[3]); w.z = pk2(im[4], im[5]); w.w = pk2(im[6], im[7]); bfr[2 + pp] = __builtin_bit_cast(bf16x8, w);
        }
        bf16x8 cfr[8];
        const float cmsk = r32 < 16 ? 1.f : 0.f;
#pragma unroll
        for (int ks = 0; ks < 8; ++ks) {
            const size_t co = ((size_t)idx * 16 + (r32 & 15)) * 64 + 8 * ks + 4 * hi;
            const f32x4 cr4 = *(const f32x4*)(a.in[I_CR] + co), ci4 = *(const f32x4*)(a.in[I_CI] + co);
            v4u w; w.x = pk2(cr4[0] * cmsk, -ci4[0] * cmsk); w.y = pk2(cr4[1] * cmsk, -ci4[1] * cmsk); w.z = pk2(cr4[2] * cmsk, -ci4[2] * cmsk); w.w = pk2(cr4[3] * cmsk, -ci4[3] * cmsk);
            cfr[ks] = __builtin_bit_cast(bf16x8, w);
        }
        float hr = 0.f, him = 0.f;
        float* Yd = dir == 0 ? Y0 : Y1;
        {
            const bf16* ub = Z + OFF_S5 + 16 * g + 8 * hi;
            v4u ur[9];
#pragma unroll
            for (int ch = 0; ch < 9; ++ch) ur[ch] = *(const v4u*)(ub + (size_t)s5_tokrow(wid * 288 + ch * 32 + r32, dir, b) * INW);
#pragma unroll
            for (int ch = 0; ch < 9; ++ch) uL[ch * 64 + lane] = ur[ch];
            asm volatile("s_waitcnt lgkmcnt(0)" ::: "memory");
        }
        for (int pass = 0; pass < 2; ++pass) {
            for (int ch = 0; ch < 9; ++ch) {
                const int s0 = wid * 288 + ch * 32;
                bf16x8 ucur = __builtin_bit_cast(bf16x8, uL[ch * 64 + lane]);
                asm volatile("s_waitcnt lgkmcnt(0)" : "+v"(ucur) :: "memory");
                float bur[32], bui[32];
#pragma unroll
                for (int jb = 0; jb < 2; ++jb) {
                    f32x16 d = {}; d = __builtin_amdgcn_mfma_f32_32x32x16_bf16(ucur, bfr[jb], d, 0, 0, 0);
#pragma unroll
                    for (int r = 0; r < 16; ++r) BuL[crow(r, hi) * 66 + 32 * jb + r32] = d[r];
                }
                asm volatile("s_waitcnt lgkmcnt(0)" : "+v"(ucur) :: "memory");
#pragma unroll
                for (int t = 0; t < 32; ++t) bur[t] = BuL[t * 66 + lane];
                asm volatile("s_waitcnt lgkmcnt(0)" : "+v"(ucur) :: "memory");
#pragma unroll
                for (int jb = 0; jb < 2; ++jb) {
                    f32x16 d = {}; d = __builtin_amdgcn_mfma_f32_32x32x16_bf16(ucur, bfr[2 + jb], d, 0, 0, 0);
#pragma unroll
                    for (int r = 0; r < 16; ++r) BuL[crow(r, hi) * 66 + 32 * jb + r32] = d[r];
                }
                asm volatile("s_waitcnt lgkmcnt(0)" ::: "memory");
#pragma unroll
                for (int t = 0; t < 32; ++t) bui[t] = BuL[t * 66 + lane];
                asm volatile("s_waitcnt lgkmcnt(0)" ::: "memory");
                if (pass == 0) {
#pragma unroll
                    for (int t = 0; t < 32; ++t) { const float nr = ar * hr - ai * him + bur[t], ni = ar * him + ai * hr + bui[t]; hr = nr; him = ni; }
                } else {
#pragma unroll
                    for (int t = 0; t < 32; ++t) { const float nr = ar * hr - ai * him + bur[t], ni = ar * him + ai * hr + bui[t]; hr = nr; him = ni;
                        ((LAS unsigned*)HL)[t * 68 + lane] = pk2(hr, him); }
                    asm volatile("s_waitcnt lgkmcnt(0)" ::: "memory");
                    f32x16 y = {};
#pragma unroll
                    for (int ks = 0; ks < 8; ++ks) { const bf16x8 af = *(const LAS bf16x8*)((const LAS unsigned char*)HL + (r32 * 136 + 16 * ks + 8 * hi) * 2);
                        y = __builtin_amdgcn_mfma_f32_32x32x16_bf16(cfr[ks], af, y, 0, 0, 0); }
                    asm volatile("s_waitcnt lgkmcnt(0)" ::: "memory");
                    if (s0 >= 256 || layer == 0) {
                        float* yp = Yd + (size_t)s5_tokrow(s0 + r32, dir, b) * 256 + 16 * g + 4 * hi;
                        *(f32x4*)yp = (f32x4){y[0], y[1], y[2], y[3]}; *(f32x4*)(yp + 8) = (f32x4){y[4], y[5], y[6], y[7]};
                    }
                }
            }
            if (pass == 0) {
                BuL[lane * 2] = hr; BuL[lane * 2 + 1] = him;
                __syncthreads();
                hr = 0.f; him = 0.f;
                for (int v = 0; v < wid; ++v) { const LAS float* cv = (const LAS float*)(lds + v * 17920); const float cr = cv[lane * 2], ci = cv[lane * 2 + 1]; const float nr = pr * hr - pi * him + cr, ni = pr * him + pi * hr + ci; hr = nr; him = ni; }
                __syncthreads();
            }
        }

    }
}

__device__ __forceinline__ void na_phase(LAS unsigned char* lds, int l) {
    CArgs& a = kargs();
    int tid_ = threadIdx.x; asm volatile("" : "+v"(tid_));
    const int tid = tid_, wid = __builtin_amdgcn_readfirstlane(tid >> 6), G = o_grid(), bid = o_bid();
    bf16* Zb = (bf16*)(a.ws + WS_Z); bf16* CAT = (bf16*)(a.ws + WS_CAT);
    LAS float* biasL = (LAS float*)(lds + 73728);
    for (int i = tid; i < 4 * 15 * 31; i += 512) biasL[i] = 8.f * a.in[I_NABIAS][l * 4 * 15 * 31 + i];
    for (int u = bid; u < 512; u += G) {
        const int b = u >> 5, head = (u >> 3) & 3, rg = u & 7; const int r = 4 * rg + (wid >> 1);
        const int lo = 4 * rg - 4 < 0 ? 0 : (4 * rg - 4 > 24 ? 24 : 4 * rg - 4); const int hi3 = 4 * rg - 1 < 0 ? 0 : (4 * rg - 1 > 24 ? 24 : 4 * rg - 1);
        const int rs = r - 4 < 0 ? 0 : (r - 4 > 24 ? 24 : r - 4);
        AttnP P{Zb, CAT, DM, b * 2048 + r * 64 + (wid & 1) * 32, OFF_NQ + head * 64, 512 + head * 64, OFF_NK + head * 64, OFF_NV + head * 64, b * 2048 + lo * 64, hi3 + 8 - lo, MLAT + b * 256, 4, 1, (wid & 1) * 32, lo - r + 7, head, rs - lo, rs - lo + 8};
        attn_unit<1>(lds, P, biasL);
    }
    if (l == 0) for (int u = bid; u < 64; u += G) {
        const int b = u >> 2, head = u & 3;
        AttnP P{Zb, CAT, DM, MLAT + b * 256 + wid * 32, OFF_NQ + head * 64, 512 + head * 64, OFF_NK + head * 64, OFF_NV + head * 64, 0, 0, MLAT + b * 256, 4, 0, 0, 0, head, 0, 0};
        attn_unit<1>(lds, P, biasL);
    }
}
__device__ __forceinline__ void gqa_phase(LAS unsigned char* lds, int l) {
    CArgs& a = kargs();
    int tid_ = threadIdx.x; asm volatile("" : "+v"(tid_));
    const int tid = tid_, wid = __builtin_amdgcn_readfirstlane(tid >> 6), G = o_grid(), bid = o_bid();
    bf16* Zb = (bf16*)(a.ws + WS_Z); bf16* CAT = (bf16*)(a.ws + WS_CAT);
    const bool bal = (G == 256); const int nmine = bal ? (bid < 128 ? 3 : 1) : (511 - bid) / G + 1;
    for (int iu = 0; iu < nmine; ++iu) {
        const int u = bal ? (bid < 128 ? bid + 128 * iu : 256 + bid) : bid + iu * G;
        const int b = u >> 5, kvh = (u >> 4) & 1, qb = u & 15; const int head = 2 * kvh + (wid >> 2);
        AttnP P{Zb, CAT, DM, b * 2048 + qb * 128 + (wid & 3) * 32, OFF_AQ + head * 64, head * 64, OFF_AK + kvh * 64, OFF_AV + kvh * 64, b * 2048, 32, MLAT + b * 256, 4, 0, 0, 0, head, 0, 0};
        attn_unit<1>(lds, P, nullptr);
    }
    if (l == 0) for (int u = bid; u < 64; u += G) {
        const int b = u >> 2, kvh = (u >> 1) & 1, qb = u & 1; const int head = 2 * kvh + (wid >> 2);
        AttnP P{Zb, CAT, DM, MLAT + b * 256 + qb * 128 + (wid & 3) * 32, OFF_AQ + head * 64, head * 64, OFF_AK + kvh * 64, OFF_AV + kvh * 64, 0, 0, MLAT + b * 256, 4, 0, 0, 0, head, 0, 0};
        attn_unit<1>(lds, P, nullptr);
    }
}

#define XB_TMO      128
#define XB_XCNT(j)  (256  + 64 * (j))
#define XB_XSUB(j)  (1280 + 64 * (j))
#define XB_XGEN(j)  (2304 + 64 * (j))
#define XB_TOP      3328
#define XB_TOPGEN   3392
#define XCD_BAR_WORDS 3456
#define XB_SPIN_CAP (1u << 18)

__device__ __forceinline__ unsigned xb_ld(unsigned* p)              { return __hip_atomic_load(p, __ATOMIC_RELAXED, __HIP_MEMORY_SCOPE_AGENT); }
__device__ __forceinline__ unsigned xb_add(unsigned* p, unsigned v) { return __hip_atomic_fetch_add(p, v, __ATOMIC_RELAXED, __HIP_MEMORY_SCOPE_AGENT); }
__device__ __forceinline__ unsigned xb_xcc_id() { return (unsigned)__builtin_amdgcn_s_getreg((3 << 11) | 20) & 0xFu; }
#define XB_SPIN(cond, bar) do { unsigned _sp = 0; while (cond) { __builtin_amdgcn_s_sleep(1); \
    if ((++_sp & 255u) == 0u) { if (xb_ld(&(bar)[XB_TMO])) break; if (_sp > XB_SPIN_CAP) { atomicAdd(&(bar)[XB_TMO], 1u); break; } } } } while (0)
struct XcdBarrier { unsigned* bar; unsigned x; volatile LAS unsigned* st; };
__device__ __forceinline__ void xcd_barrier_complete(unsigned* bar, unsigned x, unsigned& nloc, unsigned& nx) {
    const unsigned G = gridDim.x * gridDim.y * gridDim.z;
    unsigned sum, cnt, mine, sp = 0u;
    for (;;) {
        sum = 0u; cnt = 0u; mine = 0u;
#pragma unroll
        for (unsigned j = 0; j < 16; ++j) { const unsigned c = xb_ld(&bar[XB_XCNT(j)]); sum += c; cnt += (c > 0u) ? 1u : 0u; mine = (j == x) ? c : mine; }
        if (sum == G) break;
        __builtin_amdgcn_s_sleep(1);
        if ((++sp & 255u) == 0u) { if (xb_ld(&bar[XB_TMO])) break; if (sp > XB_SPIN_CAP) { atomicAdd(&bar[XB_TMO], 1u); break; } }
    }
    nloc = mine > 0u ? mine : 1u; nx = cnt > 0u ? cnt : 1u;
}

__device__ __forceinline__ void xcd_barrier(const XcdBarrier& b) {
    asm volatile("s_waitcnt vmcnt(0)" ::: "memory");
    __syncthreads();
    if (threadIdx.x == 0) {
        unsigned* bar = b.bar;
        __builtin_amdgcn_s_waitcnt(0);
        unsigned nloc = b.st[0], nx = b.st[1];
        if (nloc == 0u) { xcd_barrier_complete(bar, b.x, nloc, nx); b.st[0] = nloc; b.st[1] = nx; }
        const unsigned old = xb_add(&bar[XB_XSUB(b.x)], 1u);
        const unsigned gen = old / nloc;
        if (old + 1u == (gen + 1u) * nloc) {
            __builtin_amdgcn_fence(__ATOMIC_RELEASE, "agent");
            asm volatile("s_waitcnt vmcnt(0)" ::: "memory");
            const unsigned og = xb_add(&bar[XB_TOP], 1u);
            const unsigned tg = og / nx;
            if (og + 1u == (tg + 1u) * nx) xb_add(&bar[XB_TOPGEN], 1u);
            else XB_SPIN(xb_ld(&bar[XB_TOPGEN]) == tg, bar);
            __builtin_amdgcn_fence(__ATOMIC_ACQUIRE, "agent");
            xb_add(&bar[XB_XGEN(b.x)], 1u);
            asm volatile("s_waitcnt vmcnt(0)" ::: "memory");
        } else {
            XB_SPIN(xb_ld(&bar[XB_XGEN(b.x)]) == gen, bar);
            __builtin_amdgcn_fence(__ATOMIC_ACQUIRE, "agent");
            asm volatile("s_waitcnt vmcnt(0)" ::: "memory");
        }
    }
    __syncthreads();
}

template <class F>
__device__ __forceinline__ void run_gemm(LAS unsigned char* lds, const bf16* A, int lda, const bf16* Bt, int ldb, int M, int N, int K, const F& f, int c, long tsB = 0, int ksplit = 1 << 30, long kjumpB = 0) {
    pg8::Gemm g{A, Bt, M, N, K, lda, ldb, tsB ? tsB : (long)512 * ldb, ksplit, kjumpB}; pg8::StaticOrder S; S.init(M, N, o_grid(), c); Epi8<F> E{f};
    pg8::gemm_phase<Epi8<F>, pg8::StaticOrder, true, true>(lds, g, S, E);
}
#define WSP(off) ((bf16*)(ws + (off)))
__device__ __forceinline__ void ph_store_gemm(LAS unsigned char* lds, int l, int kind) {
    unsigned char* ws = kargs().ws; unsigned char* wb = ws + WS_W + (size_t)l * W_LAYER;
    const int Mr = l == 0 ? MT : MLAT;
    const bf16* A; const bf16* Bt; bf16* O; int lda, ldb, M, N, K, ldc, act;
    if (kind == 0)      { A = WSP(WS_XN);   lda = DM;  Bt = (const bf16*)(wb + WO_IN);  ldb = DM;  M = MT; N = INW; K = DM;  O = WSP(WS_Z);    ldc = INW; act = 0; }
    else if (kind == 1) { A = WSP(WS_CAT);  lda = DM;  Bt = (const bf16*)(wb + WO_OUT); ldb = DM;  M = Mr; N = DM;  K = DM;  O = WSP(WS_Y);    ldc = DM;  act = 0; }
    else if (kind == 2) { A = WSP(WS_XN);   lda = DM;  Bt = (const bf16*)(wb + WO_1);   ldb = DM;  M = Mr; N = DFF; K = DM;  O = WSP(WS_HMID); ldc = DFF; act = 1; }
    else if (kind == 3) { A = WSP(WS_HMID); lda = DFF; Bt = (const bf16*)(wb + WO_2);   ldb = DFF; M = Mr; N = DM;  K = DFF; O = WSP(WS_XN);   ldc = DM;  act = 0; }
    else                { A = (const bf16*)(wb + WO_CS); lda = 256; Bt = WSP(WS_Z) + OFF_FN; ldb = INW; M = 512; N = MT; K = 256; O = WSP(WS_C1); ldc = MT; act = 0; }
    run_gemm(lds, A, lda, Bt, ldb, M, N, K, FStore{O, ldc, act}, o_bid());
}
__device__ __forceinline__ void ph_d2(LAS unsigned char* lds, int l) { CArgs& a = kargs(); unsigned char* ws = a.ws;
    for (int j = 0; j < (l == 0 ? 2 : 1); ++j) {
        if (j == 0) run_gemm(lds, WSP(WS_DFT), 4096, WSP(WS_C1), MT, 2048, 4096, 4096, FD2{WSP(WS_CAT), a.in[I_BFNET] + l * 256, 0, 2048}, o_grid() - 1 - o_bid(), 2048 * 2, 32, ((long)256 * MT - 2048) * 2);
        else run_gemm(lds, WSP(WS_DFTC), 512, WSP(WS_C1) + MLAT, MT, 256, 4096, 512, FD2{WSP(WS_CAT), a.in[I_BFNET] + l * 256, MLAT, 256}, o_bid(), 256 * 2, 4, ((long)256 * MT - 256) * 2);
    } }
__device__ __forceinline__ void ph_glu(LAS unsigned char* lds, int l) { CArgs& a = kargs(); unsigned char* ws = a.ws; unsigned char* wb = ws + WS_W + (size_t)l * W_LAYER;
    const int Mr = l == 0 ? MT : MLAT;
    {
        int tid_ = threadIdx.x; asm volatile("" : "+v"(tid_));
        pg8::StaticOrder S; S.init(Mr, 256, o_grid(), o_bid()); pg8::Unit u;
        const bf16* Z = WSP(WS_Z); const float* Y0 = (const float*)(ws + WS_Y0); const float* Y1 = (const float*)(ws + WS_Y1); bf16* T = WSP(WS_T);
        const int c8 = (tid_ & 31) * 8;
        float dk[8];
#pragma unroll
        for (int e = 0; e < 8; ++e) dk[e] = a.in[I_S5D][l * 256 + c8 + e];
        for (int i = 0; S.next(i, u); ++i)
            for (int rr = tid_ >> 5; rr < 256; rr += 16) {
                const size_t row = (size_t)u.pm * 256 + rr;
                const v4u uz = *(const v4u*)(Z + row * INW + OFF_S5 + c8);
                const f32x4 a0 = *(const f32x4*)(Y0 + row * 256 + c8), a1 = *(const f32x4*)(Y0 + row * 256 + c8 + 4), b0 = *(const f32x4*)(Y1 + row * 256 + c8), b1 = *(const f32x4*)(Y1 + row * 256 + c8 + 4);
                const float uv[8] = {bflo(uz.x), bfhi(uz.x), bflo(uz.y), bfhi(uz.y), bflo(uz.z), bfhi(uz.z), bflo(uz.w), bfhi(uz.w)};
                float o[8];
#pragma unroll
                for (int e = 0; e < 8; ++e) { const float v = (e < 4 ? a0[e] + b0[e] : a1[e - 4] + b1[e - 4]) + dk[e] * uv[e];
                    const float uu = 0.7978845608028654f * (v + 0.044715f * v * v * v); o[e] = v / (1.f + __expf(-2.f * uu)); }
                v4u w; w.x = pk2(o[0], o[1]); w.y = pk2(o[2], o[3]); w.z = pk2(o[4], o[5]); w.w = pk2(o[6], o[7]);
                *(v4u*)(T + row * 256 + c8) = w;
            }
        __threadfence(); __syncthreads();
    }
    int K = 256, ld = 256; asm volatile("" : "+s"(K), "+s"(ld));
    run_gemm(lds, WSP(WS_T), ld, (const bf16*)(wb + WO_GLU), ld, Mr, 256, K, FGlu{WSP(WS_CAT), WSP(WS_T)}, o_bid()); }

__global__ void __launch_bounds__(512, 2) fwd_megakernel(Args a_unused) {
    extern __shared__ __attribute__((aligned(16))) unsigned char lds_raw[];
    LAS unsigned char* lds = (LAS unsigned char*)lds_raw;
    cg::grid_group grid = cg::this_grid();
#ifdef PROBE
    if (blockIdx.x == 0 && threadIdx.x == 0) { unsigned char* pw = kargs().ws + WS_PROBE; for (int i = 0; i < 32; ++i) ((float*)pw)[i] = 0.f; *(unsigned long long*)(pw + 256) = __builtin_amdgcn_s_memrealtime(); }
#endif
    {
        if (threadIdx.x < 2) ((volatile LAS unsigned*)(lds + LDS_BARST))[threadIdx.x] = 0u;
        if (threadIdx.x == 0) (void)xb_add(&((unsigned*)(kargs().ws + WS_BAR))[XB_XCNT(xb_xcc_id())], 1u);
        if (gridDim.x == 0x7fffffffu) grid.sync();
    }
    for (int step = 0; step < 20; ++step) {
        const int l = step < 2 ? 0 : (step - 2) / 9, k = step < 2 ? step - 2 : (step - 2) - 9 * l;
        int gk = -1;
        if (k == 0) gk = 0; else if (k == 2) gk = 4; else if (k == 4) gk = 1; else if (k == 6) gk = 2; else if (k == 7) gk = 3;
        int lbl = k == -2 ? 0 : k == -1 ? 1 : k == 0 ? 2 : k == 1 ? 5 : k == 2 ? 6 : k == 3 ? 9 : k == 4 ? 10 : k == 5 ? 11 : k == 6 ? 12 : k == 7 ? 13 : 14; (void)lbl;
#ifdef DBL_GEMM
        if (gk >= 0) { ph_store_gemm(lds, l, gk); __syncthreads(); }
#endif
#ifdef DBL_ROWS
        if (k == -1) prep_rows0(); if (k == 5 && l == 0) row_update<0>();
#endif
        if (gk >= 0) ph_store_gemm(lds, l, gk);
        else if (k == -2) prologue(lds);
        else if (k == -1) prep_rows0();
        else if (k == 1) {
            qk_prep(l);
            __syncthreads(); STAMP(3);
            na_phase(lds, l);
#ifdef DBL_NA
            __syncthreads(); na_phase(lds, l);
#endif
            __syncthreads(); STAMP(4);
            for (int u = o_bid(); u < 256; u += o_grid()) s5_unit(lds, l, u >> 4, u & 15);
#ifdef DBL_S5
            __syncthreads(); for (int u = o_bid(); u < 256; u += o_grid()) s5_unit(lds, l, u >> 4, u & 15);
#endif
        } else if (k == 3) {
            gqa_phase(lds, l);
#ifdef DBL_GQA
            __syncthreads(); gqa_phase(lds, l);
#endif
            __syncthreads(); STAMP(7);
            ph_d2(lds, l); STAMP(8);
            ph_glu(lds, l);
        } else if (k == 5) { if (l == 0) row_update<0>(); else row_update<2>(); }
        else { if (l == 0) row_update<1>(); else row_update<3>(); }
        if (k == 1) { __syncthreads(); }
        else if (step != 19) {
            XcdBarrier xb; xb.bar = (unsigned*)(kargs().ws + WS_BAR); xb.x = xb_xcc_id(); xb.st = (volatile LAS unsigned*)(lds + LDS_BARST);
            xcd_barrier(xb);
        }
        STAMP(lbl);
    }
}

extern "C" void kernel_launch(void* const* d_in, const int* in_sizes, int n_in, void* d_out, int out_size, void* d_ws, size_t ws_size, hipStream_t stream) {
    static int grid = 0;
    if (grid == 0) {
        if (n_in != 28 || ws_size < WS_END) { fprintf(stderr, "kernel_launch: unexpected n_in %d / ws_size %zu (need %zu)\n", n_in, ws_size, (size_t)WS_END); grid = -1; return; }
        int dev = 0, cus = 0, per_cu = 0;
        hipGetDevice(&dev); hipDeviceGetAttribute(&cus, hipDeviceAttributeMultiprocessorCount, dev);
        if (hipFuncSetAttribute((const void*)fwd_megakernel, hipFuncAttributeMaxDynamicSharedMemorySize, LDS_BYTES) != hipSuccess) { fprintf(stderr, "kernel_launch: hipFuncSetAttribute failed\n"); }
        if (hipOccupancyMaxActiveBlocksPerMultiprocessor(&per_cu, (const void*)fwd_megakernel, 512, LDS_BYTES) != hipSuccess || per_cu < 1) { fprintf(stderr, "kernel_launch: occupancy query says %d\n", per_cu); per_cu = 1; }
        (void)hipGetLastError();
        grid = cus * (per_cu > 1 ? 1 : per_cu);
        if (grid <= 0) grid = 256;
    }
    if (grid < 0) return;
    if (hipMemsetAsync((char*)d_ws + WS_BAR, 0, XCD_BAR_WORDS * 4, stream) != hipSuccess) { fprintf(stderr, "kernel_launch: hipMemsetAsync of the barrier words failed\n"); return; }
    Args a{};
    for (int i = 0; i < 28; ++i) a.in[i] = (const float*)d_in[i];
    a.out = (float*)d_out; a.ws = (unsigned char*)d_ws;
    void* args[] = {&a};
    hipError_t e = hipLaunchCooperativeKernel((const void*)fwd_megakernel, dim3(grid), dim3(512), args, LDS_BYTES, stream);
    if (e != hipSuccess) fprintf(stderr, "cooperative launch failed: %s (grid %d)\n", hipGetErrorString(e), grid);
}
```

```cpp
#include <hip/hip_runtime.h>
#include <hip/hip_cooperative_groups.h>
#include <cstdio>
#include <cstdint>
namespace cg = cooperative_groups;
namespace pg8 {
#define PG8_LAS __attribute__((address_space(3)))
typedef unsigned short bf16_t;
typedef short bf16x8 __attribute__((ext_vector_type(8)));
typedef float f32x4 __attribute__((ext_vector_type(4)));
typedef unsigned u32x4 __attribute__((ext_vector_type(4)));
constexpr int BM = 256, BK = 64, HALF = 128, HTB = HALF * BK * 2  , STAGE_BYTES = 8 * HTB, NXCD = 8, WGM = 8;

__host__ __device__ __forceinline__ int lds_byte(int r, int c) { const int st = (r >> 4) * 2 + (c >> 5), rr = r & 15, cc = c & 31, ob = rr * 64 + cc * 2; return st * 1024 + (ob ^ (((ob >> 9) & 1) << 5)); }
__host__ __device__ __forceinline__ void stage_rc(int b, int& R, int& C) { const int st = b / 1024, sb = b % 1024, swz = sb ^ (((sb >> 9) & 1) << 5); R = (st >> 1) * 16 + swz / 64; C = (st & 1) * 32 + (swz % 64) / 2; }
__host__ __device__ __forceinline__ int perm32(int rho) { const int n = rho >> 4, i = rho & 15; return 8 * (i >> 2) + 4 * n + (i & 3); }

struct Unit { int pm, pn; };
struct Gemm { const bf16_t* A; const bf16_t* Bt; int M, N, K, lda, ldb; long tsB; int ksplit; long kjumpB; };

struct StaticOrder {
    int nM, nN, nwg, G, c;
    __host__ __device__ void init(int M, int N, int G_, int c_) { nM = M / BM; nN = N / BM; nwg = nM * nN; G = G_; c = c_; }
    __host__ __device__ bool next(int i, Unit& u) const {
        const long L = (long)i * G + c; if (L >= nwg) return false;
        int wgid = (int)L; { const int q = nwg / NXCD, r = nwg % NXCD, xcd = wgid % NXCD, off = wgid / NXCD; wgid = (xcd < r ? xcd * (q + 1) : r * (q + 1) + (xcd - r) * q) + off; }
        const int nig = WGM * nN, gid = wgid / nig, fm = gid * WGM, gsz = (nM - fm) < WGM ? (nM - fm) : WGM;
        u.pm = fm + ((wgid % nig) % gsz); u.pn = (wgid % nig) / gsz; return true;
    }
    __device__ __forceinline__ void a_ready(const Unit&) const {}
    __device__ __forceinline__ void done(const Unit&) const {}
};
__device__ __forceinline__ unsigned cvt_pk_bf16(float lo, float hi) { unsigned r; asm volatile("v_cvt_pk_bf16_f32 %0, %1, %2" : "=v"(r) : "v"(lo), "v"(hi)); return r; }
template <class Epi, class Sched, bool ALIGN_EPI = false, bool SP2 = false>
__device__ __forceinline__ void gemm_phase(PG8_LAS unsigned char* lds, const Gemm g, const Sched& S, const Epi& E) {
    int tid_ = threadIdx.x; asm volatile("" : "+v"(tid_));
    const int tid = tid_, wid = __builtin_amdgcn_readfirstlane(tid >> 6), lane = tid & 63, wr = wid >> 2, wc = wid & 3, fr = lane & 15, fq = lane >> 4;
    const int K = g.K, nt = K / BK;
    unsigned voffA[2], voffB[2];
#pragma unroll
    for (int i = 0; i < 2; ++i) { int R, C; stage_rc(tid * 16 + i * 8192, R, C); const int Rb = Epi::PERM ? ((R & ~31) + perm32(R & 31)) : R;
        voffA[i] = (unsigned)(R * g.lda + C) * 2u; voffB[i] = (unsigned)(Rb * g.ldb + C) * 2u; }
    const size_t kstep = (size_t)(BK * 2);
    const size_t hstepA = (size_t)HALF * g.lda * 2, hstepB = (size_t)HALF * g.ldb * 2;
    const size_t tstepA = 2 * hstepA, tstepB = (size_t)g.tsB;
    const unsigned ldsw = (unsigned)wid * 1024u;
    const int aoff = lds_byte(wr * 64 + fr, fq * 8), boff = lds_byte(wc * 32 + fr, fq * 8);
#define PG8_SA(b, h) (((b) * 2 + (h)) * HTB)
#define PG8_SB(b, h) ((4 + (b) * 2 + (h)) * HTB)
#define PG8_STAGE(bufoff, gbase, voff) do { _Pragma("unroll") for (int _i = 0; _i < 2; ++_i) \
        __builtin_amdgcn_global_load_lds((const unsigned*)((const char*)(gbase) + (voff)[_i]), (PG8_LAS unsigned*)(lds + (bufoff) + ldsw + _i * 8192), 16, 0, 0); } while (0)
#define PG8_LDA(dst, b, h) do { _Pragma("unroll") for (int m = 0; m < 4; ++m) _Pragma("unroll") for (int k = 0; k < 2; ++k) dst[m][k] = *(const PG8_LAS bf16x8*)(lds + PG8_SA(b, h) + aoff + m * 2048 + k * 1024); } while (0)
#define PG8_LDB(dst, b, h) do { _Pragma("unroll") for (int n = 0; n < 2; ++n) _Pragma("unroll") for (int k = 0; k < 2; ++k) dst[n][k] = *(const PG8_LAS bf16x8*)(lds + PG8_SB(b, h) + boff + n * 2048 + k * 1024); } while (0)
#define PG8_MMA(ai, bj, At, Bt) do { __builtin_amdgcn_s_setprio(1); _Pragma("unroll") for (int m = 0; m < 4; ++m) _Pragma("unroll") for (int n = 0; n < 2; ++n) _Pragma("unroll") for (int k = 0; k < 2; ++k) \
        acc[ai][bj][m][n] = __builtin_amdgcn_mfma_f32_16x16x32_bf16(Bt[n][k], At[m][k], acc[ai][bj][m][n], 0, 0, 0); __builtin_amdgcn_s_setprio(0); } while (0)
#define PG8_WAIT_V(n) asm volatile("s_waitcnt vmcnt(" #n ")" ::: "memory")
#define PG8_WAIT_L(n) asm volatile("s_waitcnt lgkmcnt(" #n ")" ::: "memory")
#define PG8_BAR __builtin_amdgcn_s_barrier()
#define PG8_SCHED __builtin_amdgcn_sched_barrier(0)
    Unit cur, nxt; int ui = 0;
    if (!S.next(0, cur)) return;
    f32x4 acc[2][2][4][2];
#pragma unroll
    for (int a = 0; a < 2; ++a)
#pragma unroll
        for (int b = 0; b < 2; ++b)
#pragma unroll
            for (int m = 0; m < 4; ++m)
#pragma unroll
                for (int n = 0; n < 2; ++n) acc[a][b][m][n] = (f32x4){0.f, 0.f, 0.f, 0.f};
    bf16x8 At[4][2], B0[2][2], B1[2][2];
    const char* cA = (const char*)g.A + (size_t)cur.pm * tstepA; const char* cB = (const char*)g.Bt + (size_t)cur.pn * tstepB;
    S.a_ready(cur);
    if constexpr (SP2) {
        PG8_STAGE(PG8_SB(0, 0), cB, voffB); PG8_STAGE(PG8_SB(0, 1), cB + hstepB, voffB); PG8_STAGE(PG8_SA(0, 0), cA, voffA); PG8_STAGE(PG8_SA(0, 1), cA + hstepA, voffA);
        if (wr == 1) PG8_BAR;
        PG8_WAIT_V(2); PG8_BAR;
        PG8_STAGE(PG8_SB(1, 0), cB + kstep, voffB); PG8_STAGE(PG8_SA(1, 0), cA + kstep, voffA); PG8_STAGE(PG8_SB(1, 1), cB + hstepB + kstep, voffB);
        PG8_WAIT_V(6); PG8_BAR;
    } else {
        PG8_STAGE(PG8_SB(0, 0), cB, voffB); PG8_STAGE(PG8_SA(0, 0), cA, voffA); PG8_STAGE(PG8_SB(0, 1), cB + hstepB, voffB); PG8_STAGE(PG8_SA(0, 1), cA + hstepA, voffA);
        if (wr == 1) PG8_BAR;
        PG8_WAIT_V(4); PG8_BAR;
        PG8_STAGE(PG8_SB(1, 0), cB + kstep, voffB); PG8_STAGE(PG8_SA(1, 0), cA + kstep, voffA); PG8_STAGE(PG8_SB(1, 1), cB + hstepB + kstep, voffB);
        PG8_WAIT_V(6); PG8_BAR;
    }
    for (;;) {
        const bool has_next = S.next(ui + 1, nxt);
        const char* nA = has_next ? (const char*)g.A + (size_t)nxt.pm * tstepA : cA; const char* nB = has_next ? (const char*)g.Bt + (size_t)nxt.pn * tstepB : cB;
        for (int t = 0; t < nt; t += 2) {
            const bool last = (t == nt - 2);
            const char* a1 = cA + (size_t)(t + 1) * kstep;
            const char* a2 = last ? nA : cA + (size_t)(t + 2) * kstep; const char* b2 = last ? nB : cB + (size_t)(t + 2) * kstep + ((t + 2) >= g.ksplit ? g.kjumpB : 0);
            const char* a3 = a2 + kstep; const char* b3 = b2 + kstep;
            if (last && has_next) S.a_ready(nxt);
            if constexpr (SP2) {
            PG8_LDB(B0, 0, 0); PG8_LDB(B1, 0, 1); PG8_SCHED; PG8_LDA(At, 0, 0); PG8_STAGE(PG8_SA(1, 1), a1 + hstepA, voffA);
            PG8_WAIT_V(8); PG8_WAIT_L(0); PG8_BAR; PG8_MMA(0, 0, At, B0); PG8_MMA(0, 1, At, B1); PG8_BAR; PG8_SCHED;
            PG8_LDA(At, 0, 1); PG8_STAGE(PG8_SB(0, 0), b2, voffB); PG8_STAGE(PG8_SB(0, 1), b2 + hstepB, voffB); PG8_STAGE(PG8_SA(0, 0), a2, voffA);
            PG8_WAIT_V(8); PG8_WAIT_L(0); PG8_BAR; PG8_MMA(1, 0, At, B0); PG8_MMA(1, 1, At, B1); PG8_BAR; PG8_SCHED;
            PG8_LDB(B0, 1, 0); PG8_LDB(B1, 1, 1); PG8_SCHED; PG8_LDA(At, 1, 0); PG8_STAGE(PG8_SA(0, 1), a2 + hstepA, voffA);
            PG8_WAIT_V(8); PG8_WAIT_L(0); PG8_BAR; PG8_MMA(0, 0, At, B0); PG8_MMA(0, 1, At, B1); PG8_BAR; PG8_SCHED;
            PG8_LDA(At, 1, 1); PG8_STAGE(PG8_SB(1, 0), b3, voffB); PG8_STAGE(PG8_SB(1, 1), b3 + hstepB, voffB); PG8_STAGE(PG8_SA(1, 0), a3, voffA);
            PG8_WAIT_V(8); PG8_WAIT_L(0); PG8_BAR; PG8_MMA(1, 0, At, B0); PG8_MMA(1, 1, At, B1); PG8_BAR; PG8_SCHED;
            } else {
            PG8_LDB(B0, 0, 0); PG8_SCHED; PG8_LDA(At, 0, 0); PG8_STAGE(PG8_SA(1, 1), a1 + hstepA, voffA);
            PG8_WAIT_L(8); PG8_BAR; PG8_WAIT_L(0); PG8_MMA(0, 0, At, B0); PG8_BAR; PG8_SCHED;
            PG8_LDB(B1, 0, 1); PG8_STAGE(PG8_SB(0, 0), b2, voffB);
            PG8_BAR; PG8_WAIT_L(0); PG8_MMA(0, 1, At, B1); PG8_BAR;
            PG8_LDA(At, 0, 1); PG8_STAGE(PG8_SA(0, 0), a2, voffA);
            PG8_BAR; PG8_WAIT_L(0); PG8_MMA(1, 0, At, B0); PG8_BAR; PG8_SCHED;
            PG8_STAGE(PG8_SB(0, 1), b2 + hstepB, voffB);
            PG8_WAIT_V(6); PG8_BAR; PG8_MMA(1, 1, At, B1); PG8_BAR;
            PG8_LDB(B0, 1, 0); PG8_SCHED; PG8_LDA(At, 1, 0); PG8_STAGE(PG8_SA(0, 1), a2 + hstepA, voffA);
            PG8_WAIT_L(8); PG8_BAR; PG8_WAIT_L(0); PG8_MMA(0, 0, At, B0); PG8_BAR; PG8_SCHED;
            PG8_LDB(B1, 1, 1); PG8_STAGE(PG8_SB(1, 0), b3, voffB);
            PG8_BAR; PG8_WAIT_L(0); PG8_MMA(0, 1, At, B1); PG8_BAR;
            PG8_LDA(At, 1, 1); PG8_STAGE(PG8_SA(1, 0), a3, voffA);
            PG8_BAR; PG8_WAIT_L(0); PG8_MMA(1, 0, At, B0); PG8_BAR; PG8_SCHED;
            PG8_STAGE(PG8_SB(1, 1), b3 + hstepB, voffB);
            PG8_WAIT_V(6); PG8_BAR; PG8_MMA(1, 1, At, B1); PG8_BAR;
            }
        }
        if constexpr (ALIGN_EPI) { if (wr == 0) PG8_BAR; }
        if constexpr (!Epi::AFTER_DRAIN) { E(acc, cur, wr, wc, fr, fq); S.done(cur); }
        if (!has_next) break;
#pragma unroll
        for (int a = 0; a < 2; ++a)
#pragma unroll
            for (int b = 0; b < 2; ++b)
#pragma unroll
                for (int m = 0; m < 4; ++m)
#pragma unroll
                    for (int n = 0; n < 2; ++n) acc[a][b][m][n] = (f32x4){0.f, 0.f, 0.f, 0.f};
        cur = nxt; cA = nA; cB = nB; ++ui;
        if constexpr (ALIGN_EPI) { if (wr == 1) PG8_BAR; }
    }
    PG8_WAIT_V(0);
    if constexpr (!ALIGN_EPI) { if (wr == 0) PG8_BAR; }
    PG8_BAR;
    if constexpr (Epi::AFTER_DRAIN) { E.fused(acc, cur, wr, wc, fr, fq, lds, wid, lane); S.done(cur); }
#undef PG8_SA
#undef PG8_SB
#undef PG8_STAGE
#undef PG8_LDA
#undef PG8_LDB
#undef PG8_MMA
#undef PG8_WAIT_V
#undef PG8_WAIT_L
#undef PG8_BAR
#undef PG8_SCHED
}
}
#define LAS __attribute__((address_space(3)))
typedef unsigned short bf16;
typedef unsigned v4u __attribute__((ext_vector_type(4)));
typedef unsigned v2u __attribute__((ext_vector_type(2)));
typedef float f32x4 __attribute__((ext_vector_type(4)));
typedef float f32x16 __attribute__((ext_vector_type(16)));
typedef short bf16x8 __attribute__((ext_vector_type(8)));
typedef short s16x4 __attribute__((ext_vector_type(4)));

constexpr int DM = 1024, NB = 16, SEQ = 2048, CTXL = 256, MLAT = NB * SEQ, MCTX = NB * CTXL, MT = MLAT + MCTX, INW = 1792, DFF = 4096;
constexpr int OFF_AQ = 0, OFF_AK = 256, OFF_AV = 384, OFF_S5 = 512, OFF_NQ = 768, OFF_NK = 1024, OFF_NV = 1280, OFF_FN = 1536;
constexpr float EPSN = 1e-6f;
constexpr float LOG2E = 1.4426950408889634f;
constexpr size_t MiB = 1u << 20;
constexpr size_t WS_MOD = 0;
constexpr size_t WS_ROPE = 1 * MiB;
constexpr size_t WS_W = 2 * MiB, W_LAYER = 22 * MiB;
constexpr size_t WO_IN = 0, WO_OUT = WO_IN + (size_t)INW * DM * 2, WO_1 = WO_OUT + (size_t)DM * DM * 2, WO_2 = WO_1 + (size_t)DFF * DM * 2,
                 WO_GLU = WO_2 + (size_t)DFF * DM * 2, WO_CS = WO_GLU + 256 * 256 * 2, WO_END = WO_CS + 512 * 256 * 2;
static_assert(WO_END <= W_LAYER, "weights");
constexpr size_t WS_DFT = 46 * MiB, WS_DFTC = 62 * MiB, WS_XC = 64 * MiB, WS_XN = 80 * MiB;
constexpr size_t WS_T = 116 * MiB, WS_C1 = 350 * MiB;
constexpr size_t WS_Z = 152 * MiB, WS_CAT = 278 * MiB, WS_Y = 350 * MiB, WS_HMID = 152 * MiB, WS_Y0 = 440 * MiB, WS_Y1 = 476 * MiB, WS_END = 512 * MiB;
constexpr int LDS_BYTES = 147456;

struct Args { const float* in[28]; float* out; unsigned char* ws; };
typedef __attribute__((address_space(4))) const Args CArgs;
__device__ __forceinline__ CArgs& kargs() { CArgs* p = (CArgs*)__builtin_amdgcn_kernarg_segment_ptr(); asm volatile("" : "+s"(p)); return *p; }
enum { I_X = 0, I_C, I_CTX, I_CCTX, I_WADA, I_BADA, I_GPREMIX, I_GPOSTMIX, I_GPREMLP, I_GPOSTMLP, I_WIN, I_GQ, I_GK, I_AR, I_AI, I_LDT, I_BR, I_BI, I_CR, I_CI,
       I_S5D, I_WGLU, I_NABIAS, I_WFNET, I_BFNET, I_WOUT, I_W1, I_W2 };

constexpr size_t WS_PROBE = 1 * MiB + 65536;
constexpr size_t WS_BAR = 1 * MiB + 131072;
constexpr int LDS_BARST = 147456 - 64;
#ifdef PROBE
#define STAMP(lbl) do { if (blockIdx.x == 0 && threadIdx.x == 0) { unsigned char* pw_ = kargs().ws + WS_PROBE; const unsigned long long now_ = __builtin_amdgcn_s_memrealtime(); \
    unsigned long long* tp_ = (unsigned long long*)(pw_ + 256); ((float*)pw_)[lbl] += (float)(now_ - *tp_); *tp_ = now_; } } while (0)
#else
#define STAMP(lbl) do {} while (0)
#endif
__device__ __forceinline__ unsigned f2bf(float f) { unsigned u = __builtin_bit_cast(unsigned, f); return (u + 0x7fffu + ((u >> 16) & 1u)) >> 16; }
typedef float f32x2_t __attribute__((ext_vector_type(2))); typedef __bf16 bf16x2_t __attribute__((ext_vector_type(2)));
__device__ __forceinline__ unsigned pk2(float lo, float hi) { const f32x2_t v = {lo, hi}; const bf16x2_t b = __builtin_convertvector(v, bf16x2_t); return __builtin_bit_cast(unsigned, b); }
__device__ __forceinline__ float bflo(unsigned w) { return __builtin_bit_cast(float, w << 16); }
__device__ __forceinline__ float bfhi(unsigned w) { return __builtin_bit_cast(float, w & 0xffff0000u); }
__device__ __forceinline__ float bf2f(bf16 h) { return __builtin_bit_cast(float, (unsigned)h << 16); }
__device__ __forceinline__ int o_bid() { int t = blockIdx.x; asm volatile("" : "+s"(t)); return t; }
__device__ __forceinline__ int o_grid() { int t = gridDim.x; asm volatile("" : "+s"(t)); return t; }
__device__ __forceinline__ float shfl_xor_l(float v, int o, int lane) { return __builtin_bit_cast(float, __builtin_amdgcn_ds_bpermute((lane ^ o) << 2, __builtin_bit_cast(int, v))); }
__device__ __forceinline__ float wave_sum(float v, int lane) {
#pragma unroll
    for (int o = 1; o < 64; o <<= 1) v += shfl_xor_l(v, o, lane);
    return v;
}
__device__ __forceinline__ int crow(int r, int hi) { return (r & 3) + 8 * (r >> 2) + 4 * hi; }

template <class F> struct Epi8 {
    static constexpr bool PERM = true, AFTER_DRAIN = false;
    F f;
    __device__ __forceinline__ void operator()(const pg8::f32x4 (&acc)[2][2][4][2], const pg8::Unit& u, int wr, int wc, int fr, int fq) const {
        asm volatile("" : "+v"(fr), "+v"(fq));
#pragma unroll
        for (int ai = 0; ai < 2; ++ai)
#pragma unroll
            for (int m = 0; m < 4; ++m) {
                const int row = u.pm * 256 + ai * 128 + wr * 64 + m * 16 + fr;
#pragma unroll
                for (int bj = 0; bj < 2; ++bj) { const int col = u.pn * 256 + bj * 128 + wc * 32 + 8 * fq; f(row, col, acc[ai][bj][m][0], acc[ai][bj][m][1]); }
                asm volatile("" ::: "memory"); __builtin_amdgcn_sched_barrier(0);
            }
    }
};
__device__ __forceinline__ v4u pack8(f32x4 a, f32x4 b) { v4u w; w.x = pk2(a[0], a[1]); w.y = pk2(a[2], a[3]); w.z = pk2(b[0], b[1]); w.w = pk2(b[2], b[3]); return w; }
struct FStore { bf16* O; int ldc; int act;
    __device__ __forceinline__ void operator()(int row, int col, f32x4 a, f32x4 b) const {
        if (act == 1) {
#pragma unroll
            for (int i = 0; i < 4; ++i) { float x = a[i] > 0.f ? a[i] : 0.f; a[i] = x * x; float y = b[i] > 0.f ? b[i] : 0.f; b[i] = y * y; } }
        *(v4u*)(O + (size_t)row * ldc + col) = pack8(a, b); } };
struct FD2 { bf16* cat; const float* bias; int rowbase, rowsPerB;
    __device__ __forceinline__ void operator()(int row, int col, f32x4 a, f32x4 b) const {
        const int bb = col >> 8, j = col & 255; const f32x4 b0 = *(const f32x4*)(bias + j), b1 = *(const f32x4*)(bias + j + 4);
        *(v4u*)(cat + ((size_t)(rowbase + bb * rowsPerB + row) * 1024 + 768 + j)) = pack8(a + b0, b + b1); } };
struct FGlu { bf16* cat; const bf16* T;
    __device__ __forceinline__ void operator()(int row, int col, f32x4 a, f32x4 b) const {
        const v4u t = *(const v4u*)(T + (size_t)row * 256 + col);
        float tv[8] = {bflo(t.x), bfhi(t.x), bflo(t.y), bfhi(t.y), bflo(t.z), bfhi(t.z), bflo(t.w), bfhi(t.w)};
#pragma unroll
        for (int i = 0; i < 4; ++i) { a[i] = tv[i] / (1.f + __expf(-a[i])); b[i] = tv[4 + i] / (1.f + __expf(-b[i])); }
        *(v4u*)(cat + (size_t)row * 1024 + 256 + col) = pack8(a, b); } };
__device__ __forceinline__ void transpose_item(const float* W, int K, int N, bf16* WT, LAS float* scr, int item, int lane) {
    const int nblk = N / 32, kb = item / nblk, nb = item % nblk, k0 = 64 * kb, n0 = 32 * nb;
#pragma unroll
    for (int i = 0; i < 8; ++i) { const int kk = 8 * i + (lane >> 3), n4 = (lane & 7) * 4; const f32x4 v = *(const f32x4*)(W + (size_t)(k0 + kk) * N + n0 + n4);
        scr[kk * 33 + n4] = v[0]; scr[kk * 33 + n4 + 1] = v[1]; scr[kk * 33 + n4 + 2] = v[2]; scr[kk * 33 + n4 + 3] = v[3]; }
    asm volatile("s_waitcnt lgkmcnt(0)" ::: "memory");
    const int c = lane & 7;
#pragma unroll
    for (int j = 0; j < 4; ++j) { const int n = (lane >> 3) + 8 * j; const LAS float* s = scr + (8 * c) * 33 + n;
        v4u o; o.x = pk2(s[0 * 33], s[1 * 33]); o.y = pk2(s[2 * 33], s[3 * 33]); o.z = pk2(s[4 * 33], s[5 * 33]); o.w = pk2(s[6 * 33], s[7 * 33]);
        *(v4u*)(WT + (size_t)(n0 + n) * K + k0 + 8 * c) = o; }
    asm volatile("s_waitcnt lgkmcnt(0)" ::: "memory");
}

__device__ __forceinline__ void prologue(LAS unsigned char* lds) {
    CArgs& a = kargs();
    int tid_ = threadIdx.x; asm volatile("" : "+v"(tid_));
    const int tid = tid_, lane = tid & 63, wid = tid >> 6, G = o_grid();
    unsigned char* ws = a.ws;
    {
        LAS float* scr = (LAS float*)(lds + wid * 16384);
        const int gw = o_bid() * 8 + wid, NGW = G * 8;
        constexpr int I0 = (DM / 64) * (INW / 32), I1 = (DM / 64) * (DM / 32), I2 = (DM / 64) * (DFF / 32), I3 = (DFF / 64) * (DM / 32), I4 = (256 / 64) * (256 / 32);
        constexpr int PER = I0 + I1 + I2 + I3 + I4;
        for (int it = gw; it < 2 * PER; it += NGW) {
            const int l = it / PER; int r = it % PER; unsigned char* wb = ws + WS_W + (size_t)l * W_LAYER;
            if (r < I0) { transpose_item(a.in[I_WIN] + (size_t)l * DM * INW, DM, INW, (bf16*)(wb + WO_IN), scr, r, lane); continue; } r -= I0;
            if (r < I1) { transpose_item(a.in[I_WOUT] + (size_t)l * DM * DM, DM, DM, (bf16*)(wb + WO_OUT), scr, r, lane); continue; } r -= I1;
            if (r < I2) { transpose_item(a.in[I_W1] + (size_t)l * DM * DFF, DM, DFF, (bf16*)(wb + WO_1), scr, r, lane); continue; } r -= I2;
            if (r < I3) { transpose_item(a.in[I_W2] + (size_t)l * DFF * DM, DFF, DM, (bf16*)(wb + WO_2), scr, r, lane); continue; } r -= I3;
            transpose_item(a.in[I_WGLU] + (size_t)l * 256 * 256, 256, 256, (bf16*)(wb + WO_GLU), scr, r, lane);
        }
    }
    __syncthreads();
    {
        LAS float* sl = (LAS float*)lds;
        LAS float* part = (LAS float*)(lds + 17 * 1024 * 4);
        float* mod = (float*)(ws + WS_MOD);
        bool have = false;
        for (int u = o_bid(); u < 2 * 96; u += G) {
            if (!have) {
                for (int i = tid; i < 17 * 1024; i += 512) { const float cv = i < 16 * 1024 ? a.in[I_C][i] : a.in[I_CCTX][i - 16 * 1024]; sl[i] = cv / (1.f + __expf(-cv)); }
                have = true; __syncthreads();
            }
            const int l = u / 96, n0 = (u % 96) * 64;
            const float* W = a.in[I_WADA] + (size_t)l * DM * 6144 + n0 + lane;
            float acc[17];
#pragma unroll
            for (int i = 0; i < 17; ++i) acc[i] = 0.f;
            for (int k0 = wid * 128; k0 < wid * 128 + 128; k0 += 16) {
                float wv[16];
#pragma unroll
                for (int q = 0; q < 16; ++q) wv[q] = W[(size_t)(k0 + q) * 6144];
#pragma unroll
                for (int q = 0; q < 16; ++q)
#pragma unroll
                    for (int i = 0; i < 17; ++i) acc[i] += sl[i * 1024 + k0 + q] * wv[q];
            }
#pragma unroll
            for (int i = 0; i < 17; ++i) part[(wid * 17 + i) * 64 + lane] = acc[i];
            __syncthreads();
            for (int o = tid; o < 17 * 64; o += 512) {
                const int i = o >> 6, n = o & 63; float s = a.in[I_BADA][l * 6144 + n0 + n];
#pragma unroll
                for (int w = 0; w < 8; ++w) s += part[(w * 17 + i) * 64 + n];
                mod[((size_t)l * 17 + i) * 6144 + n0 + n] = s;
            }
            __syncthreads();
        }
    }
    {
        const size_t gt = (size_t)o_bid() * 512 + tid, NT = (size_t)G * 512;
        bf16* dft = (bf16*)(ws + WS_DFT);
        for (size_t i = gt; i < (size_t)2048 * 4096 / 8; i += NT) {
            const int kk = (int)(i / 512), n0 = (int)(i % 512) * 8; float v[8];
#pragma unroll
            for (int j = 0; j < 8; ++j) { const int n = n0 + j, nn = n & 2047; const float fr = (float)((kk * nn) & 2047) * (1.f / 2048.f);
                v[j] = (n < 2048 ? __builtin_amdgcn_cosf(fr) : -__builtin_amdgcn_sinf(fr)) * 0.02209708691207961f; }
            v4u o; o.x = pk2(v[0], v[1]); o.y = pk2(v[2], v[3]); o.z = pk2(v[4], v[5]); o.w = pk2(v[6], v[7]);
            *(v4u*)(dft + i * 8) = o;
        }
        bf16* dftc = (bf16*)(ws + WS_DFTC);
        for (size_t i = gt; i < (size_t)256 * 512 / 8; i += NT) {
            const int kk = (int)(i / 64), n0 = (int)(i % 64) * 8; float v[8];
#pragma unroll
            for (int j = 0; j < 8; ++j) { const int n = n0 + j, nn = n & 255; const float fr = (float)((kk * nn) & 255) * (1.f / 256.f);
                v[j] = (n < 256 ? __builtin_amdgcn_cosf(fr) : -__builtin_amdgcn_sinf(fr)) * 0.0625f; }
            v4u o; o.x = pk2(v[0], v[1]); o.y = pk2(v[2], v[3]); o.z = pk2(v[4], v[5]); o.w = pk2(v[6], v[7]);
            *(v4u*)(dftc + i * 8) = o;
        }
        for (size_t i = gt; i < (size_t)2 * 512 * 256; i += NT) {
            const int l = (int)(i / (512 * 256)), rem = (int)(i % (512 * 256)), jp = rem >> 8, cin = rem & 255, j = jp & 255, part = jp >> 8;
            const float* W = a.in[I_WFNET] + (size_t)l * 256 * 256 + (size_t)(cin >> 6) * 64 * 256 + j; const int c = cin & 63; float s = 0.f;
            for (int cp0 = 0; cp0 < 64; cp0 += 16) { float wv[16];
#pragma unroll
                for (int q = 0; q < 16; ++q) wv[q] = W[(size_t)(cp0 + q) * 256];
#pragma unroll
                for (int q = 0; q < 16; ++q) { const float fr = (float)((c * (cp0 + q)) & 63) * (1.f / 64.f); s += (part ? __builtin_amdgcn_sinf(fr) : __builtin_amdgcn_cosf(fr)) * wv[q]; } }
            ((bf16*)(ws + WS_W + (size_t)l * W_LAYER + WO_CS))[(size_t)jp * 256 + cin] = (bf16)f2bf(s * 0.125f);
        }
        float2* rope = (float2*)(ws + WS_ROPE);
        for (size_t i = gt; i < 1024; i += NT) { const int pos = (int)i >> 4, k = (int)i & 15; const float inv = exp2f(-(float)k * (13.287712379549449f / 16.f)); const float ang = (float)pos * inv;
            float sn, cs; sincosf(ang, &sn, &cs); rope[i] = make_float2(cs, sn); }
    }
}

__device__ __forceinline__ void prep_rows0() {
    CArgs& a = kargs();
    int tid_ = threadIdx.x; asm volatile("" : "+v"(tid_));
    const int lane = tid_ & 63, gw = o_bid() * 8 + (tid_ >> 6), NGW = o_grid() * 8;
    const float* mod = (const float*)(a.ws + WS_MOD); bf16* XN = (bf16*)(a.ws + WS_XN); const float* gp = a.in[I_GPREMIX];
    f32x4 vn[4];
    auto rload = [&](int row) { const float* xr = row < MLAT ? a.in[I_X] + (size_t)row * DM : a.in[I_CTX] + (size_t)(row - MLAT) * DM;
#pragma unroll
        for (int j = 0; j < 4; ++j) vn[j] = *(const f32x4*)(xr + 4 * lane + 256 * j); };
    if (gw < MT) rload(gw);
    for (int row = gw; row < MT; row += NGW) {
        const int bi = row < MLAT ? row >> 11 : 16;
        const float* mb = mod + (size_t)bi * 6144;
        f32x4 v[4]; float ss = 0.f;
#pragma unroll
        for (int j = 0; j < 4; ++j) { v[j] = vn[j]; ss += v[j][0] * v[j][0] + v[j][1] * v[j][1] + v[j][2] * v[j][2] + v[j][3] * v[j][3]; }
        if (row + NGW < MT) rload(row + NGW);
        const float rstd = rsqrtf(wave_sum(ss, lane) * (1.f / DM) + EPSN);
#pragma unroll
        for (int j = 0; j < 4; ++j) { const int k = 4 * lane + 256 * j; const f32x4 g = *(const f32x4*)(gp + k), sh = *(const f32x4*)(mb + k), sc = *(const f32x4*)(mb + 1024 + k);
            f32x4 o;
#pragma unroll
            for (int e = 0; e < 4; ++e) o[e] = (v[j][e] * rstd * g[e]) * (1.f + sc[e]) + sh[e];
            v2u w; w.x = pk2(o[0], o[1]); w.y = pk2(o[2], o[3]); *(v2u*)(XN + (size_t)row * DM + k) = w; }
    }
}
template <int WHICH>
__device__ __forceinline__ void row_update() {
    CArgs& a = kargs();
    constexpr int l = WHICH >> 1; constexpr bool MLP = WHICH & 1; constexpr bool NXT = WHICH != 3;
    const int nrows = l == 0 ? MT : MLAT;
    const bf16* Y = (const bf16*)(a.ws + (MLP ? WS_XN : WS_Y)); bf16* OB = (bf16*)(a.ws + WS_XN);
    const float* xlat_in = WHICH == 0 ? a.in[I_X] : a.out; const float* xctx_in = WHICH == 0 ? a.in[I_CTX] : (const float*)(a.ws + WS_XC);
    float* xlat_out = a.out; float* xctx_out = (float*)(a.ws + WS_XC);
    const float* mod = (const float*)(a.ws + WS_MOD);
    const float* modl = mod + (size_t)l * 17 * 6144; constexpr int gate_i = MLP ? 5 : 2;
    const float* gpost = (MLP ? a.in[I_GPOSTMLP] : a.in[I_GPOSTMIX]) + l * DM;
    const float* modn = MLP ? mod + (size_t)17 * 6144 : modl; constexpr int sh_i = MLP ? 0 : 3, sc_i = MLP ? 1 : 4;
    const float* gnext = MLP ? a.in[I_GPREMIX] + DM : a.in[I_GPREMLP] + l * DM;
    int tid_ = threadIdx.x; asm volatile("" : "+v"(tid_));
    const int lane = tid_ & 63, gw = o_bid() * 8 + (tid_ >> 6), NGW = o_grid() * 8;
    v2u ywn[4]; f32x4 xn[4];
    auto rload = [&](int row) {
        const bool lat = row < MLAT; const float* xr = lat ? xlat_in + (size_t)row * DM : xctx_in + (size_t)(row - MLAT) * DM;
#pragma unroll
        for (int j = 0; j < 4; ++j) { const int k = 4 * lane + 256 * j; ywn[j] = *(const v2u*)(Y + (size_t)row * DM + k); xn[j] = *(const f32x4*)(xr + k); } };
    if (gw < nrows) rload(gw);
    for (int row = gw; row < nrows; row += NGW) {
        const bool lat = row < MLAT; const int bi = lat ? row >> 11 : 16;
        float* xo = lat ? xlat_out + (size_t)row * DM : xctx_out + (size_t)(row - MLAT) * DM;
        const float* gate = modl + (size_t)bi * 6144 + gate_i * 1024;
        f32x4 y[4], x[4]; float ss = 0.f;
#pragma unroll
        for (int j = 0; j < 4; ++j) { const v2u w = ywn[j]; y[j] = (f32x4){bflo(w.x), bfhi(w.x), bflo(w.y), bfhi(w.y)}; x[j] = xn[j];
            ss += y[j][0] * y[j][0] + y[j][1] * y[j][1] + y[j][2] * y[j][2] + y[j][3] * y[j][3]; }
        if (row + NGW < nrows) rload(row + NGW);
        const float rstd = rsqrtf(wave_sum(ss, lane) * (1.f / DM) + EPSN); float s2 = 0.f;
#pragma unroll
        for (int j = 0; j < 4; ++j) { const int k = 4 * lane + 256 * j; const f32x4 g = *(const f32x4*)(gpost + k), gt = *(const f32x4*)(gate + k);
#pragma unroll
            for (int e = 0; e < 4; ++e) { x[j][e] = x[j][e] + gt[e] * (y[j][e] * rstd * g[e]); s2 += x[j][e] * x[j][e]; }
#ifdef PROBE
            if (WHICH == 3) { const float* pa = (const float*)(a.ws + WS_PROBE); float tot = 0.f, fa = 0.f, fb = 0.f;
                for (int i = 0; i < 15; ++i) { const float v = pa[i]; tot += v; if ((PROBE_A >> i) & 1) fa += v; if ((PROBE_B >> i) & 1) fb += v; }
                fa /= tot; fb /= tot; const float e = fa < 0.02f ? 0.02f : fa;
                for (int q = 0; q < 4; ++q) x[j][q] *= (1.f + e);
                if (row == 0 && lane == 0 && j == 0) x[j][0] += 50.f + 1000.f * fb; }
#endif
            *(f32x4*)(xo + k) = x[j]; }
        if (NXT) {
            const float rstd2 = rsqrtf(wave_sum(s2, lane) * (1.f / DM) + EPSN); const float* mb = modn + (size_t)bi * 6144;
#pragma unroll
            for (int j = 0; j < 4; ++j) { const int k = 4 * lane + 256 * j; const f32x4 g = *(const f32x4*)(gnext + k), sh = *(const f32x4*)(mb + sh_i * 1024 + k), sc = *(const f32x4*)(mb + sc_i * 1024 + k);
                f32x4 o;
#pragma unroll
                for (int e = 0; e < 4; ++e) o[e] = (x[j][e] * rstd2 * g[e]) * (1.f + sc[e]) + sh[e];
                v2u w; w.x = pk2(o[0], o[1]); w.y = pk2(o[2], o[3]); *(v2u*)(OB + (size_t)row * DM + k) = w; }
        }
    }
}

__device__ __forceinline__ void qk_prep(int layer) {
    CArgs& a = kargs();
    bf16* Z = (bf16*)(a.ws + WS_Z); const float2* rope = (const float2*)(a.ws + WS_ROPE);
    int tid_ = threadIdx.x; asm volatile("" : "+v"(tid_));
    const int gt = o_bid() * 512 + tid_, NT = o_grid() * 512;
    for (int it = gt; it < MT * 6; it += NT) {
        const int row = it / 6, slot = it % 6; const bool lat = row < MLAT;
        bf16* p = Z + (size_t)row * INW + (slot < 4 ? OFF_AQ + slot * 64 : OFF_AK + (slot - 4) * 64);
        const float* g = (slot < 4 ? a.in[I_GQ] : a.in[I_GK]) + layer * 64;
        float v[64]; float ss = 0.f;
#pragma unroll
        for (int c = 0; c < 8; ++c) { const v4u w = *(const v4u*)(p + 8 * c);
            v[8 * c + 0] = bflo(w.x); v[8 * c + 1] = bfhi(w.x); v[8 * c + 2] = bflo(w.y); v[8 * c + 3] = bfhi(w.y); v[8 * c + 4] = bflo(w.z); v[8 * c + 5] = bfhi(w.z); v[8 * c + 6] = bflo(w.w); v[8 * c + 7] = bfhi(w.w); }
#pragma unroll
        for (int i = 0; i < 64; ++i) ss += v[i] * v[i];
        const float rstd = rsqrtf(ss * (1.f / 64.f) + EPSN);
#pragma unroll
        for (int i = 0; i < 64; ++i) v[i] = v[i] * rstd * g[i];
        if (lat) {
            const int t = row & 2047, gr = t >> 6, gc = t & 63;
#pragma unroll
            for (int i = 0; i < 16; ++i) {
                const float2 cr = rope[gr * 16 + i], cc = rope[gc * 16 + i];
                const float x1 = v[i], x2 = v[16 + i]; v[i] = x1 * cr.x - x2 * cr.y; v[16 + i] = x1 * cr.y + x2 * cr.x;
                const float y1 = v[32 + i], y2 = v[48 + i]; v[32 + i] = y1 * cc.x - y2 * cc.y; v[48 + i] = y1 * cc.y + y2 * cc.x;
            }
        }
#pragma unroll
        for (int c = 0; c < 8; ++c) { v4u w; w.x = pk2(v[8 * c], v[8 * c + 1]); w.y = pk2(v[8 * c + 2], v[8 * c + 3]); w.z = pk2(v[8 * c + 4], v[8 * c + 5]); w.w = pk2(v[8 * c + 6], v[8 * c + 7]); *(v4u*)(p + 8 * c) = w; }
    }
}
struct AttnP { const bf16* Z; bf16* O; int ostride; int qtok0; int qcol; int ocol; int kcol, vcol; int loc0, nloc, ctx0, nctx;
               int na; int qgcol0; int relr0; int head; int act_lo, act_hi; };
template <int NH>
__device__ __forceinline__ void attn_unit(LAS unsigned char* lds, const AttnP& P, const LAS float* biasL) {
    int tid_ = threadIdx.x; asm volatile("" : "+v"(tid_));
    const int tid = tid_, lane = tid & 63, wid = tid >> 6, r32 = lane & 31, hi = lane >> 5;
    const int slot = (NH == 1) ? 0 : (wid >> 1);
    const bf16* Z = P.Z;
    bf16x8 qr[4];
#pragma unroll
    for (int d0 = 0; d0 < 4; ++d0) qr[d0] = *(const bf16x8*)(Z + (size_t)(P.qtok0 + r32) * INW + P.qcol + d0 * 16 + hi * 8);
    const int nt = P.nloc + P.nctx;
    v4u kreg[NH], vreg[NH];
    auto tile_tok = [&](int i) { return i < P.nloc ? P.loc0 + 64 * i : P.ctx0 + 64 * (i - P.nloc); };
    auto gload = [&](int i) { const int tok = tile_tok(i);
#pragma unroll
        for (int s = 0; s < NH; ++s) { kreg[s] = *(const v4u*)(Z + (size_t)(tok + (tid >> 3)) * INW + P.kcol + s * 64 + (tid & 7) * 8);
                                        vreg[s] = *(const v4u*)(Z + (size_t)(tok + lane) * INW + P.vcol + s * 64 + wid * 8); } };
    gload(0);
    f32x16 o0 = {}, o1 = {};
    float m = -1e30f, lsum = 0.f;
    const float sc = 0.125f * LOG2E;
    const int qg = P.qgcol0 + r32; const int cs = qg - 8 < 0 ? 0 : (qg - 8 > 48 ? 48 : qg - 8);
    auto lstore = [&](int bufoff) {
#pragma unroll
        for (int s = 0; s < NH; ++s) {
            LAS unsigned char* sb = lds + bufoff + s * 18432;
            *(LAS v4u*)(sb + ((tid >> 3) * 72 + (tid & 7) * 8) * 2) = kreg[s];
            LAS bf16* vt = (LAS bf16*)(sb + 9216);
            const unsigned w[4] = {vreg[s].x, vreg[s].y, vreg[s].z, vreg[s].w};
#pragma unroll
            for (int e = 0; e < 4; ++e) { vt[(wid * 8 + 2 * e) * 68 + lane] = (bf16)(w[e] & 0xffffu); vt[(wid * 8 + 2 * e + 1) * 68 + lane] = (bf16)(w[e] >> 16); }
        }
    };
    auto compute = [&](int i, int bufoff) {
        if (P.na && i < P.nloc && (i < P.act_lo || i >= P.act_hi)) return;
        const LAS unsigned char* kb = lds + bufoff + slot * 18432; const LAS unsigned char* vb = kb + 9216;
        f32x16 p0 = {}, p1 = {};
#pragma unroll
        for (int d0 = 0; d0 < 4; ++d0) {
            const bf16x8 a0 = *(const LAS bf16x8*)(kb + (r32 * 72 + d0 * 16 + hi * 8) * 2);
            const bf16x8 a1 = *(const LAS bf16x8*)(kb + ((32 + r32) * 72 + d0 * 16 + hi * 8) * 2);
            p0 = __builtin_amdgcn_mfma_f32_32x32x16_bf16(a0, qr[d0], p0, 0, 0, 0);
            p1 = __builtin_amdgcn_mfma_f32_32x32x16_bf16(a1, qr[d0], p1, 0, 0, 0);
        }
        if (P.na && i < P.nloc) {
            const LAS float* bl = biasL + (P.head * 15 + (P.relr0 + i)) * 31;
#pragma unroll
            for (int r = 0; r < 16; ++r) {
                const int kv0 = crow(r, hi), kv1 = kv0 + 32;
                const bool ok0 = (unsigned)(kv0 - cs) < 16u, ok1 = (unsigned)(kv1 - cs) < 16u;
                const int i0 = kv0 - qg + 15, i1 = kv1 - qg + 15;
                const float b0 = bl[i0 < 0 ? 0 : (i0 > 30 ? 30 : i0)], b1 = bl[i1 < 0 ? 0 : (i1 > 30 ? 30 : i1)];
                p0[r] = ok0 ? p0[r] + b0 : -INFINITY; p1[r] = ok1 ? p1[r] + b1 : -INFINITY;
            }
        }
        float mx = fmaxf(fmaxf(p0[0], p0[1]), p1[0]);
#pragma unroll
        for (int r = 2; r < 16; r += 2) mx = fmaxf(fmaxf(mx, p0[r]), p0[r + 1]);
#pragma unroll
        for (int r = 1; r < 15; r += 2) mx = fmaxf(fmaxf(mx, p1[r]), p1[r + 1]);
        mx = fmaxf(mx, p1[15]);
        mx = fmaxf(mx, shfl_xor_l(mx, 32, lane));
        if (__any((mx - m) * sc > 6.f)) {
            const float mn = fmaxf(m, mx), alpha = __builtin_amdgcn_exp2f((m - mn) * sc); m = mn; lsum *= alpha;
#pragma unroll
            for (int r = 0; r < 16; ++r) { o0[r] *= alpha; o1[r] *= alpha; }
        }
        const float nm = -m * sc;
        float ps = 0.f;
#pragma unroll
        for (int r = 0; r < 16; ++r) { p0[r] = __builtin_amdgcn_exp2f(fmaf(p0[r], sc, nm)); p1[r] = __builtin_amdgcn_exp2f(fmaf(p1[r], sc, nm)); ps += p0[r] + p1[r]; }
        lsum += ps;
        bf16x8 pf[4];
#pragma unroll
        for (int s = 0; s < 4; ++s) {
            v4u w;
            if (s < 2) { w.x = pk2(p0[8 * s], p0[8 * s + 1]); w.y = pk2(p0[8 * s + 2], p0[8 * s + 3]); w.z = pk2(p0[8 * s + 4], p0[8 * s + 5]); w.w = pk2(p0[8 * s + 6], p0[8 * s + 7]); }
            else { const int q = s - 2; w.x = pk2(p1[8 * q], p1[8 * q + 1]); w.y = pk2(p1[8 * q + 2], p1[8 * q + 3]); w.z = pk2(p1[8 * q + 4], p1[8 * q + 5]); w.w = pk2(p1[8 * q + 6], p1[8 * q + 7]); }
            pf[s] = __builtin_bit_cast(bf16x8, w);
        }
#pragma unroll
        for (int s = 0; s < 4; ++s) {
            const int kvb = 32 * (s >> 1) + 16 * (s & 1) + 4 * hi;
            {   const LAS unsigned char* va = vb + (r32 * 68 + kvb) * 2;
                const s16x4 lo = *(const LAS s16x4*)va, hh = *(const LAS s16x4*)(va + 16);
                const bf16x8 af = {lo[0], lo[1], lo[2], lo[3], hh[0], hh[1], hh[2], hh[3]};
                o0 = __builtin_amdgcn_mfma_f32_32x32x16_bf16(af, pf[s], o0, 0, 0, 0); }
            {   const LAS unsigned char* va = vb + ((32 + r32) * 68 + kvb) * 2;
                const s16x4 lo = *(const LAS s16x4*)va, hh = *(const LAS s16x4*)(va + 16);
                const bf16x8 af = {lo[0], lo[1], lo[2], lo[3], hh[0], hh[1], hh[2], hh[3]};
                o1 = __builtin_amdgcn_mfma_f32_32x32x16_bf16(af, pf[s], o1, 0, 0, 0); }
        }
        };
    if (NH == 1) {
        __syncthreads();
        lstore(0);
        if (nt > 1) gload(1);
        __syncthreads();
        for (int i = 0; i < nt; ++i) {
            if (i + 1 < nt) { lstore(((i + 1) & 1) * 18432); if (i + 2 < nt) gload(i + 2); }
            compute(i, (i & 1) * 18432);
            __syncthreads();
        }
    } else {
        for (int i = 0; i < nt; ++i) {
            __syncthreads();
            lstore(0);
            __syncthreads();
            if (i + 1 < nt) gload(i + 1);
            compute(i, 0);
        }
    }
    lsum += shfl_xor_l(lsum, 32, lane);
    const float inv = 1.f / lsum;
    bf16* op = P.O + (size_t)(P.qtok0 + r32) * P.ostride + P.ocol;
#pragma unroll
    for (int rg = 0; rg < 4; ++rg) {
        v2u w0, w1;
        w0.x = pk2(o0[4 * rg] * inv, o0[4 * rg + 1] * inv); w0.y = pk2(o0[4 * rg + 2] * inv, o0[4 * rg + 3] * inv);
        w1.x = pk2(o1[4 * rg] * inv, o1[4 * rg + 1] * inv); w1.y = pk2(o1[4 * rg + 2] * inv, o1[4 * rg + 3] * inv);
        *(v2u*)(op + 8 * rg + 4 * hi) = w0; *(v2u*)(op + 32 + 8 * rg + 4 * hi) = w1;
    }
}
__device__ __forceinline__ int s5_tokrow(int s, int dir, int b) {
    if (s < 256) return MLAT + b * 256 + (dir ? 255 - s : s);
    const int t = s - 256; return b * 2048 + (dir ? 2047 - t : t);
}
__device__ __forceinline__ void s5_unit(LAS unsigned char* lds, int layer, int b, int g) {
    CArgs& a = kargs();
    int tid_ = threadIdx.x; asm volatile("" : "+v"(tid_));
    const int tid = tid_, lane = tid & 63, wid = tid >> 6, r32 = lane & 31, hi = lane >> 5;
    LAS float* BuL = (LAS float*)(lds + wid * 17920);
    LAS bf16* HL = (LAS bf16*)(lds + wid * 17920);
    LAS v4u* uL = (LAS v4u*)(lds + wid * 17920 + 8704);
    const bf16* Z = (const bf16*)(a.ws + WS_Z); float* Y0 = (float*)(a.ws + WS_Y0); float* Y1 = (float*)(a.ws + WS_Y1);
    for (int dir = 0; dir < 2; ++dir) {
        const int idx = (layer * 2 + dir) * 16 + g;
        const float dt = expf(a.in[I_LDT][idx]);
        float ar, ai;
        { const float lr = fminf(a.in[I_AR][idx * 64 + lane], -1e-4f), li = a.in[I_AI][idx * 64 + lane]; const float er = expf(lr * dt); float sn, cs; sincosf(li * dt, &sn, &cs); ar = er * cs; ai = er * sn; }
        float pr = ar, pi = ai;
        float p32r, p32i;
#pragma unroll
        for (int k = 0; k < 5; ++k) { const float tr = pr * pr - pi * pi, ti = 2.f * pr * pi; pr = tr; pi = ti; }
        p32r = pr; p32i = pi;
#pragma unroll
        for (int k = 0; k < 3; ++k) { const float tr = pr * pr - pi * pi, ti = 2.f * pr * pi; pr = tr; pi = ti; }
        { const float tr = pr * p32r - pi * p32i, ti = pr * p32i + pi * p32r; pr = tr; pi = ti; }
        bf16x8 bfr[4];
#pragma unroll
        for (int pp = 0; pp < 2; ++pp) {
            const int p2 = 32 * pp + r32;
            const float lr = fminf(a.in[I_AR][idx * 64 + p2], -1e-4f), li = a.in[I_AI][idx * 64 + p2]; const float er = expf(lr * dt); float sn, cs; sincosf(li * dt, &sn, &cs);
            const float xr = er * cs - 1.f, xi = er * sn, den = 1.f / (lr * lr + li * li);
            const float cr = (xr * lr + xi * li) * den, ci = (xi * lr - xr * li) * den;
            const float* br = a.in[I_BR] + ((size_t)idx * 64 + p2) * 16 + 8 * hi; const float* bi = a.in[I_BI] + ((size_t)idx * 64 + p2) * 16 + 8 * hi;
            float re[8], im[8];
#pragma unroll
            for (int j = 0; j < 8; ++j) { const float x = br[j], y = bi[j]; re[j] = cr * x - ci * y; im[j] = cr * y + ci * x; }
            v4u w; w.x = pk2(re[0], re[1]); w.y = pk2(re[2], re[3]); w.z = pk2(re[4], re[5]); w.w = pk2(re[6], re[7]); bfr[pp] = __builtin_bit_cast(bf16x8, w);
            w.x = pk2(im[0], im[1]); w.y = pk2(im[2], im[3]); w.z = pk2(im[4], im[5]); w.w = pk2(im[6], im[7]); bfr[2 + pp] = __builtin_bit_cast(bf16x8, w);
        }
        bf16x8 cfr[8];
        const float cmsk = r32 < 16 ? 1.f : 0.f;
#pragma unroll
        for (int ks = 0; ks < 8; ++ks) {
            const size_t co = ((size_t)idx * 16 + (r32 & 15)) * 64 + 8 * ks + 4 * hi;
            const f32x4 cr4 = *(const f32x4*)(a.in[I_CR] + co), ci4 = *(const f32x4*)(a.in[I_CI] + co);
            v4u w; w.x = pk2(cr4[0] * cmsk, -ci4[0] * cmsk); w.y = pk2(cr4[1] * cmsk, -ci4[1] * cmsk); w.z = pk2(cr4[2] * cmsk, -ci4[2] * cmsk); w.w = pk2(cr4[3] * cmsk, -ci4[3] * cmsk);
            cfr[ks] = __builtin_bit_cast(bf16x8, w);
        }
        float hr = 0.f, him = 0.f;
        float* Yd = dir == 0 ? Y0 : Y1;
        {
            const bf16* ub = Z + OFF_S5 + 16 * g + 8 * hi;
            v4u ur[9];
#pragma unroll
            for (int ch = 0; ch < 9; ++ch) ur[ch] = *(const v4u*)(ub + (size_t)s5_tokrow(wid * 288 + ch * 32 + r32, dir, b) * INW);
#pragma unroll
            for (int ch = 0; ch < 9; ++ch) uL[ch * 64 + lane] = ur[ch];
            asm volatile("s_waitcnt lgkmcnt(0)" ::: "memory");
        }
        for (int pass = 0; pass < 2; ++pass) {
            for (int ch = 0; ch < 9; ++ch) {
                const int s0 = wid * 288 + ch * 32;
                bf16x8 ucur = __builtin_bit_cast(bf16x8, uL[ch * 64 + lane]);
                asm volatile("s_waitcnt lgkmcnt(0)" : "+v"(ucur) :: "memory");
                float bur[32], bui[32];
#pragma unroll
                for (int jb = 0; jb < 2; ++jb) {
                    f32x16 d = {}; d = __builtin_amdgcn_mfma_f32_32x32x16_bf16(ucur, bfr[jb], d, 0, 0, 0);
#pragma unroll
                    for (int r = 0; r < 16; ++r) BuL[crow(r, hi) * 66 + 32 * jb + r32] = d[r];
                }
                asm volatile("s_waitcnt lgkmcnt(0)" : "+v"(ucur) :: "memory");
#pragma unroll
                for (int t = 0; t < 32; ++t) bur[t] = BuL[t * 66 + lane];
                asm volatile("s_waitcnt lgkmcnt(0)" : "+v"(ucur) :: "memory");
#pragma unroll
                for (int jb = 0; jb < 2; ++jb) {
                    f32x16 d = {}; d = __builtin_amdgcn_mfma_f32_32x32x16_bf16(ucur, bfr[2 + jb], d, 0, 0, 0);
#pragma unroll
                    for (int r = 0; r < 16; ++r) BuL[crow(r, hi) * 66 + 32 * jb + r32] = d[r];
                }
                asm volatile("s_waitcnt lgkmcnt(0)" ::: "memory");
#pragma unroll
                for (int t = 0; t < 32; ++t) bui[t] = BuL[t * 66 + lane];
                asm volatile("s_waitcnt lgkmcnt(0)" ::: "memory");
                if (pass == 0) {
#pragma unroll
                    for (int t = 0; t < 32; ++t) { const float nr = ar * hr - ai * him + bur[t], ni = ar * him + ai * hr + bui[t]; hr = nr; him = ni; }
                } else {
#pragma unroll
                    for (int t = 0; t < 32; ++t) { const float nr = ar * hr - ai * him + bur[t], ni = ar * him + ai * hr + bui[t]; hr = nr; him = ni;
                        ((LAS unsigned*)HL)[t * 68 + lane] = pk2(hr, him); }
                    asm volatile("s_waitcnt lgkmcnt(0)" ::: "memory");
                    f32x16 y = {};
#pragma unroll
                    for (int ks = 0; ks < 8; ++ks) { const bf16x8 af = *(const LAS bf16x8*)((const LAS unsigned char*)HL + (r32 * 136 + 16 * ks + 8 * hi) * 2);
                        y = __builtin_amdgcn_mfma_f32_32x32x16_bf16(cfr[ks], af, y, 0, 0, 0); }
                    asm volatile("s_waitcnt lgkmcnt(0)" ::: "memory");
                    if (s0 >= 256 || layer == 0) {
                        float* yp = Yd + (size_t)s5_tokrow(s0 + r32, dir, b) * 256 + 16 * g + 4 * hi;
                        *(f32x4*)yp = (f32x4){y[0], y[1], y[2], y[3]}; *(f32x4*)(yp + 8) = (f32x4){y[4], y[5], y[6], y[7]};
                    }
                }
            }
            if (pass == 0) {
                BuL[lane * 2] = hr; BuL[lane * 2 + 1] = him;
                __syncthreads();
                hr = 0.f; him = 0.f;
                for (int v = 0; v < wid; ++v) { const LAS float* cv = (const LAS float*)(lds + v * 17920); const float cr = cv[lane * 2], ci = cv[lane * 2 + 1]; const float nr = pr * hr - pi * him + cr, ni = pr * him + pi * hr + ci; hr = nr; him = ni; }
                __syncthreads();
            }
        }

    }
}

__device__ __forceinline__ void na_phase(LAS unsigned char* lds, int l) {
    CArgs& a = kargs();
    int tid_ = threadIdx.x; asm volatile("" : "+v"(tid_));
    const int tid = tid_, wid = __builtin_amdgcn_readfirstlane(tid >> 6), G = o_grid(), bid = o_bid();
    bf16* Zb = (bf16*)(a.ws + WS_Z); bf16* CAT = (bf16*)(a.ws + WS_CAT);
    LAS float* biasL = (LAS float*)(lds + 73728);
    for (int i = tid; i < 4 * 15 * 31; i += 512) biasL[i] = 8.f * a.in[I_NABIAS][l * 4 * 15 * 31 + i];
    for (int u = bid; u < 512; u += G) {
        const int b = u >> 5, head = (u >> 3) & 3, rg = u & 7; const int r = 4 * rg + (wid >> 1);
        const int lo = 4 * rg - 4 < 0 ? 0 : (4 * rg - 4 > 24 ? 24 : 4 * rg - 4); const int hi3 = 4 * rg - 1 < 0 ? 0 : (4 * rg - 1 > 24 ? 24 : 4 * rg - 1);
        const int rs = r - 4 < 0 ? 0 : (r - 4 > 24 ? 24 : r - 4);
        AttnP P{Zb, CAT, DM, b * 2048 + r * 64 + (wid & 1) * 32, OFF_NQ + head * 64, 512 + head * 64, OFF_NK + head * 64, OFF_NV + head * 64, b * 2048 + lo * 64, hi3 + 8 - lo, MLAT + b * 256, 4, 1, (wid & 1) * 32, lo - r + 7, head, rs - lo, rs - lo + 8};
        attn_unit<1>(lds, P, biasL);
    }
    if (l == 0) for (int u = bid; u < 64; u += G) {
        const int b = u >> 2, head = u & 3;
        AttnP P{Zb, CAT, DM, MLAT + b * 256 + wid * 32, OFF_NQ + head * 64, 512 + head * 64, OFF_NK + head * 64, OFF_NV + head * 64, 0, 0, MLAT + b * 256, 4, 0, 0, 0, head, 0, 0};
        attn_unit<1>(lds, P, biasL);
    }
}
__device__ __forceinline__ void gqa_phase(LAS unsigned char* lds, int l) {
    CArgs& a = kargs();
    int tid_ = threadIdx.x; asm volatile("" : "+v"(tid_));
    const int tid = tid_, wid = __builtin_amdgcn_readfirstlane(tid >> 6), G = o_grid(), bid = o_bid();
    bf16* Zb = (bf16*)(a.ws + WS_Z); bf16* CAT = (bf16*)(a.ws + WS_CAT);
    const bool bal = (G == 256); const int nmine = bal ? (bid < 128 ? 3 : 1) : (511 - bid) / G + 1;
    for (int iu = 0; iu < nmine; ++iu) {
        const int u = bal ? (bid < 128 ? bid + 128 * iu : 256 + bid) : bid + iu * G;
        const int b = u >> 5, kvh = (u >> 4) & 1, qb = u & 15; const int head = 2 * kvh + (wid >> 2);
        AttnP P{Zb, CAT, DM, b * 2048 + qb * 128 + (wid & 3) * 32, OFF_AQ + head * 64, head * 64, OFF_AK + kvh * 64, OFF_AV + kvh * 64, b * 2048, 32, MLAT + b * 256, 4, 0, 0, 0, head, 0, 0};
        attn_unit<1>(lds, P, nullptr);
    }
    if (l == 0) for (int u = G - 1 - bid; u < 64; u += G) {
        const int b = u >> 2, kvh = (u >> 1) & 1, qb = u & 1; const int head = 2 * kvh + (wid >> 2);
        AttnP P{Zb, CAT, DM, MLAT + b * 256 + qb * 128 + (wid & 3) * 32, OFF_AQ + head * 64, head * 64, OFF_AK + kvh * 64, OFF_AV + kvh * 64, 0, 0, MLAT + b * 256, 4, 0, 0, 0, head, 0, 0};
        attn_unit<1>(lds, P, nullptr);
    }
}

#define XB_TMO      128
#define XB_XCNT(j)  (256  + 64 * (j))
#define XB_XSUB(j)  (1280 + 64 * (j))
#define XB_XGEN(j)  (2304 + 64 * (j))
#define XB_TOP      3328
#define XB_TOPGEN   3392
#define XCD_BAR_WORDS 3456
#define XB_SPIN_CAP (1u << 18)

__device__ __forceinline__ unsigned xb_ld(unsigned* p)              { return __hip_atomic_load(p, __ATOMIC_RELAXED, __HIP_MEMORY_SCOPE_AGENT); }
__device__ __forceinline__ unsigned xb_add(unsigned* p, unsigned v) { return __hip_atomic_fetch_add(p, v, __ATOMIC_RELAXED, __HIP_MEMORY_SCOPE_AGENT); }
__device__ __forceinline__ unsigned xb_xcc_id() { return (unsigned)__builtin_amdgcn_s_getreg((3 << 11) | 20) & 0xFu; }
#define XB_SPIN(cond, bar) do { unsigned _sp = 0; while (cond) { __builtin_amdgcn_s_sleep(1); \
    if ((++_sp & 255u) == 0u) { if (xb_ld(&(bar)[XB_TMO])) break; if (_sp > XB_SPIN_CAP) { atomicAdd(&(bar)[XB_TMO], 1u); break; } } } } while (0)
struct XcdBarrier { unsigned* bar; unsigned x; volatile LAS unsigned* st; };
__device__ __forceinline__ void xcd_barrier_complete(unsigned* bar, unsigned x, unsigned& nloc, unsigned& nx) {
    const unsigned G = gridDim.x * gridDim.y * gridDim.z;
    unsigned sum, cnt, mine, sp = 0u;
    for (;;) {
        sum = 0u; cnt = 0u; mine = 0u;
#pragma unroll
        for (unsigned j = 0; j < 16; ++j) { const unsigned c = xb_ld(&bar[XB_XCNT(j)]); sum += c; cnt += (c > 0u) ? 1u : 0u; mine = (j == x) ? c : mine; }
        if (sum == G) break;
        __builtin_amdgcn_s_sleep(1);
        if ((++sp & 255u) == 0u) { if (xb_ld(&bar[XB_TMO])) break; if (sp > XB_SPIN_CAP) { atomicAdd(&bar[XB_TMO], 1u); break; } }
    }
    nloc = mine > 0u ? mine : 1u; nx = cnt > 0u ? cnt : 1u;
}

__device__ __forceinline__ void xcd_barrier(const XcdBarrier& b) {
    asm volatile("s_waitcnt vmcnt(0)" ::: "memory");
    __syncthreads();
    if (threadIdx.x == 0) {
        unsigned* bar = b.bar;
        __builtin_amdgcn_s_waitcnt(0);
        unsigned nloc = b.st[0], nx = b.st[1];
        if (nloc == 0u) { xcd_barrier_complete(bar, b.x, nloc, nx); b.st[0] = nloc; b.st[1] = nx; }
        const unsigned old = xb_add(&bar[XB_XSUB(b.x)], 1u);
        const unsigned gen = old / nloc;
        if (old + 1u == (gen + 1u) * nloc) {
            __builtin_amdgcn_fence(__ATOMIC_RELEASE, "agent");
            asm volatile("s_waitcnt vmcnt(0)" ::: "memory");
            const unsigned og = xb_add(&bar[XB_TOP], 1u);
            const unsigned tg = og / nx;
            if (og + 1u == (tg + 1u) * nx) xb_add(&bar[XB_TOPGEN], 1u);
            else XB_SPIN(xb_ld(&bar[XB_TOPGEN]) == tg, bar);
            __builtin_amdgcn_fence(__ATOMIC_ACQUIRE, "agent");
            xb_add(&bar[XB_XGEN(b.x)], 1u);
            asm volatile("s_waitcnt vmcnt(0)" ::: "memory");
        } else {
            XB_SPIN(xb_ld(&bar[XB_XGEN(b.x)]) == gen, bar);
            __builtin_amdgcn_fence(__ATOMIC_ACQUIRE, "agent");
            asm volatile("s_waitcnt vmcnt(0)" ::: "memory");
        }
    }
    __syncthreads();
}

template <class F>
__device__ __forceinline__ void run_gemm(LAS unsigned char* lds, const bf16* A, int lda, const bf16* Bt, int ldb, int M, int N, int K, const F& f, int c, long tsB = 0, int ksplit = 1 << 30, long kjumpB = 0) {
    pg8::Gemm g{A, Bt, M, N, K, lda, ldb, tsB ? tsB : (long)512 * ldb, ksplit, kjumpB}; pg8::StaticOrder S; S.init(M, N, o_grid(), c); Epi8<F> E{f};
    pg8::gemm_phase<Epi8<F>, pg8::StaticOrder, true, true>(lds, g, S, E);
}
#define WSP(off) ((bf16*)(ws + (off)))
__device__ __forceinline__ void ph_store_gemm(LAS unsigned char* lds, int l, int kind) {
    unsigned char* ws = kargs().ws; unsigned char* wb = ws + WS_W + (size_t)l * W_LAYER;
    const int Mr = l == 0 ? MT : MLAT;
    const bf16* A; const bf16* Bt; bf16* O; int lda, ldb, M, N, K, ldc, act;
    if (kind == 0)      { A = WSP(WS_XN);   lda = DM;  Bt = (const bf16*)(wb + WO_IN);  ldb = DM;  M = MT; N = INW; K = DM;  O = WSP(WS_Z);    ldc = INW; act = 0; }
    else if (kind == 1) { A = WSP(WS_CAT);  lda = DM;  Bt = (const bf16*)(wb + WO_OUT); ldb = DM;  M = Mr; N = DM;  K = DM;  O = WSP(WS_Y);    ldc = DM;  act = 0; }
    else if (kind == 2) { A = WSP(WS_XN);   lda = DM;  Bt = (const bf16*)(wb + WO_1);   ldb = DM;  M = Mr; N = DFF; K = DM;  O = WSP(WS_HMID); ldc = DFF; act = 1; }
    else if (kind == 3) { A = WSP(WS_HMID); lda = DFF; Bt = (const bf16*)(wb + WO_2);   ldb = DFF; M = Mr; N = DM;  K = DFF; O = WSP(WS_XN);   ldc = DM;  act = 0; }
    else                { A = (const bf16*)(wb + WO_CS); lda = 256; Bt = WSP(WS_Z) + OFF_FN; ldb = INW; M = 512; N = MT; K = 256; O = WSP(WS_C1); ldc = MT; act = 0; }
    run_gemm(lds, A, lda, Bt, ldb, M, N, K, FStore{O, ldc, act}, o_bid());
}
__device__ __forceinline__ void ph_d2(LAS unsigned char* lds, int l) { CArgs& a = kargs(); unsigned char* ws = a.ws;
    for (int j = 0; j < (l == 0 ? 2 : 1); ++j) {
        if (j == 0) run_gemm(lds, WSP(WS_DFT), 4096, WSP(WS_C1), MT, 2048, 4096, 4096, FD2{WSP(WS_CAT), a.in[I_BFNET] + l * 256, 0, 2048}, o_grid() - 1 - o_bid(), 2048 * 2, 32, ((long)256 * MT - 2048) * 2);
        else run_gemm(lds, WSP(WS_DFTC), 512, WSP(WS_C1) + MLAT, MT, 256, 4096, 512, FD2{WSP(WS_CAT), a.in[I_BFNET] + l * 256, MLAT, 256}, o_grid() - 1 - o_bid(), 256 * 2, 4, ((long)256 * MT - 256) * 2);
    } }
__device__ __forceinline__ void ph_glu(LAS unsigned char* lds, int l) { CArgs& a = kargs(); unsigned char* ws = a.ws; unsigned char* wb = ws + WS_W + (size_t)l * W_LAYER;
    const int Mr = l == 0 ? MT : MLAT;
    {
        int tid_ = threadIdx.x; asm volatile("" : "+v"(tid_));
        pg8::StaticOrder S; S.init(Mr, 256, o_grid(), o_grid() - 1 - o_bid()); pg8::Unit u;
        const bf16* Z = WSP(WS_Z); const float* Y0 = (const float*)(ws + WS_Y0); const float* Y1 = (const float*)(ws + WS_Y1); bf16* T = WSP(WS_T);
        const int c8 = (tid_ & 31) * 8;
        float dk[8];
#pragma unroll
        for (int e = 0; e < 8; ++e) dk[e] = a.in[I_S5D][l * 256 + c8 + e];
        for (int i = 0; S.next(i, u); ++i)
            for (int rr = tid_ >> 5; rr < 256; rr += 16) {
                const size_t row = (size_t)u.pm * 256 + rr;
                const v4u uz = *(const v4u*)(Z + row * INW + OFF_S5 + c8);
                const f32x4 a0 = *(const f32x4*)(Y0 + row * 256 + c8), a1 = *(const f32x4*)(Y0 + row * 256 + c8 + 4), b0 = *(const f32x4*)(Y1 + row * 256 + c8), b1 = *(const f32x4*)(Y1 + row * 256 + c8 + 4);
                const float uv[8] = {bflo(uz.x), bfhi(uz.x), bflo(uz.y), bfhi(uz.y), bflo(uz.z), bfhi(uz.z), bflo(uz.w), bfhi(uz.w)};
                float o[8];
#pragma unroll
                for (int e = 0; e < 8; ++e) { const float v = (e < 4 ? a0[e] + b0[e] : a1[e - 4] + b1[e - 4]) + dk[e] * uv[e];
                    const float uu = 0.7978845608028654f * (v + 0.044715f * v * v * v); o[e] = v / (1.f + __expf(-2.f * uu)); }
                v4u w; w.x = pk2(o[0], o[1]); w.y = pk2(o[2], o[3]); w.z = pk2(o[4], o[5]); w.w = pk2(o[6], o[7]);
                *(v4u*)(T + row * 256 + c8) = w;
            }
        __threadfence(); __syncthreads();
    }
    int K = 256, ld = 256; asm volatile("" : "+s"(K), "+s"(ld));
    run_gemm(lds, WSP(WS_T), ld, (const bf16*)(wb + WO_GLU), ld, Mr, 256, K, FGlu{WSP(WS_CAT), WSP(WS_T)}, o_grid() - 1 - o_bid()); }

__global__ void __launch_bounds__(512, 2) fwd_megakernel(Args a_unused) {
    extern __shared__ __attribute__((aligned(16))) unsigned char lds_raw[];
    LAS unsigned char* lds = (LAS unsigned char*)lds_raw;
    cg::grid_group grid = cg::this_grid();
#ifdef PROBE
    if (blockIdx.x == 0 && threadIdx.x == 0) { unsigned char* pw = kargs().ws + WS_PROBE; for (int i = 0; i < 32; ++i) ((float*)pw)[i] = 0.f; *(unsigned long long*)(pw + 256) = __builtin_amdgcn_s_memrealtime(); }
#endif
    {
        if (threadIdx.x < 2) ((volatile LAS unsigned*)(lds + LDS_BARST))[threadIdx.x] = 0u;
        if (threadIdx.x == 0) (void)xb_add(&((unsigned*)(kargs().ws + WS_BAR))[XB_XCNT(xb_xcc_id())], 1u);
        if (gridDim.x == 0x7fffffffu) grid.sync();
    }
    for (int step = 0; step < 20; ++step) {
        const int l = step < 2 ? 0 : (step - 2) / 9, k = step < 2 ? step - 2 : (step - 2) - 9 * l;
        int gk = -1;
        if (k == 0) gk = 0; else if (k == 2) gk = 4; else if (k == 4) gk = 1; else if (k == 6) gk = 2; else if (k == 7) gk = 3;
        int lbl = k == -2 ? 0 : k == -1 ? 1 : k == 0 ? 2 : k == 1 ? 5 : k == 2 ? 6 : k == 3 ? 9 : k == 4 ? 10 : k == 5 ? 11 : k == 6 ? 12 : k == 7 ? 13 : 14; (void)lbl;
#ifdef DBL_GEMM
        if (gk >= 0) { ph_store_gemm(lds, l, gk); __syncthreads(); }
#endif
#ifdef DBL_ROWS
        if (k == -1) prep_rows0(); if (k == 5 && l == 0) row_update<0>();
#endif
        if (gk >= 0) ph_store_gemm(lds, l, gk);
        else if (k == -2) prologue(lds);
        else if (k == -1) prep_rows0();
        else if (k == 1) {
            qk_prep(l);
            __syncthreads(); STAMP(3);
            na_phase(lds, l);
#ifdef DBL_NA
            __syncthreads(); na_phase(lds, l);
#endif
            __syncthreads(); STAMP(4);
            for (int u = o_bid(); u < 256; u += o_grid()) s5_unit(lds, l, u >> 4, u & 15);
#ifdef DBL_S5
            __syncthreads(); for (int u = o_bid(); u < 256; u += o_grid()) s5_unit(lds, l, u >> 4, u & 15);
#endif
        } else if (k == 3) {
            gqa_phase(lds, l);
#ifdef DBL_GQA
            __syncthreads(); gqa_phase(lds, l);
#endif
            __syncthreads(); STAMP(7);
            ph_d2(lds, l); STAMP(8);
            ph_glu(lds, l);
        } else if (k == 5) { if (l == 0) row_update<0>(); else row_update<2>(); }
        else { if (l == 0) row_update<1>(); else row_update<3>(); }
        if (k == 1) { __syncthreads(); }
        else if (step != 19) {
            XcdBarrier xb; xb.bar = (unsigned*)(kargs().ws + WS_BAR); xb.x = xb_xcc_id(); xb.st = (volatile LAS unsigned*)(lds + LDS_BARST);
            xcd_barrier(xb);
        }
        STAMP(lbl);
    }
}

extern "C" void kernel_launch(void* const* d_in, const int* in_sizes, int n_in, void* d_out, int out_size, void* d_ws, size_t ws_size, hipStream_t stream) {
    static int grid = 0;
    if (grid == 0) {
        if (n_in != 28 || ws_size < WS_END) { fprintf(stderr, "kernel_launch: unexpected n_in %d / ws_size %zu (need %zu)\n", n_in, ws_size, (size_t)WS_END); grid = -1; return; }
        int dev = 0, cus = 0, per_cu = 0;
        hipGetDevice(&dev); hipDeviceGetAttribute(&cus, hipDeviceAttributeMultiprocessorCount, dev);
        if (hipFuncSetAttribute((const void*)fwd_megakernel, hipFuncAttributeMaxDynamicSharedMemorySize, LDS_BYTES) != hipSuccess) { fprintf(stderr, "kernel_launch: hipFuncSetAttribute failed\n"); }
        if (hipOccupancyMaxActiveBlocksPerMultiprocessor(&per_cu, (const void*)fwd_megakernel, 512, LDS_BYTES) != hipSuccess || per_cu < 1) { fprintf(stderr, "kernel_launch: occupancy query says %d\n", per_cu); per_cu = 1; }
        (void)hipGetLastError();
        grid = cus * (per_cu > 1 ? 1 : per_cu);
        if (grid <= 0) grid = 256;
    }
    if (grid < 0) return;
    if (hipMemsetAsync((char*)d_ws + WS_BAR, 0, XCD_BAR_WORDS * 4, stream) != hipSuccess) { fprintf(stderr, "kernel_launch: hipMemsetAsync of the barrier words failed\n"); return; }
    Args a{};
    for (int i = 0; i < 28; ++i) a.in[i] = (const float*)d_in[i];
    a.out = (float*)d_out; a.ws = (unsigned char*)d_ws;
    void* args[] = {&a};
    hipError_t e = hipLaunchCooperativeKernel((const void*)fwd_megakernel, dim3(grid), dim3(512), args, LDS_BYTES, stream);
    if (e != hipSuccess) fprintf(stderr, "cooperative launch failed: %s (grid %d)\n", hipGetErrorString(e), grid);
}
```

```cpp
#include <hip/hip_runtime.h>
#include <hip/hip_cooperative_groups.h>
#include <cstdio>
#include <cstdint>
namespace cg = cooperative_groups;
namespace pg8 {
#define PG8_LAS __attribute__((address_space(3)))
typedef unsigned short bf16_t;
typedef short bf16x8 __attribute__((ext_vector_type(8)));
typedef float f32x4 __attribute__((ext_vector_type(4)));
typedef unsigned u32x4 __attribute__((ext_vector_type(4)));
constexpr int BM = 256, BK = 64, HALF = 128, HTB = HALF * BK * 2  , STAGE_BYTES = 8 * HTB, NXCD = 8, WGM = 8;

__host__ __device__ __forceinline__ int lds_byte(int r, int c) { const int st = (r >> 4) * 2 + (c >> 5), rr = r & 15, cc = c & 31, ob = rr * 64 + cc * 2; return st * 1024 + (ob ^ (((ob >> 9) & 1) << 5)); }
__host__ __device__ __forceinline__ void stage_rc(int b, int& R, int& C) { const int st = b / 1024, sb = b % 1024, swz = sb ^ (((sb >> 9) & 1) << 5); R = (st >> 1) * 16 + swz / 64; C = (st & 1) * 32 + (swz % 64) / 2; }
__host__ __device__ __forceinline__ int perm32(int rho) { const int n = rho >> 4, i = rho & 15; return 8 * (i >> 2) + 4 * n + (i & 3); }

struct Unit { int pm, pn; };
struct Gemm { const bf16_t* A; const bf16_t* Bt; int M, N, K, lda, ldb; long tsB; int ksplit; long kjumpB; };

struct StaticOrder {
    int nM, nN, nwg, G, c;
    __host__ __device__ void init(int M, int N, int G_, int c_) { nM = M / BM; nN = N / BM; nwg = nM * nN; G = G_; c = c_; }
    __host__ __device__ bool next(int i, Unit& u) const {
        const long L = (long)i * G + c; if (L >= nwg) return false;
        int wgid = (int)L; { const int q = nwg / NXCD, r = nwg % NXCD, xcd = wgid % NXCD, off = wgid / NXCD; wgid = (xcd < r ? xcd * (q + 1) : r * (q + 1) + (xcd - r) * q) + off; }
        const int nig = WGM * nN, gid = wgid / nig, fm = gid * WGM, gsz = (nM - fm) < WGM ? (nM - fm) : WGM;
        u.pm = fm + ((wgid % nig) % gsz); u.pn = (wgid % nig) / gsz; return true;
    }
    __device__ __forceinline__ void a_ready(const Unit&) const {}
    __device__ __forceinline__ void done(const Unit&) const {}
};
__device__ __forceinline__ unsigned cvt_pk_bf16(float lo, float hi) { unsigned r; asm volatile("v_cvt_pk_bf16_f32 %0, %1, %2" : "=v"(r) : "v"(lo), "v"(hi)); return r; }
template <class Epi, class Sched, bool ALIGN_EPI = false, bool SP2 = false>
__device__ __forceinline__ void gemm_phase(PG8_LAS unsigned char* lds, const Gemm g, const Sched& S, const Epi& E) {
    int tid_ = threadIdx.x; asm volatile("" : "+v"(tid_));
    const int tid = tid_, wid = __builtin_amdgcn_readfirstlane(tid >> 6), lane = tid & 63, wr = wid >> 2, wc = wid & 3, fr = lane & 15, fq = lane >> 4;
    const int K = g.K, nt = K / BK;
    unsigned voffA[2], voffB[2];
#pragma unroll
    for (int i = 0; i < 2; ++i) { int R, C; stage_rc(tid * 16 + i * 8192, R, C); const int Rb = Epi::PERM ? ((R & ~31) + perm32(R & 31)) : R;
        voffA[i] = (unsigned)(R * g.lda + C) * 2u; voffB[i] = (unsigned)(Rb * g.ldb + C) * 2u; }
    const size_t kstep = (size_t)(BK * 2);
    const size_t hstepA = (size_t)HALF * g.lda * 2, hstepB = (size_t)HALF * g.ldb * 2;
    const size_t tstepA = 2 * hstepA, tstepB = (size_t)g.tsB;
    const unsigned ldsw = (unsigned)wid * 1024u;
    const int aoff = lds_byte(wr * 64 + fr, fq * 8), boff = lds_byte(wc * 32 + fr, fq * 8);
#define PG8_SA(b, h) (((b) * 2 + (h)) * HTB)
#define PG8_SB(b, h) ((4 + (b) * 2 + (h)) * HTB)
#define PG8_STAGE(bufoff, gbase, voff) do { _Pragma("unroll") for (int _i = 0; _i < 2; ++_i) \
        __builtin_amdgcn_global_load_lds((const unsigned*)((const char*)(gbase) + (voff)[_i]), (PG8_LAS unsigned*)(lds + (bufoff) + ldsw + _i * 8192), 16, 0, 0); } while (0)
#define PG8_LDA(dst, b, h) do { _Pragma("unroll") for (int m = 0; m < 4; ++m) _Pragma("unroll") for (int k = 0; k < 2; ++k) dst[m][k] = *(const PG8_LAS bf16x8*)(lds + PG8_SA(b, h) + aoff + m * 2048 + k * 1024); } while (0)
#define PG8_LDB(dst, b, h) do { _Pragma("unroll") for (int n = 0; n < 2; ++n) _Pragma("unroll") for (int k = 0; k < 2; ++k) dst[n][k] = *(const PG8_LAS bf16x8*)(lds + PG8_SB(b, h) + boff + n * 2048 + k * 1024); } while (0)
#define PG8_MMA(ai, bj, At, Bt) do { __builtin_amdgcn_s_setprio(1); _Pragma("unroll") for (int m = 0; m < 4; ++m) _Pragma("unroll") for (int n = 0; n < 2; ++n) _Pragma("unroll") for (int k = 0; k < 2; ++k) \
        acc[ai][bj][m][n] = __builtin_amdgcn_mfma_f32_16x16x32_bf16(Bt[n][k], At[m][k], acc[ai][bj][m][n], 0, 0, 0); __builtin_amdgcn_s_setprio(0); } while (0)
#define PG8_WAIT_V(n) asm volatile("s_waitcnt vmcnt(" #n ")" ::: "memory")
#define PG8_WAIT_L(n) asm volatile("s_waitcnt lgkmcnt(" #n ")" ::: "memory")
#define PG8_BAR __builtin_amdgcn_s_barrier()
#define PG8_SCHED __builtin_amdgcn_sched_barrier(0)
    Unit cur, nxt; int ui = 0;
    if (!S.next(0, cur)) return;
    f32x4 acc[2][2][4][2];
#pragma unroll
    for (int a = 0; a < 2; ++a)
#pragma unroll
        for (int b = 0; b < 2; ++b)
#pragma unroll
            for (int m = 0; m < 4; ++m)
#pragma unroll
                for (int n = 0; n < 2; ++n) acc[a][b][m][n] = (f32x4){0.f, 0.f, 0.f, 0.f};
    bf16x8 At[4][2], B0[2][2], B1[2][2];
    const char* cA = (const char*)g.A + (size_t)cur.pm * tstepA; const char* cB = (const char*)g.Bt + (size_t)cur.pn * tstepB;
    S.a_ready(cur);
    if constexpr (SP2) {
        PG8_STAGE(PG8_SB(0, 0), cB, voffB); PG8_STAGE(PG8_SB(0, 1), cB + hstepB, voffB); PG8_STAGE(PG8_SA(0, 0), cA, voffA); PG8_STAGE(PG8_SA(0, 1), cA + hstepA, voffA);
        if (wr == 1) PG8_BAR;
        PG8_WAIT_V(2); PG8_BAR;
        PG8_STAGE(PG8_SB(1, 0), cB + kstep, voffB); PG8_STAGE(PG8_SA(1, 0), cA + kstep, voffA); PG8_STAGE(PG8_SB(1, 1), cB + hstepB + kstep, voffB);
        PG8_WAIT_V(6); PG8_BAR;
    } else {
        PG8_STAGE(PG8_SB(0, 0), cB, voffB); PG8_STAGE(PG8_SA(0, 0), cA, voffA); PG8_STAGE(PG8_SB(0, 1), cB + hstepB, voffB); PG8_STAGE(PG8_SA(0, 1), cA + hstepA, voffA);
        if (wr == 1) PG8_BAR;
        PG8_WAIT_V(4); PG8_BAR;
        PG8_STAGE(PG8_SB(1, 0), cB + kstep, voffB); PG8_STAGE(PG8_SA(1, 0), cA + kstep, voffA); PG8_STAGE(PG8_SB(1, 1), cB + hstepB + kstep, voffB);
        PG8_WAIT_V(6); PG8_BAR;
    }
    for (;;) {
        const bool has_next = S.next(ui + 1, nxt);
        const char* nA = has_next ? (const char*)g.A + (size_t)nxt.pm * tstepA : cA; const char* nB = has_next ? (const char*)g.Bt + (size_t)nxt.pn * tstepB : cB;
        for (int t = 0; t < nt; t += 2) {
            const bool last = (t == nt - 2);
            const char* a1 = cA + (size_t)(t + 1) * kstep;
            const char* a2 = last ? nA : cA + (size_t)(t + 2) * kstep; const char* b2 = last ? nB : cB + (size_t)(t + 2) * kstep + ((t + 2) >= g.ksplit ? g.kjumpB : 0);
            const char* a3 = a2 + kstep; const char* b3 = b2 + kstep;
            if (last && has_next) S.a_ready(nxt);
            if constexpr (SP2) {
            PG8_LDB(B0, 0, 0); PG8_LDB(B1, 0, 1); PG8_SCHED; PG8_LDA(At, 0, 0); PG8_STAGE(PG8_SA(1, 1), a1 + hstepA, voffA);
            PG8_WAIT_V(8); PG8_WAIT_L(0); PG8_BAR; PG8_MMA(0, 0, At, B0); PG8_MMA(0, 1, At, B1); PG8_BAR; PG8_SCHED;
            PG8_LDA(At, 0, 1); PG8_STAGE(PG8_SB(0, 0), b2, voffB); PG8_STAGE(PG8_SB(0, 1), b2 + hstepB, voffB); PG8_STAGE(PG8_SA(0, 0), a2, voffA);
            PG8_WAIT_V(8); PG8_WAIT_L(0); PG8_BAR; PG8_MMA(1, 0, At, B0); PG8_MMA(1, 1, At, B1); PG8_BAR; PG8_SCHED;
            PG8_LDB(B0, 1, 0); PG8_LDB(B1, 1, 1); PG8_SCHED; PG8_LDA(At, 1, 0); PG8_STAGE(PG8_SA(0, 1), a2 + hstepA, voffA);
            PG8_WAIT_V(8); PG8_WAIT_L(0); PG8_BAR; PG8_MMA(0, 0, At, B0); PG8_MMA(0, 1, At, B1); PG8_BAR; PG8_SCHED;
            PG8_LDA(At, 1, 1); PG8_STAGE(PG8_SB(1, 0), b3, voffB); PG8_STAGE(PG8_SB(1, 1), b3 + hstepB, voffB); PG8_STAGE(PG8_SA(1, 0), a3, voffA);
            PG8_WAIT_V(8); PG8_WAIT_L(0); PG8_BAR; PG8_MMA(1, 0, At, B0); PG8_MMA(1, 1, At, B1); PG8_BAR; PG8_SCHED;
            } else {
            PG8_LDB(B0, 0, 0); PG8_SCHED; PG8_LDA(At, 0, 0); PG8_STAGE(PG8_SA(1, 1), a1 + hstepA, voffA);
            PG8_WAIT_L(8); PG8_BAR; PG8_WAIT_L(0); PG8_MMA(0, 0, At, B0); PG8_BAR; PG8_SCHED;
            PG8_LDB(B1, 0, 1); PG8_STAGE(PG8_SB(0, 0), b2, voffB);
            PG8_BAR; PG8_WAIT_L(0); PG8_MMA(0, 1, At, B1); PG8_BAR;
            PG8_LDA(At, 0, 1); PG8_STAGE(PG8_SA(0, 0), a2, voffA);
            PG8_BAR; PG8_WAIT_L(0); PG8_MMA(1, 0, At, B0); PG8_BAR; PG8_SCHED;
            PG8_STAGE(PG8_SB(0, 1), b2 + hstepB, voffB);
            PG8_WAIT_V(6); PG8_BAR; PG8_MMA(1, 1, At, B1); PG8_BAR;
            PG8_LDB(B0, 1, 0); PG8_SCHED; PG8_LDA(At, 1, 0); PG8_STAGE(PG8_SA(0, 1), a2 + hstepA, voffA);
            PG8_WAIT_L(8); PG8_BAR; PG8_WAIT_L(0); PG8_MMA(0, 0, At, B0); PG8_BAR; PG8_SCHED;
            PG8_LDB(B1, 1, 1); PG8_STAGE(PG8_SB(1, 0), b3, voffB);
            PG8_BAR; PG8_WAIT_L(0); PG8_MMA(0, 1, At, B1); PG8_BAR;
            PG8_LDA(At, 1, 1); PG8_STAGE(PG8_SA(1, 0), a3, voffA);
            PG8_BAR; PG8_WAIT_L(0); PG8_MMA(1, 0, At, B0); PG8_BAR; PG8_SCHED;
            PG8_STAGE(PG8_SB(1, 1), b3 + hstepB, voffB);
            PG8_WAIT_V(6); PG8_BAR; PG8_MMA(1, 1, At, B1); PG8_BAR;
            }
        }
        if constexpr (ALIGN_EPI) { if (wr == 0) PG8_BAR; }
        if constexpr (!Epi::AFTER_DRAIN) { E(acc, cur, wr, wc, fr, fq); S.done(cur); }
        if (!has_next) break;
#pragma unroll
        for (int a = 0; a < 2; ++a)
#pragma unroll
            for (int b = 0; b < 2; ++b)
#pragma unroll
                for (int m = 0; m < 4; ++m)
#pragma unroll
                    for (int n = 0; n < 2; ++n) acc[a][b][m][n] = (f32x4){0.f, 0.f, 0.f, 0.f};
        cur = nxt; cA = nA; cB = nB; ++ui;
        if constexpr (ALIGN_EPI) { if (wr == 1) PG8_BAR; }
    }
    PG8_WAIT_V(0);
    if constexpr (!ALIGN_EPI) { if (wr == 0) PG8_BAR; }
    PG8_BAR;
    if constexpr (Epi::AFTER_DRAIN) { E.fused(acc, cur, wr, wc, fr, fq, lds, wid, lane); S.done(cur); }
#undef PG8_SA
#undef PG8_SB
#undef PG8_STAGE
#undef PG8_LDA
#undef PG8_LDB
#undef PG8_MMA
#undef PG8_WAIT_V
#undef PG8_WAIT_L
#undef PG8_BAR
#undef PG8_SCHED
}
}
#define LAS __attribute__((address_space(3)))
typedef unsigned short bf16;
typedef unsigned v4u __attribute__((ext_vector_type(4)));
typedef unsigned v2u __attribute__((ext_vector_type(2)));
typedef float f32x4 __attribute__((ext_vector_type(4)));
typedef float f32x16 __attribute__((ext_vector_type(16)));
typedef short bf16x8 __attribute__((ext_vector_type(8)));
typedef short s16x4 __attribute__((ext_vector_type(4)));

constexpr int DM = 1024, NB = 16, SEQ = 2048, CTXL = 256, MLAT = NB * SEQ, MCTX = NB * CTXL, MT = MLAT + MCTX, INW = 1792, DFF = 4096;
constexpr int OFF_AQ = 0, OFF_AK = 256, OFF_AV = 384, OFF_S5 = 512, OFF_NQ = 768, OFF_NK = 1024, OFF_NV = 1280, OFF_FN = 1536;
constexpr float EPSN = 1e-6f;
constexpr float LOG2E = 1.4426950408889634f;
constexpr size_t MiB = 1u << 20;
constexpr size_t WS_MOD = 0;
constexpr size_t WS_ROPE = 1 * MiB;
constexpr size_t WS_W = 2 * MiB, W_LAYER = 22 * MiB;
constexpr size_t WO_IN = 0, WO_OUT = WO_IN + (size_t)INW * DM * 2, WO_1 = WO_OUT + (size_t)DM * DM * 2, WO_2 = WO_1 + (size_t)DFF * DM * 2,
                 WO_GLU = WO_2 + (size_t)DFF * DM * 2, WO_CS = WO_GLU + 256 * 256 * 2, WO_END = WO_CS + 512 * 256 * 2;
static_assert(WO_END <= W_LAYER, "weights");
constexpr size_t WS_DFT = 46 * MiB, WS_DFTC = 62 * MiB, WS_XC = 64 * MiB, WS_XN = 80 * MiB;
constexpr size_t WS_T = 116 * MiB, WS_C1 = 350 * MiB;
constexpr size_t WS_Z = 152 * MiB, WS_CAT = 278 * MiB, WS_Y = 350 * MiB, WS_HMID = 152 * MiB, WS_Y0 = 440 * MiB, WS_Y1 = 476 * MiB, WS_END = 512 * MiB;
constexpr int LDS_BYTES = 147456;

struct Args { const float* in[28]; float* out; unsigned char* ws; };
typedef __attribute__((address_space(4))) const Args CArgs;
__device__ __forceinline__ CArgs& kargs() { CArgs* p = (CArgs*)__builtin_amdgcn_kernarg_segment_ptr(); asm volatile("" : "+s"(p)); return *p; }
enum { I_X = 0, I_C, I_CTX, I_CCTX, I_WADA, I_BADA, I_GPREMIX, I_GPOSTMIX, I_GPREMLP, I_GPOSTMLP, I_WIN, I_GQ, I_GK, I_AR, I_AI, I_LDT, I_BR, I_BI, I_CR, I_CI,
       I_S5D, I_WGLU, I_NABIAS, I_WFNET, I_BFNET, I_WOUT, I_W1, I_W2 };

constexpr size_t WS_PROBE = 1 * MiB + 65536;
constexpr size_t WS_BAR = 1 * MiB + 131072;
constexpr int LDS_BARST = 147456 - 64;
#ifdef PROBE
#define STAMP(lbl) do { if (blockIdx.x == 0 && threadIdx.x == 0) { unsigned char* pw_ = kargs().ws + WS_PROBE; const unsigned long long now_ = __builtin_amdgcn_s_memrealtime(); \
    unsigned long long* tp_ = (unsigned long long*)(pw_ + 256); ((float*)pw_)[lbl] += (float)(now_ - *tp_); *tp_ = now_; } } while (0)
#else
#define STAMP(lbl) do {} while (0)
#endif
__device__ __forceinline__ unsigned f2bf(float f) { unsigned u = __builtin_bit_cast(unsigned, f); return (u + 0x7fffu + ((u >> 16) & 1u)) >> 16; }
typedef float f32x2_t __attribute__((ext_vector_type(2))); typedef __bf16 bf16x2_t __attribute__((ext_vector_type(2)));
__device__ __forceinline__ unsigned pk2(float lo, float hi) { const f32x2_t v = {lo, hi}; const bf16x2_t b = __builtin_convertvector(v, bf16x2_t); return __builtin_bit_cast(unsigned, b); }
__device__ __forceinline__ float bflo(unsigned w) { return __builtin_bit_cast(float, w << 16); }
__device__ __forceinline__ float bfhi(unsigned w) { return __builtin_bit_cast(float, w & 0xffff0000u); }
__device__ __forceinline__ float bf2f(bf16 h) { return __builtin_bit_cast(float, (unsigned)h << 16); }
__device__ __forceinline__ int o_bid() { int t = blockIdx.x; asm volatile("" : "+s"(t)); return t; }
__device__ __forceinline__ int o_grid() { int t = gridDim.x; asm volatile("" : "+s"(t)); return t; }
__device__ __forceinline__ float shfl_xor_l(float v, int o, int lane) { return __builtin_bit_cast(float, __builtin_amdgcn_ds_bpermute((lane ^ o) << 2, __builtin_bit_cast(int, v))); }
__device__ __forceinline__ float wave_sum(float v, int lane) {
#pragma unroll
    for (int o = 1; o < 64; o <<= 1) v += shfl_xor_l(v, o, lane);
    return v;
}
__device__ __forceinline__ int crow(int r, int hi) { return (r & 3) + 8 * (r >> 2) + 4 * hi; }

template <class F> struct Epi8 {
    static constexpr bool PERM = true, AFTER_DRAIN = false;
    F f;
    __device__ __forceinline__ void operator()(const pg8::f32x4 (&acc)[2][2][4][2], const pg8::Unit& u, int wr, int wc, int fr, int fq) const {
        asm volatile("" : "+v"(fr), "+v"(fq));
#pragma unroll
        for (int ai = 0; ai < 2; ++ai)
#pragma unroll
            for (int m = 0; m < 4; ++m) {
                const int row = u.pm * 256 + ai * 128 + wr * 64 + m * 16 + fr;
#pragma unroll
                for (int bj = 0; bj < 2; ++bj) { const int col = u.pn * 256 + bj * 128 + wc * 32 + 8 * fq; f(row, col, acc[ai][bj][m][0], acc[ai][bj][m][1]); }
                asm volatile("" ::: "memory"); __builtin_amdgcn_sched_barrier(0);
            }
    }
};
__device__ __forceinline__ v4u pack8(f32x4 a, f32x4 b) { v4u w; w.x = pk2(a[0], a[1]); w.y = pk2(a[2], a[3]); w.z = pk2(b[0], b[1]); w.w = pk2(b[2], b[3]); return w; }
struct FStore { bf16* O; int ldc; int act;
    __device__ __forceinline__ void operator()(int row, int col, f32x4 a, f32x4 b) const {
        if (act == 1) {
#pragma unroll
            for (int i = 0; i < 4; ++i) { float x = a[i] > 0.f ? a[i] : 0.f; a[i] = x * x; float y = b[i] > 0.f ? b[i] : 0.f; b[i] = y * y; } }
        *(v4u*)(O + (size_t)row * ldc + col) = pack8(a, b); } };
struct FD2 { bf16* cat; const float* bias; int rowbase, rowsPerB;
    __device__ __forceinline__ void operator()(int row, int col, f32x4 a, f32x4 b) const {
        const int bb = col >> 8, j = col & 255; const f32x4 b0 = *(const f32x4*)(bias + j), b1 = *(const f32x4*)(bias + j + 4);
        *(v4u*)(cat + ((size_t)(rowbase + bb * rowsPerB + row) * 1024 + 768 + j)) = pack8(a + b0, b + b1); } };
struct FGlu { bf16* cat; const bf16* T;
    __device__ __forceinline__ void operator()(int row, int col, f32x4 a, f32x4 b) const {
        const v4u t = *(const v4u*)(T + (size_t)row * 256 + col);
        float tv[8] = {bflo(t.x), bfhi(t.x), bflo(t.y), bfhi(t.y), bflo(t.z), bfhi(t.z), bflo(t.w), bfhi(t.w)};
#pragma unroll
        for (int i = 0; i < 4; ++i) { a[i] = tv[i] / (1.f + __expf(-a[i])); b[i] = tv[4 + i] / (1.f + __expf(-b[i])); }
        *(v4u*)(cat + (size_t)row * 1024 + 256 + col) = pack8(a, b); } };
__device__ __forceinline__ void transpose_item(const float* W, int K, int N, bf16* WT, LAS float* scr, int item, int lane) {
    const int nblk = N / 32, kb = item / nblk, nb = item % nblk, k0 = 64 * kb, n0 = 32 * nb;
#pragma unroll
    for (int i = 0; i < 8; ++i) { const int kk = 8 * i + (lane >> 3), n4 = (lane & 7) * 4; const f32x4 v = *(const f32x4*)(W + (size_t)(k0 + kk) * N + n0 + n4);
        scr[kk * 33 + n4] = v[0]; scr[kk * 33 + n4 + 1] = v[1]; scr[kk * 33 + n4 + 2] = v[2]; scr[kk * 33 + n4 + 3] = v[3]; }
    asm volatile("s_waitcnt lgkmcnt(0)" ::: "memory");
    const int c = lane & 7;
#pragma unroll
    for (int j = 0; j < 4; ++j) { const int n = (lane >> 3) + 8 * j; const LAS float* s = scr + (8 * c) * 33 + n;
        v4u o; o.x = pk2(s[0 * 33], s[1 * 33]); o.y = pk2(s[2 * 33], s[3 * 33]); o.z = pk2(s[4 * 33], s[5 * 33]); o.w = pk2(s[6 * 33], s[7 * 33]);
        *(v4u*)(WT + (size_t)(n0 + n) * K + k0 + 8 * c) = o; }
    asm volatile("s_waitcnt lgkmcnt(0)" ::: "memory");
}

__device__ __forceinline__ void prologue(LAS unsigned char* lds) {
    CArgs& a = kargs();
    int tid_ = threadIdx.x; asm volatile("" : "+v"(tid_));
    const int tid = tid_, lane = tid & 63, wid = tid >> 6, G = o_grid();
    unsigned char* ws = a.ws;
    {
        LAS float* scr = (LAS float*)(lds + wid * 16384);
        const int gw = o_bid() * 8 + wid, NGW = G * 8;
        constexpr int I0 = (DM / 64) * (INW / 32), I1 = (DM / 64) * (DM / 32), I2 = (DM / 64) * (DFF / 32), I3 = (DFF / 64) * (DM / 32), I4 = (256 / 64) * (256 / 32);
        constexpr int PER = I0 + I1 + I2 + I3 + I4;
        for (int it = gw; it < 2 * PER; it += NGW) {
            const int l = it / PER; int r = it % PER; unsigned char* wb = ws + WS_W + (size_t)l * W_LAYER;
            if (r < I0) { transpose_item(a.in[I_WIN] + (size_t)l * DM * INW, DM, INW, (bf16*)(wb + WO_IN), scr, r, lane); continue; } r -= I0;
            if (r < I1) { transpose_item(a.in[I_WOUT] + (size_t)l * DM * DM, DM, DM, (bf16*)(wb + WO_OUT), scr, r, lane); continue; } r -= I1;
            if (r < I2) { transpose_item(a.in[I_W1] + (size_t)l * DM * DFF, DM, DFF, (bf16*)(wb + WO_1), scr, r, lane); continue; } r -= I2;
            if (r < I3) { transpose_item(a.in[I_W2] + (size_t)l * DFF * DM, DFF, DM, (bf16*)(wb + WO_2), scr, r, lane); continue; } r -= I3;
            transpose_item(a.in[I_WGLU] + (size_t)l * 256 * 256, 256, 256, (bf16*)(wb + WO_GLU), scr, r, lane);
        }
    }
    __syncthreads();
    {
        LAS float* sl = (LAS float*)lds;
        LAS float* part = (LAS float*)(lds + 17 * 1024 * 4);
        float* mod = (float*)(ws + WS_MOD);
        bool have = false;
        for (int u = o_bid(); u < 2 * 96; u += G) {
            if (!have) {
                for (int i = tid; i < 17 * 1024; i += 512) { const float cv = i < 16 * 1024 ? a.in[I_C][i] : a.in[I_CCTX][i - 16 * 1024]; sl[i] = cv / (1.f + __expf(-cv)); }
                have = true; __syncthreads();
            }
            const int l = u / 96, n0 = (u % 96) * 64;
            const float* W = a.in[I_WADA] + (size_t)l * DM * 6144 + n0 + lane;
            float acc[17];
#pragma unroll
            for (int i = 0; i < 17; ++i) acc[i] = 0.f;
            for (int k0 = wid * 128; k0 < wid * 128 + 128; k0 += 16) {
                float wv[16];
#pragma unroll
                for (int q = 0; q < 16; ++q) wv[q] = W[(size_t)(k0 + q) * 6144];
#pragma unroll
                for (int q = 0; q < 16; ++q)
#pragma unroll
                    for (int i = 0; i < 17; ++i) acc[i] += sl[i * 1024 + k0 + q] * wv[q];
            }
#pragma unroll
            for (int i = 0; i < 17; ++i) part[(wid * 17 + i) * 64 + lane] = acc[i];
            __syncthreads();
            for (int o = tid; o < 17 * 64; o += 512) {
                const int i = o >> 6, n = o & 63; float s = a.in[I_BADA][l * 6144 + n0 + n];
#pragma unroll
                for (int w = 0; w < 8; ++w) s += part[(w * 17 + i) * 64 + n];
                mod[((size_t)l * 17 + i) * 6144 + n0 + n] = s;
            }
            __syncthreads();
        }
    }
    {
        const size_t gt = (size_t)o_bid() * 512 + tid, NT = (size_t)G * 512;
        bf16* dft = (bf16*)(ws + WS_DFT);
        for (size_t i = gt; i < (size_t)2048 * 4096 / 8; i += NT) {
            const int kk = (int)(i / 512), n0 = (int)(i % 512) * 8; float v[8];
#pragma unroll
            for (int j = 0; j < 8; ++j) { const int n = n0 + j, nn = n & 2047; const float fr = (float)((kk * nn) & 2047) * (1.f / 2048.f);
                v[j] = (n < 2048 ? __builtin_amdgcn_cosf(fr) : -__builtin_amdgcn_sinf(fr)) * 0.02209708691207961f; }
            v4u o; o.x = pk2(v[0], v[1]); o.y = pk2(v[2], v[3]); o.z = pk2(v[4], v[5]); o.w = pk2(v[6], v[7]);
            *(v4u*)(dft + i * 8) = o;
        }
        bf16* dftc = (bf16*)(ws + WS_DFTC);
        for (size_t i = gt; i < (size_t)256 * 512 / 8; i += NT) {
            const int kk = (int)(i / 64), n0 = (int)(i % 64) * 8; float v[8];
#pragma unroll
            for (int j = 0; j < 8; ++j) { const int n = n0 + j, nn = n & 255; const float fr = (float)((kk * nn) & 255) * (1.f / 256.f);
                v[j] = (n < 256 ? __builtin_amdgcn_cosf(fr) : -__builtin_amdgcn_sinf(fr)) * 0.0625f; }
            v4u o; o.x = pk2(v[0], v[1]); o.y = pk2(v[2], v[3]); o.z = pk2(v[4], v[5]); o.w = pk2(v[6], v[7]);
            *(v4u*)(dftc + i * 8) = o;
        }
        for (size_t i = gt; i < (size_t)2 * 512 * 256; i += NT) {
            const int l = (int)(i / (512 * 256)), rem = (int)(i % (512 * 256)), jp = rem >> 8, cin = rem & 255, j = jp & 255, part = jp >> 8;
            const float* W = a.in[I_WFNET] + (size_t)l * 256 * 256 + (size_t)(cin >> 6) * 64 * 256 + j; const int c = cin & 63; float s = 0.f;
            for (int cp0 = 0; cp0 < 64; cp0 += 16) { float wv[16];
#pragma unroll
                for (int q = 0; q < 16; ++q) wv[q] = W[(size_t)(cp0 + q) * 256];
#pragma unroll
                for (int q = 0; q < 16; ++q) { const float fr = (float)((c * (cp0 + q)) & 63) * (1.f / 64.f); s += (part ? __builtin_amdgcn_sinf(fr) : __builtin_amdgcn_cosf(fr)) * wv[q]; } }
            ((bf16*)(ws + WS_W + (size_t)l * W_LAYER + WO_CS))[(size_t)jp * 256 + cin] = (bf16)f2bf(s * 0.125f);
        }
        float2* rope = (float2*)(ws + WS_ROPE);
        for (size_t i = gt; i < 1024; i += NT) { const int pos = (int)i >> 4, k = (int)i & 15; const float inv = exp2f(-(float)k * (13.287712379549449f / 16.f)); const float ang = (float)pos * inv;
            float sn, cs; sincosf(ang, &sn, &cs); rope[i] = make_float2(cs, sn); }
    }
}

__device__ __forceinline__ void prep_rows0() {
    CArgs& a = kargs();
    int tid_ = threadIdx.x; asm volatile("" : "+v"(tid_));
    const int lane = tid_ & 63, gw = o_bid() * 8 + (tid_ >> 6), NGW = o_grid() * 8;
    const float* mod = (const float*)(a.ws + WS_MOD); bf16* XN = (bf16*)(a.ws + WS_XN); const float* gp = a.in[I_GPREMIX];
    f32x4 vn[4];
    auto rload = [&](int row) { const float* xr = row < MLAT ? a.in[I_X] + (size_t)row * DM : a.in[I_CTX] + (size_t)(row - MLAT) * DM;
#pragma unroll
        for (int j = 0; j < 4; ++j) vn[j] = *(const f32x4*)(xr + 4 * lane + 256 * j); };
    if (gw < MT) rload(gw);
    for (int row = gw; row < MT; row += NGW) {
        const int bi = row < MLAT ? row >> 11 : 16;
        const float* mb = mod + (size_t)bi * 6144;
        f32x4 v[4]; float ss = 0.f;
#pragma unroll
        for (int j = 0; j < 4; ++j) { v[j] = vn[j]; ss += v[j][0] * v[j][0] + v[j][1] * v[j][1] + v[j][2] * v[j][2] + v[j][3] * v[j][3]; }
        if (row + NGW < MT) rload(row + NGW);
        const float rstd = rsqrtf(wave_sum(ss, lane) * (1.f / DM) + EPSN);
#pragma unroll
        for (int j = 0; j < 4; ++j) { const int k = 4 * lane + 256 * j; const f32x4 g = *(const f32x4*)(gp + k), sh = *(const f32x4*)(mb + k), sc = *(const f32x4*)(mb + 1024 + k);
            f32x4 o;
#pragma unroll
            for (int e = 0; e < 4; ++e) o[e] = (v[j][e] * rstd * g[e]) * (1.f + sc[e]) + sh[e];
            v2u w; w.x = pk2(o[0], o[1]); w.y = pk2(o[2], o[3]); *(v2u*)(XN + (size_t)row * DM + k) = w; }
    }
}
template <int WHICH>
__device__ __forceinline__ void row_update() {
    CArgs& a = kargs();
    constexpr int l = WHICH >> 1; constexpr bool MLP = WHICH & 1; constexpr bool NXT = WHICH != 3;
    const int nrows = l == 0 ? MT : MLAT;
    const bf16* Y = (const bf16*)(a.ws + (MLP ? WS_XN : WS_Y)); bf16* OB = (bf16*)(a.ws + WS_XN);
    const float* xlat_in = WHICH == 0 ? a.in[I_X] : a.out; const float* xctx_in = WHICH == 0 ? a.in[I_CTX] : (const float*)(a.ws + WS_XC);
    float* xlat_out = a.out; float* xctx_out = (float*)(a.ws + WS_XC);
    const float* mod = (const float*)(a.ws + WS_MOD);
    const float* modl = mod + (size_t)l * 17 * 6144; constexpr int gate_i = MLP ? 5 : 2;
    const float* gpost = (MLP ? a.in[I_GPOSTMLP] : a.in[I_GPOSTMIX]) + l * DM;
    const float* modn = MLP ? mod + (size_t)17 * 6144 : modl; constexpr int sh_i = MLP ? 0 : 3, sc_i = MLP ? 1 : 4;
    const float* gnext = MLP ? a.in[I_GPREMIX] + DM : a.in[I_GPREMLP] + l * DM;
    int tid_ = threadIdx.x; asm volatile("" : "+v"(tid_));
    const int lane = tid_ & 63, gw = o_bid() * 8 + (tid_ >> 6), NGW = o_grid() * 8;
    v2u ywn[4]; f32x4 xn[4];
    auto rload = [&](int row) {
        const bool lat = row < MLAT; const float* xr = lat ? xlat_in + (size_t)row * DM : xctx_in + (size_t)(row - MLAT) * DM;
#pragma unroll
        for (int j = 0; j < 4; ++j) { const int k = 4 * lane + 256 * j; ywn[j] = *(const v2u*)(Y + (size_t)row * DM + k); xn[j] = *(const f32x4*)(xr + k); } };
    if (gw < nrows) rload(gw);
    for (int row = gw; row < nrows; row += NGW) {
        const bool lat = row < MLAT; const int bi = lat ? row >> 11 : 16;
        float* xo = lat ? xlat_out + (size_t)row * DM : xctx_out + (size_t)(row - MLAT) * DM;
        const float* gate = modl + (size_t)bi * 6144 + gate_i * 1024;
        f32x4 y[4], x[4]; float ss = 0.f;
#pragma unroll
        for (int j = 0; j < 4; ++j) { const v2u w = ywn[j]; y[j] = (f32x4){bflo(w.x), bfhi(w.x), bflo(w.y), bfhi(w.y)}; x[j] = xn[j];
            ss += y[j][0] * y[j][0] + y[j][1] * y[j][1] + y[j][2] * y[j][2] + y[j][3] * y[j][3]; }
        if (row + NGW < nrows) rload(row + NGW);
        const float rstd = rsqrtf(wave_sum(ss, lane) * (1.f / DM) + EPSN); float s2 = 0.f;
#pragma unroll
        for (int j = 0; j < 4; ++j) { const int k = 4 * lane + 256 * j; const f32x4 g = *(const f32x4*)(gpost + k), gt = *(const f32x4*)(gate + k);
#pragma unroll
            for (int e = 0; e < 4; ++e) { x[j][e] = x[j][e] + gt[e] * (y[j][e] * rstd * g[e]); s2 += x[j][e] * x[j][e]; }
#ifdef PROBE
            if (WHICH == 3) { const float* pa = (const float*)(a.ws + WS_PROBE); float tot = 0.f, fa = 0.f, fb = 0.f;
                for (int i = 0; i < 15; ++i) { const float v = pa[i]; tot += v; if ((PROBE_A >> i) & 1) fa += v; if ((PROBE_B >> i) & 1) fb += v; }
                fa /= tot; fb /= tot; const float e = fa < 0.02f ? 0.02f : fa;
                for (int q = 0; q < 4; ++q) x[j][q] *= (1.f + e);
                if (row == 0 && lane == 0 && j == 0) x[j][0] += 50.f + 1000.f * fb; }
#endif
            *(f32x4*)(xo + k) = x[j]; }
        if (NXT) {
            const float rstd2 = rsqrtf(wave_sum(s2, lane) * (1.f / DM) + EPSN); const float* mb = modn + (size_t)bi * 6144;
#pragma unroll
            for (int j = 0; j < 4; ++j) { const int k = 4 * lane + 256 * j; const f32x4 g = *(const f32x4*)(gnext + k), sh = *(const f32x4*)(mb + sh_i * 1024 + k), sc = *(const f32x4*)(mb + sc_i * 1024 + k);
                f32x4 o;
#pragma unroll
                for (int e = 0; e < 4; ++e) o[e] = (x[j][e] * rstd2 * g[e]) * (1.f + sc[e]) + sh[e];
                v2u w; w.x = pk2(o[0], o[1]); w.y = pk2(o[2], o[3]); *(v2u*)(OB + (size_t)row * DM + k) = w; }
        }
    }
}

__device__ __forceinline__ void qk_prep(int layer) {
    CArgs& a = kargs();
    bf16* Z = (bf16*)(a.ws + WS_Z); const float2* rope = (const float2*)(a.ws + WS_ROPE);
    int tid_ = threadIdx.x; asm volatile("" : "+v"(tid_));
    const int gt = o_bid() * 512 + tid_, NT = o_grid() * 512;
    for (int it = gt; it < MT * 6; it += NT) {
        const int row = it / 6, slot = it % 6; const bool lat = row < MLAT;
        bf16* p = Z + (size_t)row * INW + (slot < 4 ? OFF_AQ + slot * 64 : OFF_AK + (slot - 4) * 64);
        const float* g = (slot < 4 ? a.in[I_GQ] : a.in[I_GK]) + layer * 64;
        float v[64]; float ss = 0.f;
#pragma unroll
        for (int c = 0; c < 8; ++c) { const v4u w = *(const v4u*)(p + 8 * c);
            v[8 * c + 0] = bflo(w.x); v[8 * c + 1] = bfhi(w.x); v[8 * c + 2] = bflo(w.y); v[8 * c + 3] = bfhi(w.y); v[8 * c + 4] = bflo(w.z); v[8 * c + 5] = bfhi(w.z); v[8 * c + 6] = bflo(w.w); v[8 * c + 7] = bfhi(w.w); }
#pragma unroll
        for (int i = 0; i < 64; ++i) ss += v[i] * v[i];
        const float rstd = rsqrtf(ss * (1.f / 64.f) + EPSN);
#pragma unroll
        for (int i = 0; i < 64; ++i) v[i] = v[i] * rstd * g[i];
        if (lat) {
            const int t = row & 2047, gr = t >> 6, gc = t & 63;
#pragma unroll
            for (int i = 0; i < 16; ++i) {
                const float2 cr = rope[gr * 16 + i], cc = rope[gc * 16 + i];
                const float x1 = v[i], x2 = v[16 + i]; v[i] = x1 * cr.x - x2 * cr.y; v[16 + i] = x1 * cr.y + x2 * cr.x;
                const float y1 = v[32 + i], y2 = v[48 + i]; v[32 + i] = y1 * cc.x - y2 * cc.y; v[48 + i] = y1 * cc.y + y2 * cc.x;
            }
        }
#pragma unroll
        for (int c = 0; c < 8; ++c) { v4u w; w.x = pk2(v[8 * c], v[8 * c + 1]); w.y = pk2(v[8 * c + 2], v[8 * c + 3]); w.z = pk2(v[8 * c + 4], v[8 * c + 5]); w.w = pk2(v[8 * c + 6], v[8 * c + 7]); *(v4u*)(p + 8 * c) = w; }
    }
}
struct AttnP { const bf16* Z; bf16* O; int ostride; int qtok0; int qcol; int ocol; int kcol, vcol; int loc0, nloc, ctx0, nctx;
               int na; int qgcol0; int relr0; int head; int act_lo, act_hi; };
struct AttnQS { bf16x8 qr[4]; f32x16 o0, o1; float m, lsum; };
template <int NH, int QB = 1>
__device__ __forceinline__ void attn_unit(LAS unsigned char* lds, const AttnP& P, const LAS float* biasL) {
    int tid_ = threadIdx.x; asm volatile("" : "+v"(tid_));
    const int tid = tid_, lane = tid & 63, wid = tid >> 6, r32 = lane & 31, hi = lane >> 5;
    const int slot = (NH == 1) ? 0 : (wid >> 1);
    const bf16* Z = P.Z;
    AttnQS QA, QBs;
#pragma unroll
    for (int d0 = 0; d0 < 4; ++d0) { QA.qr[d0] = *(const bf16x8*)(Z + (size_t)(P.qtok0 + r32) * INW + P.qcol + d0 * 16 + hi * 8);
        if (QB == 2) QBs.qr[d0] = *(const bf16x8*)(Z + (size_t)(P.qtok0 + 32 + r32) * INW + P.qcol + d0 * 16 + hi * 8); }
    const int nt = P.nloc + P.nctx;
    v4u kreg[NH], vreg[NH];
    auto tile_tok = [&](int i) { return i < P.nloc ? P.loc0 + 64 * i : P.ctx0 + 64 * (i - P.nloc); };
    auto gload = [&](int i) { const int tok = tile_tok(i);
#pragma unroll
        for (int s = 0; s < NH; ++s) { kreg[s] = *(const v4u*)(Z + (size_t)(tok + (tid >> 3)) * INW + P.kcol + s * 64 + (tid & 7) * 8);
                                        vreg[s] = *(const v4u*)(Z + (size_t)(tok + lane) * INW + P.vcol + s * 64 + wid * 8); } };
    gload(0);
    QA.o0 = f32x16{}; QA.o1 = f32x16{}; QA.m = -1e30f; QA.lsum = 0.f; QBs.o0 = f32x16{}; QBs.o1 = f32x16{}; QBs.m = -1e30f; QBs.lsum = 0.f;
    const float sc = 0.125f * LOG2E;
    const int qg = P.qgcol0 + r32; const int cs = qg - 8 < 0 ? 0 : (qg - 8 > 48 ? 48 : qg - 8);
    auto lstore = [&](int bufoff) {
#pragma unroll
        for (int s = 0; s < NH; ++s) {
            LAS unsigned char* sb = lds + bufoff + s * 18432;
            *(LAS v4u*)(sb + ((tid >> 3) * 72 + (tid & 7) * 8) * 2) = kreg[s];
            LAS bf16* vt = (LAS bf16*)(sb + 9216);
            const unsigned w[4] = {vreg[s].x, vreg[s].y, vreg[s].z, vreg[s].w};
#pragma unroll
            for (int e = 0; e < 4; ++e) { vt[(wid * 8 + 2 * e) * 68 + lane] = (bf16)(w[e] & 0xffffu); vt[(wid * 8 + 2 * e + 1) * 68 + lane] = (bf16)(w[e] >> 16); }
        }
    };
    auto compute = [&](int i, int bufoff, AttnQS& S) {
        if (P.na && i < P.nloc && (i < P.act_lo || i >= P.act_hi)) return;
        const LAS unsigned char* kb = lds + bufoff + slot * 18432; const LAS unsigned char* vb = kb + 9216;
        f32x16 p0 = {}, p1 = {};
#pragma unroll
        for (int d0 = 0; d0 < 4; ++d0) {
            const bf16x8 a0 = *(const LAS bf16x8*)(kb + (r32 * 72 + d0 * 16 + hi * 8) * 2);
            const bf16x8 a1 = *(const LAS bf16x8*)(kb + ((32 + r32) * 72 + d0 * 16 + hi * 8) * 2);
            p0 = __builtin_amdgcn_mfma_f32_32x32x16_bf16(a0, S.qr[d0], p0, 0, 0, 0);
            p1 = __builtin_amdgcn_mfma_f32_32x32x16_bf16(a1, S.qr[d0], p1, 0, 0, 0);
        }
        if (P.na && i < P.nloc) {
            const LAS float* bl = biasL + (P.head * 15 + (P.relr0 + i)) * 31;
#pragma unroll
            for (int r = 0; r < 16; ++r) {
                const int kv0 = crow(r, hi), kv1 = kv0 + 32;
                const bool ok0 = (unsigned)(kv0 - cs) < 16u, ok1 = (unsigned)(kv1 - cs) < 16u;
                const int i0 = kv0 - qg + 15, i1 = kv1 - qg + 15;
                const float b0 = bl[i0 < 0 ? 0 : (i0 > 30 ? 30 : i0)], b1 = bl[i1 < 0 ? 0 : (i1 > 30 ? 30 : i1)];
                p0[r] = ok0 ? p0[r] + b0 : -INFINITY; p1[r] = ok1 ? p1[r] + b1 : -INFINITY;
            }
        }
        float mx = fmaxf(fmaxf(p0[0], p0[1]), p1[0]);
#pragma unroll
        for (int r = 2; r < 16; r += 2) mx = fmaxf(fmaxf(mx, p0[r]), p0[r + 1]);
#pragma unroll
        for (int r = 1; r < 15; r += 2) mx = fmaxf(fmaxf(mx, p1[r]), p1[r + 1]);
        mx = fmaxf(mx, p1[15]);
        mx = fmaxf(mx, shfl_xor_l(mx, 32, lane));
        if (__any((mx - S.m) * sc > 6.f)) {
            const float mn = fmaxf(S.m, mx), alpha = __builtin_amdgcn_exp2f((S.m - mn) * sc); S.m = mn; S.lsum *= alpha;
#pragma unroll
            for (int r = 0; r < 16; ++r) { S.o0[r] *= alpha; S.o1[r] *= alpha; }
        }
        const float nm = -S.m * sc;
        float ps = 0.f;
#pragma unroll
        for (int r = 0; r < 16; ++r) { p0[r] = __builtin_amdgcn_exp2f(fmaf(p0[r], sc, nm)); p1[r] = __builtin_amdgcn_exp2f(fmaf(p1[r], sc, nm)); ps += p0[r] + p1[r]; }
        S.lsum += ps;
        bf16x8 pf[4];
#pragma unroll
        for (int s = 0; s < 4; ++s) {
            v4u w;
            if (s < 2) { w.x = pk2(p0[8 * s], p0[8 * s + 1]); w.y = pk2(p0[8 * s + 2], p0[8 * s + 3]); w.z = pk2(p0[8 * s + 4], p0[8 * s + 5]); w.w = pk2(p0[8 * s + 6], p0[8 * s + 7]); }
            else { const int q = s - 2; w.x = pk2(p1[8 * q], p1[8 * q + 1]); w.y = pk2(p1[8 * q + 2], p1[8 * q + 3]); w.z = pk2(p1[8 * q + 4], p1[8 * q + 5]); w.w = pk2(p1[8 * q + 6], p1[8 * q + 7]); }
            pf[s] = __builtin_bit_cast(bf16x8, w);
        }
#pragma unroll
        for (int s = 0; s < 4; ++s) {
            const int kvb = 32 * (s >> 1) + 16 * (s & 1) + 4 * hi;
            {   const LAS unsigned char* va = vb + (r32 * 68 + kvb) * 2;
                const s16x4 lo = *(const LAS s16x4*)va, hh = *(const LAS s16x4*)(va + 16);
                const bf16x8 af = {lo[0], lo[1], lo[2], lo[3], hh[0], hh[1], hh[2], hh[3]};
                S.o0 = __builtin_amdgcn_mfma_f32_32x32x16_bf16(af, pf[s], S.o0, 0, 0, 0); }
            {   const LAS unsigned char* va = vb + ((32 + r32) * 68 + kvb) * 2;
                const s16x4 lo = *(const LAS s16x4*)va, hh = *(const LAS s16x4*)(va + 16);
                const bf16x8 af = {lo[0], lo[1], lo[2], lo[3], hh[0], hh[1], hh[2], hh[3]};
                S.o1 = __builtin_amdgcn_mfma_f32_32x32x16_bf16(af, pf[s], S.o1, 0, 0, 0); }
        }
        };
    if (NH == 1) {
        __syncthreads();
        lstore(0);
        if (nt > 1) gload(1);
        __syncthreads();
        for (int i = 0; i < nt; ++i) {
            if (i + 1 < nt) { lstore(((i + 1) & 1) * 18432); if (i + 2 < nt) gload(i + 2); }
            compute(i, (i & 1) * 18432, QA); if (QB == 2) compute(i, (i & 1) * 18432, QBs);
            __syncthreads();
        }
    } else {
        for (int i = 0; i < nt; ++i) {
            __syncthreads();
            lstore(0);
            __syncthreads();
            if (i + 1 < nt) gload(i + 1);
            compute(i, 0, QA);
        }
    }
    auto finish = [&](AttnQS& S, int qtok) {
        const float lsum = S.lsum + shfl_xor_l(S.lsum, 32, lane);
        const float inv = 1.f / lsum;
        bf16* op = P.O + (size_t)(qtok + r32) * P.ostride + P.ocol;
#pragma unroll
        for (int rg = 0; rg < 4; ++rg) {
            v2u w0, w1;
            w0.x = pk2(S.o0[4 * rg] * inv, S.o0[4 * rg + 1] * inv); w0.y = pk2(S.o0[4 * rg + 2] * inv, S.o0[4 * rg + 3] * inv);
            w1.x = pk2(S.o1[4 * rg] * inv, S.o1[4 * rg + 1] * inv); w1.y = pk2(S.o1[4 * rg + 2] * inv, S.o1[4 * rg + 3] * inv);
            *(v2u*)(op + 8 * rg + 4 * hi) = w0; *(v2u*)(op + 32 + 8 * rg + 4 * hi) = w1;
        } };
    finish(QA, P.qtok0);
    if (QB == 2) finish(QBs, P.qtok0 + 32);
}

__device__ __forceinline__ int s5_tokrow(int s, int dir, int b) {
    if (s < 256) return MLAT + b * 256 + (dir ? 255 - s : s);
    const int t = s - 256; return b * 2048 + (dir ? 2047 - t : t);
}
__device__ __forceinline__ void s5_unit(LAS unsigned char* lds, int layer, int b, int g) {
    CArgs& a = kargs();
    int tid_ = threadIdx.x; asm volatile("" : "+v"(tid_));
    const int tid = tid_, lane = tid & 63, wid = tid >> 6, r32 = lane & 31, hi = lane >> 5;
    LAS float* BuL = (LAS float*)(lds + wid * 17920);
    LAS bf16* HL = (LAS bf16*)(lds + wid * 17920);
    LAS v4u* uL = (LAS v4u*)(lds + wid * 17920 + 8704);
    const bf16* Z = (const bf16*)(a.ws + WS_Z); float* Y0 = (float*)(a.ws + WS_Y0); float* Y1 = (float*)(a.ws + WS_Y1);
    for (int dir = 0; dir < 2; ++dir) {
        const int idx = (layer * 2 + dir) * 16 + g;
        const float dt = expf(a.in[I_LDT][idx]);
        float ar, ai;
        { const float lr = fminf(a.in[I_AR][idx * 64 + lane], -1e-4f), li = a.in[I_AI][idx * 64 + lane]; const float er = expf(lr * dt); float sn, cs; sincosf(li * dt, &sn, &cs); ar = er * cs; ai = er * sn; }
        float pr = ar, pi = ai;
        float p32r, p32i;
#pragma unroll
        for (int k = 0; k < 5; ++k) { const float tr = pr * pr - pi * pi, ti = 2.f * pr * pi; pr = tr; pi = ti; }
        p32r = pr; p32i = pi;
#pragma unroll
        for (int k = 0; k < 3; ++k) { const float tr = pr * pr - pi * pi, ti = 2.f * pr * pi; pr = tr; pi = ti; }
        { const float tr = pr * p32r - pi * p32i, ti = pr * p32i + pi * p32r; pr = tr; pi = ti; }
        bf16x8 bfr[4];
#pragma unroll
        for (int pp = 0; pp < 2; ++pp) {
            const int p2 = 32 * pp + r32;
            const float lr = fminf(a.in[I_AR][idx * 64 + p2], -1e-4f), li = a.in[I_AI][idx * 64 + p2]; const float er = expf(lr * dt); float sn, cs; sincosf(li * dt, &sn, &cs);
            const float xr = er * cs - 1.f, xi = er * sn, den = 1.f / (lr * lr + li * li);
            const float cr = (xr * lr + xi * li) * den, ci = (xi * lr - xr * li) * den;
            const float* br = a.in[I_BR] + ((size_t)idx * 64 + p2) * 16 + 8 * hi; const float* bi = a.in[I_BI] + ((size_t)idx * 64 + p2) * 16 + 8 * hi;
            float re[8], im[8];
#pragma unroll
            for (int j = 0; j < 8; ++j) { const float x = br[j], y = bi[j]; re[j] = cr * x - ci * y; im[j] = cr * y + ci * x; }
            v4u w; w.x = pk2(re[0], re[1]); w.y = pk2(re[2], re[3]); w.z = pk2(re[4], re[5]); w.w = pk2(re[6], re[7]); bfr[pp] = __builtin_bit_cast(bf16x8, w);
            w.x = pk2(im[0], im[1]); w.y = pk2(im[2], im[3]); w.z = pk2(im[4], im[5]); w.w = pk2(im[6], im[7]); bfr[2 + pp] = __builtin_bit_cast(bf16x8, w);
        }
        bf16x8 cfr[8];
        const float cmsk = r32 < 16 ? 1.f : 0.f;
#pragma unroll
        for (int ks = 0; ks < 8; ++ks) {
            const size_t co = ((size_t)idx * 16 + (r32 & 15)) * 64 + 8 * ks + 4 * hi;
            const f32x4 cr4 = *(const f32x4*)(a.in[I_CR] + co), ci4 = *(const f32x4*)(a.in[I_CI] + co);
            v4u w; w.x = pk2(cr4[0] * cmsk, -ci4[0] * cmsk); w.y = pk2(cr4[1] * cmsk, -ci4[1] * cmsk); w.z = pk2(cr4[2] * cmsk, -ci4[2] * cmsk); w.w = pk2(cr4[3] * cmsk, -ci4[3] * cmsk);
            cfr[ks] = __builtin_bit_cast(bf16x8, w);
        }
        float hr = 0.f, him = 0.f;
        float* Yd = dir == 0 ? Y0 : Y1;
        {
            const bf16* ub = Z + OFF_S5 + 16 * g + 8 * hi;
            v4u ur[9];
#pragma unroll
            for (int ch = 0; ch < 9; ++ch) ur[ch] = *(const v4u*)(ub + (size_t)s5_tokrow(wid * 288 + ch * 32 + r32, dir, b) * INW);
#pragma unroll
            for (int ch = 0; ch < 9; ++ch) uL[ch * 64 + lane] = ur[ch];
            asm volatile("s_waitcnt lgkmcnt(0)" ::: "memory");
        }
        for (int pass = 0; pass < 2; ++pass) {
            for (int ch = 0; ch < 9; ++ch) {
                const int s0 = wid * 288 + ch * 32;
                bf16x8 ucur = __builtin_bit_cast(bf16x8, uL[ch * 64 + lane]);
                asm volatile("s_waitcnt lgkmcnt(0)" : "+v"(ucur) :: "memory");
                float bur[32], bui[32];
#pragma unroll
                for (int jb = 0; jb < 2; ++jb) {
                    f32x16 d = {}; d = __builtin_amdgcn_mfma_f32_32x32x16_bf16(ucur, bfr[jb], d, 0, 0, 0);
#pragma unroll
                    for (int r = 0; r < 16; ++r) BuL[crow(r, hi) * 66 + 32 * jb + r32] = d[r];
                }
                asm volatile("s_waitcnt lgkmcnt(0)" : "+v"(ucur) :: "memory");
#pragma unroll
                for (int t = 0; t < 32; ++t) bur[t] = BuL[t * 66 + lane];
                asm volatile("s_waitcnt lgkmcnt(0)" : "+v"(ucur) :: "memory");
#pragma unroll
                for (int jb = 0; jb < 2; ++jb) {
                    f32x16 d = {}; d = __builtin_amdgcn_mfma_f32_32x32x16_bf16(ucur, bfr[2 + jb], d, 0, 0, 0);
#pragma unroll
                    for (int r = 0; r < 16; ++r) BuL[crow(r, hi) * 66 + 32 * jb + r32] = d[r];
                }
                asm volatile("s_waitcnt lgkmcnt(0)" ::: "memory");
#pragma unroll
                for (int t = 0; t < 32; ++t) bui[t] = BuL[t * 66 + lane];
                asm volatile("s_waitcnt lgkmcnt(0)" ::: "memory");
                if (pass == 0) {
#pragma unroll
                    for (int t = 0; t < 32; ++t) { const float nr = ar * hr - ai * him + bur[t], ni = ar * him + ai * hr + bui[t]; hr = nr; him = ni; }
                } else {
#pragma unroll
                    for (int t = 0; t < 32; ++t) { const float nr = ar * hr - ai * him + bur[t], ni = ar * him + ai * hr + bui[t]; hr = nr; him = ni;
                        ((LAS unsigned*)HL)[t * 68 + lane] = pk2(hr, him); }
                    asm volatile("s_waitcnt lgkmcnt(0)" ::: "memory");
                    f32x16 y = {};
#pragma unroll
                    for (int ks = 0; ks < 8; ++ks) { const bf16x8 af = *(const LAS bf16x8*)((const LAS unsigned char*)HL + (r32 * 136 + 16 * ks + 8 * hi) * 2);
                        y = __builtin_amdgcn_mfma_f32_32x32x16_bf16(cfr[ks], af, y, 0, 0, 0); }
                    asm volatile("s_waitcnt lgkmcnt(0)" ::: "memory");
                    if (s0 >= 256 || layer == 0) {
                        float* yp = Yd + (size_t)s5_tokrow(s0 + r32, dir, b) * 256 + 16 * g + 4 * hi;
                        *(f32x4*)yp = (f32x4){y[0], y[1], y[2], y[3]}; *(f32x4*)(yp + 8) = (f32x4){y[4], y[5], y[6], y[7]};
                    }
                }
            }
            if (pass == 0) {
                BuL[lane * 2] = hr; BuL[lane * 2 + 1] = him;
                __syncthreads();
                hr = 0.f; him = 0.f;
                for (int v = 0; v < wid; ++v) { const LAS float* cv = (const LAS float*)(lds + v * 17920); const float cr = cv[lane * 2], ci = cv[lane * 2 + 1]; const float nr = pr * hr - pi * him + cr, ni = pr * him + pi * hr + ci; hr = nr; him = ni; }
                __syncthreads();
            }
        }

    }
}

__device__ __forceinline__ void na_phase(LAS unsigned char* lds, int l) {
    CArgs& a = kargs();
    int tid_ = threadIdx.x; asm volatile("" : "+v"(tid_));
    const int tid = tid_, wid = __builtin_amdgcn_readfirstlane(tid >> 6), G = o_grid(), bid = o_bid();
    bf16* Zb = (bf16*)(a.ws + WS_Z); bf16* CAT = (bf16*)(a.ws + WS_CAT);
    LAS float* biasL = (LAS float*)(lds + 73728);
    for (int i = tid; i < 4 * 15 * 31; i += 512) biasL[i] = 8.f * a.in[I_NABIAS][l * 4 * 15 * 31 + i];
    for (int u = bid; u < 512; u += G) {
        const int b = u >> 5, head = (u >> 3) & 3, rg = u & 7; const int r = 4 * rg + (wid >> 1);
        const int lo = 4 * rg - 4 < 0 ? 0 : (4 * rg - 4 > 24 ? 24 : 4 * rg - 4); const int hi3 = 4 * rg - 1 < 0 ? 0 : (4 * rg - 1 > 24 ? 24 : 4 * rg - 1);
        const int rs = r - 4 < 0 ? 0 : (r - 4 > 24 ? 24 : r - 4);
        AttnP P{Zb, CAT, DM, b * 2048 + r * 64 + (wid & 1) * 32, OFF_NQ + head * 64, 512 + head * 64, OFF_NK + head * 64, OFF_NV + head * 64, b * 2048 + lo * 64, hi3 + 8 - lo, MLAT + b * 256, 4, 1, (wid & 1) * 32, lo - r + 7, head, rs - lo, rs - lo + 8};
        attn_unit<1>(lds, P, biasL);
    }
    if (l == 0) for (int u = bid; u < 64; u += G) {
        const int b = u >> 2, head = u & 3;
        AttnP P{Zb, CAT, DM, MLAT + b * 256 + wid * 32, OFF_NQ + head * 64, 512 + head * 64, OFF_NK + head * 64, OFF_NV + head * 64, 0, 0, MLAT + b * 256, 4, 0, 0, 0, head, 0, 0};
        attn_unit<1>(lds, P, biasL);
    }
}
__device__ __forceinline__ void gqa_phase(LAS unsigned char* lds, int l) {
    CArgs& a = kargs();
    int tid_ = threadIdx.x; asm volatile("" : "+v"(tid_));
    const int tid = tid_, wid = __builtin_amdgcn_readfirstlane(tid >> 6), G = o_grid(), bid = o_bid();
    bf16* Zb = (bf16*)(a.ws + WS_Z); bf16* CAT = (bf16*)(a.ws + WS_CAT);
    const bool bal = (G == 256); const int nmine = bal ? (bid < 128 ? 2 : 0) : (255 - bid) / G + 1;
    for (int iu = 0; iu < nmine; ++iu) {
        const int u = bal ? bid + 128 * iu : bid + iu * G;
        const int b = u >> 4, kvh = (u >> 3) & 1, qb = u & 7; const int head = 2 * kvh + (wid >> 2);
        AttnP P{Zb, CAT, DM, b * 2048 + qb * 256 + (wid & 3) * 64, OFF_AQ + head * 64, head * 64, OFF_AK + kvh * 64, OFF_AV + kvh * 64, b * 2048, 32, MLAT + b * 256, 4, 0, 0, 0, head, 0, 0};
        attn_unit<1, 2>(lds, P, nullptr);
    }
    if (l == 0) for (int u = G - 1 - bid; u < 64; u += G) {
        const int b = u >> 2, kvh = (u >> 1) & 1, qb = u & 1; const int head = 2 * kvh + (wid >> 2);
        AttnP P{Zb, CAT, DM, MLAT + b * 256 + qb * 128 + (wid & 3) * 32, OFF_AQ + head * 64, head * 64, OFF_AK + kvh * 64, OFF_AV + kvh * 64, 0, 0, MLAT + b * 256, 4, 0, 0, 0, head, 0, 0};
        attn_unit<1>(lds, P, nullptr);
    }
}

#define XB_TMO      128
#define XB_XCNT(j)  (256  + 64 * (j))
#define XB_XSUB(j)  (1280 + 64 * (j))
#define XB_XGEN(j)  (2304 + 64 * (j))
#define XB_TOP      3328
#define XB_TOPGEN   3392
#define XCD_BAR_WORDS 3456
#define XB_SPIN_CAP (1u << 18)

__device__ __forceinline__ unsigned xb_ld(unsigned* p)              { return __hip_atomic_load(p, __ATOMIC_RELAXED, __HIP_MEMORY_SCOPE_AGENT); }
__device__ __forceinline__ unsigned xb_add(unsigned* p, unsigned v) { return __hip_atomic_fetch_add(p, v, __ATOMIC_RELAXED, __HIP_MEMORY_SCOPE_AGENT); }
__device__ __forceinline__ unsigned xb_xcc_id() { return (unsigned)__builtin_amdgcn_s_getreg((3 << 11) | 20) & 0xFu; }
#define XB_SPIN(cond, bar) do { unsigned _sp = 0; while (cond) { __builtin_amdgcn_s_sleep(1); \
    if ((++_sp & 255u) == 0u) { if (xb_ld(&(bar)[XB_TMO])) break; if (_sp > XB_SPIN_CAP) { atomicAdd(&(bar)[XB_TMO], 1u); break; } } } } while (0)
struct XcdBarrier { unsigned* bar; unsigned x; volatile LAS unsigned* st; };
__device__ __forceinline__ void xcd_barrier_complete(unsigned* bar, unsigned x, unsigned& nloc, unsigned& nx) {
    const unsigned G = gridDim.x * gridDim.y * gridDim.z;
    unsigned sum, cnt, mine, sp = 0u;
    for (;;) {
        sum = 0u; cnt = 0u; mine = 0u;
#pragma unroll
        for (unsigned j = 0; j < 16; ++j) { const unsigned c = xb_ld(&bar[XB_XCNT(j)]); sum += c; cnt += (c > 0u) ? 1u : 0u; mine = (j == x) ? c : mine; }
        if (sum == G) break;
        __builtin_amdgcn_s_sleep(1);
        if ((++sp & 255u) == 0u) { if (xb_ld(&bar[XB_TMO])) break; if (sp > XB_SPIN_CAP) { atomicAdd(&bar[XB_TMO], 1u); break; } }
    }
    nloc = mine > 0u ? mine : 1u; nx = cnt > 0u ? cnt : 1u;
}

__device__ __forceinline__ void xcd_barrier(const XcdBarrier& b) {
    asm volatile("s_waitcnt vmcnt(0)" ::: "memory");
    __syncthreads();
    if (threadIdx.x == 0) {
        unsigned* bar = b.bar;
        __builtin_amdgcn_s_waitcnt(0);
        unsigned nloc = b.st[0], nx = b.st[1];
        if (nloc == 0u) { xcd_barrier_complete(bar, b.x, nloc, nx); b.st[0] = nloc; b.st[1] = nx; }
        const unsigned old = xb_add(&bar[XB_XSUB(b.x)], 1u);
        const unsigned gen = old / nloc;
        if (old + 1u == (gen + 1u) * nloc) {
            __builtin_amdgcn_fence(__ATOMIC_RELEASE, "agent");
            asm volatile("s_waitcnt vmcnt(0)" ::: "memory");
            const unsigned og = xb_add(&bar[XB_TOP], 1u);
            const unsigned tg = og / nx;
            if (og + 1u == (tg + 1u) * nx) xb_add(&bar[XB_TOPGEN], 1u);
            else XB_SPIN(xb_ld(&bar[XB_TOPGEN]) == tg, bar);
            __builtin_amdgcn_fence(__ATOMIC_ACQUIRE, "agent");
            xb_add(&bar[XB_XGEN(b.x)], 1u);
            asm volatile("s_waitcnt vmcnt(0)" ::: "memory");
        } else {
            XB_SPIN(xb_ld(&bar[XB_XGEN(b.x)]) == gen, bar);
            __builtin_amdgcn_fence(__ATOMIC_ACQUIRE, "agent");
            asm volatile("s_waitcnt vmcnt(0)" ::: "memory");
        }
    }
    __syncthreads();
}

template <class F>
__device__ __forceinline__ void run_gemm(LAS unsigned char* lds, const bf16* A, int lda, const bf16* Bt, int ldb, int M, int N, int K, const F& f, int c, long tsB = 0, int ksplit = 1 << 30, long kjumpB = 0) {
    pg8::Gemm g{A, Bt, M, N, K, lda, ldb, tsB ? tsB : (long)512 * ldb, ksplit, kjumpB}; pg8::StaticOrder S; S.init(M, N, o_grid(), c); Epi8<F> E{f};
    pg8::gemm_phase<Epi8<F>, pg8::StaticOrder, true, true>(lds, g, S, E);
}
#define WSP(off) ((bf16*)(ws + (off)))
__device__ __forceinline__ void ph_store_gemm(LAS unsigned char* lds, int l, int kind) {
    unsigned char* ws = kargs().ws; unsigned char* wb = ws + WS_W + (size_t)l * W_LAYER;
    const int Mr = l == 0 ? MT : MLAT;
    const bf16* A; const bf16* Bt; bf16* O; int lda, ldb, M, N, K, ldc, act;
    if (kind == 0)      { A = WSP(WS_XN);   lda = DM;  Bt = (const bf16*)(wb + WO_IN);  ldb = DM;  M = MT; N = INW; K = DM;  O = WSP(WS_Z);    ldc = INW; act = 0; }
    else if (kind == 1) { A = WSP(WS_CAT);  lda = DM;  Bt = (const bf16*)(wb + WO_OUT); ldb = DM;  M = Mr; N = DM;  K = DM;  O = WSP(WS_Y);    ldc = DM;  act = 0; }
    else if (kind == 2) { A = WSP(WS_XN);   lda = DM;  Bt = (const bf16*)(wb + WO_1);   ldb = DM;  M = Mr; N = DFF; K = DM;  O = WSP(WS_HMID); ldc = DFF; act = 1; }
    else if (kind == 3) { A = WSP(WS_HMID); lda = DFF; Bt = (const bf16*)(wb + WO_2);   ldb = DFF; M = Mr; N = DM;  K = DFF; O = WSP(WS_XN);   ldc = DM;  act = 0; }
    else                { A = (const bf16*)(wb + WO_CS); lda = 256; Bt = WSP(WS_Z) + OFF_FN; ldb = INW; M = 512; N = MT; K = 256; O = WSP(WS_C1); ldc = MT; act = 0; }
    run_gemm(lds, A, lda, Bt, ldb, M, N, K, FStore{O, ldc, act}, o_bid());
}
__device__ __forceinline__ void ph_d2(LAS unsigned char* lds, int l) { CArgs& a = kargs(); unsigned char* ws = a.ws;
    for (int j = 0; j < (l == 0 ? 2 : 1); ++j) {
        if (j == 0) run_gemm(lds, WSP(WS_DFT), 4096, WSP(WS_C1), MT, 2048, 4096, 4096, FD2{WSP(WS_CAT), a.in[I_BFNET] + l * 256, 0, 2048}, o_grid() - 1 - o_bid(), 2048 * 2, 32, ((long)256 * MT - 2048) * 2);
        else run_gemm(lds, WSP(WS_DFTC), 512, WSP(WS_C1) + MLAT, MT, 256, 4096, 512, FD2{WSP(WS_CAT), a.in[I_BFNET] + l * 256, MLAT, 256}, o_grid() - 1 - o_bid(), 256 * 2, 4, ((long)256 * MT - 256) * 2);
    } }
__device__ __forceinline__ void ph_glu(LAS unsigned char* lds, int l) { CArgs& a = kargs(); unsigned char* ws = a.ws; unsigned char* wb = ws + WS_W + (size_t)l * W_LAYER;
    const int Mr = l == 0 ? MT : MLAT;
    {
        int tid_ = threadIdx.x; asm volatile("" : "+v"(tid_));
        pg8::StaticOrder S; S.init(Mr, 256, o_grid(), o_grid() - 1 - o_bid()); pg8::Unit u;
        const bf16* Z = WSP(WS_Z); const float* Y0 = (const float*)(ws + WS_Y0); const float* Y1 = (const float*)(ws + WS_Y1); bf16* T = WSP(WS_T);
        const int c8 = (tid_ & 31) * 8;
        float dk[8];
#pragma unroll
        for (int e = 0; e < 8; ++e) dk[e] = a.in[I_S5D][l * 256 + c8 + e];
        for (int i = 0; S.next(i, u); ++i)
            for (int rr = tid_ >> 5; rr < 256; rr += 16) {
                const size_t row = (size_t)u.pm * 256 + rr;
                const v4u uz = *(const v4u*)(Z + row * INW + OFF_S5 + c8);
                const f32x4 a0 = *(const f32x4*)(Y0 + row * 256 + c8), a1 = *(const f32x4*)(Y0 + row * 256 + c8 + 4), b0 = *(const f32x4*)(Y1 + row * 256 + c8), b1 = *(const f32x4*)(Y1 + row * 256 + c8 + 4);
                const float uv[8] = {bflo(uz.x), bfhi(uz.x), bflo(uz.y), bfhi(uz.y), bflo(uz.z), bfhi(uz.z), bflo(uz.w), bfhi(uz.w)};
                float o[8];
#pragma unroll
                for (int e = 0; e < 8; ++e) { const float v = (e < 4 ? a0[e] + b0[e] : a1[e - 4] + b1[e - 4]) + dk[e] * uv[e];
                    const float uu = 0.7978845608028654f * (v + 0.044715f * v * v * v); o[e] = v / (1.f + __expf(-2.f * uu)); }
                v4u w; w.x = pk2(o[0], o[1]); w.y = pk2(o[2], o[3]); w.z = pk2(o[4], o[5]); w.w = pk2(o[6], o[7]);
                *(v4u*)(T + row * 256 + c8) = w;
            }
        __threadfence(); __syncthreads();
    }
    int K = 256, ld = 256; asm volatile("" : "+s"(K), "+s"(ld));
    run_gemm(lds, WSP(WS_T), ld, (const bf16*)(wb + WO_GLU), ld, Mr, 256, K, FGlu{WSP(WS_CAT), WSP(WS_T)}, o_grid() - 1 - o_bid()); }

__global__ void __launch_bounds__(512, 2) fwd_megakernel(Args a_unused) {
    extern __shared__ __attribute__((aligned(16))) unsigned char lds_raw[];
    LAS unsigned char* lds = (LAS unsigned char*)lds_raw;
    cg::grid_group grid = cg::this_grid();
#ifdef PROBE
    if (blockIdx.x == 0 && threadIdx.x == 0) { unsigned char* pw = kargs().ws + WS_PROBE; for (int i = 0; i < 32; ++i) ((float*)pw)[i] = 0.f; *(unsigned long long*)(pw + 256) = __builtin_amdgcn_s_memrealtime(); }
#endif
    {
        if (threadIdx.x < 2) ((volatile LAS unsigned*)(lds + LDS_BARST))[threadIdx.x] = 0u;
        if (threadIdx.x == 0) (void)xb_add(&((unsigned*)(kargs().ws + WS_BAR))[XB_XCNT(xb_xcc_id())], 1u);
        if (gridDim.x == 0x7fffffffu) grid.sync();
    }
    for (int step = 0; step < 20; ++step) {
        const int l = step < 2 ? 0 : (step - 2) / 9, k = step < 2 ? step - 2 : (step - 2) - 9 * l;
        int gk = -1;
        if (k == 0) gk = 0; else if (k == 2) gk = 4; else if (k == 4) gk = 1; else if (k == 6) gk = 2; else if (k == 7) gk = 3;
        int lbl = k == -2 ? 0 : k == -1 ? 1 : k == 0 ? 2 : k == 1 ? 5 : k == 2 ? 6 : k == 3 ? 9 : k == 4 ? 10 : k == 5 ? 11 : k == 6 ? 12 : k == 7 ? 13 : 14; (void)lbl;
#ifdef DBL_GEMM
        if (gk >= 0) { ph_store_gemm(lds, l, gk); __syncthreads(); }
#endif
#ifdef DBL_ROWS
        if (k == -1) prep_rows0(); if (k == 5 && l == 0) row_update<0>();
#endif
        if (gk >= 0) ph_store_gemm(lds, l, gk);
        else if (k == -2) prologue(lds);
        else if (k == -1) prep_rows0();
        else if (k == 1) {
            qk_prep(l);
            __syncthreads(); STAMP(3);
            na_phase(lds, l);
#ifdef DBL_NA
            __syncthreads(); na_phase(lds, l);
#endif
            __syncthreads(); STAMP(4);
            for (int u = o_bid(); u < 256; u += o_grid()) s5_unit(lds, l, u >> 4, u & 15);
#ifdef DBL_S5
            __syncthreads(); for (int u = o_bid(); u < 256; u += o_grid()) s5_unit(lds, l, u >> 4, u & 15);
#endif
        } else if (k == 3) {
            gqa_phase(lds, l);
#ifdef DBL_GQA
            __syncthreads(); gqa_phase(lds, l);
#endif
            __syncthreads(); STAMP(7);
            ph_d2(lds, l); STAMP(8);
            ph_glu(lds, l);
        } else if (k == 5) { if (l == 0) row_update<0>(); else row_update<2>(); }
        else { if (l == 0) row_update<1>(); else row_update<3>(); }
        if (k == 1) { __syncthreads(); }
        else if (step != 19) {
            XcdBarrier xb; xb.bar = (unsigned*)(kargs().ws + WS_BAR); xb.x = xb_xcc_id(); xb.st = (volatile LAS unsigned*)(lds + LDS_BARST);
            xcd_barrier(xb);
        }
        STAMP(lbl);
    }
}

extern "C" void kernel_launch(void* const* d_in, const int* in_sizes, int n_in, void* d_out, int out_size, void* d_ws, size_t ws_size, hipStream_t stream) {
    static int grid = 0;
    if (grid == 0) {
        if (n_in != 28 || ws_size < WS_END) { fprintf(stderr, "kernel_launch: unexpected n_in %d / ws_size %zu (need %zu)\n", n_in, ws_size, (size_t)WS_END); grid = -1; return; }
        int dev = 0, cus = 0, per_cu = 0;
        hipGetDevice(&dev); hipDeviceGetAttribute(&cus, hipDeviceAttributeMultiprocessorCount, dev);
        if (hipFuncSetAttribute((const void*)fwd_megakernel, hipFuncAttributeMaxDynamicSharedMemorySize, LDS_BYTES) != hipSuccess) { fprintf(stderr, "kernel_launch: hipFuncSetAttribute failed\n"); }
        if (hipOccupancyMaxActiveBlocksPerMultiprocessor(&per_cu, (const void*)fwd_megakernel, 512, LDS_BYTES) != hipSuccess || per_cu < 1) { fprintf(stderr, "kernel_launch: occupancy query says %d\n", per_cu); per_cu = 1; }
        (void)hipGetLastError();
        grid = cus * (per_cu > 1 ? 1 : per_cu);
        if (grid <= 0) grid = 256;
    }
    if (grid < 0) return;
    if (hipMemsetAsync((char*)d_ws + WS_BAR, 0, XCD_BAR_WORDS * 4, stream) != hipSuccess) { fprintf(stderr, "kernel_launch: hipMemsetAsync of the barrier words failed\n"); return; }
    Args a{};
    for (int i = 0; i < 28; ++i) a.in[i] = (const float*)d_in[i];
    a.out = (float*)d_out; a.ws = (unsigned char*)d_ws;
    void* args[] = {&a};
    hipError_t e = hipLaunchCooperativeKernel((const void*)fwd_megakernel, dim3(grid), dim3(512), args, LDS_BYTES, stream);
    if (e != hipSuccess) fprintf(stderr, "cooperative launch failed: %s (grid %d)\n", hipGetErrorString(e), grid);
}
```

```cpp
#include <hip/hip_runtime.h>
#include <hip/hip_cooperative_groups.h>
#include <cstdio>
#include <cstdint>
namespace cg = cooperative_groups;
namespace pg8 {
#define PG8_LAS __attribute__((address_space(3)))
typedef unsigned short bf16_t;
typedef short bf16x8 __attribute__((ext_vector_type(8)));
typedef float f32x4 __attribute__((ext_vector_type(4)));
typedef unsigned u32x4 __attribute__((ext_vector_type(4)));
constexpr int BM = 256, BK = 64, HALF = 128, HTB = HALF * BK * 2  , STAGE_BYTES = 8 * HTB, NXCD = 8, WGM = 8;

__host__ __device__ __forceinline__ int lds_byte(int r, int c) { const int st = (r >> 4) * 2 + (c >> 5), rr = r & 15, cc = c & 31, ob = rr * 64 + cc * 2; return st * 1024 + (ob ^ (((ob >> 9) & 1) << 5)); }
__host__ __device__ __forceinline__ void stage_rc(int b, int& R, int& C) { const int st = b / 1024, sb = b % 1024, swz = sb ^ (((sb >> 9) & 1) << 5); R = (st >> 1) * 16 + swz / 64; C = (st & 1) * 32 + (swz % 64) / 2; }
__host__ __device__ __forceinline__ int perm32(int rho) { const int n = rho >> 4, i = rho & 15; return 8 * (i >> 2) + 4 * n + (i & 3); }

struct Unit { int pm, pn; };
struct Gemm { const bf16_t* A; const bf16_t* Bt; int M, N, K, lda, ldb; long tsB; int ksplit; long kjumpB; };

struct StaticOrder {
    int nM, nN, nwg, G, c;
    __host__ __device__ void init(int M, int N, int G_, int c_) { nM = M / BM; nN = N / BM; nwg = nM * nN; G = G_; c = c_; }
    __host__ __device__ bool next(int i, Unit& u) const {
        const long L = (long)i * G + c; if (L >= nwg) return false;
        int wgid = (int)L; { const int q = nwg / NXCD, r = nwg % NXCD, xcd = wgid % NXCD, off = wgid / NXCD; wgid = (xcd < r ? xcd * (q + 1) : r * (q + 1) + (xcd - r) * q) + off; }
        const int nig = WGM * nN, gid = wgid / nig, fm = gid * WGM, gsz = (nM - fm) < WGM ? (nM - fm) : WGM;
        u.pm = fm + ((wgid % nig) % gsz); u.pn = (wgid % nig) / gsz; return true;
    }
    __device__ __forceinline__ void a_ready(const Unit&) const {}
    __device__ __forceinline__ void done(const Unit&) const {}
};
__device__ __forceinline__ unsigned cvt_pk_bf16(float lo, float hi) { unsigned r; asm volatile("v_cvt_pk_bf16_f32 %0, %1, %2" : "=v"(r) : "v"(lo), "v"(hi)); return r; }
template <class Epi, class Sched, bool ALIGN_EPI = false, bool SP2 = false>
__device__ __forceinline__ void gemm_phase(PG8_LAS unsigned char* lds, const Gemm g, const Sched& S, const Epi& E) {
    int tid_ = threadIdx.x; asm volatile("" : "+v"(tid_));
    const int tid = tid_, wid = __builtin_amdgcn_readfirstlane(tid >> 6), lane = tid & 63, wr = wid >> 2, wc = wid & 3, fr = lane & 15, fq = lane >> 4;
    const int K = g.K, nt = K / BK;
    unsigned voffA[2], voffB[2];
#pragma unroll
    for (int i = 0; i < 2; ++i) { int R, C; stage_rc(tid * 16 + i * 8192, R, C); const int Rb = Epi::PERM ? ((R & ~31) + perm32(R & 31)) : R;
        voffA[i] = (unsigned)(R * g.lda + C) * 2u; voffB[i] = (unsigned)(Rb * g.ldb + C) * 2u; }
    const size_t kstep = (size_t)(BK * 2);
    const size_t hstepA = (size_t)HALF * g.lda * 2, hstepB = (size_t)HALF * g.ldb * 2;
    const size_t tstepA = 2 * hstepA, tstepB = (size_t)g.tsB;
    const unsigned ldsw = (unsigned)wid * 1024u;
    const int aoff = lds_byte(wr * 64 + fr, fq * 8), boff = lds_byte(wc * 32 + fr, fq * 8);
#define PG8_SA(b, h) (((b) * 2 + (h)) * HTB)
#define PG8_SB(b, h) ((4 + (b) * 2 + (h)) * HTB)
#define PG8_STAGE(bufoff, gbase, voff) do { _Pragma("unroll") for (int _i = 0; _i < 2; ++_i) \
        __builtin_amdgcn_global_load_lds((const unsigned*)((const char*)(gbase) + (voff)[_i]), (PG8_LAS unsigned*)(lds + (bufoff) + ldsw + _i * 8192), 16, 0, 0); } while (0)
#define PG8_LDA(dst, b, h) do { _Pragma("unroll") for (int m = 0; m < 4; ++m) _Pragma("unroll") for (int k = 0; k < 2; ++k) dst[m][k] = *(const PG8_LAS bf16x8*)(lds + PG8_SA(b, h) + aoff + m * 2048 + k * 1024); } while (0)
#define PG8_LDB(dst, b, h) do { _Pragma("unroll") for (int n = 0; n < 2; ++n) _Pragma("unroll") for (int k = 0; k < 2; ++k) dst[n][k] = *(const PG8_LAS bf16x8*)(lds + PG8_SB(b, h) + boff + n * 2048 + k * 1024); } while (0)
#define PG8_MMA(ai, bj, At, Bt) do { __builtin_amdgcn_s_setprio(1); _Pragma("unroll") for (int m = 0; m < 4; ++m) _Pragma("unroll") for (int n = 0; n < 2; ++n) _Pragma("unroll") for (int k = 0; k < 2; ++k) \
        acc[ai][bj][m][n] = __builtin_amdgcn_mfma_f32_16x16x32_bf16(Bt[n][k], At[m][k], acc[ai][bj][m][n], 0, 0, 0); __builtin_amdgcn_s_setprio(0); } while (0)
#define PG8_WAIT_V(n) asm volatile("s_waitcnt vmcnt(" #n ")" ::: "memory")
#define PG8_WAIT_L(n) asm volatile("s_waitcnt lgkmcnt(" #n ")" ::: "memory")
#define PG8_BAR __builtin_amdgcn_s_barrier()
#define PG8_SCHED __builtin_amdgcn_sched_barrier(0)
    Unit cur, nxt; int ui = 0;
    if (!S.next(0, cur)) return;
    f32x4 acc[2][2][4][2];
#pragma unroll
    for (int a = 0; a < 2; ++a)
#pragma unroll
        for (int b = 0; b < 2; ++b)
#pragma unroll
            for (int m = 0; m < 4; ++m)
#pragma unroll
                for (int n = 0; n < 2; ++n) acc[a][b][m][n] = (f32x4){0.f, 0.f, 0.f, 0.f};
    bf16x8 At[4][2], B0[2][2], B1[2][2];
    const char* cA = (const char*)g.A + (size_t)cur.pm * tstepA; const char* cB = (const char*)g.Bt + (size_t)cur.pn * tstepB;
    S.a_ready(cur);
    if constexpr (SP2) {
        PG8_STAGE(PG8_SB(0, 0), cB, voffB); PG8_STAGE(PG8_SB(0, 1), cB + hstepB, voffB); PG8_STAGE(PG8_SA(0, 0), cA, voffA); PG8_STAGE(PG8_SA(0, 1), cA + hstepA, voffA);
        if (wr == 1) PG8_BAR;
        PG8_WAIT_V(2); PG8_BAR;
        PG8_STAGE(PG8_SB(1, 0), cB + kstep, voffB); PG8_STAGE(PG8_SA(1, 0), cA + kstep, voffA); PG8_STAGE(PG8_SB(1, 1), cB + hstepB + kstep, voffB);
        PG8_WAIT_V(6); PG8_BAR;
    } else {
        PG8_STAGE(PG8_SB(0, 0), cB, voffB); PG8_STAGE(PG8_SA(0, 0), cA, voffA); PG8_STAGE(PG8_SB(0, 1), cB + hstepB, voffB); PG8_STAGE(PG8_SA(0, 1), cA + hstepA, voffA);
        if (wr == 1) PG8_BAR;
        PG8_WAIT_V(4); PG8_BAR;
        PG8_STAGE(PG8_SB(1, 0), cB + kstep, voffB); PG8_STAGE(PG8_SA(1, 0), cA + kstep, voffA); PG8_STAGE(PG8_SB(1, 1), cB + hstepB + kstep, voffB);
        PG8_WAIT_V(6); PG8_BAR;
    }
    for (;;) {
        const bool has_next = S.next(ui + 1, nxt);
        const char* nA = has_next ? (const char*)g.A + (size_t)nxt.pm * tstepA : cA; const char* nB = has_next ? (const char*)g.Bt + (size_t)nxt.pn * tstepB : cB;
        for (int t = 0; t < nt; t += 2) {
            const bool last = (t == nt - 2);
            const char* a1 = cA + (size_t)(t + 1) * kstep;
            const char* a2 = last ? nA : cA + (size_t)(t + 2) * kstep; const char* b2 = last ? nB : cB + (size_t)(t + 2) * kstep + ((t + 2) >= g.ksplit ? g.kjumpB : 0);
            const char* a3 = a2 + kstep; const char* b3 = b2 + kstep;
            if (last && has_next) S.a_ready(nxt);
            if constexpr (SP2) {
            PG8_LDB(B0, 0, 0); PG8_LDB(B1, 0, 1); PG8_SCHED; PG8_LDA(At, 0, 0); PG8_STAGE(PG8_SA(1, 1), a1 + hstepA, voffA);
            PG8_WAIT_V(8); PG8_WAIT_L(0); PG8_BAR; PG8_MMA(0, 0, At, B0); PG8_MMA(0, 1, At, B1); PG8_BAR; PG8_SCHED;
            PG8_LDA(At, 0, 1); PG8_STAGE(PG8_SB(0, 0), b2, voffB); PG8_STAGE(PG8_SB(0, 1), b2 + hstepB, voffB); PG8_STAGE(PG8_SA(0, 0), a2, voffA);
            PG8_WAIT_V(8); PG8_WAIT_L(0); PG8_BAR; PG8_MMA(1, 0, At, B0); PG8_MMA(1, 1, At, B1); PG8_BAR; PG8_SCHED;
            PG8_LDB(B0, 1, 0); PG8_LDB(B1, 1, 1); PG8_SCHED; PG8_LDA(At, 1, 0); PG8_STAGE(PG8_SA(0, 1), a2 + hstepA, voffA);
            PG8_WAIT_V(8); PG8_WAIT_L(0); PG8_BAR; PG8_MMA(0, 0, At, B0); PG8_MMA(0, 1, At, B1); PG8_BAR; PG8_SCHED;
            PG8_LDA(At, 1, 1); PG8_STAGE(PG8_SB(1, 0), b3, voffB); PG8_STAGE(PG8_SB(1, 1), b3 + hstepB, voffB); PG8_STAGE(PG8_SA(1, 0), a3, voffA);
            PG8_WAIT_V(8); PG8_WAIT_L(0); PG8_BAR; PG8_MMA(1, 0, At, B0); PG8_MMA(1, 1, At, B1); PG8_BAR; PG8_SCHED;
            } else {
            PG8_LDB(B0, 0, 0); PG8_SCHED; PG8_LDA(At, 0, 0); PG8_STAGE(PG8_SA(1, 1), a1 + hstepA, voffA);
            PG8_WAIT_L(8); PG8_BAR; PG8_WAIT_L(0); PG8_MMA(0, 0, At, B0); PG8_BAR; PG8_SCHED;
            PG8_LDB(B1, 0, 1); PG8_STAGE(PG8_SB(0, 0), b2, voffB);
            PG8_BAR; PG8_WAIT_L(0); PG8_MMA(0, 1, At, B1); PG8_BAR;
            PG8_LDA(At, 0, 1); PG8_STAGE(PG8_SA(0, 0), a2, voffA);
            PG8_BAR; PG8_WAIT_L(0); PG8_MMA(1, 0, At, B0); PG8_BAR; PG8_SCHED;
            PG8_STAGE(PG8_SB(0, 1), b2 + hstepB, voffB);
            PG8_WAIT_V(6); PG8_BAR; PG8_MMA(1, 1, At, B1); PG8_BAR;
            PG8_LDB(B0, 1, 0); PG8_SCHED; PG8_LDA(At, 1, 0); PG8_STAGE(PG8_SA(0, 1), a2 + hstepA, voffA);
            PG8_WAIT_L(8); PG8_BAR; PG8_WAIT_L(0); PG8_MMA(0, 0, At, B0); PG8_BAR; PG8_SCHED;
            PG8_LDB(B1, 1, 1); PG8_STAGE(PG8_SB(1, 0), b3, voffB);
            PG8_BAR; PG8_WAIT_L(0); PG8_MMA(0, 1, At, B1); PG8_BAR;
            PG8_LDA(At, 1, 1); PG8_STAGE(PG8_SA(1, 0), a3, voffA);
            PG8_BAR; PG8_WAIT_L(0); PG8_MMA(1, 0, At, B0); PG8_BAR; PG8_SCHED;
            PG8_STAGE(PG8_SB(1, 1), b3 + hstepB, voffB);
            PG8_WAIT_V(6); PG8_BAR; PG8_MMA(1, 1, At, B1); PG8_BAR;
            }
        }
        if constexpr (ALIGN_EPI) { if (wr == 0) PG8_BAR; }
        if constexpr (!Epi::AFTER_DRAIN) { E(acc, cur, wr, wc, fr, fq); S.done(cur); }
        if (!has_next) break;
#pragma unroll
        for (int a = 0; a < 2; ++a)
#pragma unroll
            for (int b = 0; b < 2; ++b)
#pragma unroll
                for (int m = 0; m < 4; ++m)
#pragma unroll
                    for (int n = 0; n < 2; ++n) acc[a][b][m][n] = (f32x4){0.f, 0.f, 0.f, 0.f};
        cur = nxt; cA = nA; cB = nB; ++ui;
        if constexpr (ALIGN_EPI) { if (wr == 1) PG8_BAR; }
    }
    PG8_WAIT_V(0);
    if constexpr (!ALIGN_EPI) { if (wr == 0) PG8_BAR; }
    PG8_BAR;
    if constexpr (Epi::AFTER_DRAIN) { E.fused(acc, cur, wr, wc, fr, fq, lds, wid, lane); S.done(cur); }
#undef PG8_SA
#undef PG8_SB
#undef PG8_STAGE
#undef PG8_LDA
#undef PG8_LDB
#undef PG8_MMA
#undef PG8_WAIT_V
#undef PG8_WAIT_L
#undef PG8_BAR
#undef PG8_SCHED
}
}
#define LAS __attribute__((address_space(3)))
typedef unsigned short bf16;
typedef unsigned v4u __attribute__((ext_vector_type(4)));
typedef unsigned v2u __attribute__((ext_vector_type(2)));
typedef float f32x4 __attribute__((ext_vector_type(4)));
typedef float f32x16 __attribute__((ext_vector_type(16)));
typedef short bf16x8 __attribute__((ext_vector_type(8)));
typedef short s16x4 __attribute__((ext_vector_type(4)));

constexpr int DM = 1024, NB = 16, SEQ = 2048, CTXL = 256, MLAT = NB * SEQ, MCTX = NB * CTXL, MT = MLAT + MCTX, INW = 1792, DFF = 4096;
constexpr int OFF_AQ = 0, OFF_AK = 256, OFF_AV = 384, OFF_S5 = 512, OFF_NQ = 768, OFF_NK = 1024, OFF_NV = 1280, OFF_FN = 1536;
constexpr float EPSN = 1e-6f;
constexpr float LOG2E = 1.4426950408889634f;
constexpr size_t MiB = 1u << 20;
constexpr size_t WS_MOD = 0;
constexpr size_t WS_ROPE = 1 * MiB;
constexpr size_t WS_W = 2 * MiB, W_LAYER = 22 * MiB;
constexpr size_t WO_IN = 0, WO_OUT = WO_IN + (size_t)INW * DM * 2, WO_1 = WO_OUT + (size_t)DM * DM * 2, WO_2 = WO_1 + (size_t)DFF * DM * 2,
                 WO_GLU = WO_2 + (size_t)DFF * DM * 2, WO_CS = WO_GLU + 256 * 256 * 2, WO_END = WO_CS + 512 * 256 * 2;
static_assert(WO_END <= W_LAYER, "weights");
constexpr size_t WS_DFT = 46 * MiB, WS_DFTC = 62 * MiB, WS_XC = 64 * MiB, WS_XN = 80 * MiB;
constexpr size_t WS_T = 116 * MiB, WS_C1 = 350 * MiB;
constexpr size_t WS_Z = 152 * MiB, WS_CAT = 278 * MiB, WS_Y = 350 * MiB, WS_HMID = 152 * MiB, WS_Y0 = 440 * MiB, WS_Y1 = 476 * MiB, WS_END = 512 * MiB;
constexpr int LDS_BYTES = 147456;

struct Args { const float* in[28]; float* out; unsigned char* ws; };
typedef __attribute__((address_space(4))) const Args CArgs;
__device__ __forceinline__ CArgs& kargs() { CArgs* p = (CArgs*)__builtin_amdgcn_kernarg_segment_ptr(); asm volatile("" : "+s"(p)); return *p; }
enum { I_X = 0, I_C, I_CTX, I_CCTX, I_WADA, I_BADA, I_GPREMIX, I_GPOSTMIX, I_GPREMLP, I_GPOSTMLP, I_WIN, I_GQ, I_GK, I_AR, I_AI, I_LDT, I_BR, I_BI, I_CR, I_CI,
       I_S5D, I_WGLU, I_NABIAS, I_WFNET, I_BFNET, I_WOUT, I_W1, I_W2 };

constexpr size_t WS_PROBE = 1 * MiB + 65536;
constexpr size_t WS_BAR = 1 * MiB + 131072;
constexpr int LDS_BARST = 147456 - 64;
#ifdef PROBE
#define STAMP(lbl) do { if (blockIdx.x == 0 && threadIdx.x == 0) { unsigned char* pw_ = kargs().ws + WS_PROBE; const unsigned long long now_ = __builtin_amdgcn_s_memrealtime(); \
    unsigned long long* tp_ = (unsigned long long*)(pw_ + 256); ((float*)pw_)[lbl] += (float)(now_ - *tp_); *tp_ = now_; } } while (0)
#else
#define STAMP(lbl) do {} while (0)
#endif
__device__ __forceinline__ unsigned f2bf(float f) { unsigned u = __builtin_bit_cast(unsigned, f); return (u + 0x7fffu + ((u >> 16) & 1u)) >> 16; }
typedef float f32x2_t __attribute__((ext_vector_type(2))); typedef __bf16 bf16x2_t __attribute__((ext_vector_type(2)));
__device__ __forceinline__ unsigned pk2(float lo, float hi) { const f32x2_t v = {lo, hi}; const bf16x2_t b = __builtin_convertvector(v, bf16x2_t); return __builtin_bit_cast(unsigned, b); }
__device__ __forceinline__ float bflo(unsigned w) { return __builtin_bit_cast(float, w << 16); }
__device__ __forceinline__ float bfhi(unsigned w) { return __builtin_bit_cast(float, w & 0xffff0000u); }
__device__ __forceinline__ float bf2f(bf16 h) { return __builtin_bit_cast(float, (unsigned)h << 16); }
__device__ __forceinline__ int o_bid() { int t = blockIdx.x; asm volatile("" : "+s"(t)); return t; }
__device__ __forceinline__ int o_grid() { int t = gridDim.x; asm volatile("" : "+s"(t)); return t; }
__device__ __forceinline__ float shfl_xor_l(float v, int o, int lane) { return __builtin_bit_cast(float, __builtin_amdgcn_ds_bpermute((lane ^ o) << 2, __builtin_bit_cast(int, v))); }
__device__ __forceinline__ float wave_sum(float v, int lane) {
#pragma unroll
    for (int o = 1; o < 64; o <<= 1) v += shfl_xor_l(v, o, lane);
    return v;
}
__device__ __forceinline__ int crow(int r, int hi) { return (r & 3) + 8 * (r >> 2) + 4 * hi; }

template <class F> struct Epi8 {
    static constexpr bool PERM = true, AFTER_DRAIN = false;
    F f;
    __device__ __forceinline__ void operator()(const pg8::f32x4 (&acc)[2][2][4][2], const pg8::Unit& u, int wr, int wc, int fr, int fq) const {
        asm volatile("" : "+v"(fr), "+v"(fq));
#pragma unroll
        for (int ai = 0; ai < 2; ++ai)
#pragma unroll
            for (int m = 0; m < 4; ++m) {
                const int row = u.pm * 256 + ai * 128 + wr * 64 + m * 16 + fr;
#pragma unroll
                for (int bj = 0; bj < 2; ++bj) { const int col = u.pn * 256 + bj * 128 + wc * 32 + 8 * fq; f(row, col, acc[ai][bj][m][0], acc[ai][bj][m][1]); }
                asm volatile("" ::: "memory"); __builtin_amdgcn_sched_barrier(0);
            }
    }
};
__device__ __forceinline__ v4u pack8(f32x4 a, f32x4 b) { v4u w; w.x = pk2(a[0], a[1]); w.y = pk2(a[2], a[3]); w.z = pk2(b[0], b[1]); w.w = pk2(b[2], b[3]); return w; }
struct FStore { bf16* O; int ldc; int act;
    __device__ __forceinline__ void operator()(int row, int col, f32x4 a, f32x4 b) const {
        if (act == 1) {
#pragma unroll
            for (int i = 0; i < 4; ++i) { float x = a[i] > 0.f ? a[i] : 0.f; a[i] = x * x; float y = b[i] > 0.f ? b[i] : 0.f; b[i] = y * y; } }
        *(v4u*)(O + (size_t)row * ldc + col) = pack8(a, b); } };
struct FD2 { bf16* cat; const float* bias; int rowbase, rowsPerB;
    __device__ __forceinline__ void operator()(int row, int col, f32x4 a, f32x4 b) const {
        const int bb = col >> 8, j = col & 255; const f32x4 b0 = *(const f32x4*)(bias + j), b1 = *(const f32x4*)(bias + j + 4);
        *(v4u*)(cat + ((size_t)(rowbase + bb * rowsPerB + row) * 1024 + 768 + j)) = pack8(a + b0, b + b1); } };
struct FGlu { bf16* cat; const bf16* T;
    __device__ __forceinline__ void operator()(int row, int col, f32x4 a, f32x4 b) const {
        const v4u t = *(const v4u*)(T + (size_t)row * 256 + col);
        float tv[8] = {bflo(t.x), bfhi(t.x), bflo(t.y), bfhi(t.y), bflo(t.z), bfhi(t.z), bflo(t.w), bfhi(t.w)};
#pragma unroll
        for (int i = 0; i < 4; ++i) { a[i] = tv[i] / (1.f + __expf(-a[i])); b[i] = tv[4 + i] / (1.f + __expf(-b[i])); }
        *(v4u*)(cat + (size_t)row * 1024 + 256 + col) = pack8(a, b); } };
__device__ __forceinline__ void transpose_item(const float* W, int K, int N, bf16* WT, LAS float* scr, int item, int lane) {
    const int nblk = N / 32, kb = item / nblk, nb = item % nblk, k0 = 64 * kb, n0 = 32 * nb;
#pragma unroll
    for (int i = 0; i < 8; ++i) { const int kk = 8 * i + (lane >> 3), n4 = (lane & 7) * 4; const f32x4 v = *(const f32x4*)(W + (size_t)(k0 + kk) * N + n0 + n4);
        scr[kk * 33 + n4] = v[0]; scr[kk * 33 + n4 + 1] = v[1]; scr[kk * 33 + n4 + 2] = v[2]; scr[kk * 33 + n4 + 3] = v[3]; }
    asm volatile("s_waitcnt lgkmcnt(0)" ::: "memory");
    const int c = lane & 7;
#pragma unroll
    for (int j = 0; j < 4; ++j) { const int n = (lane >> 3) + 8 * j; const LAS float* s = scr + (8 * c) * 33 + n;
        v4u o; o.x = pk2(s[0 * 33], s[1 * 33]); o.y = pk2(s[2 * 33], s[3 * 33]); o.z = pk2(s[4 * 33], s[5 * 33]); o.w = pk2(s[6 * 33], s[7 * 33]);
        *(v4u*)(WT + (size_t)(n0 + n) * K + k0 + 8 * c) = o; }
    asm volatile("s_waitcnt lgkmcnt(0)" ::: "memory");
}

__device__ __forceinline__ void prologue(LAS unsigned char* lds) {
    CArgs& a = kargs();
    int tid_ = threadIdx.x; asm volatile("" : "+v"(tid_));
    const int tid = tid_, lane = tid & 63, wid = tid >> 6, G = o_grid();
    unsigned char* ws = a.ws;
    {
        LAS float* scr = (LAS float*)(lds + wid * 16384);
        const int gw = o_bid() * 8 + wid, NGW = G * 8;
        constexpr int I0 = (DM / 64) * (INW / 32), I1 = (DM / 64) * (DM / 32), I2 = (DM / 64) * (DFF / 32), I3 = (DFF / 64) * (DM / 32), I4 = (256 / 64) * (256 / 32);
        constexpr int PER = I0 + I1 + I2 + I3 + I4;
        for (int it = gw; it < 2 * PER; it += NGW) {
            const int l = it / PER; int r = it % PER; unsigned char* wb = ws + WS_W + (size_t)l * W_LAYER;
            if (r < I0) { transpose_item(a.in[I_WIN] + (size_t)l * DM * INW, DM, INW, (bf16*)(wb + WO_IN), scr, r, lane); continue; } r -= I0;
            if (r < I1) { transpose_item(a.in[I_WOUT] + (size_t)l * DM * DM, DM, DM, (bf16*)(wb + WO_OUT), scr, r, lane); continue; } r -= I1;
            if (r < I2) { transpose_item(a.in[I_W1] + (size_t)l * DM * DFF, DM, DFF, (bf16*)(wb + WO_1), scr, r, lane); continue; } r -= I2;
            if (r < I3) { transpose_item(a.in[I_W2] + (size_t)l * DFF * DM, DFF, DM, (bf16*)(wb + WO_2), scr, r, lane); continue; } r -= I3;
            transpose_item(a.in[I_WGLU] + (size_t)l * 256 * 256, 256, 256, (bf16*)(wb + WO_GLU), scr, r, lane);
        }
    }
    __syncthreads();
    {
        LAS float* sl = (LAS float*)lds;
        LAS float* part = (LAS float*)(lds + 17 * 1024 * 4);
        float* mod = (float*)(ws + WS_MOD);
        bool have = false;
        for (int u = o_bid(); u < 2 * 96; u += G) {
            if (!have) {
                for (int i = tid; i < 17 * 1024; i += 512) { const float cv = i < 16 * 1024 ? a.in[I_C][i] : a.in[I_CCTX][i - 16 * 1024]; sl[i] = cv / (1.f + __expf(-cv)); }
                have = true; __syncthreads();
            }
            const int l = u / 96, n0 = (u % 96) * 64;
            const float* W = a.in[I_WADA] + (size_t)l * DM * 6144 + n0 + lane;
            float acc[17];
#pragma unroll
            for (int i = 0; i < 17; ++i) acc[i] = 0.f;
            for (int k0 = wid * 128; k0 < wid * 128 + 128; k0 += 16) {
                float wv[16];
#pragma unroll
                for (int q = 0; q < 16; ++q) wv[q] = W[(size_t)(k0 + q) * 6144];
#pragma unroll
                for (int q = 0; q < 16; ++q)
#pragma unroll
                    for (int i = 0; i < 17; ++i) acc[i] += sl[i * 1024 + k0 + q] * wv[q];
            }
#pragma unroll
            for (int i = 0; i < 17; ++i) part[(wid * 17 + i) * 64 + lane] = acc[i];
            __syncthreads();
            for (int o = tid; o < 17 * 64; o += 512) {
                const int i = o >> 6, n = o & 63; float s = a.in[I_BADA][l * 6144 + n0 + n];
#pragma unroll
                for (int w = 0; w < 8; ++w) s += part[(w * 17 + i) * 64 + n];
                mod[((size_t)l * 17 + i) * 6144 + n0 + n] = s;
            }
            __syncthreads();
        }
    }
    {
        const size_t gt = (size_t)o_bid() * 512 + tid, NT = (size_t)G * 512;
        bf16* dft = (bf16*)(ws + WS_DFT);
        for (size_t i = gt; i < (size_t)2048 * 4096 / 8; i += NT) {
            const int kk = (int)(i / 512), n0 = (int)(i % 512) * 8; float v[8];
#pragma unroll
            for (int j = 0; j < 8; ++j) { const int n = n0 + j, nn = n & 2047; const float fr = (float)((kk * nn) & 2047) * (1.f / 2048.f);
                v[j] = (n < 2048 ? __builtin_amdgcn_cosf(fr) : -__builtin_amdgcn_sinf(fr)) * 0.02209708691207961f; }
            v4u o; o.x = pk2(v[0], v[1]); o.y = pk2(v[2], v[3]); o.z = pk2(v[4], v[5]); o.w = pk2(v[6], v[7]);
            *(v4u*)(dft + i * 8) = o;
        }
        bf16* dftc = (bf16*)(ws + WS_DFTC);
        for (size_t i = gt; i < (size_t)256 * 512 / 8; i += NT) {
            const int kk = (int)(i / 64), n0 = (int)(i % 64) * 8; float v[8];
#pragma unroll
            for (int j = 0; j < 8; ++j) { const int n = n0 + j, nn = n & 255; const float fr = (float)((kk * nn) & 255) * (1.f / 256.f);
                v[j] = (n < 256 ? __builtin_amdgcn_cosf(fr) : -__builtin_amdgcn_sinf(fr)) * 0.0625f; }
            v4u o; o.x = pk2(v[0], v[1]); o.y = pk2(v[2], v[3]); o.z = pk2(v[4], v[5]); o.w = pk2(v[6], v[7]);
            *(v4u*)(dftc + i * 8) = o;
        }
        for (size_t i = gt; i < (size_t)2 * 512 * 256; i += NT) {
            const int l = (int)(i / (512 * 256)), rem = (int)(i % (512 * 256)), jp = rem >> 8, cin = rem & 255, j = jp & 255, part = jp >> 8;
            const float* W = a.in[I_WFNET] + (size_t)l * 256 * 256 + (size_t)(cin >> 6) * 64 * 256 + j; const int c = cin & 63; float s = 0.f;
            for (int cp0 = 0; cp0 < 64; cp0 += 16) { float wv[16];
#pragma unroll
                for (int q = 0; q < 16; ++q) wv[q] = W[(size_t)(cp0 + q) * 256];
#pragma unroll
                for (int q = 0; q < 16; ++q) { const float fr = (float)((c * (cp0 + q)) & 63) * (1.f / 64.f); s += (part ? __builtin_amdgcn_sinf(fr) : __builtin_amdgcn_cosf(fr)) * wv[q]; } }
            ((bf16*)(ws + WS_W + (size_t)l * W_LAYER + WO_CS))[(size_t)jp * 256 + cin] = (bf16)f2bf(s * 0.125f);
        }
        float2* rope = (float2*)(ws + WS_ROPE);
        for (size_t i = gt; i < 1024; i += NT) { const int pos = (int)i >> 4, k = (int)i & 15; const float inv = exp2f(-(float)k * (13.287712379549449f / 16.f)); const float ang = (float)pos * inv;
            float sn, cs; sincosf(ang, &sn, &cs); rope[i] = make_float2(cs, sn); }
    }
}

__device__ __forceinline__ void prep_rows0() {
    CArgs& a = kargs();
    int tid_ = threadIdx.x; asm volatile("" : "+v"(tid_));
    const int lane = tid_ & 63, gw = o_bid() * 8 + (tid_ >> 6), NGW = o_grid() * 8;
    const float* mod = (const float*)(a.ws + WS_MOD); bf16* XN = (bf16*)(a.ws + WS_XN); const float* gp = a.in[I_GPREMIX];
    f32x4 vn[4];
    auto rload = [&](int row) { const float* xr = row < MLAT ? a.in[I_X] + (size_t)row * DM : a.in[I_CTX] + (size_t)(row - MLAT) * DM;
#pragma unroll
        for (int j = 0; j < 4; ++j) vn[j] = *(const f32x4*)(xr + 4 * lane + 256 * j); };
    if (gw < MT) rload(gw);
    for (int row = gw; row < MT; row += NGW) {
        const int bi = row < MLAT ? row >> 11 : 16;
        const float* mb = mod + (size_t)bi * 6144;
        f32x4 v[4]; float ss = 0.f;
#pragma unroll
        for (int j = 0; j < 4; ++j) { v[j] = vn[j]; ss += v[j][0] * v[j][0] + v[j][1] * v[j][1] + v[j][2] * v[j][2] + v[j][3] * v[j][3]; }
        if (row + NGW < MT) rload(row + NGW);
        const float rstd = rsqrtf(wave_sum(ss, lane) * (1.f / DM) + EPSN);
#pragma unroll
        for (int j = 0; j < 4; ++j) { const int k = 4 * lane + 256 * j; const f32x4 g = *(const f32x4*)(gp + k), sh = *(const f32x4*)(mb + k), sc = *(const f32x4*)(mb + 1024 + k);
            f32x4 o;
#pragma unroll
            for (int e = 0; e < 4; ++e) o[e] = (v[j][e] * rstd * g[e]) * (1.f + sc[e]) + sh[e];
            v2u w; w.x = pk2(o[0], o[1]); w.y = pk2(o[2], o[3]); *(v2u*)(XN + (size_t)row * DM + k) = w; }
    }
}
template <int WHICH>
__device__ __forceinline__ void row_update() {
    CArgs& a = kargs();
    constexpr int l = WHICH >> 1; constexpr bool MLP = WHICH & 1; constexpr bool NXT = WHICH != 3;
    const int nrows = l == 0 ? MT : MLAT;
    const bf16* Y = (const bf16*)(a.ws + (MLP ? WS_XN : WS_Y)); bf16* OB = (bf16*)(a.ws + WS_XN);
    const float* xlat_in = WHICH == 0 ? a.in[I_X] : a.out; const float* xctx_in = WHICH == 0 ? a.in[I_CTX] : (const float*)(a.ws + WS_XC);
    float* xlat_out = a.out; float* xctx_out = (float*)(a.ws + WS_XC);
    const float* mod = (const float*)(a.ws + WS_MOD);
    const float* modl = mod + (size_t)l * 17 * 6144; constexpr int gate_i = MLP ? 5 : 2;
    const float* gpost = (MLP ? a.in[I_GPOSTMLP] : a.in[I_GPOSTMIX]) + l * DM;
    const float* modn = MLP ? mod + (size_t)17 * 6144 : modl; constexpr int sh_i = MLP ? 0 : 3, sc_i = MLP ? 1 : 4;
    const float* gnext = MLP ? a.in[I_GPREMIX] + DM : a.in[I_GPREMLP] + l * DM;
    int tid_ = threadIdx.x; asm volatile("" : "+v"(tid_));
    const int lane = tid_ & 63, gw = o_bid() * 8 + (tid_ >> 6), NGW = o_grid() * 8;
    v2u ywn[4]; f32x4 xn[4];
    auto rload = [&](int row) {
        const bool lat = row < MLAT; const float* xr = lat ? xlat_in + (size_t)row * DM : xctx_in + (size_t)(row - MLAT) * DM;
#pragma unroll
        for (int j = 0; j < 4; ++j) { const int k = 4 * lane + 256 * j; ywn[j] = *(const v2u*)(Y + (size_t)row * DM + k); xn[j] = *(const f32x4*)(xr + k); } };
    if (gw < nrows) rload(gw);
    for (int row = gw; row < nrows; row += NGW) {
        const bool lat = row < MLAT; const int bi = lat ? row >> 11 : 16;
        float* xo = lat ? xlat_out + (size_t)row * DM : xctx_out + (size_t)(row - MLAT) * DM;
        const float* gate = modl + (size_t)bi * 6144 + gate_i * 1024;
        f32x4 y[4], x[4]; float ss = 0.f;
#pragma unroll
        for (int j = 0; j < 4; ++j) { const v2u w = ywn[j]; y[j] = (f32x4){bflo(w.x), bfhi(w.x), bflo(w.y), bfhi(w.y)}; x[j] = xn[j];
            ss += y[j][0] * y[j][0] + y[j][1] * y[j][1] + y[j][2] * y[j][2] + y[j][3] * y[j][3]; }
        if (row + NGW < nrows) rload(row + NGW);
        const float rstd = rsqrtf(wave_sum(ss, lane) * (1.f / DM) + EPSN); float s2 = 0.f;
#pragma unroll
        for (int j = 0; j < 4; ++j) { const int k = 4 * lane + 256 * j; const f32x4 g = *(const f32x4*)(gpost + k), gt = *(const f32x4*)(gate + k);
#pragma unroll
            for (int e = 0; e < 4; ++e) { x[j][e] = x[j][e] + gt[e] * (y[j][e] * rstd * g[e]); s2 += x[j][e] * x[j][e]; }
#ifdef PROBE
            if (WHICH == 3) { const float* pa = (const float*)(a.ws + WS_PROBE); float tot = 0.f, fa = 0.f, fb = 0.f;
                for (int i = 0; i < 15; ++i) { const float v = pa[i]; tot += v; if ((PROBE_A >> i) & 1) fa += v; if ((PROBE_B >> i) & 1) fb += v; }
                fa /= tot; fb /= tot; const float e = fa < 0.02f ? 0.02f : fa;
                for (int q = 0; q < 4; ++q) x[j][q] *= (1.f + e);
                if (row == 0 && lane == 0 && j == 0) x[j][0] += 50.f + 1000.f * fb; }
#endif
            *(f32x4*)(xo + k) = x[j]; }
        if (NXT) {
            const float rstd2 = rsqrtf(wave_sum(s2, lane) * (1.f / DM) + EPSN); const float* mb = modn + (size_t)bi * 6144;
#pragma unroll
            for (int j = 0; j < 4; ++j) { const int k = 4 * lane + 256 * j; const f32x4 g = *(const f32x4*)(gnext + k), sh = *(const f32x4*)(mb + sh_i * 1024 + k), sc = *(const f32x4*)(mb + sc_i * 1024 + k);
                f32x4 o;
#pragma unroll
                for (int e = 0; e < 4; ++e) o[e] = (x[j][e] * rstd2 * g[e]) * (1.f + sc[e]) + sh[e];
                v2u w; w.x = pk2(o[0], o[1]); w.y = pk2(o[2], o[3]); *(v2u*)(OB + (size_t)row * DM + k) = w; }
        }
    }
}

__device__ __forceinline__ void qk_prep(int layer) {
    CArgs& a = kargs();
    bf16* Z = (bf16*)(a.ws + WS_Z); const float2* rope = (const float2*)(a.ws + WS_ROPE);
    int tid_ = threadIdx.x; asm volatile("" : "+v"(tid_));
    const int gt = o_bid() * 512 + tid_, NT = o_grid() * 512;
    for (int it = gt; it < MT * 6; it += NT) {
        const int row = it / 6, slot = it % 6; const bool lat = row < MLAT;
        bf16* p = Z + (size_t)row * INW + (slot < 4 ? OFF_AQ + slot * 64 : OFF_AK + (slot - 4) * 64);
        const float* g = (slot < 4 ? a.in[I_GQ] : a.in[I_GK]) + layer * 64;
        float v[64]; float ss = 0.f;
#pragma unroll
        for (int c = 0; c < 8; ++c) { const v4u w = *(const v4u*)(p + 8 * c);
            v[8 * c + 0] = bflo(w.x); v[8 * c + 1] = bfhi(w.x); v[8 * c + 2] = bflo(w.y); v[8 * c + 3] = bfhi(w.y); v[8 * c + 4] = bflo(w.z); v[8 * c + 5] = bfhi(w.z); v[8 * c + 6] = bflo(w.w); v[8 * c + 7] = bfhi(w.w); }
#pragma unroll
        for (int i = 0; i < 64; ++i) ss += v[i] * v[i];
        const float rstd = rsqrtf(ss * (1.f / 64.f) + EPSN);
#pragma unroll
        for (int i = 0; i < 64; ++i) v[i] = v[i] * rstd * g[i];
        if (lat) {
            const int t = row & 2047, gr = t >> 6, gc = t & 63;
#pragma unroll
            for (int i = 0; i < 16; ++i) {
                const float2 cr = rope[gr * 16 + i], cc = rope[gc * 16 + i];
                const float x1 = v[i], x2 = v[16 + i]; v[i] = x1 * cr.x - x2 * cr.y; v[16 + i] = x1 * cr.y + x2 * cr.x;
                const float y1 = v[32 + i], y2 = v[48 + i]; v[32 + i] = y1 * cc.x - y2 * cc.y; v[48 + i] = y1 * cc.y + y2 * cc.x;
            }
        }
#pragma unroll
        for (int c = 0; c < 8; ++c) { v4u w; w.x = pk2(v[8 * c], v[8 * c + 1]); w.y = pk2(v[8 * c + 2], v[8 * c + 3]); w.z = pk2(v[8 * c + 4], v[8 * c + 5]); w.w = pk2(v[8 * c + 6], v[8 * c + 7]); *(v4u*)(p + 8 * c) = w; }
    }
}
struct AttnP { const bf16* Z; bf16* O; int ostride; int qtok0; int qcol; int ocol; int kcol, vcol; int loc0, nloc, ctx0, nctx;
               int na; int qgcol0; int relr0; int head; int act_lo, act_hi; };
struct AttnQS { bf16x8 qr[4]; f32x16 o0, o1; float m, lsum; };
template <int NH, int QB = 1>
__device__ __forceinline__ void attn_unit(LAS unsigned char* lds, const AttnP& P, const LAS float* biasL) {
    int tid_ = threadIdx.x; asm volatile("" : "+v"(tid_));
    const int tid = tid_, lane = tid & 63, wid = tid >> 6, r32 = lane & 31, hi = lane >> 5;
    const int slot = (NH == 1) ? 0 : (wid >> 1);
    const bf16* Z = P.Z;
    AttnQS QA, QBs;
#pragma unroll
    for (int d0 = 0; d0 < 4; ++d0) { QA.qr[d0] = *(const bf16x8*)(Z + (size_t)(P.qtok0 + r32) * INW + P.qcol + d0 * 16 + hi * 8);
        if (QB == 2) QBs.qr[d0] = *(const bf16x8*)(Z + (size_t)(P.qtok0 + 32 + r32) * INW + P.qcol + d0 * 16 + hi * 8); }
    const int nt = P.nloc + P.nctx;
    v4u kreg[NH], vreg[NH];
    auto tile_tok = [&](int i) { return i < P.nloc ? P.loc0 + 64 * i : P.ctx0 + 64 * (i - P.nloc); };
    auto gload = [&](int i) { const int tok = tile_tok(i);
#pragma unroll
        for (int s = 0; s < NH; ++s) { kreg[s] = *(const v4u*)(Z + (size_t)(tok + (tid >> 3)) * INW + P.kcol + s * 64 + (tid & 7) * 8);
                                        vreg[s] = *(const v4u*)(Z + (size_t)(tok + lane) * INW + P.vcol + s * 64 + wid * 8); } };
    gload(0);
    QA.o0 = f32x16{}; QA.o1 = f32x16{}; QA.m = -1e30f; QA.lsum = 0.f; QBs.o0 = f32x16{}; QBs.o1 = f32x16{}; QBs.m = -1e30f; QBs.lsum = 0.f;
    const float sc = 0.125f * LOG2E;
    const int qg = P.qgcol0 + r32; const int cs = qg - 8 < 0 ? 0 : (qg - 8 > 48 ? 48 : qg - 8);
    auto lstore = [&](int bufoff) {
#pragma unroll
        for (int s = 0; s < NH; ++s) {
            LAS unsigned char* sb = lds + bufoff + s * 18432;
            *(LAS v4u*)(sb + ((tid >> 3) * 72 + (tid & 7) * 8) * 2) = kreg[s];
            LAS bf16* vt = (LAS bf16*)(sb + 9216);
            const unsigned w[4] = {vreg[s].x, vreg[s].y, vreg[s].z, vreg[s].w};
#pragma unroll
            for (int e = 0; e < 4; ++e) { vt[(wid * 8 + 2 * e) * 68 + lane] = (bf16)(w[e] & 0xffffu); vt[(wid * 8 + 2 * e + 1) * 68 + lane] = (bf16)(w[e] >> 16); }
        }
    };
    auto compute = [&](int i, int bufoff, AttnQS& S) {
        if (P.na && i < P.nloc && (i < P.act_lo || i >= P.act_hi)) return;
        const LAS unsigned char* kb = lds + bufoff + slot * 18432; const LAS unsigned char* vb = kb + 9216;
        f32x16 p0 = {}, p1 = {};
#pragma unroll
        for (int d0 = 0; d0 < 4; ++d0) {
            const bf16x8 a0 = *(const LAS bf16x8*)(kb + (r32 * 72 + d0 * 16 + hi * 8) * 2);
            const bf16x8 a1 = *(const LAS bf16x8*)(kb + ((32 + r32) * 72 + d0 * 16 + hi * 8) * 2);
            p0 = __builtin_amdgcn_mfma_f32_32x32x16_bf16(a0, S.qr[d0], p0, 0, 0, 0);
            p1 = __builtin_amdgcn_mfma_f32_32x32x16_bf16(a1, S.qr[d0], p1, 0, 0, 0);
        }
        if (P.na && i < P.nloc) {
            const LAS float* bl = biasL + (P.head * 15 + (P.relr0 + i)) * 31;
#pragma unroll
            for (int r = 0; r < 16; ++r) {
                const int kv0 = crow(r, hi), kv1 = kv0 + 32;
                const bool ok0 = (unsigned)(kv0 - cs) < 16u, ok1 = (unsigned)(kv1 - cs) < 16u;
                const int i0 = kv0 - qg + 15, i1 = kv1 - qg + 15;
                const float b0 = bl[i0 < 0 ? 0 : (i0 > 30 ? 30 : i0)], b1 = bl[i1 < 0 ? 0 : (i1 > 30 ? 30 : i1)];
                p0[r] = ok0 ? p0[r] + b0 : -INFINITY; p1[r] = ok1 ? p1[r] + b1 : -INFINITY;
            }
        }
        float mx = fmaxf(fmaxf(p0[0], p0[1]), p1[0]);
#pragma unroll
        for (int r = 2; r < 16; r += 2) mx = fmaxf(fmaxf(mx, p0[r]), p0[r + 1]);
#pragma unroll
        for (int r = 1; r < 15; r += 2) mx = fmaxf(fmaxf(mx, p1[r]), p1[r + 1]);
        mx = fmaxf(mx, p1[15]);
        mx = fmaxf(mx, shfl_xor_l(mx, 32, lane));
        if (__any((mx - S.m) * sc > 6.f)) {
            const float mn = fmaxf(S.m, mx), alpha = __builtin_amdgcn_exp2f((S.m - mn) * sc); S.m = mn; S.lsum *= alpha;
#pragma unroll
            for (int r = 0; r < 16; ++r) { S.o0[r] *= alpha; S.o1[r] *= alpha; }
        }
        const float nm = -S.m * sc;
        float ps = 0.f;
#pragma unroll
        for (int r = 0; r < 16; ++r) { p0[r] = __builtin_amdgcn_exp2f(fmaf(p0[r], sc, nm)); p1[r] = __builtin_amdgcn_exp2f(fmaf(p1[r], sc, nm)); ps += p0[r] + p1[r]; }
        S.lsum += ps;
        bf16x8 pf[4];
#pragma unroll
        for (int s = 0; s < 4; ++s) {
            v4u w;
            if (s < 2) { w.x = pk2(p0[8 * s], p0[8 * s + 1]); w.y = pk2(p0[8 * s + 2], p0[8 * s + 3]); w.z = pk2(p0[8 * s + 4], p0[8 * s + 5]); w.w = pk2(p0[8 * s + 6], p0[8 * s + 7]); }
            else { const int q = s - 2; w.x = pk2(p1[8 * q], p1[8 * q + 1]); w.y = pk2(p1[8 * q + 2], p1[8 * q + 3]); w.z = pk2(p1[8 * q + 4], p1[8 * q + 5]); w.w = pk2(p1[8 * q + 6], p1[8 * q + 7]); }
            pf[s] = __builtin_bit_cast(bf16x8, w);
        }
#pragma unroll
        for (int s = 0; s < 4; ++s) {
            const int kvb = 32 * (s >> 1) + 16 * (s & 1) + 4 * hi;
            {   const LAS unsigned char* va = vb + (r32 * 68 + kvb) * 2;
                const s16x4 lo = *(const LAS s16x4*)va, hh = *(const LAS s16x4*)(va + 16);
                const bf16x8 af = {lo[0], lo[1], lo[2], lo[3], hh[0], hh[1], hh[2], hh[3]};
                S.o0 = __builtin_amdgcn_mfma_f32_32x32x16_bf16(af, pf[s], S.o0, 0, 0, 0); }
            {   const LAS unsigned char* va = vb + ((32 + r32) * 68 + kvb) * 2;
                const s16x4 lo = *(const LAS s16x4*)va, hh = *(const LAS s16x4*)(va + 16);
                const bf16x8 af = {lo[0], lo[1], lo[2], lo[3], hh[0], hh[1], hh[2], hh[3]};
                S.o1 = __builtin_amdgcn_mfma_f32_32x32x16_bf16(af, pf[s], S.o1, 0, 0, 0); }
        }
        };
    if (NH == 1) {
        __syncthreads();
        lstore(0);
        if (nt > 1) gload(1);
        __syncthreads();
        for (int i = 0; i < nt; ++i) {
            if (i + 1 < nt) { lstore(((i + 1) & 1) * 18432); if (i + 2 < nt) gload(i + 2); }
            compute(i, (i & 1) * 18432, QA); if (QB == 2) compute(i, (i & 1) * 18432, QBs);
            __syncthreads();
        }
    } else {
        for (int i = 0; i < nt; ++i) {
            __syncthreads();
            lstore(0);
            __syncthreads();
            if (i + 1 < nt) gload(i + 1);
            compute(i, 0, QA);
        }
    }
    auto finish = [&](AttnQS& S, int qtok) {
        const float lsum = S.lsum + shfl_xor_l(S.lsum, 32, lane);
        const float inv = 1.f / lsum;
        bf16* op = P.O + (size_t)(qtok + r32) * P.ostride + P.ocol;
#pragma unroll
        for (int rg = 0; rg < 4; ++rg) {
            v2u w0, w1;
            w0.x = pk2(S.o0[4 * rg] * inv, S.o0[4 * rg + 1] * inv); w0.y = pk2(S.o0[4 * rg + 2] * inv, S.o0[4 * rg + 3] * inv);
            w1.x = pk2(S.o1[4 * rg] * inv, S.o1[4 * rg + 1] * inv); w1.y = pk2(S.o1[4 * rg + 2] * inv, S.o1[4 * rg + 3] * inv);
            *(v2u*)(op + 8 * rg + 4 * hi) = w0; *(v2u*)(op + 32 + 8 * rg + 4 * hi) = w1;
        } };
    finish(QA, P.qtok0);
    if (QB == 2) finish(QBs, P.qtok0 + 32);
}

__device__ __forceinline__ int s5_tokrow(int s, int dir, int b) {
    if (s < 256) return MLAT + b * 256 + (dir ? 255 - s : s);
    const int t = s - 256; return b * 2048 + (dir ? 2047 - t : t);
}
__device__ __forceinline__ void s5_unit(LAS unsigned char* lds, int layer, int b, int g) {
    CArgs& a = kargs();
    int tid_ = threadIdx.x; asm volatile("" : "+v"(tid_));
    const int tid = tid_, lane = tid & 63, wid = tid >> 6, r32 = lane & 31, hi = lane >> 5;
    LAS float* BuL = (LAS float*)(lds + wid * 17920);
    LAS bf16* HL = (LAS bf16*)(lds + wid * 17920);
    LAS v4u* uL = (LAS v4u*)(lds + wid * 17920 + 8704);
    const bf16* Z = (const bf16*)(a.ws + WS_Z); float* Y0 = (float*)(a.ws + WS_Y0); float* Y1 = (float*)(a.ws + WS_Y1);
    for (int dir = 0; dir < 2; ++dir) {
        const int idx = (layer * 2 + dir) * 16 + g;
        const float dt = expf(a.in[I_LDT][idx]);
        float ar, ai;
        { const float lr = fminf(a.in[I_AR][idx * 64 + lane], -1e-4f), li = a.in[I_AI][idx * 64 + lane]; const float er = expf(lr * dt); float sn, cs; sincosf(li * dt, &sn, &cs); ar = er * cs; ai = er * sn; }
        float pr = ar, pi = ai;
        float p32r, p32i;
#pragma unroll
        for (int k = 0; k < 5; ++k) { const float tr = pr * pr - pi * pi, ti = 2.f * pr * pi; pr = tr; pi = ti; }
        p32r = pr; p32i = pi;
#pragma unroll
        for (int k = 0; k < 3; ++k) { const float tr = pr * pr - pi * pi, ti = 2.f * pr * pi; pr = tr; pi = ti; }
        { const float tr = pr * p32r - pi * p32i, ti = pr * p32i + pi * p32r; pr = tr; pi = ti; }
        bf16x8 bfr[4];
        float aR[2], aI[2];
#pragma unroll
        for (int pp = 0; pp < 2; ++pp) {
            const int p2 = 32 * pp + r32;
            const float lr = fminf(a.in[I_AR][idx * 64 + p2], -1e-4f), li = a.in[I_AI][idx * 64 + p2]; const float er = expf(lr * dt); float sn, cs; sincosf(li * dt, &sn, &cs);
            aR[pp] = er * cs; aI[pp] = er * sn;
            const float xr = er * cs - 1.f, xi = er * sn, den = 1.f / (lr * lr + li * li);
            const float cr = (xr * lr + xi * li) * den, ci = (xi * lr - xr * li) * den;
            const float* br = a.in[I_BR] + ((size_t)idx * 64 + p2) * 16 + 8 * hi; const float* bi = a.in[I_BI] + ((size_t)idx * 64 + p2) * 16 + 8 * hi;
            float re[8], im[8];
#pragma unroll
            for (int j = 0; j < 8; ++j) { const float x = br[j], y = bi[j]; re[j] = cr * x - ci * y; im[j] = cr * y + ci * x; }
            v4u w; w.x = pk2(re[0], re[1]); w.y = pk2(re[2], re[3]); w.z = pk2(re[4], re[5]); w.w = pk2(re[6], re[7]); bfr[pp] = __builtin_bit_cast(bf16x8, w);
            w.x = pk2(im[0], im[1]); w.y = pk2(im[2], im[3]); w.z = pk2(im[4], im[5]); w.w = pk2(im[6], im[7]); bfr[2 + pp] = __builtin_bit_cast(bf16x8, w);
        }
        bf16x8 cfr[8];
        const float cmsk = r32 < 16 ? 1.f : 0.f;
#pragma unroll
        for (int ks = 0; ks < 8; ++ks) {
            const size_t co = ((size_t)idx * 16 + (r32 & 15)) * 64 + 8 * ks + 4 * hi;
            const f32x4 cr4 = *(const f32x4*)(a.in[I_CR] + co), ci4 = *(const f32x4*)(a.in[I_CI] + co);
            v4u w; w.x = pk2(cr4[0] * cmsk, -ci4[0] * cmsk); w.y = pk2(cr4[1] * cmsk, -ci4[1] * cmsk); w.z = pk2(cr4[2] * cmsk, -ci4[2] * cmsk); w.w = pk2(cr4[3] * cmsk, -ci4[3] * cmsk);
            cfr[ks] = __builtin_bit_cast(bf16x8, w);
        }
        float hr = 0.f, him = 0.f;
        float* Yd = dir == 0 ? Y0 : Y1;
        {
            const bf16* ub = Z + OFF_S5 + 16 * g + 8 * hi;
            v4u ur[9];
#pragma unroll
            for (int ch = 0; ch < 9; ++ch) ur[ch] = *(const v4u*)(ub + (size_t)s5_tokrow(wid * 288 + ch * 32 + r32, dir, b) * INW);
#pragma unroll
            for (int ch = 0; ch < 9; ++ch) uL[ch * 64 + lane] = ur[ch];
            asm volatile("s_waitcnt lgkmcnt(0)" ::: "memory");
        }
        for (int pass = 0; pass < 2; ++pass) {
            if (pass == 0) {
                float hx[2][2] = {{0.f, 0.f}, {0.f, 0.f}};
                for (int ch = 0; ch < 9; ++ch) {
                    const bf16x8 ucur = __builtin_bit_cast(bf16x8, uL[ch * 64 + lane]);
#pragma unroll
                    for (int X = 0; X < 2; ++X) {
                        f32x16 re = {}, im = {};
                        re = __builtin_amdgcn_mfma_f32_32x32x16_bf16(ucur, bfr[X], re, 0, 0, 0); im = __builtin_amdgcn_mfma_f32_32x32x16_bf16(ucur, bfr[2 + X], im, 0, 0, 0);
                        const float ar_ = aR[X], ai_ = aI[X];
                        float a4r_, a4i_, a8r_, a8i_, a32r_, a32i_;
                        { float tr = ar_, ti = ai_;
#pragma unroll
                          for (int k = 0; k < 5; ++k) { const float nr = tr * tr - ti * ti, ni = 2.f * tr * ti; tr = nr; ti = ni; if (k == 1) { a4r_ = tr; a4i_ = ti; } if (k == 2) { a8r_ = tr; a8i_ = ti; } }
                          a32r_ = tr; a32i_ = ti; }
                        float Sr = 0.f, Si = 0.f;
#pragma unroll
                        for (int q = 0; q < 4; ++q) {
                            float gr = re[4 * q], gi = im[4 * q];
#pragma unroll
                            for (int i = 1; i < 4; ++i) { const float nr = gr * ar_ - gi * ai_ + re[4 * q + i], ni = gr * ai_ + gi * ar_ + im[4 * q + i]; gr = nr; gi = ni; }
                            if (q == 0) { Sr = gr; Si = gi; } else { const float nr = Sr * a8r_ - Si * a8i_ + gr, ni = Sr * a8i_ + Si * a8r_ + gi; Sr = nr; Si = ni; }
                        }
                        const float fr = hi ? 1.f : a4r_, fi = hi ? 0.f : a4i_;
                        const float Pr = Sr * fr - Si * fi, Pi = Sr * fi + Si * fr;
                        const float Cr = Pr, Ci = Pi;
                        const float nr = hx[X][0] * a32r_ - hx[X][1] * a32i_ + Cr, ni = hx[X][0] * a32i_ + hx[X][1] * a32r_ + Ci; hx[X][0] = nr; hx[X][1] = ni;
                    }
                }
#pragma unroll
                for (int X = 0; X < 2; ++X) { hx[X][0] += shfl_xor_l(hx[X][0], 32, lane); hx[X][1] += shfl_xor_l(hx[X][1], 32, lane); }
                hr = hi ? hx[1][0] : hx[0][0]; him = hi ? hx[1][1] : hx[0][1];
            } else
            for (int ch = 0; ch < 9; ++ch) {
                const int s0 = wid * 288 + ch * 32;
                bf16x8 ucur = __builtin_bit_cast(bf16x8, uL[ch * 64 + lane]);
                asm volatile("s_waitcnt lgkmcnt(0)" : "+v"(ucur) :: "memory");
                float bur[32], bui[32];
#pragma unroll
                for (int jb = 0; jb < 2; ++jb) {
                    f32x16 d = {}; d = __builtin_amdgcn_mfma_f32_32x32x16_bf16(ucur, bfr[jb], d, 0, 0, 0);
#pragma unroll
                    for (int r = 0; r < 16; ++r) BuL[crow(r, hi) * 66 + 32 * jb + r32] = d[r];
                }
                asm volatile("s_waitcnt lgkmcnt(0)" : "+v"(ucur) :: "memory");
#pragma unroll
                for (int t = 0; t < 32; ++t) bur[t] = BuL[t * 66 + lane];
                asm volatile("s_waitcnt lgkmcnt(0)" : "+v"(ucur) :: "memory");
#pragma unroll
                for (int jb = 0; jb < 2; ++jb) {
                    f32x16 d = {}; d = __builtin_amdgcn_mfma_f32_32x32x16_bf16(ucur, bfr[2 + jb], d, 0, 0, 0);
#pragma unroll
                    for (int r = 0; r < 16; ++r) BuL[crow(r, hi) * 66 + 32 * jb + r32] = d[r];
                }
                asm volatile("s_waitcnt lgkmcnt(0)" ::: "memory");
#pragma unroll
                for (int t = 0; t < 32; ++t) bui[t] = BuL[t * 66 + lane];
                asm volatile("s_waitcnt lgkmcnt(0)" ::: "memory");
                if (pass == 0) {
#pragma unroll
                    for (int t = 0; t < 32; ++t) { const float nr = ar * hr - ai * him + bur[t], ni = ar * him + ai * hr + bui[t]; hr = nr; him = ni; }
                } else {
#pragma unroll
                    for (int t = 0; t < 32; ++t) { const float nr = ar * hr - ai * him + bur[t], ni = ar * him + ai * hr + bui[t]; hr = nr; him = ni;
                        ((LAS unsigned*)HL)[t * 68 + lane] = pk2(hr, him); }
                    asm volatile("s_waitcnt lgkmcnt(0)" ::: "memory");
                    f32x16 y = {};
#pragma unroll
                    for (int ks = 0; ks < 8; ++ks) { const bf16x8 af = *(const LAS bf16x8*)((const LAS unsigned char*)HL + (r32 * 136 + 16 * ks + 8 * hi) * 2);
                        y = __builtin_amdgcn_mfma_f32_32x32x16_bf16(cfr[ks], af, y, 0, 0, 0); }
                    asm volatile("s_waitcnt lgkmcnt(0)" ::: "memory");
                    if (s0 >= 256 || layer == 0) {
                        float* yp = Yd + (size_t)s5_tokrow(s0 + r32, dir, b) * 256 + 16 * g + 4 * hi;
                        *(f32x4*)yp = (f32x4){y[0], y[1], y[2], y[3]}; *(f32x4*)(yp + 8) = (f32x4){y[4], y[5], y[6], y[7]};
                    }
                }
            }
            if (pass == 0) {
                BuL[lane * 2] = hr; BuL[lane * 2 + 1] = him;
                __syncthreads();
                hr = 0.f; him = 0.f;
                for (int v = 0; v < wid; ++v) { const LAS float* cv = (const LAS float*)(lds + v * 17920); const float cr = cv[lane * 2], ci = cv[lane * 2 + 1]; const float nr = pr * hr - pi * him + cr, ni = pr * him + pi * hr + ci; hr = nr; him = ni; }
                __syncthreads();
            }
        }

    }
}

__device__ __forceinline__ void na_phase(LAS unsigned char* lds, int l) {
    CArgs& a = kargs();
    int tid_ = threadIdx.x; asm volatile("" : "+v"(tid_));
    const int tid = tid_, wid = __builtin_amdgcn_readfirstlane(tid >> 6), G = o_grid(), bid = o_bid();
    bf16* Zb = (bf16*)(a.ws + WS_Z); bf16* CAT = (bf16*)(a.ws + WS_CAT);
    LAS float* biasL = (LAS float*)(lds + 73728);
    for (int i = tid; i < 4 * 15 * 31; i += 512) biasL[i] = 8.f * a.in[I_NABIAS][l * 4 * 15 * 31 + i];
    for (int u = bid; u < 512; u += G) {
        const int b = u >> 5, head = (u >> 3) & 3, rg = u & 7; const int r = 4 * rg + (wid >> 1);
        const int lo = 4 * rg - 4 < 0 ? 0 : (4 * rg - 4 > 24 ? 24 : 4 * rg - 4); const int hi3 = 4 * rg - 1 < 0 ? 0 : (4 * rg - 1 > 24 ? 24 : 4 * rg - 1);
        const int rs = r - 4 < 0 ? 0 : (r - 4 > 24 ? 24 : r - 4);
        AttnP P{Zb, CAT, DM, b * 2048 + r * 64 + (wid & 1) * 32, OFF_NQ + head * 64, 512 + head * 64, OFF_NK + head * 64, OFF_NV + head * 64, b * 2048 + lo * 64, hi3 + 8 - lo, MLAT + b * 256, 4, 1, (wid & 1) * 32, lo - r + 7, head, rs - lo, rs - lo + 8};
        attn_unit<1>(lds, P, biasL);
    }
    if (l == 0) for (int u = bid; u < 64; u += G) {
        const int b = u >> 2, head = u & 3;
        AttnP P{Zb, CAT, DM, MLAT + b * 256 + wid * 32, OFF_NQ + head * 64, 512 + head * 64, OFF_NK + head * 64, OFF_NV + head * 64, 0, 0, MLAT + b * 256, 4, 0, 0, 0, head, 0, 0};
        attn_unit<1>(lds, P, biasL);
    }
}
__device__ __forceinline__ void gqa_phase(LAS unsigned char* lds, int l) {
    CArgs& a = kargs();
    int tid_ = threadIdx.x; asm volatile("" : "+v"(tid_));
    const int tid = tid_, wid = __builtin_amdgcn_readfirstlane(tid >> 6), G = o_grid(), bid = o_bid();
    bf16* Zb = (bf16*)(a.ws + WS_Z); bf16* CAT = (bf16*)(a.ws + WS_CAT);
    const bool bal = (G == 256); const int nmine = bal ? (bid < 128 ? 2 : 0) : (255 - bid) / G + 1;
    for (int iu = 0; iu < nmine; ++iu) {
        const int u = bal ? bid + 128 * iu : bid + iu * G;
        const int b = u >> 4, kvh = (u >> 3) & 1, qb = u & 7; const int head = 2 * kvh + (wid >> 2);
        AttnP P{Zb, CAT, DM, b * 2048 + qb * 256 + (wid & 3) * 64, OFF_AQ + head * 64, head * 64, OFF_AK + kvh * 64, OFF_AV + kvh * 64, b * 2048, 32, MLAT + b * 256, 4, 0, 0, 0, head, 0, 0};
        attn_unit<1, 2>(lds, P, nullptr);
    }
    if (l == 0) for (int u = G - 1 - bid; u < 64; u += G) {
        const int b = u >> 2, kvh = (u >> 1) & 1, qb = u & 1; const int head = 2 * kvh + (wid >> 2);
        AttnP P{Zb, CAT, DM, MLAT + b * 256 + qb * 128 + (wid & 3) * 32, OFF_AQ + head * 64, head * 64, OFF_AK + kvh * 64, OFF_AV + kvh * 64, 0, 0, MLAT + b * 256, 4, 0, 0, 0, head, 0, 0};
        attn_unit<1>(lds, P, nullptr);
    }
}

#define XB_TMO      128
#define XB_XCNT(j)  (256  + 64 * (j))
#define XB_XSUB(j)  (1280 + 64 * (j))
#define XB_XGEN(j)  (2304 + 64 * (j))
#define XB_TOP      3328
#define XB_TOPGEN   3392
#define XCD_BAR_WORDS 3456
#define XB_SPIN_CAP (1u << 18)

__device__ __forceinline__ unsigned xb_ld(unsigned* p)              { return __hip_atomic_load(p, __ATOMIC_RELAXED, __HIP_MEMORY_SCOPE_AGENT); }
__device__ __forceinline__ unsigned xb_add(unsigned* p, unsigned v) { return __hip_atomic_fetch_add(p, v, __ATOMIC_RELAXED, __HIP_MEMORY_SCOPE_AGENT); }
__device__ __forceinline__ unsigned xb_xcc_id() { return (unsigned)__builtin_amdgcn_s_getreg((3 << 11) | 20) & 0xFu; }
#define XB_SPIN(cond, bar) do { unsigned _sp = 0; while (cond) { __builtin_amdgcn_s_sleep(1); \
    if ((++_sp & 255u) == 0u) { if (xb_ld(&(bar)[XB_TMO])) break; if (_sp > XB_SPIN_CAP) { atomicAdd(&(bar)[XB_TMO], 1u); break; } } } } while (0)
struct XcdBarrier { unsigned* bar; unsigned x; volatile LAS unsigned* st; };
__device__ __forceinline__ void xcd_barrier_complete(unsigned* bar, unsigned x, unsigned& nloc, unsigned& nx) {
    const unsigned G = gridDim.x * gridDim.y * gridDim.z;
    unsigned sum, cnt, mine, sp = 0u;
    for (;;) {
        sum = 0u; cnt = 0u; mine = 0u;
#pragma unroll
        for (unsigned j = 0; j < 16; ++j) { const unsigned c = xb_ld(&bar[XB_XCNT(j)]); sum += c; cnt += (c > 0u) ? 1u : 0u; mine = (j == x) ? c : mine; }
        if (sum == G) break;
        __builtin_amdgcn_s_sleep(1);
        if ((++sp & 255u) == 0u) { if (xb_ld(&bar[XB_TMO])) break; if (sp > XB_SPIN_CAP) { atomicAdd(&bar[XB_TMO], 1u); break; } }
    }
    nloc = mine > 0u ? mine : 1u; nx = cnt > 0u ? cnt : 1u;
}

__device__ __forceinline__ void xcd_barrier(const XcdBarrier& b) {
    asm volatile("s_waitcnt vmcnt(0)" ::: "memory");
    __syncthreads();
    if (threadIdx.x == 0) {
        unsigned* bar = b.bar;
        __builtin_amdgcn_s_waitcnt(0);
        unsigned nloc = b.st[0], nx = b.st[1];
        if (nloc == 0u) { xcd_barrier_complete(bar, b.x, nloc, nx); b.st[0] = nloc; b.st[1] = nx; }
        const unsigned old = xb_add(&bar[XB_XSUB(b.x)], 1u);
        const unsigned gen = old / nloc;
        if (old + 1u == (gen + 1u) * nloc) {
            __builtin_amdgcn_fence(__ATOMIC_RELEASE, "agent");
            asm volatile("s_waitcnt vmcnt(0)" ::: "memory");
            const unsigned og = xb_add(&bar[XB_TOP], 1u);
            const unsigned tg = og / nx;
            if (og + 1u == (tg + 1u) * nx) xb_add(&bar[XB_TOPGEN], 1u);
            else XB_SPIN(xb_ld(&bar[XB_TOPGEN]) == tg, bar);
            __builtin_amdgcn_fence(__ATOMIC_ACQUIRE, "agent");
            xb_add(&bar[XB_XGEN(b.x)], 1u);
            asm volatile("s_waitcnt vmcnt(0)" ::: "memory");
        } else {
            XB_SPIN(xb_ld(&bar[XB_XGEN(b.x)]) == gen, bar);
            __builtin_amdgcn_fence(__ATOMIC_ACQUIRE, "agent");
            asm volatile("s_waitcnt vmcnt(0)" ::: "memory");
        }
    }
    __syncthreads();
}

template <class F>
__device__ __forceinline__ void run_gemm(LAS unsigned char* lds, const bf16* A, int lda, const bf16* Bt, int ldb, int M, int N, int K, const F& f, int c, long tsB = 0, int ksplit = 1 << 30, long kjumpB = 0) {
    pg8::Gemm g{A, Bt, M, N, K, lda, ldb, tsB ? tsB : (long)512 * ldb, ksplit, kjumpB}; pg8::StaticOrder S; S.init(M, N, o_grid(), c); Epi8<F> E{f};
    pg8::gemm_phase<Epi8<F>, pg8::StaticOrder, true, true>(lds, g, S, E);
}
#define WSP(off) ((bf16*)(ws + (off)))
__device__ __forceinline__ void ph_store_gemm(LAS unsigned char* lds, int l, int kind) {
    unsigned char* ws = kargs().ws; unsigned char* wb = ws + WS_W + (size_t)l * W_LAYER;
    const int Mr = l == 0 ? MT : MLAT;
    const bf16* A; const bf16* Bt; bf16* O; int lda, ldb, M, N, K, ldc, act;
    if (kind == 0)      { A = WSP(WS_XN);   lda = DM;  Bt = (const bf16*)(wb + WO_IN);  ldb = DM;  M = MT; N = INW; K = DM;  O = WSP(WS_Z);    ldc = INW; act = 0; }
    else if (kind == 1) { A = WSP(WS_CAT);  lda = DM;  Bt = (const bf16*)(wb + WO_OUT); ldb = DM;  M = Mr; N = DM;  K = DM;  O = WSP(WS_Y);    ldc = DM;  act = 0; }
    else if (kind == 2) { A = WSP(WS_XN);   lda = DM;  Bt = (const bf16*)(wb + WO_1);   ldb = DM;  M = Mr; N = DFF; K = DM;  O = WSP(WS_HMID); ldc = DFF; act = 1; }
    else if (kind == 3) { A = WSP(WS_HMID); lda = DFF; Bt = (const bf16*)(wb + WO_2);   ldb = DFF; M = Mr; N = DM;  K = DFF; O = WSP(WS_XN);   ldc = DM;  act = 0; }
    else                { A = (const bf16*)(wb + WO_CS); lda = 256; Bt = WSP(WS_Z) + OFF_FN; ldb = INW; M = 512; N = MT; K = 256; O = WSP(WS_C1); ldc = MT; act = 0; }
    run_gemm(lds, A, lda, Bt, ldb, M, N, K, FStore{O, ldc, act}, o_bid());
}
__device__ __forceinline__ void ph_d2(LAS unsigned char* lds, int l) { CArgs& a = kargs(); unsigned char* ws = a.ws;
    for (int j = 0; j < (l == 0 ? 2 : 1); ++j) {
        if (j == 0) run_gemm(lds, WSP(WS_DFT), 4096, WSP(WS_C1), MT, 2048, 4096, 4096, FD2{WSP(WS_CAT), a.in[I_BFNET] + l * 256, 0, 2048}, o_grid() - 1 - o_bid(), 2048 * 2, 32, ((long)256 * MT - 2048) * 2);
        else run_gemm(lds, WSP(WS_DFTC), 512, WSP(WS_C1) + MLAT, MT, 256, 4096, 512, FD2{WSP(WS_CAT), a.in[I_BFNET] + l * 256, MLAT, 256}, o_grid() - 1 - o_bid(), 256 * 2, 4, ((long)256 * MT - 256) * 2);
    } }
__device__ __forceinline__ void ph_glu(LAS unsigned char* lds, int l) { CArgs& a = kargs(); unsigned char* ws = a.ws; unsigned char* wb = ws + WS_W + (size_t)l * W_LAYER;
    const int Mr = l == 0 ? MT : MLAT;
    {
        int tid_ = threadIdx.x; asm volatile("" : "+v"(tid_));
        pg8::StaticOrder S; S.init(Mr, 256, o_grid(), o_grid() - 1 - o_bid()); pg8::Unit u;
        const bf16* Z = WSP(WS_Z); const float* Y0 = (const float*)(ws + WS_Y0); const float* Y1 = (const float*)(ws + WS_Y1); bf16* T = WSP(WS_T);
        const int c8 = (tid_ & 31) * 8;
        float dk[8];
#pragma unroll
        for (int e = 0; e < 8; ++e) dk[e] = a.in[I_S5D][l * 256 + c8 + e];
        for (int i = 0; S.next(i, u); ++i)
            for (int rr = tid_ >> 5; rr < 256; rr += 16) {
                const size_t row = (size_t)u.pm * 256 + rr;
                const v4u uz = *(const v4u*)(Z + row * INW + OFF_S5 + c8);
                const f32x4 a0 = *(const f32x4*)(Y0 + row * 256 + c8), a1 = *(const f32x4*)(Y0 + row * 256 + c8 + 4), b0 = *(const f32x4*)(Y1 + row * 256 + c8), b1 = *(const f32x4*)(Y1 + row * 256 + c8 + 4);
                const float uv[8] = {bflo(uz.x), bfhi(uz.x), bflo(uz.y), bfhi(uz.y), bflo(uz.z), bfhi(uz.z), bflo(uz.w), bfhi(uz.w)};
                float o[8];
#pragma unroll
                for (int e = 0; e < 8; ++e) { const float v = (e < 4 ? a0[e] + b0[e] : a1[e - 4] + b1[e - 4]) + dk[e] * uv[e];
                    const float uu = 0.7978845608028654f * (v + 0.044715f * v * v * v); o[e] = v / (1.f + __expf(-2.f * uu)); }
                v4u w; w.x = pk2(o[0], o[1]); w.y = pk2(o[2], o[3]); w.z = pk2(o[4], o[5]); w.w = pk2(o[6], o[7]);
                *(v4u*)(T + row * 256 + c8) = w;
            }
        __threadfence(); __syncthreads();
    }
    int K = 256, ld = 256; asm volatile("" : "+s"(K), "+s"(ld));
    run_gemm(lds, WSP(WS_T), ld, (const bf16*)(wb + WO_GLU), ld, Mr, 256, K, FGlu{WSP(WS_CAT), WSP(WS_T)}, o_grid() - 1 - o_bid()); }

__global__ void __launch_bounds__(512, 2) fwd_megakernel(Args a_unused) {
    extern __shared__ __attribute__((aligned(16))) unsigned char lds_raw[];
    LAS unsigned char* lds = (LAS unsigned char*)lds_raw;
    cg::grid_group grid = cg::this_grid();
#ifdef PROBE
    if (blockIdx.x == 0 && threadIdx.x == 0) { unsigned char* pw = kargs().ws + WS_PROBE; for (int i = 0; i < 32; ++i) ((float*)pw)[i] = 0.f; *(unsigned long long*)(pw + 256) = __builtin_amdgcn_s_memrealtime(); }
#endif
    {
        if (threadIdx.x < 2) ((volatile LAS unsigned*)(lds + LDS_BARST))[threadIdx.x] = 0u;
        if (threadIdx.x == 0) (void)xb_add(&((unsigned*)(kargs().ws + WS_BAR))[XB_XCNT(xb_xcc_id())], 1u);
        if (gridDim.x == 0x7fffffffu) grid.sync();
    }
    for (int step = 0; step < 20; ++step) {
        const int l = step < 2 ? 0 : (step - 2) / 9, k = step < 2 ? step - 2 : (step - 2) - 9 * l;
        int gk = -1;
        if (k == 0) gk = 0; else if (k == 2) gk = 4; else if (k == 4) gk = 1; else if (k == 6) gk = 2; else if (k == 7) gk = 3;
        int lbl = k == -2 ? 0 : k == -1 ? 1 : k == 0 ? 2 : k == 1 ? 5 : k == 2 ? 6 : k == 3 ? 9 : k == 4 ? 10 : k == 5 ? 11 : k == 6 ? 12 : k == 7 ? 13 : 14; (void)lbl;
#ifdef DBL_GEMM
        if (gk >= 0) { ph_store_gemm(lds, l, gk); __syncthreads(); }
#endif
#ifdef DBL_ROWS
        if (k == -1) prep_rows0(); if (k == 5 && l == 0) row_update<0>();
#endif
        if (gk >= 0) ph_store_gemm(lds, l, gk);
        else if (k == -2) prologue(lds);
        else if (k == -1) prep_rows0();
        else if (k == 1) {
            qk_prep(l);
            __syncthreads(); STAMP(3);
            na_phase(lds, l);
#ifdef DBL_NA
            __syncthreads(); na_phase(lds, l);
#endif
            __syncthreads(); STAMP(4);
            for (int u = o_bid(); u < 256; u += o_grid()) s5_unit(lds, l, u >> 4, u & 15);
#ifdef DBL_S5
            __syncthreads(); for (int u = o_bid(); u < 256; u += o_grid()) s5_unit(lds, l, u >> 4, u & 15);
#endif
        } else if (k == 3) {
            gqa_phase(lds, l);
#ifdef DBL_GQA
            __syncthreads(); gqa_phase(lds, l);
#endif
            __syncthreads(); STAMP(7);
            ph_d2(lds, l); STAMP(8);
            ph_glu(lds, l);
        } else if (k == 5) { if (l == 0) row_update<0>(); else row_update<2>(); }
        else { if (l == 0) row_update<1>(); else row_update<3>(); }
        if (k == 1) { __syncthreads(); }
        else if (step != 19) {
            XcdBarrier xb; xb.bar = (unsigned*)(kargs().ws + WS_BAR); xb.x = xb_xcc_id(); xb.st = (volatile LAS unsigned*)(lds + LDS_BARST);
            xcd_barrier(xb);
        }
        STAMP(lbl);
    }
}

extern "C" void kernel_launch(void* const* d_in, const int* in_sizes, int n_in, void* d_out, int out_size, void* d_ws, size_t ws_size, hipStream_t stream) {
    static int grid = 0;
    if (grid == 0) {
        if (n_in != 28 || ws_size < WS_END) { fprintf(stderr, "kernel_launch: unexpected n_in %d / ws_size %zu (need %zu)\n", n_in, ws_size, (size_t)WS_END); grid = -1; return; }
        int dev = 0, cus = 0, per_cu = 0;
        hipGetDevice(&dev); hipDeviceGetAttribute(&cus, hipDeviceAttributeMultiprocessorCount, dev);
        if (hipFuncSetAttribute((const void*)fwd_megakernel, hipFuncAttributeMaxDynamicSharedMemorySize, LDS_BYTES) != hipSuccess) { fprintf(stderr, "kernel_launch: hipFuncSetAttribute failed\n"); }
        if (hipOccupancyMaxActiveBlocksPerMultiprocessor(&per_cu, (const void*)fwd_megakernel, 512, LDS_BYTES) != hipSuccess || per_cu < 1) { fprintf(stderr, "kernel_launch: occupancy query says %d\n", per_cu); per_cu = 1; }
        (void)hipGetLastError();
        grid = cus * (per_cu > 1 ? 1 : per_cu);
        if (grid <= 0) grid = 256;
    }
    if (grid < 0) return;
    if (hipMemsetAsync((char*)d_ws + WS_BAR, 0, XCD_BAR_WORDS * 4, stream) != hipSuccess) { fprintf(stderr, "kernel_launch: hipMemsetAsync of the barrier words failed\n"); return; }
    Args a{};
    for (int i = 0; i < 28; ++i) a.in[i] = (const float*)d_in[i];
    a.out = (float*)d_out; a.ws = (unsigned char*)d_ws;
    void* args[] = {&a};
    hipError_t e = hipLaunchCooperativeKernel((const void*)fwd_megakernel, dim3(grid), dim3(512), args, LDS_BYTES, stream);
    if (e != hipSuccess) fprintf(stderr, "cooperative launch failed: %s (grid %d)\n", hipGetErrorString(e), grid);
}
```

```cpp
#include <hip/hip_runtime.h>
#include <hip/hip_cooperative_groups.h>
#include <cstdio>
#include <cstdint>
namespace cg = cooperative_groups;
namespace pg8 {
#define PG8_LAS __attribute__((address_space(3)))
typedef unsigned short bf16_t;
typedef short bf16x8 __attribute__((ext_vector_type(8)));
typedef float f32x4 __attribute__((ext_vector_type(4)));
typedef unsigned u32x4 __attribute__((ext_vector_type(4)));
constexpr int BM = 256, BK = 64, HALF = 128, HTB = HALF * BK * 2  , STAGE_BYTES = 8 * HTB, NXCD = 8, WGM = 8;

__host__ __device__ __forceinline__ int lds_byte(int r, int c) { const int st = (r >> 4) * 2 + (c >> 5), rr = r & 15, cc = c & 31, ob = rr * 64 + cc * 2; return st * 1024 + (ob ^ (((ob >> 9) & 1) << 5)); }
__host__ __device__ __forceinline__ void stage_rc(int b, int& R, int& C) { const int st = b / 1024, sb = b % 1024, swz = sb ^ (((sb >> 9) & 1) << 5); R = (st >> 1) * 16 + swz / 64; C = (st & 1) * 32 + (swz % 64) / 2; }
__host__ __device__ __forceinline__ int perm32(int rho) { const int n = rho >> 4, i = rho & 15; return 8 * (i >> 2) + 4 * n + (i & 3); }

struct Unit { int pm, pn; };
struct Gemm { const bf16_t* A; const bf16_t* Bt; int M, N, K, lda, ldb; long tsB; int ksplit; long kjumpB; };

struct StaticOrder {
    int nM, nN, nwg, G, c;
    __host__ __device__ void init(int M, int N, int G_, int c_) { nM = M / BM; nN = N / BM; nwg = nM * nN; G = G_; c = c_; }
    __host__ __device__ bool next(int i, Unit& u) const {
        const long L = (long)i * G + c; if (L >= nwg) return false;
        int wgid = (int)L; { const int q = nwg / NXCD, r = nwg % NXCD, xcd = wgid % NXCD, off = wgid / NXCD; wgid = (xcd < r ? xcd * (q + 1) : r * (q + 1) + (xcd - r) * q) + off; }
        const int nig = WGM * nN, gid = wgid / nig, fm = gid * WGM, gsz = (nM - fm) < WGM ? (nM - fm) : WGM;
        u.pm = fm + ((wgid % nig) % gsz); u.pn = (wgid % nig) / gsz; return true;
    }
    __device__ __forceinline__ void a_ready(const Unit&) const {}
    __device__ __forceinline__ void done(const Unit&) const {}
};
__device__ __forceinline__ unsigned cvt_pk_bf16(float lo, float hi) { unsigned r; asm volatile("v_cvt_pk_bf16_f32 %0, %1, %2" : "=v"(r) : "v"(lo), "v"(hi)); return r; }
template <class Epi, class Sched, bool ALIGN_EPI = false, bool SP2 = false>
__device__ __forceinline__ void gemm_phase(PG8_LAS unsigned char* lds, const Gemm g, const Sched& S, const Epi& E) {
    int tid_ = threadIdx.x; asm volatile("" : "+v"(tid_));
    const int tid = tid_, wid = __builtin_amdgcn_readfirstlane(tid >> 6), lane = tid & 63, wr = wid >> 2, wc = wid & 3, fr = lane & 15, fq = lane >> 4;
    const int K = g.K, nt = K / BK;
    unsigned voffA[2], voffB[2];
#pragma unroll
    for (int i = 0; i < 2; ++i) { int R, C; stage_rc(tid * 16 + i * 8192, R, C); const int Rb = Epi::PERM ? ((R & ~31) + perm32(R & 31)) : R;
        voffA[i] = (unsigned)(R * g.lda + C) * 2u; voffB[i] = (unsigned)(Rb * g.ldb + C) * 2u; }
    const size_t kstep = (size_t)(BK * 2);
    const size_t hstepA = (size_t)HALF * g.lda * 2, hstepB = (size_t)HALF * g.ldb * 2;
    const size_t tstepA = 2 * hstepA, tstepB = (size_t)g.tsB;
    const unsigned ldsw = (unsigned)wid * 1024u;
    const int aoff = lds_byte(wr * 64 + fr, fq * 8), boff = lds_byte(wc * 32 + fr, fq * 8);
#define PG8_SA(b, h) (((b) * 2 + (h)) * HTB)
#define PG8_SB(b, h) ((4 + (b) * 2 + (h)) * HTB)
#define PG8_STAGE(bufoff, gbase, voff) do { _Pragma("unroll") for (int _i = 0; _i < 2; ++_i) \
        __builtin_amdgcn_global_load_lds((const unsigned*)((const char*)(gbase) + (voff)[_i]), (PG8_LAS unsigned*)(lds + (bufoff) + ldsw + _i * 8192), 16, 0, 0); } while (0)
#define PG8_LDA(dst, b, h) do { _Pragma("unroll") for (int m = 0; m < 4; ++m) _Pragma("unroll") for (int k = 0; k < 2; ++k) dst[m][k] = *(const PG8_LAS bf16x8*)(lds + PG8_SA(b, h) + aoff + m * 2048 + k * 1024); } while (0)
#define PG8_LDB(dst, b, h) do { _Pragma("unroll") for (int n = 0; n < 2; ++n) _Pragma("unroll") for (int k = 0; k < 2; ++k) dst[n][k] = *(const PG8_LAS bf16x8*)(lds + PG8_SB(b, h) + boff + n * 2048 + k * 1024); } while (0)
#define PG8_MMA(ai, bj, At, Bt) do { __builtin_amdgcn_s_setprio(1); _Pragma("unroll") for (int m = 0; m < 4; ++m) _Pragma("unroll") for (int n = 0; n < 2; ++n) _Pragma("unroll") for (int k = 0; k < 2; ++k) \
        acc[ai][bj][m][n] = __builtin_amdgcn_mfma_f32_16x16x32_bf16(Bt[n][k], At[m][k], acc[ai][bj][m][n], 0, 0, 0); __builtin_amdgcn_s_setprio(0); } while (0)
#define PG8_WAIT_V(n) asm volatile("s_waitcnt vmcnt(" #n ")" ::: "memory")
#define PG8_WAIT_L(n) asm volatile("s_waitcnt lgkmcnt(" #n ")" ::: "memory")
#define PG8_BAR __builtin_amdgcn_s_barrier()
#define PG8_SCHED __builtin_amdgcn_sched_barrier(0)
    Unit cur, nxt; int ui = 0;
    if (!S.next(0, cur)) return;
    f32x4 acc[2][2][4][2];
#pragma unroll
    for (int a = 0; a < 2; ++a)
#pragma unroll
        for (int b = 0; b < 2; ++b)
#pragma unroll
            for (int m = 0; m < 4; ++m)
#pragma unroll
                for (int n = 0; n < 2; ++n) acc[a][b][m][n] = (f32x4){0.f, 0.f, 0.f, 0.f};
    bf16x8 At[4][2], B0[2][2], B1[2][2];
    const char* cA = (const char*)g.A + (size_t)cur.pm * tstepA; const char* cB = (const char*)g.Bt + (size_t)cur.pn * tstepB;
    S.a_ready(cur);
    if constexpr (SP2) {
        PG8_STAGE(PG8_SB(0, 0), cB, voffB); PG8_STAGE(PG8_SB(0, 1), cB + hstepB, voffB); PG8_STAGE(PG8_SA(0, 0), cA, voffA); PG8_STAGE(PG8_SA(0, 1), cA + hstepA, voffA);
        if (wr == 1) PG8_BAR;
        PG8_WAIT_V(2); PG8_BAR;
        PG8_STAGE(PG8_SB(1, 0), cB + kstep, voffB); PG8_STAGE(PG8_SA(1, 0), cA + kstep, voffA); PG8_STAGE(PG8_SB(1, 1), cB + hstepB + kstep, voffB);
        PG8_WAIT_V(6); PG8_BAR;
    } else {
        PG8_STAGE(PG8_SB(0, 0), cB, voffB); PG8_STAGE(PG8_SA(0, 0), cA, voffA); PG8_STAGE(PG8_SB(0, 1), cB + hstepB, voffB); PG8_STAGE(PG8_SA(0, 1), cA + hstepA, voffA);
        if (wr == 1) PG8_BAR;
        PG8_WAIT_V(4); PG8_BAR;
        PG8_STAGE(PG8_SB(1, 0), cB + kstep, voffB); PG8_STAGE(PG8_SA(1, 0), cA + kstep, voffA); PG8_STAGE(PG8_SB(1, 1), cB + hstepB + kstep, voffB);
        PG8_WAIT_V(6); PG8_BAR;
    }
    for (;;) {
        const bool has_next = S.next(ui + 1, nxt);
        const char* nA = has_next ? (const char*)g.A + (size_t)nxt.pm * tstepA : cA; const char* nB = has_next ? (const char*)g.Bt + (size_t)nxt.pn * tstepB : cB;
        for (int t = 0; t < nt; t += 2) {
            const bool last = (t == nt - 2);
            const char* a1 = cA + (size_t)(t + 1) * kstep;
            const char* a2 = last ? nA : cA + (size_t)(t + 2) * kstep; const char* b2 = last ? nB : cB + (size_t)(t + 2) * kstep + ((t + 2) >= g.ksplit ? g.kjumpB : 0);
            const char* a3 = a2 + kstep; const char* b3 = b2 + kstep;
            if (last && has_next) S.a_ready(nxt);
            if constexpr (SP2) {
            PG8_LDB(B0, 0, 0); PG8_LDB(B1, 0, 1); PG8_SCHED; PG8_LDA(At, 0, 0); PG8_STAGE(PG8_SA(1, 1), a1 + hstepA, voffA);
            PG8_WAIT_V(8); PG8_WAIT_L(0); PG8_BAR; PG8_MMA(0, 0, At, B0); PG8_MMA(0, 1, At, B1); PG8_BAR; PG8_SCHED;
            PG8_LDA(At, 0, 1); PG8_STAGE(PG8_SB(0, 0), b2, voffB); PG8_STAGE(PG8_SB(0, 1), b2 + hstepB, voffB); PG8_STAGE(PG8_SA(0, 0), a2, voffA);
            PG8_WAIT_V(8); PG8_WAIT_L(0); PG8_BAR; PG8_MMA(1, 0, At, B0); PG8_MMA(1, 1, At, B1); PG8_BAR; PG8_SCHED;
            PG8_LDB(B0, 1, 0); PG8_LDB(B1, 1, 1); PG8_SCHED; PG8_LDA(At, 1, 0); PG8_STAGE(PG8_SA(0, 1), a2 + hstepA, voffA);
            PG8_WAIT_V(8); PG8_WAIT_L(0); PG8_BAR; PG8_MMA(0, 0, At, B0); PG8_MMA(0, 1, At, B1); PG8_BAR; PG8_SCHED;
            PG8_LDA(At, 1, 1); PG8_STAGE(PG8_SB(1, 0), b3, voffB); PG8_STAGE(PG8_SB(1, 1), b3 + hstepB, voffB); PG8_STAGE(PG8_SA(1, 0), a3, voffA);
            PG8_WAIT_V(8); PG8_WAIT_L(0); PG8_BAR; PG8_MMA(1, 0, At, B0); PG8_MMA(1, 1, At, B1); PG8_BAR; PG8_SCHED;
            } else {
            PG8_LDB(B0, 0, 0); PG8_SCHED; PG8_LDA(At, 0, 0); PG8_STAGE(PG8_SA(1, 1), a1 + hstepA, voffA);
            PG8_WAIT_L(8); PG8_BAR; PG8_WAIT_L(0); PG8_MMA(0, 0, At, B0); PG8_BAR; PG8_SCHED;
            PG8_LDB(B1, 0, 1); PG8_STAGE(PG8_SB(0, 0), b2, voffB);
            PG8_BAR; PG8_WAIT_L(0); PG8_MMA(0, 1, At, B1); PG8_BAR;
            PG8_LDA(At, 0, 1); PG8_STAGE(PG8_SA(0, 0), a2, voffA);
            PG8_BAR; PG8_WAIT_L(0); PG8_MMA(1, 0, At, B0); PG8_BAR; PG8_SCHED;
            PG8_STAGE(PG8_SB(0, 1), b2 + hstepB, voffB);
            PG8_WAIT_V(6); PG8_BAR; PG8_MMA(1, 1, At, B1); PG8_BAR;
            PG8_LDB(B0, 1, 0); PG8_SCHED; PG8_LDA(At, 1, 0); PG8_STAGE(PG8_SA(0, 1), a2 + hstepA, voffA);
            PG8_WAIT_L(8); PG8_BAR; PG8_WAIT_L(0); PG8_MMA(0, 0, At, B0); PG8_BAR; PG8_SCHED;
            PG8_LDB(B1, 1, 1); PG8_STAGE(PG8_SB(1, 0), b3, voffB);
            PG8_BAR; PG8_WAIT_L(0); PG8_MMA(0, 1, At, B1); PG8_BAR;
            PG8_LDA(At, 1, 1); PG8_STAGE(PG8_SA(1, 0), a3, voffA);
            PG8_BAR; PG8_WAIT_L(0); PG8_MMA(1, 0, At, B0); PG8_BAR; PG8_SCHED;
            PG8_STAGE(PG8_SB(1, 1), b3 + hstepB, voffB);
            PG8_WAIT_V(6); PG8_BAR; PG8_MMA(1, 1, At, B1); PG8_BAR;
            }
        }
        if constexpr (ALIGN_EPI) { if (wr == 0) PG8_BAR; }
        if constexpr (!Epi::AFTER_DRAIN) { E(acc, cur, wr, wc, fr, fq); S.done(cur); }
        if (!has_next) break;
#pragma unroll
        for (int a = 0; a < 2; ++a)
#pragma unroll
            for (int b = 0; b < 2; ++b)
#pragma unroll
                for (int m = 0; m < 4; ++m)
#pragma unroll
                    for (int n = 0; n < 2; ++n) acc[a][b][m][n] = (f32x4){0.f, 0.f, 0.f, 0.f};
        cur = nxt; cA = nA; cB = nB; ++ui;
        if constexpr (ALIGN_EPI) { if (wr == 1) PG8_BAR; }
    }
    PG8_WAIT_V(0);
    if constexpr (!ALIGN_EPI) { if (wr == 0) PG8_BAR; }
    PG8_BAR;
    if constexpr (Epi::AFTER_DRAIN) { E.fused(acc, cur, wr, wc, fr, fq, lds, wid, lane); S.done(cur); }
#undef PG8_SA
#undef PG8_SB
#undef PG8_STAGE
#undef PG8_LDA
#undef PG8_LDB
#undef PG8_MMA
#undef PG8_WAIT_V
#undef PG8_WAIT_L
#undef PG8_BAR
#undef PG8_SCHED
}
}
#define LAS __attribute__((address_space(3)))
typedef unsigned short bf16;
typedef unsigned v4u __attribute__((ext_vector_type(4)));
typedef unsigned v2u __attribute__((ext_vector_type(2)));
typedef float f32x4 __attribute__((ext_vector_type(4)));
typedef float f32x16 __attribute__((ext_vector_type(16)));
typedef short bf16x8 __attribute__((ext_vector_type(8)));
typedef short s16x4 __attribute__((ext_vector_type(4)));

constexpr int DM = 1024, NB = 16, SEQ = 2048, CTXL = 256, MLAT = NB * SEQ, MCTX = NB * CTXL, MT = MLAT + MCTX, INW = 1792, DFF = 4096;
constexpr int OFF_AQ = 0, OFF_AK = 256, OFF_AV = 384, OFF_S5 = 512, OFF_NQ = 768, OFF_NK = 1024, OFF_NV = 1280, OFF_FN = 1536;
constexpr float EPSN = 1e-6f;
constexpr float LOG2E = 1.4426950408889634f;
constexpr size_t MiB = 1u << 20;
constexpr size_t WS_MOD = 0;
constexpr size_t WS_ROPE = 1 * MiB;
constexpr size_t WS_W = 2 * MiB, W_LAYER = 22 * MiB;
constexpr size_t WO_IN = 0, WO_OUT = WO_IN + (size_t)INW * DM * 2, WO_1 = WO_OUT + (size_t)DM * DM * 2, WO_2 = WO_1 + (size_t)DFF * DM * 2,
                 WO_GLU = WO_2 + (size_t)DFF * DM * 2, WO_CS = WO_GLU + 256 * 256 * 2, WO_END = WO_CS + 512 * 256 * 2;
static_assert(WO_END <= W_LAYER, "weights");
constexpr size_t WS_DFT = 46 * MiB, WS_DFTC = 62 * MiB, WS_XC = 64 * MiB, WS_XN = 80 * MiB;
constexpr size_t WS_T = 116 * MiB, WS_C1 = 350 * MiB;
constexpr size_t WS_Z = 152 * MiB, WS_CAT = 278 * MiB, WS_Y = 350 * MiB, WS_HMID = 152 * MiB, WS_Y0 = 440 * MiB, WS_Y1 = 476 * MiB, WS_END = 512 * MiB;
constexpr int LDS_BYTES = 147456;

struct Args { const float* in[28]; float* out; unsigned char* ws; };
typedef __attribute__((address_space(4))) const Args CArgs;
__device__ __forceinline__ CArgs& kargs() { CArgs* p = (CArgs*)__builtin_amdgcn_kernarg_segment_ptr(); asm volatile("" : "+s"(p)); return *p; }
enum { I_X = 0, I_C, I_CTX, I_CCTX, I_WADA, I_BADA, I_GPREMIX, I_GPOSTMIX, I_GPREMLP, I_GPOSTMLP, I_WIN, I_GQ, I_GK, I_AR, I_AI, I_LDT, I_BR, I_BI, I_CR, I_CI,
       I_S5D, I_WGLU, I_NABIAS, I_WFNET, I_BFNET, I_WOUT, I_W1, I_W2 };

constexpr size_t WS_PROBE = 1 * MiB + 65536;
constexpr size_t WS_BAR = 1 * MiB + 131072;
constexpr int LDS_BARST = 147456 - 64;
#ifdef PROBE
#define STAMP(lbl) do { if (blockIdx.x == 0 && threadIdx.x == 0) { unsigned char* pw_ = kargs().ws + WS_PROBE; const unsigned long long now_ = __builtin_amdgcn_s_memrealtime(); \
    unsigned long long* tp_ = (unsigned long long*)(pw_ + 256); ((float*)pw_)[lbl] += (float)(now_ - *tp_); *tp_ = now_; } } while (0)
#else
#define STAMP(lbl) do {} while (0)
#endif
__device__ __forceinline__ unsigned f2bf(float f) { unsigned u = __builtin_bit_cast(unsigned, f); return (u + 0x7fffu + ((u >> 16) & 1u)) >> 16; }
typedef float f32x2_t __attribute__((ext_vector_type(2))); typedef __bf16 bf16x2_t __attribute__((ext_vector_type(2)));
__device__ __forceinline__ unsigned pk2(float lo, float hi) { const f32x2_t v = {lo, hi}; const bf16x2_t b = __builtin_convertvector(v, bf16x2_t); return __builtin_bit_cast(unsigned, b); }
__device__ __forceinline__ float bflo(unsigned w) { return __builtin_bit_cast(float, w << 16); }
__device__ __forceinline__ float bfhi(unsigned w) { return __builtin_bit_cast(float, w & 0xffff0000u); }
__device__ __forceinline__ float bf2f(bf16 h) { return __builtin_bit_cast(float, (unsigned)h << 16); }
__device__ __forceinline__ int o_bid() { int t = blockIdx.x; asm volatile("" : "+s"(t)); return t; }
__device__ __forceinline__ int o_grid() { int t = gridDim.x; asm volatile("" : "+s"(t)); return t; }
__device__ __forceinline__ float shfl_xor_l(float v, int o, int lane) { return __builtin_bit_cast(float, __builtin_amdgcn_ds_bpermute((lane ^ o) << 2, __builtin_bit_cast(int, v))); }
__device__ __forceinline__ float wave_sum(float v, int lane) {
#pragma unroll
    for (int o = 1; o < 64; o <<= 1) v += shfl_xor_l(v, o, lane);
    return v;
}
__device__ __forceinline__ int crow(int r, int hi) { return (r & 3) + 8 * (r >> 2) + 4 * hi; }

template <class F> struct Epi8 {
    static constexpr bool PERM = true, AFTER_DRAIN = false;
    F f;
    __device__ __forceinline__ void operator()(const pg8::f32x4 (&acc)[2][2][4][2], const pg8::Unit& u, int wr, int wc, int fr, int fq) const {
        asm volatile("" : "+v"(fr), "+v"(fq));
#pragma unroll
        for (int ai = 0; ai < 2; ++ai)
#pragma unroll
            for (int m = 0; m < 4; ++m) {
                const int row = u.pm * 256 + ai * 128 + wr * 64 + m * 16 + fr;
#pragma unroll
                for (int bj = 0; bj < 2; ++bj) { const int col = u.pn * 256 + bj * 128 + wc * 32 + 8 * fq; f(row, col, acc[ai][bj][m][0], acc[ai][bj][m][1]); }
                asm volatile("" ::: "memory"); __builtin_amdgcn_sched_barrier(0);
            }
    }
};
__device__ __forceinline__ v4u pack8(f32x4 a, f32x4 b) { v4u w; w.x = pk2(a[0], a[1]); w.y = pk2(a[2], a[3]); w.z = pk2(b[0], b[1]); w.w = pk2(b[2], b[3]); return w; }
struct FStore { bf16* O; int ldc; int act;
    __device__ __forceinline__ void operator()(int row, int col, f32x4 a, f32x4 b) const {
        if (act == 1) {
#pragma unroll
            for (int i = 0; i < 4; ++i) { float x = a[i] > 0.f ? a[i] : 0.f; a[i] = x * x; float y = b[i] > 0.f ? b[i] : 0.f; b[i] = y * y; } }
        *(v4u*)(O + (size_t)row * ldc + col) = pack8(a, b); } };
struct FD2 { bf16* cat; const float* bias; int rowbase, rowsPerB;
    __device__ __forceinline__ void operator()(int row, int col, f32x4 a, f32x4 b) const {
        const int bb = col >> 8, j = col & 255; const f32x4 b0 = *(const f32x4*)(bias + j), b1 = *(const f32x4*)(bias + j + 4);
        *(v4u*)(cat + ((size_t)(rowbase + bb * rowsPerB + row) * 1024 + 768 + j)) = pack8(a + b0, b + b1); } };
struct FGlu { bf16* cat; const bf16* T;
    __device__ __forceinline__ void operator()(int row, int col, f32x4 a, f32x4 b) const {
        const v4u t = *(const v4u*)(T + (size_t)row * 256 + col);
        float tv[8] = {bflo(t.x), bfhi(t.x), bflo(t.y), bfhi(t.y), bflo(t.z), bfhi(t.z), bflo(t.w), bfhi(t.w)};
#pragma unroll
        for (int i = 0; i < 4; ++i) { a[i] = tv[i] / (1.f + __expf(-a[i])); b[i] = tv[4 + i] / (1.f + __expf(-b[i])); }
        *(v4u*)(cat + (size_t)row * 1024 + 256 + col) = pack8(a, b); } };
__device__ __forceinline__ void transpose_item(const float* W, int K, int N, bf16* WT, LAS float* scr, int item, int lane) {
    const int nblk = N / 32, kb = item / nblk, nb = item % nblk, k0 = 64 * kb, n0 = 32 * nb;
#pragma unroll
    for (int i = 0; i < 8; ++i) { const int kk = 8 * i + (lane >> 3), n4 = (lane & 7) * 4; const f32x4 v = *(const f32x4*)(W + (size_t)(k0 + kk) * N + n0 + n4);
        scr[kk * 33 + n4] = v[0]; scr[kk * 33 + n4 + 1] = v[1]; scr[kk * 33 + n4 + 2] = v[2]; scr[kk * 33 + n4 + 3] = v[3]; }
    asm volatile("s_waitcnt lgkmcnt(0)" ::: "memory");
    const int c = lane & 7;
#pragma unroll
    for (int j = 0; j < 4; ++j) { const int n = (lane >> 3) + 8 * j; const LAS float* s = scr + (8 * c) * 33 + n;
        v4u o; o.x = pk2(s[0 * 33], s[1 * 33]); o.y = pk2(s[2 * 33], s[3 * 33]); o.z = pk2(s[4 * 33], s[5 * 33]); o.w = pk2(s[6 * 33], s[7 * 33]);
        *(v4u*)(WT + (size_t)(n0 + n) * K + k0 + 8 * c) = o; }
    asm volatile("s_waitcnt lgkmcnt(0)" ::: "memory");
}

__device__ __forceinline__ void prologue(LAS unsigned char* lds) {
    CArgs& a = kargs();
    int tid_ = threadIdx.x; asm volatile("" : "+v"(tid_));
    const int tid = tid_, lane = tid & 63, wid = tid >> 6, G = o_grid();
    unsigned char* ws = a.ws;
    {
        LAS float* scr = (LAS float*)(lds + wid * 16384);
        const int gw = o_bid() * 8 + wid, NGW = G * 8;
        constexpr int I0 = (DM / 64) * (INW / 32), I1 = (DM / 64) * (DM / 32), I2 = (DM / 64) * (DFF / 32), I3 = (DFF / 64) * (DM / 32), I4 = (256 / 64) * (256 / 32);
        constexpr int PER = I0 + I1 + I2 + I3 + I4;
        for (int it = gw; it < 2 * PER; it += NGW) {
            const int l = it / PER; int r = it % PER; unsigned char* wb = ws + WS_W + (size_t)l * W_LAYER;
            if (r < I0) { transpose_item(a.in[I_WIN] + (size_t)l * DM * INW, DM, INW, (bf16*)(wb + WO_IN), scr, r, lane); continue; } r -= I0;
            if (r < I1) { transpose_item(a.in[I_WOUT] + (size_t)l * DM * DM, DM, DM, (bf16*)(wb + WO_OUT), scr, r, lane); continue; } r -= I1;
            if (r < I2) { transpose_item(a.in[I_W1] + (size_t)l * DM * DFF, DM, DFF, (bf16*)(wb + WO_1), scr, r, lane); continue; } r -= I2;
            if (r < I3) { transpose_item(a.in[I_W2] + (size_t)l * DFF * DM, DFF, DM, (bf16*)(wb + WO_2), scr, r, lane); continue; } r -= I3;
            transpose_item(a.in[I_WGLU] + (size_t)l * 256 * 256, 256, 256, (bf16*)(wb + WO_GLU), scr, r, lane);
        }
    }
    __syncthreads();
    {
        LAS float* sl = (LAS float*)lds;
        LAS float* part = (LAS float*)(lds + 17 * 1024 * 4);
        float* mod = (float*)(ws + WS_MOD);
        bool have = false;
        for (int u = o_bid(); u < 2 * 96; u += G) {
            if (!have) {
                for (int i = tid; i < 17 * 1024; i += 512) { const float cv = i < 16 * 1024 ? a.in[I_C][i] : a.in[I_CCTX][i - 16 * 1024]; sl[i] = cv / (1.f + __expf(-cv)); }
                have = true; __syncthreads();
            }
            const int l = u / 96, n0 = (u % 96) * 64;
            const float* W = a.in[I_WADA] + (size_t)l * DM * 6144 + n0 + lane;
            float acc[17];
#pragma unroll
            for (int i = 0; i < 17; ++i) acc[i] = 0.f;
            for (int k0 = wid * 128; k0 < wid * 128 + 128; k0 += 16) {
                float wv[16];
#pragma unroll
                for (int q = 0; q < 16; ++q) wv[q] = W[(size_t)(k0 + q) * 6144];
#pragma unroll
                for (int q = 0; q < 16; ++q)
#pragma unroll
                    for (int i = 0; i < 17; ++i) acc[i] += sl[i * 1024 + k0 + q] * wv[q];
            }
#pragma unroll
            for (int i = 0; i < 17; ++i) part[(wid * 17 + i) * 64 + lane] = acc[i];
            __syncthreads();
            for (int o = tid; o < 17 * 64; o += 512) {
                const int i = o >> 6, n = o & 63; float s = a.in[I_BADA][l * 6144 + n0 + n];
#pragma unroll
                for (int w = 0; w < 8; ++w) s += part[(w * 17 + i) * 64 + n];
                mod[((size_t)l * 17 + i) * 6144 + n0 + n] = s;
            }
            __syncthreads();
        }
    }
    {
        const size_t gt = (size_t)o_bid() * 512 + tid, NT = (size_t)G * 512;
        bf16* dft = (bf16*)(ws + WS_DFT);
        for (size_t i = gt; i < (size_t)2048 * 4096 / 8; i += NT) {
            const int kk = (int)(i / 512), n0 = (int)(i % 512) * 8; float v[8];
#pragma unroll
            for (int j = 0; j < 8; ++j) { const int n = n0 + j, nn = n & 2047; const float fr = (float)((kk * nn) & 2047) * (1.f / 2048.f);
                v[j] = (n < 2048 ? __builtin_amdgcn_cosf(fr) : -__builtin_amdgcn_sinf(fr)) * 0.02209708691207961f; }
            v4u o; o.x = pk2(v[0], v[1]); o.y = pk2(v[2], v[3]); o.z = pk2(v[4], v[5]); o.w = pk2(v[6], v[7]);
            *(v4u*)(dft + i * 8) = o;
        }
        bf16* dftc = (bf16*)(ws + WS_DFTC);
        for (size_t i = gt; i < (size_t)256 * 512 / 8; i += NT) {
            const int kk = (int)(i / 64), n0 = (int)(i % 64) * 8; float v[8];
#pragma unroll
            for (int j = 0; j < 8; ++j) { const int n = n0 + j, nn = n & 255; const float fr = (float)((kk * nn) & 255) * (1.f / 256.f);
                v[j] = (n < 256 ? __builtin_amdgcn_cosf(fr) : -__builtin_amdgcn_sinf(fr)) * 0.0625f; }
            v4u o; o.x = pk2(v[0], v[1]); o.y = pk2(v[2], v[3]); o.z = pk2(v[4], v[5]); o.w = pk2(v[6], v[7]);
            *(v4u*)(dftc + i * 8) = o;
        }
        for (size_t i = gt; i < (size_t)2 * 512 * 256; i += NT) {
            const int l = (int)(i / (512 * 256)), rem = (int)(i % (512 * 256)), jp = rem >> 8, cin = rem & 255, j = jp & 255, part = jp >> 8;
            const float* W = a.in[I_WFNET] + (size_t)l * 256 * 256 + (size_t)(cin >> 6) * 64 * 256 + j; const int c = cin & 63; float s = 0.f;
            for (int cp0 = 0; cp0 < 64; cp0 += 16) { float wv[16];
#pragma unroll
                for (int q = 0; q < 16; ++q) wv[q] = W[(size_t)(cp0 + q) * 256];
#pragma unroll
                for (int q = 0; q < 16; ++q) { const float fr = (float)((c * (cp0 + q)) & 63) * (1.f / 64.f); s += (part ? __builtin_amdgcn_sinf(fr) : __builtin_amdgcn_cosf(fr)) * wv[q]; } }
            ((bf16*)(ws + WS_W + (size_t)l * W_LAYER + WO_CS))[(size_t)jp * 256 + cin] = (bf16)f2bf(s * 0.125f);
        }
        float2* rope = (float2*)(ws + WS_ROPE);
        for (size_t i = gt; i < 1024; i += NT) { const int pos = (int)i >> 4, k = (int)i & 15; const float inv = exp2f(-(float)k * (13.287712379549449f / 16.f)); const float ang = (float)pos * inv;
            float sn, cs; sincosf(ang, &sn, &cs); rope[i] = make_float2(cs, sn); }
    }
}

__device__ __forceinline__ void prep_rows0() {
    CArgs& a = kargs();
    int tid_ = threadIdx.x; asm volatile("" : "+v"(tid_));
    const int lane = tid_ & 63, gw = o_bid() * 8 + (tid_ >> 6), NGW = o_grid() * 8;
    const float* mod = (const float*)(a.ws + WS_MOD); bf16* XN = (bf16*)(a.ws + WS_XN); const float* gp = a.in[I_GPREMIX];
    f32x4 vn[4];
    auto rload = [&](int row) { const float* xr = row < MLAT ? a.in[I_X] + (size_t)row * DM : a.in[I_CTX] + (size_t)(row - MLAT) * DM;
#pragma unroll
        for (int j = 0; j < 4; ++j) vn[j] = *(const f32x4*)(xr + 4 * lane + 256 * j); };
    if (gw < MT) rload(gw);
    for (int row = gw; row < MT; row += NGW) {
        const int bi = row < MLAT ? row >> 11 : 16;
        const float* mb = mod + (size_t)bi * 6144;
        f32x4 v[4]; float ss = 0.f;
#pragma unroll
        for (int j = 0; j < 4; ++j) { v[j] = vn[j]; ss += v[j][0] * v[j][0] + v[j][1] * v[j][1] + v[j][2] * v[j][2] + v[j][3] * v[j][3]; }
        if (row + NGW < MT) rload(row + NGW);
        const float rstd = rsqrtf(wave_sum(ss, lane) * (1.f / DM) + EPSN);
#pragma unroll
        for (int j = 0; j < 4; ++j) { const int k = 4 * lane + 256 * j; const f32x4 g = *(const f32x4*)(gp + k), sh = *(const f32x4*)(mb + k), sc = *(const f32x4*)(mb + 1024 + k);
            f32x4 o;
#pragma unroll
            for (int e = 0; e < 4; ++e) o[e] = (v[j][e] * rstd * g[e]) * (1.f + sc[e]) + sh[e];
            v2u w; w.x = pk2(o[0], o[1]); w.y = pk2(o[2], o[3]); *(v2u*)(XN + (size_t)row * DM + k) = w; }
    }
}
template <int WHICH>
__device__ __forceinline__ void row_update() {
    CArgs& a = kargs();
    constexpr int l = WHICH >> 1; constexpr bool MLP = WHICH & 1; constexpr bool NXT = WHICH != 3;
    const int nrows = l == 0 ? MT : MLAT;
    const bf16* Y = (const bf16*)(a.ws + (MLP ? WS_XN : WS_Y)); bf16* OB = (bf16*)(a.ws + WS_XN);
    const float* xlat_in = WHICH == 0 ? a.in[I_X] : a.out; const float* xctx_in = WHICH == 0 ? a.in[I_CTX] : (const float*)(a.ws + WS_XC);
    float* xlat_out = a.out; float* xctx_out = (float*)(a.ws + WS_XC);
    const float* mod = (const float*)(a.ws + WS_MOD);
    const float* modl = mod + (size_t)l * 17 * 6144; constexpr int gate_i = MLP ? 5 : 2;
    const float* gpost = (MLP ? a.in[I_GPOSTMLP] : a.in[I_GPOSTMIX]) + l * DM;
    const float* modn = MLP ? mod + (size_t)17 * 6144 : modl; constexpr int sh_i = MLP ? 0 : 3, sc_i = MLP ? 1 : 4;
    const float* gnext = MLP ? a.in[I_GPREMIX] + DM : a.in[I_GPREMLP] + l * DM;
    int tid_ = threadIdx.x; asm volatile("" : "+v"(tid_));
    const int lane = tid_ & 63, gw = o_bid() * 8 + (tid_ >> 6), NGW = o_grid() * 8;
    v2u ywn[4]; f32x4 xn[4];
    auto rload = [&](int row) {
        const bool lat = row < MLAT; const float* xr = lat ? xlat_in + (size_t)row * DM : xctx_in + (size_t)(row - MLAT) * DM;
#pragma unroll
        for (int j = 0; j < 4; ++j) { const int k = 4 * lane + 256 * j; ywn[j] = *(const v2u*)(Y + (size_t)row * DM + k); xn[j] = *(const f32x4*)(xr + k); } };
    if (gw < nrows) rload(gw);
    for (int row = gw; row < nrows; row += NGW) {
        const bool lat = row < MLAT; const int bi = lat ? row >> 11 : 16;
        float* xo = lat ? xlat_out + (size_t)row * DM : xctx_out + (size_t)(row - MLAT) * DM;
        const float* gate = modl + (size_t)bi * 6144 + gate_i * 1024;
        f32x4 y[4], x[4]; float ss = 0.f;
#pragma unroll
        for (int j = 0; j < 4; ++j) { const v2u w = ywn[j]; y[j] = (f32x4){bflo(w.x), bfhi(w.x), bflo(w.y), bfhi(w.y)}; x[j] = xn[j];
            ss += y[j][0] * y[j][0] + y[j][1] * y[j][1] + y[j][2] * y[j][2] + y[j][3] * y[j][3]; }
        if (row + NGW < nrows) rload(row + NGW);
        const float rstd = rsqrtf(wave_sum(ss, lane) * (1.f / DM) + EPSN); float s2 = 0.f;
#pragma unroll
        for (int j = 0; j < 4; ++j) { const int k = 4 * lane + 256 * j; const f32x4 g = *(const f32x4*)(gpost + k), gt = *(const f32x4*)(gate + k);
#pragma unroll
            for (int e = 0; e < 4; ++e) { x[j][e] = x[j][e] + gt[e] * (y[j][e] * rstd * g[e]); s2 += x[j][e] * x[j][e]; }
#ifdef PROBE
            if (WHICH == 3) { const float* pa = (const float*)(a.ws + WS_PROBE); float tot = 0.f, fa = 0.f, fb = 0.f;
                for (int i = 0; i < 15; ++i) { const float v = pa[i]; tot += v; if ((PROBE_A >> i) & 1) fa += v; if ((PROBE_B >> i) & 1) fb += v; }
                fa /= tot; fb /= tot; const float e = fa < 0.02f ? 0.02f : fa;
                for (int q = 0; q < 4; ++q) x[j][q] *= (1.f + e);
                if (row == 0 && lane == 0 && j == 0) x[j][0] += 50.f + 1000.f * fb; }
#endif
            *(f32x4*)(xo + k) = x[j]; }
        if (NXT) {
            const float rstd2 = rsqrtf(wave_sum(s2, lane) * (1.f / DM) + EPSN); const float* mb = modn + (size_t)bi * 6144;
#pragma unroll
            for (int j = 0; j < 4; ++j) { const int k = 4 * lane + 256 * j; const f32x4 g = *(const f32x4*)(gnext + k), sh = *(const f32x4*)(mb + sh_i * 1024 + k), sc = *(const f32x4*)(mb + sc_i * 1024 + k);
                f32x4 o;
#pragma unroll
                for (int e = 0; e < 4; ++e) o[e] = (x[j][e] * rstd2 * g[e]) * (1.f + sc[e]) + sh[e];
                v2u w; w.x = pk2(o[0], o[1]); w.y = pk2(o[2], o[3]); *(v2u*)(OB + (size_t)row * DM + k) = w; }
        }
    }
}

__device__ __forceinline__ void qk_prep(int layer) {
    CArgs& a = kargs();
    bf16* Z = (bf16*)(a.ws + WS_Z); const float2* rope = (const float2*)(a.ws + WS_ROPE);
    int tid_ = threadIdx.x; asm volatile("" : "+v"(tid_));
    const int gt = o_bid() * 512 + tid_, NT = o_grid() * 512;
    for (int it = gt; it < MT * 6; it += NT) {
        const int row = it / 6, slot = it % 6; const bool lat = row < MLAT;
        bf16* p = Z + (size_t)row * INW + (slot < 4 ? OFF_AQ + slot * 64 : OFF_AK + (slot - 4) * 64);
        const float* g = (slot < 4 ? a.in[I_GQ] : a.in[I_GK]) + layer * 64;
        float v[64]; float ss = 0.f;
#pragma unroll
        for (int c = 0; c < 8; ++c) { const v4u w = *(const v4u*)(p + 8 * c);
            v[8 * c + 0] = bflo(w.x); v[8 * c + 1] = bfhi(w.x); v[8 * c + 2] = bflo(w.y); v[8 * c + 3] = bfhi(w.y); v[8 * c + 4] = bflo(w.z); v[8 * c + 5] = bfhi(w.z); v[8 * c + 6] = bflo(w.w); v[8 * c + 7] = bfhi(w.w); }
#pragma unroll
        for (int i = 0; i < 64; ++i) ss += v[i] * v[i];
        const float rstd = rsqrtf(ss * (1.f / 64.f) + EPSN);
#pragma unroll
        for (int i = 0; i < 64; ++i) v[i] = v[i] * rstd * g[i];
        if (lat) {
            const int t = row & 2047, gr = t >> 6, gc = t & 63;
#pragma unroll
            for (int i = 0; i < 16; ++i) {
                const float2 cr = rope[gr * 16 + i], cc = rope[gc * 16 + i];
                const float x1 = v[i], x2 = v[16 + i]; v[i] = x1 * cr.x - x2 * cr.y; v[16 + i] = x1 * cr.y + x2 * cr.x;
                const float y1 = v[32 + i], y2 = v[48 + i]; v[32 + i] = y1 * cc.x - y2 * cc.y; v[48 + i] = y1 * cc.y + y2 * cc.x;
            }
        }
#pragma unroll
        for (int c = 0; c < 8; ++c) { v4u w; w.x = pk2(v[8 * c], v[8 * c + 1]); w.y = pk2(v[8 * c + 2], v[8 * c + 3]); w.z = pk2(v[8 * c + 4], v[8 * c + 5]); w.w = pk2(v[8 * c + 6], v[8 * c + 7]); *(v4u*)(p + 8 * c) = w; }
    }
}
struct AttnP { const bf16* Z; bf16* O; int ostride; int qtok0; int qcol; int ocol; int kcol, vcol; int loc0, nloc, ctx0, nctx;
               int na; int qgcol0; int relr0; int head; int act_lo, act_hi; };
struct AttnQS { bf16x8 qr[4]; f32x16 o0, o1; float m, lsum; };
template <int NH, int QB = 1>
__device__ __forceinline__ void attn_unit(LAS unsigned char* lds, const AttnP& P, const LAS float* biasL) {
    int tid_ = threadIdx.x; asm volatile("" : "+v"(tid_));
    const int tid = tid_, lane = tid & 63, wid = tid >> 6, r32 = lane & 31, hi = lane >> 5;
    const int slot = (NH == 1) ? 0 : (wid >> 1);
    const bf16* Z = P.Z;
    AttnQS QA, QBs;
#pragma unroll
    for (int d0 = 0; d0 < 4; ++d0) { QA.qr[d0] = *(const bf16x8*)(Z + (size_t)(P.qtok0 + r32) * INW + P.qcol + d0 * 16 + hi * 8);
        if (QB == 2) QBs.qr[d0] = *(const bf16x8*)(Z + (size_t)(P.qtok0 + 32 + r32) * INW + P.qcol + d0 * 16 + hi * 8); }
    const int nt = P.nloc + P.nctx;
    v4u kreg[NH], vreg[NH];
    auto tile_tok = [&](int i) { return i < P.nloc ? P.loc0 + 64 * i : P.ctx0 + 64 * (i - P.nloc); };
    auto gload = [&](int i) { const int tok = tile_tok(i);
#pragma unroll
        for (int s = 0; s < NH; ++s) { kreg[s] = *(const v4u*)(Z + (size_t)(tok + (tid >> 3)) * INW + P.kcol + s * 64 + (tid & 7) * 8);
                                        vreg[s] = *(const v4u*)(Z + (size_t)(tok + lane) * INW + P.vcol + s * 64 + wid * 8); } };
    gload(0);
    QA.o0 = f32x16{}; QA.o1 = f32x16{}; QA.m = -1e30f; QA.lsum = 0.f; QBs.o0 = f32x16{}; QBs.o1 = f32x16{}; QBs.m = -1e30f; QBs.lsum = 0.f;
    const float sc = 0.125f * LOG2E;
    const int qg = P.qgcol0 + r32; const int cs = qg - 8 < 0 ? 0 : (qg - 8 > 48 ? 48 : qg - 8);
    auto lstore = [&](int bufoff) {
#pragma unroll
        for (int s = 0; s < NH; ++s) {
            LAS unsigned char* sb = lds + bufoff + s * 18432;
            *(LAS v4u*)(sb + ((tid >> 3) * 72 + (tid & 7) * 8) * 2) = kreg[s];
            LAS bf16* vt = (LAS bf16*)(sb + 9216);
            const unsigned w[4] = {vreg[s].x, vreg[s].y, vreg[s].z, vreg[s].w};
#pragma unroll
            for (int e = 0; e < 4; ++e) { vt[(wid * 8 + 2 * e) * 68 + lane] = (bf16)(w[e] & 0xffffu); vt[(wid * 8 + 2 * e + 1) * 68 + lane] = (bf16)(w[e] >> 16); }
        }
    };
    auto compute = [&](int i, int bufoff, AttnQS& S) {
        if (P.na && i < P.nloc && (i < P.act_lo || i >= P.act_hi)) return;
        const LAS unsigned char* kb = lds + bufoff + slot * 18432; const LAS unsigned char* vb = kb + 9216;
        f32x16 p0 = {}, p1 = {};
#pragma unroll
        for (int d0 = 0; d0 < 4; ++d0) {
            const bf16x8 a0 = *(const LAS bf16x8*)(kb + (r32 * 72 + d0 * 16 + hi * 8) * 2);
            const bf16x8 a1 = *(const LAS bf16x8*)(kb + ((32 + r32) * 72 + d0 * 16 + hi * 8) * 2);
            p0 = __builtin_amdgcn_mfma_f32_32x32x16_bf16(a0, S.qr[d0], p0, 0, 0, 0);
            p1 = __builtin_amdgcn_mfma_f32_32x32x16_bf16(a1, S.qr[d0], p1, 0, 0, 0);
        }
        if (P.na && i < P.nloc) {
            const LAS float* bl = biasL + (P.head * 15 + (P.relr0 + i)) * 31;
#pragma unroll
            for (int r = 0; r < 16; ++r) {
                const int kv0 = crow(r, hi), kv1 = kv0 + 32;
                const bool ok0 = (unsigned)(kv0 - cs) < 16u, ok1 = (unsigned)(kv1 - cs) < 16u;
                const int i0 = kv0 - qg + 15, i1 = kv1 - qg + 15;
                const float b0 = bl[i0 < 0 ? 0 : (i0 > 30 ? 30 : i0)], b1 = bl[i1 < 0 ? 0 : (i1 > 30 ? 30 : i1)];
                p0[r] = ok0 ? p0[r] + b0 : -INFINITY; p1[r] = ok1 ? p1[r] + b1 : -INFINITY;
            }
        }
        float mx = fmaxf(fmaxf(p0[0], p0[1]), p1[0]);
#pragma unroll
        for (int r = 2; r < 16; r += 2) mx = fmaxf(fmaxf(mx, p0[r]), p0[r + 1]);
#pragma unroll
        for (int r = 1; r < 15; r += 2) mx = fmaxf(fmaxf(mx, p1[r]), p1[r + 1]);
        mx = fmaxf(mx, p1[15]);
        mx = fmaxf(mx, shfl_xor_l(mx, 32, lane));
        if (__any((mx - S.m) * sc > 6.f)) {
            const float mn = fmaxf(S.m, mx), alpha = __builtin_amdgcn_exp2f((S.m - mn) * sc); S.m = mn; S.lsum *= alpha;
#pragma unroll
            for (int r = 0; r < 16; ++r) { S.o0[r] *= alpha; S.o1[r] *= alpha; }
        }
        const float nm = -S.m * sc;
        float ps = 0.f;
#pragma unroll
        for (int r = 0; r < 16; ++r) { p0[r] = __builtin_amdgcn_exp2f(fmaf(p0[r], sc, nm)); p1[r] = __builtin_amdgcn_exp2f(fmaf(p1[r], sc, nm)); ps += p0[r] + p1[r]; }
        S.lsum += ps;
        bf16x8 pf[4];
#pragma unroll
        for (int s = 0; s < 4; ++s) {
            v4u w;
            if (s < 2) { w.x = pk2(p0[8 * s], p0[8 * s + 1]); w.y = pk2(p0[8 * s + 2], p0[8 * s + 3]); w.z = pk2(p0[8 * s + 4], p0[8 * s + 5]); w.w = pk2(p0[8 * s + 6], p0[8 * s + 7]); }
            else { const int q = s - 2; w.x = pk2(p1[8 * q], p1[8 * q + 1]); w.y = pk2(p1[8 * q + 2], p1[8 * q + 3]); w.z = pk2(p1[8 * q + 4], p1[8 * q + 5]); w.w = pk2(p1[8 * q + 6], p1[8 * q + 7]); }
            pf[s] = __builtin_bit_cast(bf16x8, w);
        }
#pragma unroll
        for (int s = 0; s < 4; ++s) {
            const int kvb = 32 * (s >> 1) + 16 * (s & 1) + 4 * hi;
            {   const LAS unsigned char* va = vb + (r32 * 68 + kvb) * 2;
                const s16x4 lo = *(const LAS s16x4*)va, hh = *(const LAS s16x4*)(va + 16);
                const bf16x8 af = {lo[0], lo[1], lo[2], lo[3], hh[0], hh[1], hh[2], hh[3]};
                S.o0 = __builtin_amdgcn_mfma_f32_32x32x16_bf16(af, pf[s], S.o0, 0, 0, 0); }
            {   const LAS unsigned char* va = vb + ((32 + r32) * 68 + kvb) * 2;
                const s16x4 lo = *(const LAS s16x4*)va, hh = *(const LAS s16x4*)(va + 16);
                const bf16x8 af = {lo[0], lo[1], lo[2], lo[3], hh[0], hh[1], hh[2], hh[3]};
                S.o1 = __builtin_amdgcn_mfma_f32_32x32x16_bf16(af, pf[s], S.o1, 0, 0, 0); }
        }
        };
    if (NH == 1) {
        __syncthreads();
        lstore(0);
        if (nt > 1) gload(1);
        __syncthreads();
        for (int i = 0; i < nt; ++i) {
            if (i + 1 < nt) { lstore(((i + 1) & 1) * 18432); if (i + 2 < nt) gload(i + 2); }
            compute(i, (i & 1) * 18432, QA); if (QB == 2) compute(i, (i & 1) * 18432, QBs);
            __syncthreads();
        }
    } else {
        for (int i = 0; i < nt; ++i) {
            __syncthreads();
            lstore(0);
            __syncthreads();
            if (i + 1 < nt) gload(i + 1);
            compute(i, 0, QA);
        }
    }
    auto finish = [&](AttnQS& S, int qtok) {
        const float lsum = S.lsum + shfl_xor_l(S.lsum, 32, lane);
        const float inv = 1.f / lsum;
        bf16* op = P.O + (size_t)(qtok + r32) * P.ostride + P.ocol;
#pragma unroll
        for (int rg = 0; rg < 4; ++rg) {
            v2u w0, w1;
            w0.x = pk2(S.o0[4 * rg] * inv, S.o0[4 * rg + 1] * inv); w0.y = pk2(S.o0[4 * rg + 2] * inv, S.o0[4 * rg + 3] * inv);
            w1.x = pk2(S.o1[4 * rg] * inv, S.o1[4 * rg + 1] * inv); w1.y = pk2(S.o1[4 * rg + 2] * inv, S.o1[4 * rg + 3] * inv);
            *(v2u*)(op + 8 * rg + 4 * hi) = w0; *(v2u*)(op + 32 + 8 * rg + 4 * hi) = w1;
        } };
    finish(QA, P.qtok0);
    if (QB == 2) finish(QBs, P.qtok0 + 32);
}

__device__ __forceinline__ int s5_tokrow(int s, int dir, int b) {
    if (s < 256) return MLAT + b * 256 + (dir ? 255 - s : s);
    const int t = s - 256; return b * 2048 + (dir ? 2047 - t : t);
}
__device__ __forceinline__ void s5_unit(LAS unsigned char* lds, int layer, int b, int g) {
    CArgs& a = kargs();
    int tid_ = threadIdx.x; asm volatile("" : "+v"(tid_));
    const int tid = tid_, lane = tid & 63, wid = tid >> 6, r32 = lane & 31, hi = lane >> 5;
    LAS float* BuL = (LAS float*)(lds + wid * 17920);
    LAS bf16* HL = (LAS bf16*)(lds + wid * 17920);
    LAS v4u* uL = (LAS v4u*)(lds + wid * 17920 + 8704);
    const bf16* Z = (const bf16*)(a.ws + WS_Z); float* Y0 = (float*)(a.ws + WS_Y0); float* Y1 = (float*)(a.ws + WS_Y1);
    for (int dir = 0; dir < 2; ++dir) {
        const int idx = (layer * 2 + dir) * 16 + g;
        const float dt = expf(a.in[I_LDT][idx]);
        float ar, ai;
        { const float lr = fminf(a.in[I_AR][idx * 64 + lane], -1e-4f), li = a.in[I_AI][idx * 64 + lane]; const float er = expf(lr * dt); float sn, cs; sincosf(li * dt, &sn, &cs); ar = er * cs; ai = er * sn; }
        float pr = ar, pi = ai;
        float p32r, p32i;
#pragma unroll
        for (int k = 0; k < 5; ++k) { const float tr = pr * pr - pi * pi, ti = 2.f * pr * pi; pr = tr; pi = ti; }
        p32r = pr; p32i = pi;
#pragma unroll
        for (int k = 0; k < 3; ++k) { const float tr = pr * pr - pi * pi, ti = 2.f * pr * pi; pr = tr; pi = ti; }
        { const float tr = pr * p32r - pi * p32i, ti = pr * p32i + pi * p32r; pr = tr; pi = ti; }
        bf16x8 bfr[4];
        float aR[2], aI[2];
#pragma unroll
        for (int pp = 0; pp < 2; ++pp) {
            const int p2 = 32 * pp + r32;
            const float lr = fminf(a.in[I_AR][idx * 64 + p2], -1e-4f), li = a.in[I_AI][idx * 64 + p2]; const float er = expf(lr * dt); float sn, cs; sincosf(li * dt, &sn, &cs);
            aR[pp] = er * cs; aI[pp] = er * sn;
            const float xr = er * cs - 1.f, xi = er * sn, den = 1.f / (lr * lr + li * li);
            const float cr = (xr * lr + xi * li) * den, ci = (xi * lr - xr * li) * den;
            const float* br = a.in[I_BR] + ((size_t)idx * 64 + p2) * 16 + 8 * hi; const float* bi = a.in[I_BI] + ((size_t)idx * 64 + p2) * 16 + 8 * hi;
            float re[8], im[8];
#pragma unroll
            for (int j = 0; j < 8; ++j) { const float x = br[j], y = bi[j]; re[j] = cr * x - ci * y; im[j] = cr * y + ci * x; }
            v4u w; w.x = pk2(re[0], re[1]); w.y = pk2(re[2], re[3]); w.z = pk2(re[4], re[5]); w.w = pk2(re[6], re[7]); bfr[pp] = __builtin_bit_cast(bf16x8, w);
            w.x = pk2(im[0], im[1]); w.y = pk2(im[2], im[3]); w.z = pk2(im[4], im[5]); w.w = pk2(im[6], im[7]); bfr[2 + pp] = __builtin_bit_cast(bf16x8, w);
        }
        bf16x8 cfr[8];
        const float cmsk = r32 < 16 ? 1.f : 0.f;
#pragma unroll
        for (int ks = 0; ks < 8; ++ks) {
            const size_t co = ((size_t)idx * 16 + (r32 & 15)) * 64 + 8 * ks + 4 * hi;
            const f32x4 cr4 = *(const f32x4*)(a.in[I_CR] + co), ci4 = *(const f32x4*)(a.in[I_CI] + co);
            v4u w; w.x = pk2(cr4[0] * cmsk, -ci4[0] * cmsk); w.y = pk2(cr4[1] * cmsk, -ci4[1] * cmsk); w.z = pk2(cr4[2] * cmsk, -ci4[2] * cmsk); w.w = pk2(cr4[3] * cmsk, -ci4[3] * cmsk);
            cfr[ks] = __builtin_bit_cast(bf16x8, w);
        }
        float hr = 0.f, him = 0.f;
        float* Yd = dir == 0 ? Y0 : Y1;
        {
            const bf16* ub = Z + OFF_S5 + 16 * g + 8 * hi;
            v4u ur[9];
#pragma unroll
            for (int ch = 0; ch < 9; ++ch) ur[ch] = *(const v4u*)(ub + (size_t)s5_tokrow(wid * 288 + ch * 32 + r32, dir, b) * INW);
#pragma unroll
            for (int ch = 0; ch < 9; ++ch) uL[ch * 64 + lane] = ur[ch];
            asm volatile("s_waitcnt lgkmcnt(0)" ::: "memory");
        }
        for (int pass = 0; pass < 2; ++pass) {
            if (pass == 0) {
                float hx[2][2] = {{0.f, 0.f}, {0.f, 0.f}};
                for (int ch = 0; ch < 9; ++ch) {
                    const bf16x8 ucur = __builtin_bit_cast(bf16x8, uL[ch * 64 + lane]);
#pragma unroll
                    for (int X = 0; X < 2; ++X) {
                        f32x16 re = {}, im = {};
                        re = __builtin_amdgcn_mfma_f32_32x32x16_bf16(ucur, bfr[X], re, 0, 0, 0); im = __builtin_amdgcn_mfma_f32_32x32x16_bf16(ucur, bfr[2 + X], im, 0, 0, 0);
                        const float ar_ = aR[X], ai_ = aI[X];
                        float a4r_, a4i_, a8r_, a8i_, a32r_, a32i_;
                        { float tr = ar_, ti = ai_;
#pragma unroll
                          for (int k = 0; k < 5; ++k) { const float nr = tr * tr - ti * ti, ni = 2.f * tr * ti; tr = nr; ti = ni; if (k == 1) { a4r_ = tr; a4i_ = ti; } if (k == 2) { a8r_ = tr; a8i_ = ti; } }
                          a32r_ = tr; a32i_ = ti; }
                        float Sr = 0.f, Si = 0.f;
#pragma unroll
                        for (int q = 0; q < 4; ++q) {
                            float gr = re[4 * q], gi = im[4 * q];
#pragma unroll
                            for (int i = 1; i < 4; ++i) { const float nr = gr * ar_ - gi * ai_ + re[4 * q + i], ni = gr * ai_ + gi * ar_ + im[4 * q + i]; gr = nr; gi = ni; }
                            if (q == 0) { Sr = gr; Si = gi; } else { const float nr = Sr * a8r_ - Si * a8i_ + gr, ni = Sr * a8i_ + Si * a8r_ + gi; Sr = nr; Si = ni; }
                        }
                        const float fr = hi ? 1.f : a4r_, fi = hi ? 0.f : a4i_;
                        const float Pr = Sr * fr - Si * fi, Pi = Sr * fi + Si * fr;
                        const float Cr = Pr, Ci = Pi;
                        const float nr = hx[X][0] * a32r_ - hx[X][1] * a32i_ + Cr, ni = hx[X][0] * a32i_ + hx[X][1] * a32r_ + Ci; hx[X][0] = nr; hx[X][1] = ni;
                    }
                }
#pragma unroll
                for (int X = 0; X < 2; ++X) { hx[X][0] += shfl_xor_l(hx[X][0], 32, lane); hx[X][1] += shfl_xor_l(hx[X][1], 32, lane); }
                hr = hi ? hx[1][0] : hx[0][0]; him = hi ? hx[1][1] : hx[0][1];
            } else
            for (int ch = 0; ch < 9; ++ch) {
                const int s0 = wid * 288 + ch * 32;
                bf16x8 ucur = __builtin_bit_cast(bf16x8, uL[ch * 64 + lane]);
                asm volatile("s_waitcnt lgkmcnt(0)" : "+v"(ucur) :: "memory");
                float bur[32], bui[32];
#pragma unroll
                for (int jb = 0; jb < 2; ++jb) {
                    f32x16 d = {}; d = __builtin_amdgcn_mfma_f32_32x32x16_bf16(ucur, bfr[jb], d, 0, 0, 0);
#pragma unroll
                    for (int r = 0; r < 16; ++r) BuL[crow(r, hi) * 66 + 32 * jb + r32] = d[r];
                }
                asm volatile("s_waitcnt lgkmcnt(0)" : "+v"(ucur) :: "memory");
#pragma unroll
                for (int t = 0; t < 32; ++t) bur[t] = BuL[t * 66 + lane];
                asm volatile("s_waitcnt lgkmcnt(0)" : "+v"(ucur) :: "memory");
#pragma unroll
                for (int jb = 0; jb < 2; ++jb) {
                    f32x16 d = {}; d = __builtin_amdgcn_mfma_f32_32x32x16_bf16(ucur, bfr[2 + jb], d, 0, 0, 0);
#pragma unroll
                    for (int r = 0; r < 16; ++r) BuL[crow(r, hi) * 66 + 32 * jb + r32] = d[r];
                }
                asm volatile("s_waitcnt lgkmcnt(0)" ::: "memory");
#pragma unroll
                for (int t = 0; t < 32; ++t) bui[t] = BuL[t * 66 + lane];
                asm volatile("s_waitcnt lgkmcnt(0)" ::: "memory");
                if (pass == 0) {
#pragma unroll
                    for (int t = 0; t < 32; ++t) { const float nr = ar * hr - ai * him + bur[t], ni = ar * him + ai * hr + bui[t]; hr = nr; him = ni; }
                } else {
#pragma unroll
                    for (int t = 0; t < 32; ++t) { const float nr = ar * hr - ai * him + bur[t], ni = ar * him + ai * hr + bui[t]; hr = nr; him = ni;
                        ((LAS unsigned*)HL)[t * 68 + lane] = pk2(hr, him); }
                    asm volatile("s_waitcnt lgkmcnt(0)" ::: "memory");
                    f32x16 y = {};
#pragma unroll
                    for (int ks = 0; ks < 8; ++ks) { const bf16x8 af = *(const LAS bf16x8*)((const LAS unsigned char*)HL + (r32 * 136 + 16 * ks + 8 * hi) * 2);
                        y = __builtin_amdgcn_mfma_f32_32x32x16_bf16(cfr[ks], af, y, 0, 0, 0); }
                    asm volatile("s_waitcnt lgkmcnt(0)" ::: "memory");
                    if (s0 >= 256 || layer == 0) {
                        float* yp = Yd + (size_t)s5_tokrow(s0 + r32, dir, b) * 256 + 16 * g + 4 * hi;
                        *(f32x4*)yp = (f32x4){y[0], y[1], y[2], y[3]}; *(f32x4*)(yp + 8) = (f32x4){y[4], y[5], y[6], y[7]};
                    }
                }
            }
            if (pass == 0) {
                BuL[lane * 2] = hr; BuL[lane * 2 + 1] = him;
                __syncthreads();
                hr = 0.f; him = 0.f;
                for (int v = 0; v < wid; ++v) { const LAS float* cv = (const LAS float*)(lds + v * 17920); const float cr = cv[lane * 2], ci = cv[lane * 2 + 1]; const float nr = pr * hr - pi * him + cr, ni = pr * him + pi * hr + ci; hr = nr; him = ni; }
                __syncthreads();
            }
        }

    }
}

__device__ __forceinline__ void na_phase(LAS unsigned char* lds, int l) {
    CArgs& a = kargs();
    int tid_ = threadIdx.x; asm volatile("" : "+v"(tid_));
    const int tid = tid_, wid = __builtin_amdgcn_readfirstlane(tid >> 6), G = o_grid(), bid = o_bid();
    bf16* Zb = (bf16*)(a.ws + WS_Z); bf16* CAT = (bf16*)(a.ws + WS_CAT);
    LAS float* biasL = (LAS float*)(lds + 73728);
    for (int i = tid; i < 4 * 15 * 31; i += 512) biasL[i] = 8.f * a.in[I_NABIAS][l * 4 * 15 * 31 + i];
    for (int u = bid; u < 512; u += G) {
        const int b = u >> 5, head = (u >> 3) & 3, rg = u & 7; const int r = 4 * rg + (wid >> 1);
        const int lo = 4 * rg - 4 < 0 ? 0 : (4 * rg - 4 > 24 ? 24 : 4 * rg - 4); const int hi3 = 4 * rg - 1 < 0 ? 0 : (4 * rg - 1 > 24 ? 24 : 4 * rg - 1);
        const int rs = r - 4 < 0 ? 0 : (r - 4 > 24 ? 24 : r - 4);
        AttnP P{Zb, CAT, DM, b * 2048 + r * 64 + (wid & 1) * 32, OFF_NQ + head * 64, 512 + head * 64, OFF_NK + head * 64, OFF_NV + head * 64, b * 2048 + lo * 64, hi3 + 8 - lo, MLAT + b * 256, 4, 1, (wid & 1) * 32, lo - r + 7, head, rs - lo, rs - lo + 8};
        attn_unit<1>(lds, P, biasL);
    }
    if (l == 0) for (int u = bid; u < 64; u += G) {
        const int b = u >> 2, head = u & 3;
        AttnP P{Zb, CAT, DM, MLAT + b * 256 + wid * 32, OFF_NQ + head * 64, 512 + head * 64, OFF_NK + head * 64, OFF_NV + head * 64, 0, 0, MLAT + b * 256, 4, 0, 0, 0, head, 0, 0};
        attn_unit<1>(lds, P, biasL);
    }
}
__device__ __forceinline__ void gqa_phase(LAS unsigned char* lds, int l) {
    CArgs& a = kargs();
    int tid_ = threadIdx.x; asm volatile("" : "+v"(tid_));
    const int tid = tid_, wid = __builtin_amdgcn_readfirstlane(tid >> 6), G = o_grid(), bid = o_bid();
    bf16* Zb = (bf16*)(a.ws + WS_Z); bf16* CAT = (bf16*)(a.ws + WS_CAT);
    const bool bal = (G == 256); const int nmine = bal ? (bid < 128 ? 2 : 0) : (255 - bid) / G + 1;
    for (int iu = 0; iu < nmine; ++iu) {
        const int u = bal ? bid + 128 * iu : bid + iu * G;
        const int b = u >> 4, kvh = (u >> 3) & 1, qb = u & 7; const int head = 2 * kvh + (wid >> 2);
        AttnP P{Zb, CAT, DM, b * 2048 + qb * 256 + (wid & 3) * 64, OFF_AQ + head * 64, head * 64, OFF_AK + kvh * 64, OFF_AV + kvh * 64, b * 2048, 32, MLAT + b * 256, 4, 0, 0, 0, head, 0, 0};
        attn_unit<1, 2>(lds, P, nullptr);
    }
    if (l == 0) for (int u = G - 1 - bid; u < 64; u += G) {
        const int b = u >> 2, kvh = (u >> 1) & 1, qb = u & 1; const int head = 2 * kvh + (wid >> 2);
        AttnP P{Zb, CAT, DM, MLAT + b * 256 + qb * 128 + (wid & 3) * 32, OFF_AQ + head * 64, head * 64, OFF_AK + kvh * 64, OFF_AV + kvh * 64, 0, 0, MLAT + b * 256, 4, 0, 0, 0, head, 0, 0};
        attn_unit<1>(lds, P, nullptr);
    }
}

#define XB_TMO      128
#define XB_XCNT(j)  (256  + 64 * (j))
#define XB_XSUB(j)  (1280 + 64 * (j))
#define XB_XGEN(j)  (2304 + 64 * (j))
#define XB_TOP      3328
#define XB_TOPGEN   3392
#define XCD_BAR_WORDS 3456
#define XB_SPIN_CAP (1u << 18)

__device__ __forceinline__ unsigned xb_ld(unsigned* p)              { return __hip_atomic_load(p, __ATOMIC_RELAXED, __HIP_MEMORY_SCOPE_AGENT); }
__device__ __forceinline__ unsigned xb_add(unsigned* p, unsigned v) { return __hip_atomic_fetch_add(p, v, __ATOMIC_RELAXED, __HIP_MEMORY_SCOPE_AGENT); }
__device__ __forceinline__ unsigned xb_xcc_id() { return (unsigned)__builtin_amdgcn_s_getreg((3 << 11) | 20) & 0xFu; }
#define XB_SPIN(cond, bar) do { unsigned _sp = 0; while (cond) { __builtin_amdgcn_s_sleep(1); \
    if ((++_sp & 255u) == 0u) { if (xb_ld(&(bar)[XB_TMO])) break; if (_sp > XB_SPIN_CAP) { atomicAdd(&(bar)[XB_TMO], 1u); break; } } } } while (0)
struct XcdBarrier { unsigned* bar; unsigned x; volatile LAS unsigned* st; };
__device__ __forceinline__ void xcd_barrier_complete(unsigned* bar, unsigned x, unsigned& nloc, unsigned& nx) {
    const unsigned G = gridDim.x * gridDim.y * gridDim.z;
    unsigned sum, cnt, mine, sp = 0u;
    for (;;) {
        sum = 0u; cnt = 0u; mine = 0u;
#pragma unroll
        for (unsigned j = 0; j < 16; ++j) { const unsigned c = xb_ld(&bar[XB_XCNT(j)]); sum += c; cnt += (c > 0u) ? 1u : 0u; mine = (j == x) ? c : mine; }
        if (sum == G) break;
        __builtin_amdgcn_s_sleep(1);
        if ((++sp & 255u) == 0u) { if (xb_ld(&bar[XB_TMO])) break; if (sp > XB_SPIN_CAP) { atomicAdd(&bar[XB_TMO], 1u); break; } }
    }
    nloc = mine > 0u ? mine : 1u; nx = cnt > 0u ? cnt : 1u;
}

__device__ __forceinline__ void xcd_barrier(const XcdBarrier& b) {
    asm volatile("s_waitcnt vmcnt(0)" ::: "memory");
    __syncthreads();
    if (threadIdx.x == 0) {
        unsigned* bar = b.bar;
        __builtin_amdgcn_s_waitcnt(0);
        unsigned nloc = b.st[0], nx = b.st[1];
        if (nloc == 0u) { xcd_barrier_complete(bar, b.x, nloc, nx); b.st[0] = nloc; b.st[1] = nx; }
        const unsigned old = xb_add(&bar[XB_XSUB(b.x)], 1u);
        const unsigned gen = old / nloc;
        if (old + 1u == (gen + 1u) * nloc) {
            __builtin_amdgcn_fence(__ATOMIC_RELEASE, "agent");
            asm volatile("s_waitcnt vmcnt(0)" ::: "memory");
            const unsigned og = xb_add(&bar[XB_TOP], 1u);
            const unsigned tg = og / nx;
            if (og + 1u == (tg + 1u) * nx) xb_add(&bar[XB_TOPGEN], 1u);
            else XB_SPIN(xb_ld(&bar[XB_TOPGEN]) == tg, bar);
            __builtin_amdgcn_fence(__ATOMIC_ACQUIRE, "agent");
            xb_add(&bar[XB_XGEN(b.x)], 1u);
            asm volatile("s_waitcnt vmcnt(0)" ::: "memory");
        } else {
            XB_SPIN(xb_ld(&bar[XB_XGEN(b.x)]) == gen, bar);
            __builtin_amdgcn_fence(__ATOMIC_ACQUIRE, "agent");
            asm volatile("s_waitcnt vmcnt(0)" ::: "memory");
        }
    }
    __syncthreads();
}

template <class F>
__device__ __forceinline__ void run_gemm(LAS unsigned char* lds, const bf16* A, int lda, const bf16* Bt, int ldb, int M, int N, int K, const F& f, int c, long tsB = 0, int ksplit = 1 << 30, long kjumpB = 0, int gsched = 0) {
    pg8::Gemm g{A, Bt, M, N, K, lda, ldb, tsB ? tsB : (long)512 * ldb, ksplit, kjumpB}; pg8::StaticOrder S; S.init(M, N, gsched ? gsched : o_grid(), c); Epi8<F> E{f};
    pg8::gemm_phase<Epi8<F>, pg8::StaticOrder, true, true>(lds, g, S, E);
}
#define WSP(off) ((bf16*)(ws + (off)))
__device__ __forceinline__ void ph_store_gemm(LAS unsigned char* lds, int l, int kind) {
    unsigned char* ws = kargs().ws; unsigned char* wb = ws + WS_W + (size_t)l * W_LAYER;
    const int Mr = l == 0 ? MT : MLAT;
    const bf16* A; const bf16* Bt; bf16* O; int lda, ldb, M, N, K, ldc, act;
    if (kind == 0)      { A = WSP(WS_XN);   lda = DM;  Bt = (const bf16*)(wb + WO_IN);  ldb = DM;  M = MT; N = INW; K = DM;  O = WSP(WS_Z);    ldc = INW; act = 0; }
    else if (kind == 1) { A = WSP(WS_CAT);  lda = DM;  Bt = (const bf16*)(wb + WO_OUT); ldb = DM;  M = Mr; N = DM;  K = DM;  O = WSP(WS_Y);    ldc = DM;  act = 0; }
    else if (kind == 2) { A = WSP(WS_XN);   lda = DM;  Bt = (const bf16*)(wb + WO_1);   ldb = DM;  M = Mr; N = DFF; K = DM;  O = WSP(WS_HMID); ldc = DFF; act = 1; }
    else if (kind == 3) { A = WSP(WS_HMID); lda = DFF; Bt = (const bf16*)(wb + WO_2);   ldb = DFF; M = Mr; N = DM;  K = DFF; O = WSP(WS_XN);   ldc = DM;  act = 0; }
    else                { A = (const bf16*)(wb + WO_CS); lda = 256; Bt = WSP(WS_Z) + OFF_FN; ldb = INW; M = 512; N = MT; K = 256; O = WSP(WS_C1); ldc = MT; act = 0; }
    run_gemm(lds, A, lda, Bt, ldb, M, N, K, FStore{O, ldc, act}, o_bid());
}
__device__ __forceinline__ void ph_d2(LAS unsigned char* lds, int l) { CArgs& a = kargs(); unsigned char* ws = a.ws;
    for (int j = 0; j < (l == 0 ? 2 : 1); ++j) {
        if (j == 0) run_gemm(lds, WSP(WS_DFT), 4096, WSP(WS_C1), MT, 2048, 4096, 4096, FD2{WSP(WS_CAT), a.in[I_BFNET] + l * 256, 0, 2048}, o_grid() - 1 - o_bid(), 2048 * 2, 32, ((long)256 * MT - 2048) * 2);
        else run_gemm(lds, WSP(WS_DFTC), 512, WSP(WS_C1) + MLAT, MT, 256, 4096, 512, FD2{WSP(WS_CAT), a.in[I_BFNET] + l * 256, MLAT, 256}, o_grid() - 1 - o_bid(), 256 * 2, 4, ((long)256 * MT - 256) * 2);
    } }
__device__ __forceinline__ void ph_glu(LAS unsigned char* lds, int l) { CArgs& a = kargs(); unsigned char* ws = a.ws; unsigned char* wb = ws + WS_W + (size_t)l * W_LAYER;
    const int Mr = l == 0 ? MT : MLAT;
    const bool half = (o_grid() == 256); if (half && o_bid() < 128) return;
    const int gs = half ? 128 : o_grid(), cg_ = half ? o_bid() - 128 : o_grid() - 1 - o_bid();
    {
        int tid_ = threadIdx.x; asm volatile("" : "+v"(tid_));
        pg8::StaticOrder S; S.init(Mr, 256, gs, cg_); pg8::Unit u;
        const bf16* Z = WSP(WS_Z); const float* Y0 = (const float*)(ws + WS_Y0); const float* Y1 = (const float*)(ws + WS_Y1); bf16* T = WSP(WS_T);
        const int c8 = (tid_ & 31) * 8;
        float dk[8];
#pragma unroll
        for (int e = 0; e < 8; ++e) dk[e] = a.in[I_S5D][l * 256 + c8 + e];
        for (int i = 0; S.next(i, u); ++i)
            for (int rr = tid_ >> 5; rr < 256; rr += 16) {
                const size_t row = (size_t)u.pm * 256 + rr;
                const v4u uz = *(const v4u*)(Z + row * INW + OFF_S5 + c8);
                const f32x4 a0 = *(const f32x4*)(Y0 + row * 256 + c8), a1 = *(const f32x4*)(Y0 + row * 256 + c8 + 4), b0 = *(const f32x4*)(Y1 + row * 256 + c8), b1 = *(const f32x4*)(Y1 + row * 256 + c8 + 4);
                const float uv[8] = {bflo(uz.x), bfhi(uz.x), bflo(uz.y), bfhi(uz.y), bflo(uz.z), bfhi(uz.z), bflo(uz.w), bfhi(uz.w)};
                float o[8];
#pragma unroll
                for (int e = 0; e < 8; ++e) { const float v = (e < 4 ? a0[e] + b0[e] : a1[e - 4] + b1[e - 4]) + dk[e] * uv[e];
                    const float uu = 0.7978845608028654f * (v + 0.044715f * v * v * v); o[e] = v / (1.f + __expf(-2.f * uu)); }
                v4u w; w.x = pk2(o[0], o[1]); w.y = pk2(o[2], o[3]); w.z = pk2(o[4], o[5]); w.w = pk2(o[6], o[7]);
                *(v4u*)(T + row * 256 + c8) = w;
            }
        __threadfence(); __syncthreads();
    }
    int K = 256, ld = 256; asm volatile("" : "+s"(K), "+s"(ld));
    run_gemm(lds, WSP(WS_T), ld, (const bf16*)(wb + WO_GLU), ld, Mr, 256, K, FGlu{WSP(WS_CAT), WSP(WS_T)}, cg_, 0, 1 << 30, 0, gs); }

__global__ void __launch_bounds__(512, 2) fwd_megakernel(Args a_unused) {
    extern __shared__ __attribute__((aligned(16))) unsigned char lds_raw[];
    LAS unsigned char* lds = (LAS unsigned char*)lds_raw;
    cg::grid_group grid = cg::this_grid();
#ifdef PROBE
    if (blockIdx.x == 0 && threadIdx.x == 0) { unsigned char* pw = kargs().ws + WS_PROBE; for (int i = 0; i < 32; ++i) ((float*)pw)[i] = 0.f; *(unsigned long long*)(pw + 256) = __builtin_amdgcn_s_memrealtime(); }
#endif
    {
        if (threadIdx.x < 2) ((volatile LAS unsigned*)(lds + LDS_BARST))[threadIdx.x] = 0u;
        if (threadIdx.x == 0) (void)xb_add(&((unsigned*)(kargs().ws + WS_BAR))[XB_XCNT(xb_xcc_id())], 1u);
        if (gridDim.x == 0x7fffffffu) grid.sync();
    }
    for (int step = 0; step < 20; ++step) {
        const int l = step < 2 ? 0 : (step - 2) / 9, k = step < 2 ? step - 2 : (step - 2) - 9 * l;
        int gk = -1;
        if (k == 0) gk = 0; else if (k == 2) gk = 4; else if (k == 4) gk = 1; else if (k == 6) gk = 2; else if (k == 7) gk = 3;
        int lbl = k == -2 ? 0 : k == -1 ? 1 : k == 0 ? 2 : k == 1 ? 5 : k == 2 ? 6 : k == 3 ? 9 : k == 4 ? 10 : k == 5 ? 11 : k == 6 ? 12 : k == 7 ? 13 : 14; (void)lbl;
#ifdef DBL_GEMM
        if (gk >= 0) { ph_store_gemm(lds, l, gk); __syncthreads(); }
#endif
#ifdef DBL_ROWS
        if (k == -1) prep_rows0(); if (k == 5 && l == 0) row_update<0>();
#endif
        if (gk >= 0) ph_store_gemm(lds, l, gk);
        else if (k == -2) prologue(lds);
        else if (k == -1) prep_rows0();
        else if (k == 1) {
            qk_prep(l);
            __syncthreads(); STAMP(3);
            na_phase(lds, l);
#ifdef DBL_NA
            __syncthreads(); na_phase(lds, l);
#endif
            __syncthreads(); STAMP(4);
            for (int u = o_bid(); u < 256; u += o_grid()) s5_unit(lds, l, u >> 4, u & 15);
#ifdef DBL_S5
            __syncthreads(); for (int u = o_bid(); u < 256; u += o_grid()) s5_unit(lds, l, u >> 4, u & 15);
#endif
        } else if (k == 3) {
            gqa_phase(lds, l);
#ifdef DBL_GQA
            __syncthreads(); gqa_phase(lds, l);
#endif
            __syncthreads(); STAMP(7);
            ph_d2(lds, l); STAMP(8);
            ph_glu(lds, l);
        } else if (k == 5) { if (l == 0) row_update<0>(); else row_update<2>(); }
        else { if (l == 0) row_update<1>(); else row_update<3>(); }
        if (k == 1) { __syncthreads(); }
        else if (step != 19) {
            XcdBarrier xb; xb.bar = (unsigned*)(kargs().ws + WS_BAR); xb.x = xb_xcc_id(); xb.st = (volatile LAS unsigned*)(lds + LDS_BARST);
            xcd_barrier(xb);
        }
        STAMP(lbl);
    }
}

extern "C" void kernel_launch(void* const* d_in, const int* in_sizes, int n_in, void* d_out, int out_size, void* d_ws, size_t ws_size, hipStream_t stream) {
    static int grid = 0;
    if (grid == 0) {
        if (n_in != 28 || ws_size < WS_END) { fprintf(stderr, "kernel_launch: unexpected n_in %d / ws_size %zu (need %zu)\n", n_in, ws_size, (size_t)WS_END); grid = -1; return; }
        int dev = 0, cus = 0, per_cu = 0;
        hipGetDevice(&dev); hipDeviceGetAttribute(&cus, hipDeviceAttributeMultiprocessorCount, dev);
        if (hipFuncSetAttribute((const void*)fwd_megakernel, hipFuncAttributeMaxDynamicSharedMemorySize, LDS_BYTES) != hipSuccess) { fprintf(stderr, "kernel_launch: hipFuncSetAttribute failed\n"); }
        if (hipOccupancyMaxActiveBlocksPerMultiprocessor(&per_cu, (const void*)fwd_megakernel, 512, LDS_BYTES) != hipSuccess || per_cu < 1) { fprintf(stderr, "kernel_launch: occupancy query says %d\n", per_cu); per_cu = 1; }
        (void)hipGetLastError();
        grid = cus * (per_cu > 1 ? 1 : per_cu);
        if (grid <= 0) grid = 256;
    }
    if (grid < 0) return;
    if (hipMemsetAsync((char*)d_ws + WS_BAR, 0, XCD_BAR_WORDS * 4, stream) != hipSuccess) { fprintf(stderr, "kernel_launch: hipMemsetAsync of the barrier words failed\n"); return; }
    Args a{};
    for (int i = 0; i < 28; ++i) a.in[i] = (const float*)d_in[i];
    a.out = (float*)d_out; a.ws = (unsigned char*)d_ws;
    void* args[] = {&a};
    hipError_t e = hipLaunchCooperativeKernel((const void*)fwd_megakernel, dim3(grid), dim3(512), args, LDS_BYTES, stream);
    if (e != hipSuccess) fprintf(stderr, "cooperative launch failed: %s (grid %d)\n", hipGetErrorString(e), grid);
}
```

```cpp
#include <hip/hip_runtime.h>
#include <hip/hip_cooperative_groups.h>
#include <cstdio>
#include <cstdint>
namespace cg = cooperative_groups;
namespace pg8 {
#define PG8_LAS __attribute__((address_space(3)))
typedef unsigned short bf16_t;
typedef short bf16x8 __attribute__((ext_vector_type(8)));
typedef float f32x4 __attribute__((ext_vector_type(4)));
typedef unsigned u32x4 __attribute__((ext_vector_type(4)));
constexpr int BM = 256, BK = 64, HALF = 128, HTB = HALF * BK * 2  , STAGE_BYTES = 8 * HTB, NXCD = 8, WGM = 8;

__host__ __device__ __forceinline__ int lds_byte(int r, int c) { const int st = (r >> 4) * 2 + (c >> 5), rr = r & 15, cc = c & 31, ob = rr * 64 + cc * 2; return st * 1024 + (ob ^ (((ob >> 9) & 1) << 5)); }
__host__ __device__ __forceinline__ void stage_rc(int b, int& R, int& C) { const int st = b / 1024, sb = b % 1024, swz = sb ^ (((sb >> 9) & 1) << 5); R = (st >> 1) * 16 + swz / 64; C = (st & 1) * 32 + (swz % 64) / 2; }
__host__ __device__ __forceinline__ int perm32(int rho) { const int n = rho >> 4, i = rho & 15; return 8 * (i >> 2) + 4 * n + (i & 3); }

struct Unit { int pm, pn; };
struct Gemm { const bf16_t* A; const bf16_t* Bt; int M, N, K, lda, ldb; long tsB; int ksplit; long kjumpB; };

struct StaticOrder {
    int nM, nN, nwg, G, c;
    __host__ __device__ void init(int M, int N, int G_, int c_) { nM = M / BM; nN = N / BM; nwg = nM * nN; G = G_; c = c_; }
    __host__ __device__ bool next(int i, Unit& u) const {
        const long L = (long)i * G + c; if (L >= nwg) return false;
        int wgid = (int)L; { const int q = nwg / NXCD, r = nwg % NXCD, xcd = wgid % NXCD, off = wgid / NXCD; wgid = (xcd < r ? xcd * (q + 1) : r * (q + 1) + (xcd - r) * q) + off; }
        const int nig = WGM * nN, gid = wgid / nig, fm = gid * WGM, gsz = (nM - fm) < WGM ? (nM - fm) : WGM;
        u.pm = fm + ((wgid % nig) % gsz); u.pn = (wgid % nig) / gsz; return true;
    }
    __device__ __forceinline__ void a_ready(const Unit&) const {}
    __device__ __forceinline__ void done(const Unit&) const {}
};
__device__ __forceinline__ unsigned cvt_pk_bf16(float lo, float hi) { unsigned r; asm volatile("v_cvt_pk_bf16_f32 %0, %1, %2" : "=v"(r) : "v"(lo), "v"(hi)); return r; }
template <class Epi, class Sched, bool ALIGN_EPI = false, bool SP2 = false>
__device__ __forceinline__ void gemm_phase(PG8_LAS unsigned char* lds, const Gemm g, const Sched& S, const Epi& E) {
    int tid_ = threadIdx.x; asm volatile("" : "+v"(tid_));
    const int tid = tid_, wid = __builtin_amdgcn_readfirstlane(tid >> 6), lane = tid & 63, wr = wid >> 2, wc = wid & 3, fr = lane & 15, fq = lane >> 4;
    const int K = g.K, nt = K / BK;
    unsigned voffA[2], voffB[2];
#pragma unroll
    for (int i = 0; i < 2; ++i) { int R, C; stage_rc(tid * 16 + i * 8192, R, C); const int Rb = Epi::PERM ? ((R & ~31) + perm32(R & 31)) : R;
        voffA[i] = (unsigned)(R * g.lda + C) * 2u; voffB[i] = (unsigned)(Rb * g.ldb + C) * 2u; }
    const size_t kstep = (size_t)(BK * 2);
    const size_t hstepA = (size_t)HALF * g.lda * 2, hstepB = (size_t)HALF * g.ldb * 2;
    const size_t tstepA = 2 * hstepA, tstepB = (size_t)g.tsB;
    const unsigned ldsw = (unsigned)wid * 1024u;
    const int aoff = lds_byte(wr * 64 + fr, fq * 8), boff = lds_byte(wc * 32 + fr, fq * 8);
#define PG8_SA(b, h) (((b) * 2 + (h)) * HTB)
#define PG8_SB(b, h) ((4 + (b) * 2 + (h)) * HTB)
#define PG8_STAGE(bufoff, gbase, voff) do { _Pragma("unroll") for (int _i = 0; _i < 2; ++_i) \
        __builtin_amdgcn_global_load_lds((const unsigned*)((const char*)(gbase) + (voff)[_i]), (PG8_LAS unsigned*)(lds + (bufoff) + ldsw + _i * 8192), 16, 0, 0); } while (0)
#define PG8_LDA(dst, b, h) do { _Pragma("unroll") for (int m = 0; m < 4; ++m) _Pragma("unroll") for (int k = 0; k < 2; ++k) dst[m][k] = *(const PG8_LAS bf16x8*)(lds + PG8_SA(b, h) + aoff + m * 2048 + k * 1024); } while (0)
#define PG8_LDB(dst, b, h) do { _Pragma("unroll") for (int n = 0; n < 2; ++n) _Pragma("unroll") for (int k = 0; k < 2; ++k) dst[n][k] = *(const PG8_LAS bf16x8*)(lds + PG8_SB(b, h) + boff + n * 2048 + k * 1024); } while (0)
#define PG8_MMA(ai, bj, At, Bt) do { __builtin_amdgcn_s_setprio(1); _Pragma("unroll") for (int m = 0; m < 4; ++m) _Pragma("unroll") for (int n = 0; n < 2; ++n) _Pragma("unroll") for (int k = 0; k < 2; ++k) \
        acc[ai][bj][m][n] = __builtin_amdgcn_mfma_f32_16x16x32_bf16(Bt[n][k], At[m][k], acc[ai][bj][m][n], 0, 0, 0); __builtin_amdgcn_s_setprio(0); } while (0)
#define PG8_WAIT_V(n) asm volatile("s_waitcnt vmcnt(" #n ")" ::: "memory")
#define PG8_WAIT_L(n) asm volatile("s_waitcnt lgkmcnt(" #n ")" ::: "memory")
#define PG8_BAR __builtin_amdgcn_s_barrier()
#define PG8_SCHED __builtin_amdgcn_sched_barrier(0)
    Unit cur, nxt; int ui = 0;
    if (!S.next(0, cur)) return;
    f32x4 acc[2][2][4][2];
#pragma unroll
    for (int a = 0; a < 2; ++a)
#pragma unroll
        for (int b = 0; b < 2; ++b)
#pragma unroll
            for (int m = 0; m < 4; ++m)
#pragma unroll
                for (int n = 0; n < 2; ++n) acc[a][b][m][n] = (f32x4){0.f, 0.f, 0.f, 0.f};
    bf16x8 At[4][2], B0[2][2], B1[2][2];
    const char* cA = (const char*)g.A + (size_t)cur.pm * tstepA; const char* cB = (const char*)g.Bt + (size_t)cur.pn * tstepB;
    S.a_ready(cur);
    if constexpr (SP2) {
        PG8_STAGE(PG8_SB(0, 0), cB, voffB); PG8_STAGE(PG8_SB(0, 1), cB + hstepB, voffB); PG8_STAGE(PG8_SA(0, 0), cA, voffA); PG8_STAGE(PG8_SA(0, 1), cA + hstepA, voffA);
        if (wr == 1) PG8_BAR;
        PG8_WAIT_V(2); PG8_BAR;
        PG8_STAGE(PG8_SB(1, 0), cB + kstep, voffB); PG8_STAGE(PG8_SA(1, 0), cA + kstep, voffA); PG8_STAGE(PG8_SB(1, 1), cB + hstepB + kstep, voffB);
        PG8_WAIT_V(6); PG8_BAR;
    } else {
        PG8_STAGE(PG8_SB(0, 0), cB, voffB); PG8_STAGE(PG8_SA(0, 0), cA, voffA); PG8_STAGE(PG8_SB(0, 1), cB + hstepB, voffB); PG8_STAGE(PG8_SA(0, 1), cA + hstepA, voffA);
        if (wr == 1) PG8_BAR;
        PG8_WAIT_V(4); PG8_BAR;
        PG8_STAGE(PG8_SB(1, 0), cB + kstep, voffB); PG8_STAGE(PG8_SA(1, 0), cA + kstep, voffA); PG8_STAGE(PG8_SB(1, 1), cB + hstepB + kstep, voffB);
        PG8_WAIT_V(6); PG8_BAR;
    }
    for (;;) {
        const bool has_next = S.next(ui + 1, nxt);
        const char* nA = has_next ? (const char*)g.A + (size_t)nxt.pm * tstepA : cA; const char* nB = has_next ? (const char*)g.Bt + (size_t)nxt.pn * tstepB : cB;
        for (int t = 0; t < nt; t += 2) {
            const bool last = (t == nt - 2);
            const char* a1 = cA + (size_t)(t + 1) * kstep;
            const char* a2 = last ? nA : cA + (size_t)(t + 2) * kstep; const char* b2 = last ? nB : cB + (size_t)(t + 2) * kstep + ((t + 2) >= g.ksplit ? g.kjumpB : 0);
            const char* a3 = a2 + kstep; const char* b3 = b2 + kstep;
            if (last && has_next) S.a_ready(nxt);
            if constexpr (SP2) {
            PG8_LDB(B0, 0, 0); PG8_LDB(B1, 0, 1); PG8_SCHED; PG8_LDA(At, 0, 0); PG8_STAGE(PG8_SA(1, 1), a1 + hstepA, voffA);
            PG8_WAIT_V(8); PG8_WAIT_L(0); PG8_BAR; PG8_MMA(0, 0, At, B0); PG8_MMA(0, 1, At, B1); PG8_BAR; PG8_SCHED;
            PG8_LDA(At, 0, 1); PG8_STAGE(PG8_SB(0, 0), b2, voffB); PG8_STAGE(PG8_SB(0, 1), b2 + hstepB, voffB); PG8_STAGE(PG8_SA(0, 0), a2, voffA);
            PG8_WAIT_V(8); PG8_WAIT_L(0); PG8_BAR; PG8_MMA(1, 0, At, B0); PG8_MMA(1, 1, At, B1); PG8_BAR; PG8_SCHED;
            PG8_LDB(B0, 1, 0); PG8_LDB(B1, 1, 1); PG8_SCHED; PG8_LDA(At, 1, 0); PG8_STAGE(PG8_SA(0, 1), a2 + hstepA, voffA);
            PG8_WAIT_V(8); PG8_WAIT_L(0); PG8_BAR; PG8_MMA(0, 0, At, B0); PG8_MMA(0, 1, At, B1); PG8_BAR; PG8_SCHED;
            PG8_LDA(At, 1, 1); PG8_STAGE(PG8_SB(1, 0), b3, voffB); PG8_STAGE(PG8_SB(1, 1), b3 + hstepB, voffB); PG8_STAGE(PG8_SA(1, 0), a3, voffA);
            PG8_WAIT_V(8); PG8_WAIT_L(0); PG8_BAR; PG8_MMA(1, 0, At, B0); PG8_MMA(1, 1, At, B1); PG8_BAR; PG8_SCHED;
            } else {
            PG8_LDB(B0, 0, 0); PG8_SCHED; PG8_LDA(At, 0, 0); PG8_STAGE(PG8_SA(1, 1), a1 + hstepA, voffA);
            PG8_WAIT_L(8); PG8_BAR; PG8_WAIT_L(0); PG8_MMA(0, 0, At, B0); PG8_BAR; PG8_SCHED;
            PG8_LDB(B1, 0, 1); PG8_STAGE(PG8_SB(0, 0), b2, voffB);
            PG8_BAR; PG8_WAIT_L(0); PG8_MMA(0, 1, At, B1); PG8_BAR;
            PG8_LDA(At, 0, 1); PG8_STAGE(PG8_SA(0, 0), a2, voffA);
            PG8_BAR; PG8_WAIT_L(0); PG8_MMA(1, 0, At, B0); PG8_BAR; PG8_SCHED;
            PG8_STAGE(PG8_SB(0, 1), b2 + hstepB, voffB);
            PG8_WAIT_V(6); PG8_BAR; PG8_MMA(1, 1, At, B1); PG8_BAR;
            PG8_LDB(B0, 1, 0); PG8_SCHED; PG8_LDA(At, 1, 0); PG8_STAGE(PG8_SA(0, 1), a2 + hstepA, voffA);
            PG8_WAIT_L(8); PG8_BAR; PG8_WAIT_L(0); PG8_MMA(0, 0, At, B0); PG8_BAR; PG8_SCHED;
            PG8_LDB(B1, 1, 1); PG8_STAGE(PG8_SB(1, 0), b3, voffB);
            PG8_BAR; PG8_WAIT_L(0); PG8_MMA(0, 1, At, B1); PG8_BAR;
            PG8_LDA(At, 1, 1); PG8_STAGE(PG8_SA(1, 0), a3, voffA);
            PG8_BAR; PG8_WAIT_L(0); PG8_MMA(1, 0, At, B0); PG8_BAR; PG8_SCHED;
            PG8_STAGE(PG8_SB(1, 1), b3 + hstepB, voffB);
            PG8_WAIT_V(6); PG8_BAR; PG8_MMA(1, 1, At, B1); PG8_BAR;
            }
        }
        if constexpr (ALIGN_EPI) { if (wr == 0) PG8_BAR; }
        if constexpr (!Epi::AFTER_DRAIN) { E(acc, cur, wr, wc, fr, fq); S.done(cur); }
        if (!has_next) break;
#pragma unroll
        for (int a = 0; a < 2; ++a)
#pragma unroll
            for (int b = 0; b < 2; ++b)
#pragma unroll
                for (int m = 0; m < 4; ++m)
#pragma unroll
                    for (int n = 0; n < 2; ++n) acc[a][b][m][n] = (f32x4){0.f, 0.f, 0.f, 0.f};
        cur = nxt; cA = nA; cB = nB; ++ui;
        if constexpr (ALIGN_EPI) { if (wr == 1) PG8_BAR; }
    }
    PG8_WAIT_V(0);
    if constexpr (!ALIGN_EPI) { if (wr == 0) PG8_BAR; }
    PG8_BAR;
    if constexpr (Epi::AFTER_DRAIN) { E.fused(acc, cur, wr, wc, fr, fq, lds, wid, lane); S.done(cur); }
#undef PG8_SA
#undef PG8_SB
#undef PG8_STAGE
#undef PG8_LDA
#undef PG8_LDB
#undef PG8_MMA
#undef PG8_WAIT_V
#undef PG8_WAIT_L
#undef PG8_BAR
#undef PG8_SCHED
}
}
#define LAS __attribute__((address_space(3)))
typedef unsigned short bf16;
typedef unsigned v4u __attribute__((ext_vector_type(4)));
typedef unsigned v2u __attribute__((ext_vector_type(2)));
typedef float f32x4 __attribute__((ext_vector_type(4)));
typedef float f32x16 __attribute__((ext_vector_type(16)));
typedef short bf16x8 __attribute__((ext_vector_type(8)));
typedef short s16x4 __attribute__((ext_vector_type(4)));

constexpr int DM = 1024, NB = 16, SEQ = 2048, CTXL = 256, MLAT = NB * SEQ, MCTX = NB * CTXL, MT = MLAT + MCTX, INW = 1792, DFF = 4096;
constexpr int OFF_AQ = 0, OFF_AK = 256, OFF_AV = 384, OFF_S5 = 512, OFF_NQ = 768, OFF_NK = 1024, OFF_NV = 1280, OFF_FN = 1536;
constexpr float EPSN = 1e-6f;
constexpr float LOG2E = 1.4426950408889634f;
constexpr size_t MiB = 1u << 20;
constexpr size_t WS_MOD = 0;
constexpr size_t WS_ROPE = 1 * MiB;
constexpr size_t WS_W = 2 * MiB, W_LAYER = 22 * MiB;
constexpr size_t WO_IN = 0, WO_OUT = WO_IN + (size_t)INW * DM * 2, WO_1 = WO_OUT + (size_t)DM * DM * 2, WO_2 = WO_1 + (size_t)DFF * DM * 2,
                 WO_GLU = WO_2 + (size_t)DFF * DM * 2, WO_CS = WO_GLU + 256 * 256 * 2, WO_END = WO_CS + 512 * 256 * 2;
static_assert(WO_END <= W_LAYER, "weights");
constexpr size_t WS_DFT = 46 * MiB, WS_DFTC = 62 * MiB, WS_XC = 64 * MiB, WS_XN = 80 * MiB;
constexpr size_t WS_T = 116 * MiB, WS_C1 = 350 * MiB;
constexpr size_t WS_Z = 152 * MiB, WS_CAT = 278 * MiB, WS_Y = 350 * MiB, WS_HMID = 152 * MiB, WS_Y0 = 440 * MiB, WS_Y1 = 476 * MiB, WS_END = 512 * MiB;
constexpr int LDS_BYTES = 147456;

struct Args { const float* in[28]; float* out; unsigned char* ws; };
typedef __attribute__((address_space(4))) const Args CArgs;
__device__ __forceinline__ CArgs& kargs() { CArgs* p = (CArgs*)__builtin_amdgcn_kernarg_segment_ptr(); asm volatile("" : "+s"(p)); return *p; }
enum { I_X = 0, I_C, I_CTX, I_CCTX, I_WADA, I_BADA, I_GPREMIX, I_GPOSTMIX, I_GPREMLP, I_GPOSTMLP, I_WIN, I_GQ, I_GK, I_AR, I_AI, I_LDT, I_BR, I_BI, I_CR, I_CI,
       I_S5D, I_WGLU, I_NABIAS, I_WFNET, I_BFNET, I_WOUT, I_W1, I_W2 };

constexpr size_t WS_PROBE = 1 * MiB + 65536;
constexpr size_t WS_BAR = 1 * MiB + 131072;
constexpr int LDS_BARST = 147456 - 64;
#ifdef PROBE
#define STAMP(lbl) do { if (blockIdx.x == 0 && threadIdx.x == 0) { unsigned char* pw_ = kargs().ws + WS_PROBE; const unsigned long long now_ = __builtin_amdgcn_s_memrealtime(); \
    unsigned long long* tp_ = (unsigned long long*)(pw_ + 256); ((float*)pw_)[lbl] += (float)(now_ - *tp_); *tp_ = now_; } } while (0)
#else
#define STAMP(lbl) do {} while (0)
#endif
__device__ __forceinline__ unsigned f2bf(float f) { unsigned u = __builtin_bit_cast(unsigned, f); return (u + 0x7fffu + ((u >> 16) & 1u)) >> 16; }
typedef float f32x2_t __attribute__((ext_vector_type(2))); typedef __bf16 bf16x2_t __attribute__((ext_vector_type(2)));
__device__ __forceinline__ unsigned pk2(float lo, float hi) { const f32x2_t v = {lo, hi}; const bf16x2_t b = __builtin_convertvector(v, bf16x2_t); return __builtin_bit_cast(unsigned, b); }
__device__ __forceinline__ float bflo(unsigned w) { return __builtin_bit_cast(float, w << 16); }
__device__ __forceinline__ float bfhi(unsigned w) { return __builtin_bit_cast(float, w & 0xffff0000u); }
__device__ __forceinline__ float bf2f(bf16 h) { return __builtin_bit_cast(float, (unsigned)h << 16); }
__device__ __forceinline__ int o_bid() { int t = blockIdx.x; asm volatile("" : "+s"(t)); return t; }
__device__ __forceinline__ int o_grid() { int t = gridDim.x; asm volatile("" : "+s"(t)); return t; }
__device__ __forceinline__ float shfl_xor_l(float v, int o, int lane) { return __builtin_bit_cast(float, __builtin_amdgcn_ds_bpermute((lane ^ o) << 2, __builtin_bit_cast(int, v))); }
__device__ __forceinline__ float wave_sum(float v, int lane) {
#pragma unroll
    for (int o = 1; o < 64; o <<= 1) v += shfl_xor_l(v, o, lane);
    return v;
}
__device__ __forceinline__ int crow(int r, int hi) { return (r & 3) + 8 * (r >> 2) + 4 * hi; }

template <class F> struct Epi8 {
    static constexpr bool PERM = true, AFTER_DRAIN = false;
    F f;
    __device__ __forceinline__ void operator()(const pg8::f32x4 (&acc)[2][2][4][2], const pg8::Unit& u, int wr, int wc, int fr, int fq) const {
        asm volatile("" : "+v"(fr), "+v"(fq));
#pragma unroll
        for (int ai = 0; ai < 2; ++ai)
#pragma unroll
            for (int m = 0; m < 4; ++m) {
                const int row = u.pm * 256 + ai * 128 + wr * 64 + m * 16 + fr;
#pragma unroll
                for (int bj = 0; bj < 2; ++bj) { const int col = u.pn * 256 + bj * 128 + wc * 32 + 8 * fq; f(row, col, acc[ai][bj][m][0], acc[ai][bj][m][1]); }
                asm volatile("" ::: "memory"); __builtin_amdgcn_sched_barrier(0);
            }
    }
};
__device__ __forceinline__ v4u pack8(f32x4 a, f32x4 b) { v4u w; w.x = pk2(a[0], a[1]); w.y = pk2(a[2], a[3]); w.z = pk2(b[0], b[1]); w.w = pk2(b[2], b[3]); return w; }
struct FStore { bf16* O; int ldc; int act;
    __device__ __forceinline__ void operator()(int row, int col, f32x4 a, f32x4 b) const {
        if (act == 1) {
#pragma unroll
            for (int i = 0; i < 4; ++i) { float x = a[i] > 0.f ? a[i] : 0.f; a[i] = x * x; float y = b[i] > 0.f ? b[i] : 0.f; b[i] = y * y; } }
        *(v4u*)(O + (size_t)row * ldc + col) = pack8(a, b); } };
struct FD2 { bf16* cat; const float* bias; int rowbase, rowsPerB;
    __device__ __forceinline__ void operator()(int row, int col, f32x4 a, f32x4 b) const {
        const int bb = col >> 8, j = col & 255; const f32x4 b0 = *(const f32x4*)(bias + j), b1 = *(const f32x4*)(bias + j + 4);
        *(v4u*)(cat + ((size_t)(rowbase + bb * rowsPerB + row) * 1024 + 768 + j)) = pack8(a + b0, b + b1); } };
struct FGlu { bf16* cat; const bf16* T;
    __device__ __forceinline__ void operator()(int row, int col, f32x4 a, f32x4 b) const {
        const v4u t = *(const v4u*)(T + (size_t)row * 256 + col);
        float tv[8] = {bflo(t.x), bfhi(t.x), bflo(t.y), bfhi(t.y), bflo(t.z), bfhi(t.z), bflo(t.w), bfhi(t.w)};
#pragma unroll
        for (int i = 0; i < 4; ++i) { a[i] = tv[i] / (1.f + __expf(-a[i])); b[i] = tv[4 + i] / (1.f + __expf(-b[i])); }
        *(v4u*)(cat + (size_t)row * 1024 + 256 + col) = pack8(a, b); } };
__device__ __forceinline__ void transpose_item(const float* W, int K, int N, bf16* WT, LAS float* scr, int item, int lane) {
    const int nblk = N / 32, kb = item / nblk, nb = item % nblk, k0 = 64 * kb, n0 = 32 * nb;
#pragma unroll
    for (int i = 0; i < 8; ++i) { const int kk = 8 * i + (lane >> 3), n4 = (lane & 7) * 4; const f32x4 v = *(const f32x4*)(W + (size_t)(k0 + kk) * N + n0 + n4);
        scr[kk * 33 + n4] = v[0]; scr[kk * 33 + n4 + 1] = v[1]; scr[kk * 33 + n4 + 2] = v[2]; scr[kk * 33 + n4 + 3] = v[3]; }
    asm volatile("s_waitcnt lgkmcnt(0)" ::: "memory");
    const int c = lane & 7;
#pragma unroll
    for (int j = 0; j < 4; ++j) { const int n = (lane >> 3) + 8 * j; const LAS float* s = scr + (8 * c) * 33 + n;
        v4u o; o.x = pk2(s[0 * 33], s[1 * 33]); o.y = pk2(s[2 * 33], s[3 * 33]); o.z = pk2(s[4 * 33], s[5 * 33]); o.w = pk2(s[6 * 33], s[7 * 33]);
        *(v4u*)(WT + (size_t)(n0 + n) * K + k0 + 8 * c) = o; }
    asm volatile("s_waitcnt lgkmcnt(0)" ::: "memory");
}

__device__ __forceinline__ void prologue(LAS unsigned char* lds) {
    CArgs& a = kargs();
    int tid_ = threadIdx.x; asm volatile("" : "+v"(tid_));
    const int tid = tid_, lane = tid & 63, wid = tid >> 6, G = o_grid();
    unsigned char* ws = a.ws;
    {
        LAS float* scr = (LAS float*)(lds + wid * 16384);
        const int gw = o_bid() * 8 + wid, NGW = G * 8;
        constexpr int I0 = (DM / 64) * (INW / 32), I1 = (DM / 64) * (DM / 32), I2 = (DM / 64) * (DFF / 32), I3 = (DFF / 64) * (DM / 32), I4 = (256 / 64) * (256 / 32);
        constexpr int PER = I0 + I1 + I2 + I3 + I4;
        for (int it = gw; it < 2 * PER; it += NGW) {
            const int l = it / PER; int r = it % PER; unsigned char* wb = ws + WS_W + (size_t)l * W_LAYER;
            if (r < I0) { transpose_item(a.in[I_WIN] + (size_t)l * DM * INW, DM, INW, (bf16*)(wb + WO_IN), scr, r, lane); continue; } r -= I0;
            if (r < I1) { transpose_item(a.in[I_WOUT] + (size_t)l * DM * DM, DM, DM, (bf16*)(wb + WO_OUT), scr, r, lane); continue; } r -= I1;
            if (r < I2) { transpose_item(a.in[I_W1] + (size_t)l * DM * DFF, DM, DFF, (bf16*)(wb + WO_1), scr, r, lane); continue; } r -= I2;
            if (r < I3) { transpose_item(a.in[I_W2] + (size_t)l * DFF * DM, DFF, DM, (bf16*)(wb + WO_2), scr, r, lane); continue; } r -= I3;
            transpose_item(a.in[I_WGLU] + (size_t)l * 256 * 256, 256, 256, (bf16*)(wb + WO_GLU), scr, r, lane);
        }
    }
    __syncthreads();
    {
        LAS float* sl = (LAS float*)lds;
        LAS float* part = (LAS float*)(lds + 17 * 1024 * 4);
        float* mod = (float*)(ws + WS_MOD);
        bool have = false;
        for (int u = o_bid(); u < 2 * 96; u += G) {
            if (!have) {
                for (int i = tid; i < 17 * 1024; i += 512) { const float cv = i < 16 * 1024 ? a.in[I_C][i] : a.in[I_CCTX][i - 16 * 1024]; sl[i] = cv / (1.f + __expf(-cv)); }
                have = true; __syncthreads();
            }
            const int l = u / 96, n0 = (u % 96) * 64;
            const float* W = a.in[I_WADA] + (size_t)l * DM * 6144 + n0 + lane;
            float acc[17];
#pragma unroll
            for (int i = 0; i < 17; ++i) acc[i] = 0.f;
            for (int k0 = wid * 128; k0 < wid * 128 + 128; k0 += 16) {
                float wv[16];
#pragma unroll
                for (int q = 0; q < 16; ++q) wv[q] = W[(size_t)(k0 + q) * 6144];
#pragma unroll
                for (int q = 0; q < 16; ++q)
#pragma unroll
                    for (int i = 0; i < 17; ++i) acc[i] += sl[i * 1024 + k0 + q] * wv[q];
            }
#pragma unroll
            for (int i = 0; i < 17; ++i) part[(wid * 17 + i) * 64 + lane] = acc[i];
            __syncthreads();
            for (int o = tid; o < 17 * 64; o += 512) {
                const int i = o >> 6, n = o & 63; float s = a.in[I_BADA][l * 6144 + n0 + n];
#pragma unroll
                for (int w = 0; w < 8; ++w) s += part[(w * 17 + i) * 64 + n];
                mod[((size_t)l * 17 + i) * 6144 + n0 + n] = s;
            }
            __syncthreads();
        }
    }
    {
        const size_t gt = (size_t)o_bid() * 512 + tid, NT = (size_t)G * 512;
        bf16* dft = (bf16*)(ws + WS_DFT);
        for (size_t i = gt; i < (size_t)2048 * 4096 / 8; i += NT) {
            const int kk = (int)(i / 512), n0 = (int)(i % 512) * 8; float v[8];
#pragma unroll
            for (int j = 0; j < 8; ++j) { const int n = n0 + j, nn = n & 2047; const float fr = (float)((kk * nn) & 2047) * (1.f / 2048.f);
                v[j] = (n < 2048 ? __builtin_amdgcn_cosf(fr) : -__builtin_amdgcn_sinf(fr)) * 0.02209708691207961f; }
            v4u o; o.x = pk2(v[0], v[1]); o.y = pk2(v[2], v[3]); o.z = pk2(v[4], v[5]); o.w = pk2(v[6], v[7]);
            *(v4u*)(dft + i * 8) = o;
        }
        bf16* dftc = (bf16*)(ws + WS_DFTC);
        for (size_t i = gt; i < (size_t)256 * 512 / 8; i += NT) {
            const int kk = (int)(i / 64), n0 = (int)(i % 64) * 8; float v[8];
#pragma unroll
            for (int j = 0; j < 8; ++j) { const int n = n0 + j, nn = n & 255; const float fr = (float)((kk * nn) & 255) * (1.f / 256.f);
                v[j] = (n < 256 ? __builtin_amdgcn_cosf(fr) : -__builtin_amdgcn_sinf(fr)) * 0.0625f; }
            v4u o; o.x = pk2(v[0], v[1]); o.y = pk2(v[2], v[3]); o.z = pk2(v[4], v[5]); o.w = pk2(v[6], v[7]);
            *(v4u*)(dftc + i * 8) = o;
        }
        for (size_t i = gt; i < (size_t)2 * 512 * 256; i += NT) {
            const int l = (int)(i / (512 * 256)), rem = (int)(i % (512 * 256)), jp = rem >> 8, cin = rem & 255, j = jp & 255, part = jp >> 8;
            const float* W = a.in[I_WFNET] + (size_t)l * 256 * 256 + (size_t)(cin >> 6) * 64 * 256 + j; const int c = cin & 63; float s = 0.f;
            for (int cp0 = 0; cp0 < 64; cp0 += 16) { float wv[16];
#pragma unroll
                for (int q = 0; q < 16; ++q) wv[q] = W[(size_t)(cp0 + q) * 256];
#pragma unroll
                for (int q = 0; q < 16; ++q) { const float fr = (float)((c * (cp0 + q)) & 63) * (1.f / 64.f); s += (part ? __builtin_amdgcn_sinf(fr) : __builtin_amdgcn_cosf(fr)) * wv[q]; } }
            ((bf16*)(ws + WS_W + (size_t)l * W_LAYER + WO_CS))[(size_t)jp * 256 + cin] = (bf16)f2bf(s * 0.125f);
        }
        float2* rope = (float2*)(ws + WS_ROPE);
        for (size_t i = gt; i < 1024; i += NT) { const int pos = (int)i >> 4, k = (int)i & 15; const float inv = exp2f(-(float)k * (13.287712379549449f / 16.f)); const float ang = (float)pos * inv;
            float sn, cs; sincosf(ang, &sn, &cs); rope[i] = make_float2(cs, sn); }
    }
}

__device__ __forceinline__ void prep_rows0() {
    CArgs& a = kargs();
    int tid_ = threadIdx.x; asm volatile("" : "+v"(tid_));
    const int lane = tid_ & 63, gw = o_bid() * 8 + (tid_ >> 6), NGW = o_grid() * 8;
    const float* mod = (const float*)(a.ws + WS_MOD); bf16* XN = (bf16*)(a.ws + WS_XN); const float* gp = a.in[I_GPREMIX];
    f32x4 vn[4];
    auto rload = [&](int row) { const float* xr = row < MLAT ? a.in[I_X] + (size_t)row * DM : a.in[I_CTX] + (size_t)(row - MLAT) * DM;
#pragma unroll
        for (int j = 0; j < 4; ++j) vn[j] = *(const f32x4*)(xr + 4 * lane + 256 * j); };
    if (gw < MT) rload(gw);
    for (int row = gw; row < MT; row += NGW) {
        const int bi = row < MLAT ? row >> 11 : 16;
        const float* mb = mod + (size_t)bi * 6144;
        f32x4 v[4]; float ss = 0.f;
#pragma unroll
        for (int j = 0; j < 4; ++j) { v[j] = vn[j]; ss += v[j][0] * v[j][0] + v[j][1] * v[j][1] + v[j][2] * v[j][2] + v[j][3] * v[j][3]; }
        if (row + NGW < MT) rload(row + NGW);
        const float rstd = rsqrtf(wave_sum(ss, lane) * (1.f / DM) + EPSN);
#pragma unroll
        for (int j = 0; j < 4; ++j) { const int k = 4 * lane + 256 * j; const f32x4 g = *(const f32x4*)(gp + k), sh = *(const f32x4*)(mb + k), sc = *(const f32x4*)(mb + 1024 + k);
            f32x4 o;
#pragma unroll
            for (int e = 0; e < 4; ++e) o[e] = (v[j][e] * rstd * g[e]) * (1.f + sc[e]) + sh[e];
            v2u w; w.x = pk2(o[0], o[1]); w.y = pk2(o[2], o[3]); *(v2u*)(XN + (size_t)row * DM + k) = w; }
    }
}
template <int WHICH>
__device__ __forceinline__ void row_update() {
    CArgs& a = kargs();
    constexpr int l = WHICH >> 1; constexpr bool MLP = WHICH & 1; constexpr bool NXT = WHICH != 3;
    const int nrows = l == 0 ? MT : MLAT;
    const bf16* Y = (const bf16*)(a.ws + (MLP ? WS_XN : WS_Y)); bf16* OB = (bf16*)(a.ws + WS_XN);
    const float* xlat_in = WHICH == 0 ? a.in[I_X] : a.out; const float* xctx_in = WHICH == 0 ? a.in[I_CTX] : (const float*)(a.ws + WS_XC);
    float* xlat_out = a.out; float* xctx_out = (float*)(a.ws + WS_XC);
    const float* mod = (const float*)(a.ws + WS_MOD);
    const float* modl = mod + (size_t)l * 17 * 6144; constexpr int gate_i = MLP ? 5 : 2;
    const float* gpost = (MLP ? a.in[I_GPOSTMLP] : a.in[I_GPOSTMIX]) + l * DM;
    const float* modn = MLP ? mod + (size_t)17 * 6144 : modl; constexpr int sh_i = MLP ? 0 : 3, sc_i = MLP ? 1 : 4;
    const float* gnext = MLP ? a.in[I_GPREMIX] + DM : a.in[I_GPREMLP] + l * DM;
    int tid_ = threadIdx.x; asm volatile("" : "+v"(tid_));
    const int lane = tid_ & 63, gw = o_bid() * 8 + (tid_ >> 6), NGW = o_grid() * 8;
    v2u ywn[4]; f32x4 xn[4];
    auto rload = [&](int row) {
        const bool lat = row < MLAT; const float* xr = lat ? xlat_in + (size_t)row * DM : xctx_in + (size_t)(row - MLAT) * DM;
#pragma unroll
        for (int j = 0; j < 4; ++j) { const int k = 4 * lane + 256 * j; ywn[j] = *(const v2u*)(Y + (size_t)row * DM + k); xn[j] = *(const f32x4*)(xr + k); } };
    if (gw < nrows) rload(gw);
    for (int row = gw; row < nrows; row += NGW) {
        const bool lat = row < MLAT; const int bi = lat ? row >> 11 : 16;
        float* xo = lat ? xlat_out + (size_t)row * DM : xctx_out + (size_t)(row - MLAT) * DM;
        const float* gate = modl + (size_t)bi * 6144 + gate_i * 1024;
        f32x4 y[4], x[4]; float ss = 0.f;
#pragma unroll
        for (int j = 0; j < 4; ++j) { const v2u w = ywn[j]; y[j] = (f32x4){bflo(w.x), bfhi(w.x), bflo(w.y), bfhi(w.y)}; x[j] = xn[j];
            ss += y[j][0] * y[j][0] + y[j][1] * y[j][1] + y[j][2] * y[j][2] + y[j][3] * y[j][3]; }
        if (row + NGW < nrows) rload(row + NGW);
        const float rstd = rsqrtf(wave_sum(ss, lane) * (1.f / DM) + EPSN); float s2 = 0.f;
#pragma unroll
        for (int j = 0; j < 4; ++j) { const int k = 4 * lane + 256 * j; const f32x4 g = *(const f32x4*)(gpost + k), gt = *(const f32x4*)(gate + k);
#pragma unroll
            for (int e = 0; e < 4; ++e) { x[j][e] = x[j][e] + gt[e] * (y[j][e] * rstd * g[e]); s2 += x[j][e] * x[j][e]; }
#ifdef PROBE
            if (WHICH == 3) { const float* pa = (const float*)(a.ws + WS_PROBE); float tot = 0.f, fa = 0.f, fb = 0.f;
                for (int i = 0; i < 15; ++i) { const float v = pa[i]; tot += v; if ((PROBE_A >> i) & 1) fa += v; if ((PROBE_B >> i) & 1) fb += v; }
                fa /= tot; fb /= tot; const float e = fa < 0.02f ? 0.02f : fa;
                for (int q = 0; q < 4; ++q) x[j][q] *= (1.f + e);
                if (row == 0 && lane == 0 && j == 0) x[j][0] += 50.f + 1000.f * fb; }
#endif
            *(f32x4*)(xo + k) = x[j]; }
        if (NXT) {
            const float rstd2 = rsqrtf(wave_sum(s2, lane) * (1.f / DM) + EPSN); const float* mb = modn + (size_t)bi * 6144;
#pragma unroll
            for (int j = 0; j < 4; ++j) { const int k = 4 * lane + 256 * j; const f32x4 g = *(const f32x4*)(gnext + k), sh = *(const f32x4*)(mb + sh_i * 1024 + k), sc = *(const f32x4*)(mb + sc_i * 1024 + k);
                f32x4 o;
#pragma unroll
                for (int e = 0; e < 4; ++e) o[e] = (x[j][e] * rstd2 * g[e]) * (1.f + sc[e]) + sh[e];
                v2u w; w.x = pk2(o[0], o[1]); w.y = pk2(o[2], o[3]); *(v2u*)(OB + (size_t)row * DM + k) = w; }
        }
    }
}

__device__ __forceinline__ void qk_prep(int layer) {
    CArgs& a = kargs();
    bf16* Z = (bf16*)(a.ws + WS_Z); const float2* rope = (const float2*)(a.ws + WS_ROPE);
    int tid_ = threadIdx.x; asm volatile("" : "+v"(tid_));
    const int gt = o_bid() * 512 + tid_, NT = o_grid() * 512;
    for (int it = gt; it < MT * 6; it += NT) {
        const int row = it / 6, slot = it % 6; const bool lat = row < MLAT;
        bf16* p = Z + (size_t)row * INW + (slot < 4 ? OFF_AQ + slot * 64 : OFF_AK + (slot - 4) * 64);
        const float* g = (slot < 4 ? a.in[I_GQ] : a.in[I_GK]) + layer * 64;
        float v[64]; float ss = 0.f;
#pragma unroll
        for (int c = 0; c < 8; ++c) { const v4u w = *(const v4u*)(p + 8 * c);
            v[8 * c + 0] = bflo(w.x); v[8 * c + 1] = bfhi(w.x); v[8 * c + 2] = bflo(w.y); v[8 * c + 3] = bfhi(w.y); v[8 * c + 4] = bflo(w.z); v[8 * c + 5] = bfhi(w.z); v[8 * c + 6] = bflo(w.w); v[8 * c + 7] = bfhi(w.w); }
#pragma unroll
        for (int i = 0; i < 64; ++i) ss += v[i] * v[i];
        const float rstd = rsqrtf(ss * (1.f / 64.f) + EPSN);
#pragma unroll
        for (int i = 0; i < 64; ++i) v[i] = v[i] * rstd * g[i];
        if (lat) {
            const int t = row & 2047, gr = t >> 6, gc = t & 63;
#pragma unroll
            for (int i = 0; i < 16; ++i) {
                const float2 cr = rope[gr * 16 + i], cc = rope[gc * 16 + i];
                const float x1 = v[i], x2 = v[16 + i]; v[i] = x1 * cr.x - x2 * cr.y; v[16 + i] = x1 * cr.y + x2 * cr.x;
                const float y1 = v[32 + i], y2 = v[48 + i]; v[32 + i] = y1 * cc.x - y2 * cc.y; v[48 + i] = y1 * cc.y + y2 * cc.x;
            }
        }
#pragma unroll
        for (int c = 0; c < 8; ++c) { v4u w; w.x = pk2(v[8 * c], v[8 * c + 1]); w.y = pk2(v[8 * c + 2], v[8 * c + 3]); w.z = pk2(v[8 * c + 4], v[8 * c + 5]); w.w = pk2(v[8 * c + 6], v[8 * c + 7]); *(v4u*)(p + 8 * c) = w; }
    }
}
struct AttnP { const bf16* Z; bf16* O; int ostride; int qtok0; int qcol; int ocol; int kcol, vcol; int loc0, nloc, ctx0, nctx;
               int na; int qgcol0; int relr0; int head; int act_lo, act_hi; };
struct AttnQS { bf16x8 qr[4]; f32x16 o0, o1; float m, lsum; };
template <int NH, int QB = 1>
__device__ __forceinline__ void attn_unit(LAS unsigned char* lds, const AttnP& P, const LAS float* biasL) {
    int tid_ = threadIdx.x; asm volatile("" : "+v"(tid_));
    const int tid = tid_, lane = tid & 63, wid = tid >> 6, r32 = lane & 31, hi = lane >> 5;
    const int slot = (NH == 1) ? 0 : (wid >> 1);
    const bf16* Z = P.Z;
    AttnQS QA, QBs;
#pragma unroll
    for (int d0 = 0; d0 < 4; ++d0) { QA.qr[d0] = *(const bf16x8*)(Z + (size_t)(P.qtok0 + r32) * INW + P.qcol + d0 * 16 + hi * 8);
        if (QB == 2) QBs.qr[d0] = *(const bf16x8*)(Z + (size_t)(P.qtok0 + 32 + r32) * INW + P.qcol + d0 * 16 + hi * 8); }
    const int nt = P.nloc + P.nctx;
    v4u kreg[NH], vreg[NH];
    auto tile_tok = [&](int i) { return i < P.nloc ? P.loc0 + 64 * i : P.ctx0 + 64 * (i - P.nloc); };
    auto gload = [&](int i) { const int tok = tile_tok(i);
#pragma unroll
        for (int s = 0; s < NH; ++s) { kreg[s] = *(const v4u*)(Z + (size_t)(tok + (tid >> 3)) * INW + P.kcol + s * 64 + (tid & 7) * 8);
                                        vreg[s] = *(const v4u*)(Z + (size_t)(tok + lane) * INW + P.vcol + s * 64 + wid * 8); } };
    gload(0);
    QA.o0 = f32x16{}; QA.o1 = f32x16{}; QA.m = -1e30f; QA.lsum = 0.f; QBs.o0 = f32x16{}; QBs.o1 = f32x16{}; QBs.m = -1e30f; QBs.lsum = 0.f;
    const float sc = 0.125f * LOG2E;
    const int qg = P.qgcol0 + r32; const int cs = qg - 8 < 0 ? 0 : (qg - 8 > 48 ? 48 : qg - 8);
    auto lstore = [&](int bufoff) {
#pragma unroll
        for (int s = 0; s < NH; ++s) {
            LAS unsigned char* sb = lds + bufoff + s * 18432;
            *(LAS v4u*)(sb + ((tid >> 3) * 72 + (tid & 7) * 8) * 2) = kreg[s];
            LAS bf16* vt = (LAS bf16*)(sb + 9216);
            const unsigned w[4] = {vreg[s].x, vreg[s].y, vreg[s].z, vreg[s].w};
#pragma unroll
            for (int e = 0; e < 4; ++e) { vt[(wid * 8 + 2 * e) * 68 + lane] = (bf16)(w[e] & 0xffffu); vt[(wid * 8 + 2 * e + 1) * 68 + lane] = (bf16)(w[e] >> 16); }
        }
    };
    auto compute = [&](int i, int bufoff, AttnQS& S) {
        if (P.na && i < P.nloc && (i < P.act_lo || i >= P.act_hi)) return;
        const LAS unsigned char* kb = lds + bufoff + slot * 18432; const LAS unsigned char* vb = kb + 9216;
        f32x16 p0 = {}, p1 = {};
#pragma unroll
        for (int d0 = 0; d0 < 4; ++d0) {
            const bf16x8 a0 = *(const LAS bf16x8*)(kb + (r32 * 72 + d0 * 16 + hi * 8) * 2);
            const bf16x8 a1 = *(const LAS bf16x8*)(kb + ((32 + r32) * 72 + d0 * 16 + hi * 8) * 2);
            p0 = __builtin_amdgcn_mfma_f32_32x32x16_bf16(a0, S.qr[d0], p0, 0, 0, 0);
            p1 = __builtin_amdgcn_mfma_f32_32x32x16_bf16(a1, S.qr[d0], p1, 0, 0, 0);
        }
        if (P.na && i < P.nloc) {
            const LAS float* bl = biasL + (P.head * 15 + (P.relr0 + i)) * 31;
#pragma unroll
            for (int r = 0; r < 16; ++r) {
                const int kv0 = crow(r, hi), kv1 = kv0 + 32;
                const bool ok0 = (unsigned)(kv0 - cs) < 16u, ok1 = (unsigned)(kv1 - cs) < 16u;
                const int i0 = kv0 - qg + 15, i1 = kv1 - qg + 15;
                const float b0 = bl[i0 < 0 ? 0 : (i0 > 30 ? 30 : i0)], b1 = bl[i1 < 0 ? 0 : (i1 > 30 ? 30 : i1)];
                p0[r] = ok0 ? p0[r] + b0 : -INFINITY; p1[r] = ok1 ? p1[r] + b1 : -INFINITY;
            }
        }
        float mx = fmaxf(fmaxf(p0[0], p0[1]), p1[0]);
#pragma unroll
        for (int r = 2; r < 16; r += 2) mx = fmaxf(fmaxf(mx, p0[r]), p0[r + 1]);
#pragma unroll
        for (int r = 1; r < 15; r += 2) mx = fmaxf(fmaxf(mx, p1[r]), p1[r + 1]);
        mx = fmaxf(mx, p1[15]);
        mx = fmaxf(mx, shfl_xor_l(mx, 32, lane));
        if (__any((mx - S.m) * sc > 6.f)) {
            const float mn = fmaxf(S.m, mx), alpha = __builtin_amdgcn_exp2f((S.m - mn) * sc); S.m = mn; S.lsum *= alpha;
#pragma unroll
            for (int r = 0; r < 16; ++r) { S.o0[r] *= alpha; S.o1[r] *= alpha; }
        }
        const float nm = -S.m * sc;
        float ps = 0.f;
#pragma unroll
        for (int r = 0; r < 16; ++r) { p0[r] = __builtin_amdgcn_exp2f(fmaf(p0[r], sc, nm)); p1[r] = __builtin_amdgcn_exp2f(fmaf(p1[r], sc, nm)); ps += p0[r] + p1[r]; }
        S.lsum += ps;
        bf16x8 pf[4];
#pragma unroll
        for (int s = 0; s < 4; ++s) {
            v4u w;
            if (s < 2) { w.x = pk2(p0[8 * s], p0[8 * s + 1]); w.y = pk2(p0[8 * s + 2], p0[8 * s + 3]); w.z = pk2(p0[8 * s + 4], p0[8 * s + 5]); w.w = pk2(p0[8 * s + 6], p0[8 * s + 7]); }
            else { const int q = s - 2; w.x = pk2(p1[8 * q], p1[8 * q + 1]); w.y = pk2(p1[8 * q + 2], p1[8 * q + 3]); w.z = pk2(p1[8 * q + 4], p1[8 * q + 5]); w.w = pk2(p1[8 * q + 6], p1[8 * q + 7]); }
            pf[s] = __builtin_bit_cast(bf16x8, w);
        }
#pragma unroll
        for (int s = 0; s < 4; ++s) {
            const int kvb = 32 * (s >> 1) + 16 * (s & 1) + 4 * hi;
            {   const LAS unsigned char* va = vb + (r32 * 68 + kvb) * 2;
                const s16x4 lo = *(const LAS s16x4*)va, hh = *(const LAS s16x4*)(va + 16);
                const bf16x8 af = {lo[0], lo[1], lo[2], lo[3], hh[0], hh[1], hh[2], hh[3]};
                S.o0 = __builtin_amdgcn_mfma_f32_32x32x16_bf16(af, pf[s], S.o0, 0, 0, 0); }
            {   const LAS unsigned char* va = vb + ((32 + r32) * 68 + kvb) * 2;
                const s16x4 lo = *(const LAS s16x4*)va, hh = *(const LAS s16x4*)(va + 16);
                const bf16x8 af = {lo[0], lo[1], lo[2], lo[3], hh[0], hh[1], hh[2], hh[3]};
                S.o1 = __builtin_amdgcn_mfma_f32_32x32x16_bf16(af, pf[s], S.o1, 0, 0, 0); }
        }
        };
    if (NH == 1) {
        __syncthreads();
        lstore(0);
        if (nt > 1) gload(1);
        __syncthreads();
        for (int i = 0; i < nt; ++i) {
            if (i + 1 < nt) { lstore(((i + 1) & 1) * 18432); if (i + 2 < nt) gload(i + 2); }
            compute(i, (i & 1) * 18432, QA); if (QB == 2) compute(i, (i & 1) * 18432, QBs);
            __syncthreads();
        }
    } else {
        for (int i = 0; i < nt; ++i) {
            __syncthreads();
            lstore(0);
            __syncthreads();
            if (i + 1 < nt) gload(i + 1);
            compute(i, 0, QA);
        }
    }
    auto finish = [&](AttnQS& S, int qtok) {
        const float lsum = S.lsum + shfl_xor_l(S.lsum, 32, lane);
        const float inv = 1.f / lsum;
        bf16* op = P.O + (size_t)(qtok + r32) * P.ostride + P.ocol;
#pragma unroll
        for (int rg = 0; rg < 4; ++rg) {
            v2u w0, w1;
            w0.x = pk2(S.o0[4 * rg] * inv, S.o0[4 * rg + 1] * inv); w0.y = pk2(S.o0[4 * rg + 2] * inv, S.o0[4 * rg + 3] * inv);
            w1.x = pk2(S.o1[4 * rg] * inv, S.o1[4 * rg + 1] * inv); w1.y = pk2(S.o1[4 * rg + 2] * inv, S.o1[4 * rg + 3] * inv);
            *(v2u*)(op + 8 * rg + 4 * hi) = w0; *(v2u*)(op + 32 + 8 * rg + 4 * hi) = w1;
        } };
    finish(QA, P.qtok0);
    if (QB == 2) finish(QBs, P.qtok0 + 32);
}

__device__ __forceinline__ int s5_tokrow(int s, int dir, int b) {
    if (s < 256) return MLAT + b * 256 + (dir ? 255 - s : s);
    const int t = s - 256; return b * 2048 + (dir ? 2047 - t : t);
}
__device__ __forceinline__ void s5_unit(LAS unsigned char* lds, int layer, int b, int g) {
    CArgs& a = kargs();
    int tid_ = threadIdx.x; asm volatile("" : "+v"(tid_));
    const int tid = tid_, lane = tid & 63, wid = tid >> 6, r32 = lane & 31, hi = lane >> 5;
    LAS float* BuL = (LAS float*)(lds + wid * 17920);
    LAS bf16* HL = (LAS bf16*)(lds + wid * 17920);
    LAS v4u* uL = (LAS v4u*)(lds + wid * 17920 + 8704);
    const bf16* Z = (const bf16*)(a.ws + WS_Z); float* Y0 = (float*)(a.ws + WS_Y0); float* Y1 = (float*)(a.ws + WS_Y1);
    for (int dir = 0; dir < 2; ++dir) {
        const int idx = (layer * 2 + dir) * 16 + g;
        const float dt = expf(a.in[I_LDT][idx]);
        float ar, ai;
        { const float lr = fminf(a.in[I_AR][idx * 64 + lane], -1e-4f), li = a.in[I_AI][idx * 64 + lane]; const float er = expf(lr * dt); float sn, cs; sincosf(li * dt, &sn, &cs); ar = er * cs; ai = er * sn; }
        float pr = ar, pi = ai;
        float p32r, p32i;
#pragma unroll
        for (int k = 0; k < 5; ++k) { const float tr = pr * pr - pi * pi, ti = 2.f * pr * pi; pr = tr; pi = ti; }
        p32r = pr; p32i = pi;
#pragma unroll
        for (int k = 0; k < 3; ++k) { const float tr = pr * pr - pi * pi, ti = 2.f * pr * pi; pr = tr; pi = ti; }
        { const float tr = pr * p32r - pi * p32i, ti = pr * p32i + pi * p32r; pr = tr; pi = ti; }
        bf16x8 bfr[4];
        float aR[2], aI[2];
#pragma unroll
        for (int pp = 0; pp < 2; ++pp) {
            const int p2 = 32 * pp + r32;
            const float lr = fminf(a.in[I_AR][idx * 64 + p2], -1e-4f), li = a.in[I_AI][idx * 64 + p2]; const float er = expf(lr * dt); float sn, cs; sincosf(li * dt, &sn, &cs);
            aR[pp] = er * cs; aI[pp] = er * sn;
            const float xr = er * cs - 1.f, xi = er * sn, den = 1.f / (lr * lr + li * li);
            const float cr = (xr * lr + xi * li) * den, ci = (xi * lr - xr * li) * den;
            const float* br = a.in[I_BR] + ((size_t)idx * 64 + p2) * 16 + 8 * hi; const float* bi = a.in[I_BI] + ((size_t)idx * 64 + p2) * 16 + 8 * hi;
            float re[8], im[8];
#pragma unroll
            for (int j = 0; j < 8; ++j) { const float x = br[j], y = bi[j]; re[j] = cr * x - ci * y; im[j] = cr * y + ci * x; }
            v4u w; w.x = pk2(re[0], re[1]); w.y = pk2(re[2], re[3]); w.z = pk2(re[4], re[5]); w.w = pk2(re[6], re[7]); bfr[pp] = __builtin_bit_cast(bf16x8, w);
            w.x = pk2(im[0], im[1]); w.y = pk2(im[2], im[3]); w.z = pk2(im[4], im[5]); w.w = pk2(im[6], im[7]); bfr[2 + pp] = __builtin_bit_cast(bf16x8, w);
        }
        bf16x8 cfr[8];
        const float cmsk = r32 < 16 ? 1.f : 0.f;
#pragma unroll
        for (int ks = 0; ks < 8; ++ks) {
            const size_t co = ((size_t)idx * 16 + (r32 & 15)) * 64 + 8 * ks + 4 * hi;
            const f32x4 cr4 = *(const f32x4*)(a.in[I_CR] + co), ci4 = *(const f32x4*)(a.in[I_CI] + co);
            v4u w; w.x = pk2(cr4[0] * cmsk, -ci4[0] * cmsk); w.y = pk2(cr4[1] * cmsk, -ci4[1] * cmsk); w.z = pk2(cr4[2] * cmsk, -ci4[2] * cmsk); w.w = pk2(cr4[3] * cmsk, -ci4[3] * cmsk);
            cfr[ks] = __builtin_bit_cast(bf16x8, w);
        }
        float hr = 0.f, him = 0.f;
        float* Yd = dir == 0 ? Y0 : Y1;
        {
            const bf16* ub = Z + OFF_S5 + 16 * g + 8 * hi;
            v4u ur[9];
#pragma unroll
            for (int ch = 0; ch < 9; ++ch) ur[ch] = *(const v4u*)(ub + (size_t)s5_tokrow(wid * 288 + ch * 32 + r32, dir, b) * INW);
#pragma unroll
            for (int ch = 0; ch < 9; ++ch) uL[ch * 64 + lane] = ur[ch];
            asm volatile("s_waitcnt lgkmcnt(0)" ::: "memory");
        }
        for (int pass = 0; pass < 2; ++pass) {
            if (pass == 0) {
                float hx[2][2] = {{0.f, 0.f}, {0.f, 0.f}};
                for (int ch = 0; ch < 9; ++ch) {
                    const bf16x8 ucur = __builtin_bit_cast(bf16x8, uL[ch * 64 + lane]);
#pragma unroll
                    for (int X = 0; X < 2; ++X) {
                        f32x16 re = {}, im = {};
                        re = __builtin_amdgcn_mfma_f32_32x32x16_bf16(ucur, bfr[X], re, 0, 0, 0); im = __builtin_amdgcn_mfma_f32_32x32x16_bf16(ucur, bfr[2 + X], im, 0, 0, 0);
                        const float ar_ = aR[X], ai_ = aI[X];
                        float a4r_, a4i_, a8r_, a8i_, a32r_, a32i_;
                        { float tr = ar_, ti = ai_;
#pragma unroll
                          for (int k = 0; k < 5; ++k) { const float nr = tr * tr - ti * ti, ni = 2.f * tr * ti; tr = nr; ti = ni; if (k == 1) { a4r_ = tr; a4i_ = ti; } if (k == 2) { a8r_ = tr; a8i_ = ti; } }
                          a32r_ = tr; a32i_ = ti; }
                        float Sr = 0.f, Si = 0.f;
#pragma unroll
                        for (int q = 0; q < 4; ++q) {
                            float gr = re[4 * q], gi = im[4 * q];
#pragma unroll
                            for (int i = 1; i < 4; ++i) { const float nr = gr * ar_ - gi * ai_ + re[4 * q + i], ni = gr * ai_ + gi * ar_ + im[4 * q + i]; gr = nr; gi = ni; }
                            if (q == 0) { Sr = gr; Si = gi; } else { const float nr = Sr * a8r_ - Si * a8i_ + gr, ni = Sr * a8i_ + Si * a8r_ + gi; Sr = nr; Si = ni; }
                        }
                        const float fr = hi ? 1.f : a4r_, fi = hi ? 0.f : a4i_;
                        const float Pr = Sr * fr - Si * fi, Pi = Sr * fi + Si * fr;
                        const float Cr = Pr, Ci = Pi;
                        const float nr = hx[X][0] * a32r_ - hx[X][1] * a32i_ + Cr, ni = hx[X][0] * a32i_ + hx[X][1] * a32r_ + Ci; hx[X][0] = nr; hx[X][1] = ni;
                    }
                }
#pragma unroll
                for (int X = 0; X < 2; ++X) { hx[X][0] += shfl_xor_l(hx[X][0], 32, lane); hx[X][1] += shfl_xor_l(hx[X][1], 32, lane); }
                hr = hi ? hx[1][0] : hx[0][0]; him = hi ? hx[1][1] : hx[0][1];
            } else
            for (int ch = 0; ch < 9; ++ch) {
                const int s0 = wid * 288 + ch * 32;
                bf16x8 ucur = __builtin_bit_cast(bf16x8, uL[ch * 64 + lane]);
                asm volatile("s_waitcnt lgkmcnt(0)" : "+v"(ucur) :: "memory");
                float bur[32], bui[32];
#pragma unroll
                for (int jb = 0; jb < 2; ++jb) {
                    f32x16 d = {}; d = __builtin_amdgcn_mfma_f32_32x32x16_bf16(ucur, bfr[jb], d, 0, 0, 0);
#pragma unroll
                    for (int r = 0; r < 16; ++r) BuL[crow(r, hi) * 66 + 32 * jb + r32] = d[r];
                }
                asm volatile("s_waitcnt lgkmcnt(0)" : "+v"(ucur) :: "memory");
#pragma unroll
                for (int t = 0; t < 32; ++t) bur[t] = BuL[t * 66 + lane];
                asm volatile("s_waitcnt lgkmcnt(0)" : "+v"(ucur) :: "memory");
#pragma unroll
                for (int jb = 0; jb < 2; ++jb) {
                    f32x16 d = {}; d = __builtin_amdgcn_mfma_f32_32x32x16_bf16(ucur, bfr[2 + jb], d, 0, 0, 0);
#pragma unroll
                    for (int r = 0; r < 16; ++r) BuL[crow(r, hi) * 66 + 32 * jb + r32] = d[r];
                }
                asm volatile("s_waitcnt lgkmcnt(0)" ::: "memory");
#pragma unroll
                for (int t = 0; t < 32; ++t) bui[t] = BuL[t * 66 + lane];
                asm volatile("s_waitcnt lgkmcnt(0)" ::: "memory");
                if (pass == 0) {
#pragma unroll
                    for (int t = 0; t < 32; ++t) { const float nr = ar * hr - ai * him + bur[t], ni = ar * him + ai * hr + bui[t]; hr = nr; him = ni; }
                } else {
#pragma unroll
                    for (int t = 0; t < 32; ++t) { const float nr = ar * hr - ai * him + bur[t], ni = ar * him + ai * hr + bui[t]; hr = nr; him = ni;
                        ((LAS unsigned*)HL)[t * 68 + lane] = pk2(hr, him); }
                    asm volatile("s_waitcnt lgkmcnt(0)" ::: "memory");
                    f32x16 y = {};
#pragma unroll
                    for (int ks = 0; ks < 8; ++ks) { const bf16x8 af = *(const LAS bf16x8*)((const LAS unsigned char*)HL + (r32 * 136 + 16 * ks + 8 * hi) * 2);
                        y = __builtin_amdgcn_mfma_f32_32x32x16_bf16(cfr[ks], af, y, 0, 0, 0); }
                    asm volatile("s_waitcnt lgkmcnt(0)" ::: "memory");
                    if (s0 >= 256 || layer == 0) {
                        float* yp = Yd + (size_t)s5_tokrow(s0 + r32, dir, b) * 256 + 16 * g + 4 * hi;
                        *(f32x4*)yp = (f32x4){y[0], y[1], y[2], y[3]}; *(f32x4*)(yp + 8) = (f32x4){y[4], y[5], y[6], y[7]};
                    }
                }
            }
            if (pass == 0) {
                BuL[lane * 2] = hr; BuL[lane * 2 + 1] = him;
                __syncthreads();
                hr = 0.f; him = 0.f;
                for (int v = 0; v < wid; ++v) { const LAS float* cv = (const LAS float*)(lds + v * 17920); const float cr = cv[lane * 2], ci = cv[lane * 2 + 1]; const float nr = pr * hr - pi * him + cr, ni = pr * him + pi * hr + ci; hr = nr; him = ni; }
                __syncthreads();
            }
        }

    }
}

__device__ __forceinline__ void na_phase(LAS unsigned char* lds, int l) {
    CArgs& a = kargs();
    int tid_ = threadIdx.x; asm volatile("" : "+v"(tid_));
    const int tid = tid_, wid = __builtin_amdgcn_readfirstlane(tid >> 6), G = o_grid(), bid = o_bid();
    bf16* Zb = (bf16*)(a.ws + WS_Z); bf16* CAT = (bf16*)(a.ws + WS_CAT);
    LAS float* biasL = (LAS float*)(lds + 73728);
    for (int i = tid; i < 4 * 15 * 31; i += 512) biasL[i] = 8.f * a.in[I_NABIAS][l * 4 * 15 * 31 + i];
    for (int u = bid; u < 512; u += G) {
        const int b = u >> 5, head = (u >> 3) & 3, rg = u & 7; const int r = 4 * rg + (wid >> 1);
        const int lo = 4 * rg - 4 < 0 ? 0 : (4 * rg - 4 > 24 ? 24 : 4 * rg - 4); const int hi3 = 4 * rg - 1 < 0 ? 0 : (4 * rg - 1 > 24 ? 24 : 4 * rg - 1);
        const int rs = r - 4 < 0 ? 0 : (r - 4 > 24 ? 24 : r - 4);
        AttnP P{Zb, CAT, DM, b * 2048 + r * 64 + (wid & 1) * 32, OFF_NQ + head * 64, 512 + head * 64, OFF_NK + head * 64, OFF_NV + head * 64, b * 2048 + lo * 64, hi3 + 8 - lo, MLAT + b * 256, 4, 1, (wid & 1) * 32, lo - r + 7, head, rs - lo, rs - lo + 8};
        attn_unit<1>(lds, P, biasL);
    }
    if (l == 0) for (int u = bid; u < 64; u += G) {
        const int b = u >> 2, head = u & 3;
        AttnP P{Zb, CAT, DM, MLAT + b * 256 + wid * 32, OFF_NQ + head * 64, 512 + head * 64, OFF_NK + head * 64, OFF_NV + head * 64, 0, 0, MLAT + b * 256, 4, 0, 0, 0, head, 0, 0};
        attn_unit<1>(lds, P, biasL);
    }
}
__device__ __forceinline__ void gqa_phase(LAS unsigned char* lds, int l) {
    CArgs& a = kargs();
    int tid_ = threadIdx.x; asm volatile("" : "+v"(tid_));
    const int tid = tid_, wid = __builtin_amdgcn_readfirstlane(tid >> 6), G = o_grid(), bid = o_bid();
    bf16* Zb = (bf16*)(a.ws + WS_Z); bf16* CAT = (bf16*)(a.ws + WS_CAT);
    const bool bal = (G == 256); const int nmine = bal ? (bid < 128 ? 2 : 0) : (255 - bid) / G + 1;
    for (int iu = 0; iu < nmine; ++iu) {
        const int u = bal ? bid + 128 * iu : bid + iu * G;
        const int b = u >> 4, kvh = (u >> 3) & 1, qb = u & 7; const int head = 2 * kvh + (wid >> 2);
        AttnP P{Zb, CAT, DM, b * 2048 + qb * 256 + (wid & 3) * 64, OFF_AQ + head * 64, head * 64, OFF_AK + kvh * 64, OFF_AV + kvh * 64, b * 2048, 32, MLAT + b * 256, 4, 0, 0, 0, head, 0, 0};
        attn_unit<1, 2>(lds, P, nullptr);
    }
    if (l == 0) for (int u = G - 1 - bid; u < 64; u += G) {
        const int b = u >> 2, kvh = (u >> 1) & 1, qb = u & 1; const int head = 2 * kvh + (wid >> 2);
        AttnP P{Zb, CAT, DM, MLAT + b * 256 + qb * 128 + (wid & 3) * 32, OFF_AQ + head * 64, head * 64, OFF_AK + kvh * 64, OFF_AV + kvh * 64, 0, 0, MLAT + b * 256, 4, 0, 0, 0, head, 0, 0};
        attn_unit<1>(lds, P, nullptr);
    }
}

#define XB_TMO      128
#define XB_XCNT(j)  (256  + 64 * (j))
#define XB_XSUB(j)  (1280 + 64 * (j))
#define XB_XGEN(j)  (2304 + 64 * (j))
#define XB_TOP      3328
#define XB_TOPGEN   3392
#define XCD_BAR_WORDS 3456
#define XB_SPIN_CAP (1u << 18)

__device__ __forceinline__ unsigned xb_ld(unsigned* p)              { return __hip_atomic_load(p, __ATOMIC_RELAXED, __HIP_MEMORY_SCOPE_AGENT); }
__device__ __forceinline__ unsigned xb_add(unsigned* p, unsigned v) { return __hip_atomic_fetch_add(p, v, __ATOMIC_RELAXED, __HIP_MEMORY_SCOPE_AGENT); }
__device__ __forceinline__ unsigned xb_xcc_id() { return (unsigned)__builtin_amdgcn_s_getreg((3 << 11) | 20) & 0xFu; }
#define XB_SPIN(cond, bar) do { unsigned _sp = 0; while (cond) { __builtin_amdgcn_s_sleep(1); \
    if ((++_sp & 255u) == 0u) { if (xb_ld(&(bar)[XB_TMO])) break; if (_sp > XB_SPIN_CAP) { atomicAdd(&(bar)[XB_TMO], 1u); break; } } } } while (0)
struct XcdBarrier { unsigned* bar; unsigned x; volatile LAS unsigned* st; };
__device__ __forceinline__ void xcd_barrier_complete(unsigned* bar, unsigned x, unsigned& nloc, unsigned& nx) {
    const unsigned G = gridDim.x * gridDim.y * gridDim.z;
    unsigned sum, cnt, mine, sp = 0u;
    for (;;) {
        sum = 0u; cnt = 0u; mine = 0u;
#pragma unroll
        for (unsigned j = 0; j < 16; ++j) { const unsigned c = xb_ld(&bar[XB_XCNT(j)]); sum += c; cnt += (c > 0u) ? 1u : 0u; mine = (j == x) ? c : mine; }
        if (sum == G) break;
        __builtin_amdgcn_s_sleep(1);
        if ((++sp & 255u) == 0u) { if (xb_ld(&bar[XB_TMO])) break; if (sp > XB_SPIN_CAP) { atomicAdd(&bar[XB_TMO], 1u); break; } }
    }
    nloc = mine > 0u ? mine : 1u; nx = cnt > 0u ? cnt : 1u;
}

__device__ __forceinline__ void xcd_barrier(const XcdBarrier& b) {
    asm volatile("s_waitcnt vmcnt(0)" ::: "memory");
    __syncthreads();
    if (threadIdx.x == 0) {
        unsigned* bar = b.bar;
        __builtin_amdgcn_s_waitcnt(0);
        unsigned nloc = b.st[0], nx = b.st[1];
        if (nloc == 0u) { xcd_barrier_complete(bar, b.x, nloc, nx); b.st[0] = nloc; b.st[1] = nx; }
        const unsigned old = xb_add(&bar[XB_XSUB(b.x)], 1u);
        const unsigned gen = old / nloc;
        if (old + 1u == (gen + 1u) * nloc) {
            __builtin_amdgcn_fence(__ATOMIC_RELEASE, "agent");
            asm volatile("s_waitcnt vmcnt(0)" ::: "memory");
            const unsigned og = xb_add(&bar[XB_TOP], 1u);
            const unsigned tg = og / nx;
            if (og + 1u == (tg + 1u) * nx) xb_add(&bar[XB_TOPGEN], 1u);
            else XB_SPIN(xb_ld(&bar[XB_TOPGEN]) == tg, bar);
            __builtin_amdgcn_fence(__ATOMIC_ACQUIRE, "agent");
            xb_add(&bar[XB_XGEN(b.x)], 1u);
            asm volatile("s_waitcnt vmcnt(0)" ::: "memory");
        } else {
            XB_SPIN(xb_ld(&bar[XB_XGEN(b.x)]) == gen, bar);
            __builtin_amdgcn_fence(__ATOMIC_ACQUIRE, "agent");
            asm volatile("s_waitcnt vmcnt(0)" ::: "memory");
        }
    }
    __syncthreads();
}

template <class F>
__device__ __forceinline__ void run_gemm(LAS unsigned char* lds, const bf16* A, int lda, const bf16* Bt, int ldb, int M, int N, int K, const F& f, int c, long tsB = 0, int ksplit = 1 << 30, long kjumpB = 0, int gsched = 0) {
    pg8::Gemm g{A, Bt, M, N, K, lda, ldb, tsB ? tsB : (long)512 * ldb, ksplit, kjumpB}; pg8::StaticOrder S; S.init(M, N, gsched ? gsched : o_grid(), c); Epi8<F> E{f};
    pg8::gemm_phase<Epi8<F>, pg8::StaticOrder, true, true>(lds, g, S, E);
}
#define WSP(off) ((bf16*)(ws + (off)))
__device__ __forceinline__ void ph_store_gemm(LAS unsigned char* lds, int l, int kind) {
    unsigned char* ws = kargs().ws; unsigned char* wb = ws + WS_W + (size_t)l * W_LAYER;
    const int Mr = l == 0 ? MT : MLAT;
    const bf16* A; const bf16* Bt; bf16* O; int lda, ldb, M, N, K, ldc, act;
    if (kind == 0)      { A = WSP(WS_XN);   lda = DM;  Bt = (const bf16*)(wb + WO_IN);  ldb = DM;  M = MT; N = INW; K = DM;  O = WSP(WS_Z);    ldc = INW; act = 0; }
    else if (kind == 1) { A = WSP(WS_CAT);  lda = DM;  Bt = (const bf16*)(wb + WO_OUT); ldb = DM;  M = Mr; N = DM;  K = DM;  O = WSP(WS_Y);    ldc = DM;  act = 0; }
    else if (kind == 2) { A = WSP(WS_XN);   lda = DM;  Bt = (const bf16*)(wb + WO_1);   ldb = DM;  M = Mr; N = DFF; K = DM;  O = WSP(WS_HMID); ldc = DFF; act = 1; }
    else if (kind == 3) { A = WSP(WS_HMID); lda = DFF; Bt = (const bf16*)(wb + WO_2);   ldb = DFF; M = Mr; N = DM;  K = DFF; O = WSP(WS_XN);   ldc = DM;  act = 0; }
    else                { A = (const bf16*)(wb + WO_CS); lda = 256; Bt = WSP(WS_Z) + OFF_FN; ldb = INW; M = 512; N = MT; K = 256; O = WSP(WS_C1); ldc = MT; act = 0; }
    run_gemm(lds, A, lda, Bt, ldb, M, N, K, FStore{O, ldc, act}, o_bid());
}
__device__ __forceinline__ void ph_d2(LAS unsigned char* lds, int l) { CArgs& a = kargs(); unsigned char* ws = a.ws;
    for (int j = 0; j < (l == 0 ? 2 : 1); ++j) {
        if (j == 0) run_gemm(lds, WSP(WS_DFT), 4096, WSP(WS_C1), MT, 2048, 4096, 4096, FD2{WSP(WS_CAT), a.in[I_BFNET] + l * 256, 0, 2048}, o_grid() - 1 - o_bid(), 2048 * 2, 32, ((long)256 * MT - 2048) * 2);
        else run_gemm(lds, WSP(WS_DFTC), 512, WSP(WS_C1) + MLAT, MT, 256, 4096, 512, FD2{WSP(WS_CAT), a.in[I_BFNET] + l * 256, MLAT, 256}, o_grid() - 1 - o_bid(), 256 * 2, 4, ((long)256 * MT - 256) * 2);
    } }
__device__ __forceinline__ void ph_glu(LAS unsigned char* lds, int l) { CArgs& a = kargs(); unsigned char* ws = a.ws; unsigned char* wb = ws + WS_W + (size_t)l * W_LAYER;
    const int Mr = l == 0 ? MT : MLAT;
    const bool half = (o_grid() == 256); if (half && o_bid() < 128) return;
    const int gs = half ? 128 : o_grid(), cg_ = half ? o_bid() - 128 : o_grid() - 1 - o_bid();
    {
        int tid_ = threadIdx.x; asm volatile("" : "+v"(tid_));
        pg8::StaticOrder S; S.init(Mr, 256, gs, cg_); pg8::Unit u;
        const bf16* Z = WSP(WS_Z); const float* Y0 = (const float*)(ws + WS_Y0); const float* Y1 = (const float*)(ws + WS_Y1); bf16* T = WSP(WS_T);
        const int c8 = (tid_ & 31) * 8;
        float dk[8];
#pragma unroll
        for (int e = 0; e < 8; ++e) dk[e] = a.in[I_S5D][l * 256 + c8 + e];
        for (int i = 0; S.next(i, u); ++i)
            for (int rr = tid_ >> 5; rr < 256; rr += 16) {
                const size_t row = (size_t)u.pm * 256 + rr;
                const v4u uz = *(const v4u*)(Z + row * INW + OFF_S5 + c8);
                const f32x4 a0 = *(const f32x4*)(Y0 + row * 256 + c8), a1 = *(const f32x4*)(Y0 + row * 256 + c8 + 4), b0 = *(const f32x4*)(Y1 + row * 256 + c8), b1 = *(const f32x4*)(Y1 + row * 256 + c8 + 4);
                const float uv[8] = {bflo(uz.x), bfhi(uz.x), bflo(uz.y), bfhi(uz.y), bflo(uz.z), bfhi(uz.z), bflo(uz.w), bfhi(uz.w)};
                float o[8];
#pragma unroll
                for (int e = 0; e < 8; ++e) { const float v = (e < 4 ? a0[e] + b0[e] : a1[e - 4] + b1[e - 4]) + dk[e] * uv[e];
                    const float uu = 0.7978845608028654f * (v + 0.044715f * v * v * v); o[e] = v / (1.f + __expf(-2.f * uu)); }
                v4u w; w.x = pk2(o[0], o[1]); w.y = pk2(o[2], o[3]); w.z = pk2(o[4], o[5]); w.w = pk2(o[6], o[7]);
                *(v4u*)(T + row * 256 + c8) = w;
            }
        asm volatile("s_waitcnt vmcnt(0)" ::: "memory"); __syncthreads();
    }
    int K = 256, ld = 256; asm volatile("" : "+s"(K), "+s"(ld));
    run_gemm(lds, WSP(WS_T), ld, (const bf16*)(wb + WO_GLU), ld, Mr, 256, K, FGlu{WSP(WS_CAT), WSP(WS_T)}, cg_, 0, 1 << 30, 0, gs); }

__global__ void __launch_bounds__(512, 2) fwd_megakernel(Args a_unused) {
    extern __shared__ __attribute__((aligned(16))) unsigned char lds_raw[];
    LAS unsigned char* lds = (LAS unsigned char*)lds_raw;
    cg::grid_group grid = cg::this_grid();
#ifdef PROBE
    if (blockIdx.x == 0 && threadIdx.x == 0) { unsigned char* pw = kargs().ws + WS_PROBE; for (int i = 0; i < 32; ++i) ((float*)pw)[i] = 0.f; *(unsigned long long*)(pw + 256) = __builtin_amdgcn_s_memrealtime(); }
#endif
    {
        if (threadIdx.x < 2) ((volatile LAS unsigned*)(lds + LDS_BARST))[threadIdx.x] = 0u;
        if (threadIdx.x == 0) (void)xb_add(&((unsigned*)(kargs().ws + WS_BAR))[XB_XCNT(xb_xcc_id())], 1u);
        if (gridDim.x == 0x7fffffffu) grid.sync();
    }
    for (int step = 0; step < 20; ++step) {
        const int l = step < 2 ? 0 : (step - 2) / 9, k = step < 2 ? step - 2 : (step - 2) - 9 * l;
        int gk = -1;
        if (k == 0) gk = 0; else if (k == 2) gk = 4; else if (k == 4) gk = 1; else if (k == 6) gk = 2; else if (k == 7) gk = 3;
        int lbl = k == -2 ? 0 : k == -1 ? 1 : k == 0 ? 2 : k == 1 ? 5 : k == 2 ? 6 : k == 3 ? 9 : k == 4 ? 10 : k == 5 ? 11 : k == 6 ? 12 : k == 7 ? 13 : 14; (void)lbl;
#ifdef DBL_GEMM
        if (gk >= 0) { ph_store_gemm(lds, l, gk); __syncthreads(); }
#endif
#ifdef DBL_ROWS
        if (k == -1) prep_rows0(); if (k == 5 && l == 0) row_update<0>();
#endif
        if (gk >= 0) ph_store_gemm(lds, l, gk);
        else if (k == -2) prologue(lds);
        else if (k == -1) prep_rows0();
        else if (k == 1) {
            qk_prep(l);
            __syncthreads(); STAMP(3);
            na_phase(lds, l);
#ifdef DBL_NA
            __syncthreads(); na_phase(lds, l);
#endif
            __syncthreads(); STAMP(4);
            for (int u = o_bid(); u < 256; u += o_grid()) s5_unit(lds, l, u >> 4, u & 15);
#ifdef DBL_S5
            __syncthreads(); for (int u = o_bid(); u < 256; u += o_grid()) s5_unit(lds, l, u >> 4, u & 15);
#endif
        } else if (k == 3) {
            gqa_phase(lds, l);
#ifdef DBL_GQA
            __syncthreads(); gqa_phase(lds, l);
#endif
            __syncthreads(); STAMP(7);
            ph_d2(lds, l); STAMP(8);
            ph_glu(lds, l);
        } else if (k == 5) { if (l == 0) row_update<0>(); else row_update<2>(); }
        else { if (l == 0) row_update<1>(); else row_update<3>(); }
        if (k == 1) { __syncthreads(); }
        else if (step != 19) {
            XcdBarrier xb; xb.bar = (unsigned*)(kargs().ws + WS_BAR); xb.x = xb_xcc_id(); xb.st = (volatile LAS unsigned*)(lds + LDS_BARST);
            xcd_barrier(xb);
        }
        STAMP(lbl);
    }
}

extern "C" void kernel_launch(void* const* d_in, const int* in_sizes, int n_in, void* d_out, int out_size, void* d_ws, size_t ws_size, hipStream_t stream) {
    static int grid = 0;
    if (grid == 0) {
        if (n_in != 28 || ws_size < WS_END) { fprintf(stderr, "kernel_launch: unexpected n_in %d / ws_size %zu (need %zu)\n", n_in, ws_size, (size_t)WS_END); grid = -1; return; }
        int dev = 0, cus = 0, per_cu = 0;
        hipGetDevice(&dev); hipDeviceGetAttribute(&cus, hipDeviceAttributeMultiprocessorCount, dev);
        if (hipFuncSetAttribute((const void*)fwd_megakernel, hipFuncAttributeMaxDynamicSharedMemorySize, LDS_BYTES) != hipSuccess) { fprintf(stderr, "kernel_launch: hipFuncSetAttribute failed\n"); }
        if (hipOccupancyMaxActiveBlocksPerMultiprocessor(&per_cu, (const void*)fwd_megakernel, 512, LDS_BYTES) != hipSuccess || per_cu < 1) { fprintf(stderr, "kernel_launch: occupancy query says %d\n", per_cu); per_cu = 1; }
        (void)hipGetLastError();
        grid = cus * (per_cu > 1 ? 1 : per_cu);
        if (grid <= 0) grid = 256;
    }
    if (grid < 0) return;
    if (hipMemsetAsync((char*)d_ws + WS_BAR, 0, XCD_BAR_WORDS * 4, stream) != hipSuccess) { fprintf(stderr, "kernel_launch: hipMemsetAsync of the barrier words failed\n"); return; }
    Args a{};
    for (int i = 0; i < 28; ++i) a.in[i] = (const float*)d_in[i];
    a.out = (float*)d_out; a.ws = (unsigned char*)d_ws;
    void* args[] = {&a};
    hipError_t e = hipLaunchCooperativeKernel((const void*)fwd_megakernel, dim3(grid), dim3(512), args, LDS_BYTES, stream);
    if (e != hipSuccess) fprintf(stderr, "cooperative launch failed: %s (grid %d)\n", hipGetErrorString(e), grid);
}
```
